# Optimizing an MI355X kernel written in HIP

```python
import jax, jax.numpy as jnp
from jax import lax
import numpy as np

D_MODEL = 1024
BATCH = 2
SEQ = 8192
DEPTH = 2
DEC_BATCH = 16
DEC_SEQ = 16
PAST_LEN = 4096

CHUNK = 64
POOL_WIDTH = D_MODEL // 4
POOL_GROUPS = 4
POOL_GROUP_DIM = POOL_WIDTH // POOL_GROUPS
POOL_WINDOWS = (2, 4, 8, 16)
POOL_HIST = max(POOL_WINDOWS) - 1
ATT_WIDTH = D_MODEL - POOL_WIDTH
HEAD_DIM = 64
N_HEADS = ATT_WIDTH // HEAD_DIM
MIX_WIDTH = POOL_WIDTH + ATT_WIDTH
IN_COLS = POOL_WIDTH + 3 * ATT_WIDTH + N_HEADS
D_FF = 4 * D_MODEL
Q_BLOCK = 128
EPS = 1e-6
FORGET_W_SCALE = 0.1

kernel_name = "hymba_pool_fox_stream_step"


def rms_norm(x):
    xf = x.astype(jnp.float32)
    return (xf * lax.rsqrt(jnp.mean(xf * xf, axis=-1, keepdims=True) + EPS)).astype(x.dtype)


def modulate(x, shift, scale):
    return x * (1 + scale[:, None, :]) + shift[:, None, :]


def pool_mixer(u, hist, pos0, w_pool, pool_scale):
    B, T, _ = u.shape
    z = jnp.concatenate([hist.astype(u.dtype), u], axis=1)
    zf = z.astype(jnp.float32)
    cs = jnp.concatenate([jnp.zeros_like(zf[:, :1]), jnp.cumsum(zf, axis=1)], axis=1)
    pos = (pos0 + jnp.arange(T)).astype(jnp.float32)
    end = POOL_HIST + 1
    uf = u.astype(jnp.float32)
    outs = []
    for g, w in enumerate(POOL_WINDOWS):
        sl = slice(g * POOL_GROUP_DIM, (g + 1) * POOL_GROUP_DIM)
        win_sum = cs[:, end:end + T, sl] - cs[:, end - w:end - w + T, sl]
        count = jnp.minimum(pos + 1.0, float(w))[None, :, None]
        outs.append(win_sum / count - uf[..., sl])
    mixed = jnp.stack(outs, axis=2).astype(u.dtype)
    y = jnp.einsum('btgc,gcd->btgd', mixed, w_pool).reshape(B, T, POOL_WIDTH)
    return y * pool_scale, z[:, -POOL_HIST:]


def fox_block(q, k, v, fq, fk, q_pos, k_pos):
    s = jnp.einsum('bqhd,bkhd->bhqk', q, k, preferred_element_type=jnp.float32) * (HEAD_DIM ** -0.5)
    s = s + jnp.swapaxes(fq, 1, 2)[..., :, None] - jnp.swapaxes(fk, 1, 2)[..., None, :]
    mask = (k_pos[None, :] <= q_pos[:, None])[None, None]
    p = jax.nn.softmax(jnp.where(mask, s, -jnp.inf), axis=-1)
    return jnp.einsum('bhqk,bkhd->bqhd', p.astype(v.dtype), v)


def fox_prompt(q, k, v, F):
    B, T = q.shape[:2]
    nb = T // Q_BLOCK
    qb = q.reshape(B, nb, Q_BLOCK, N_HEADS, HEAD_DIM).swapaxes(0, 1)
    fb = F.reshape(B, nb, Q_BLOCK, N_HEADS).swapaxes(0, 1)
    pb = jnp.arange(T).reshape(nb, Q_BLOCK)
    k_pos = jnp.arange(T)
    out = lax.map(lambda a: fox_block(a[0], k, v, a[1], F, a[2], k_pos), (qb, fb, pb))
    return out.swapaxes(0, 1).reshape(B, T, N_HEADS, HEAD_DIM)


def trunk_layer(x, c, pool_hist, past_k, past_v, past_logf, pos0,
                w_mod, b_mod, w_in, b_f, q_gain, k_gain, w_pool, pool_scale, w_out, w_up, w_down):
    B, T, _ = x.shape

    mod = jax.nn.silu(c) @ w_mod + b_mod
    sh1, sc1, g1, sh2, sc2, g2 = jnp.split(mod, 6, axis=-1)

    h = modulate(rms_norm(x), sh1, sc1)
    proj = h @ w_in
    u = proj[..., :POOL_WIDTH]
    o = POOL_WIDTH
    q = proj[..., o:o + ATT_WIDTH].reshape(B, T, N_HEADS, HEAD_DIM)
    k = proj[..., o + ATT_WIDTH:o + 2 * ATT_WIDTH].reshape(B, T, N_HEADS, HEAD_DIM)
    v = proj[..., o + 2 * ATT_WIDTH:o + 3 * ATT_WIDTH].reshape(B, T, N_HEADS, HEAD_DIM)
    f_logit = proj[..., o + 3 * ATT_WIDTH:]
    q = rms_norm(q) * q_gain
    k = rms_norm(k) * k_gain
    logf = jax.nn.log_sigmoid(f_logit.astype(jnp.float32) + b_f.astype(jnp.float32))

    pool_y, pool_state = pool_mixer(u, pool_hist, pos0, w_pool, pool_scale)

    if past_k is None:
        att = fox_prompt(q, k, v, jnp.cumsum(logf, axis=1))
    else:
        P = past_k.shape[1]
        k_all = jnp.concatenate([past_k.astype(k.dtype), k], axis=1)
        v_all = jnp.concatenate([past_v.astype(v.dtype), v], axis=1)
        F_all = jnp.cumsum(jnp.concatenate([past_logf.astype(jnp.float32), logf], axis=1), axis=1)
        att = fox_block(q, k_all, v_all, F_all[:, P:], F_all, P + jnp.arange(T), jnp.arange(P + T))

    mix = jnp.concatenate([pool_y, att.reshape(B, T, ATT_WIDTH)], axis=-1)
    x = x + g1[:, None, :] * (mix @ w_out)

    h2 = modulate(rms_norm(x), sh2, sc2)
    ff = jnp.square(jax.nn.relu(h2 @ w_up)) @ w_down
    x = x + g2[:, None, :] * ff
    return x, k, v, logf.astype(x.dtype), pool_state


def setup_inputs(seed: int = 0) -> dict:
    key = jax.random.key(seed)
    ks = jax.random.split(key, 20)
    f32 = jnp.float32

    def nrm(k, shape, s=1.0):
        return s * jax.random.normal(k, shape, f32)

    head_bias = jnp.linspace(1.0, 7.0, N_HEADS, dtype=f32)
    w_in = nrm(ks[10], (DEPTH, D_MODEL, IN_COLS), D_MODEL ** -0.5)
    w_in = w_in.at[..., POOL_WIDTH + 3 * ATT_WIDTH:].multiply(FORGET_W_SCALE)
    b_f = head_bias[None, :] + nrm(ks[11], (DEPTH, N_HEADS), 0.1)
    cache_logf = jax.nn.log_sigmoid(head_bias + nrm(ks[6], (DEPTH, DEC_BATCH, PAST_LEN, N_HEADS), 0.3))
    return {
        'x_prompt': nrm(ks[0], (BATCH, SEQ, D_MODEL)),
        'x_sample': nrm(ks[1], (DEC_BATCH, DEC_SEQ, D_MODEL)),
        'c_prompt': nrm(ks[2], (BATCH, D_MODEL)),
        'c_sample': nrm(ks[3], (DEC_BATCH, D_MODEL)),
        'cache_k': nrm(ks[4], (DEPTH, DEC_BATCH, PAST_LEN, N_HEADS, HEAD_DIM)),
        'cache_v': nrm(ks[5], (DEPTH, DEC_BATCH, PAST_LEN, N_HEADS, HEAD_DIM)),
        'cache_logf': cache_logf,
        'cache_pool': nrm(ks[7], (DEPTH, DEC_BATCH, POOL_HIST, POOL_WIDTH)),
        'w_mod': nrm(ks[8], (DEPTH, D_MODEL, 6 * D_MODEL), 0.5 * D_MODEL ** -0.5),
        'b_mod': nrm(ks[9], (DEPTH, 6 * D_MODEL), 0.02),
        'w_in': w_in,
        'b_f': b_f,
        'q_gain': 1.0 + nrm(ks[12], (DEPTH, HEAD_DIM), 0.02),
        'k_gain': 1.0 + nrm(ks[13], (DEPTH, HEAD_DIM), 0.02),
        'w_pool': nrm(ks[14], (DEPTH, POOL_GROUPS, POOL_GROUP_DIM, POOL_GROUP_DIM), POOL_GROUP_DIM ** -0.5),
        'pool_scale': 1.0 + nrm(ks[15], (DEPTH, POOL_WIDTH), 0.02),
        'w_out': nrm(ks[16], (DEPTH, MIX_WIDTH, D_MODEL), MIX_WIDTH ** -0.5),
        'w_up': nrm(ks[17], (DEPTH, D_MODEL, D_FF), D_MODEL ** -0.5),
        'w_down': nrm(ks[18], (DEPTH, D_FF, D_MODEL), D_FF ** -0.5),
    }


def reference(x_prompt, x_sample, c_prompt, c_sample, cache_k, cache_v, cache_logf, cache_pool,
              w_mod, b_mod, w_in, b_f, q_gain, k_gain, w_pool, pool_scale, w_out, w_up, w_down):
    y_prompt, y_sample = x_prompt, x_sample
    k_p, v_p, f_p, p_p = [], [], [], []
    k_s, v_s, f_s, p_s = [], [], [], []
    past = cache_k.shape[2]
    pool_zero = jnp.zeros((x_prompt.shape[0], POOL_HIST, POOL_WIDTH), x_prompt.dtype)
    for l in range(DEPTH):
        wts = (w_mod[l], b_mod[l], w_in[l], b_f[l], q_gain[l], k_gain[l],
               w_pool[l], pool_scale[l], w_out[l], w_up[l], w_down[l])
        y_prompt, kl, vl, fl, pl = trunk_layer(y_prompt, c_prompt, pool_zero, None, None, None, 0, *wts)
        k_p.append(kl); v_p.append(vl); f_p.append(fl); p_p.append(pl)
        y_sample, kl, vl, fl, pl = trunk_layer(y_sample, c_sample, cache_pool[l], cache_k[l], cache_v[l],
                                               cache_logf[l], past, *wts)
        k_s.append(kl); v_s.append(vl); f_s.append(fl); p_s.append(pl)
    return (y_prompt, y_sample,
            jnp.stack(k_p), jnp.stack(v_p), jnp.stack(f_p), jnp.stack(p_p),
            jnp.stack(k_s), jnp.stack(v_s), jnp.stack(f_s), jnp.stack(p_s))
```

```cpp
#include <hip/hip_runtime.h>
#include <hip/hip_cooperative_groups.h>
#include <cstdio>
#include <cstdint>
namespace cg = cooperative_groups;

#define LAS __attribute__((address_space(3)))
typedef unsigned short bf16_t;
typedef short bf16x8 __attribute__((ext_vector_type(8)));
typedef short s16x4 __attribute__((ext_vector_type(4)));
typedef float f32x4 __attribute__((ext_vector_type(4)));
typedef float f32x2 __attribute__((ext_vector_type(2)));
typedef unsigned u32x4 __attribute__((ext_vector_type(4)));
typedef unsigned u32x2 __attribute__((ext_vector_type(2)));

constexpr int D = 1024, T = 8192, NBP = 2, SB = 16, ST = 16, PAST = 4096;
constexpr int MP = NBP * T, MS = SB * ST, M = MP + MS;
constexpr int NH = 12, HD = 64, AW = 768, PW = 256, INC = 2572, NMAIN = 2560, FF = 4096;
constexpr int NMODROW = 18, MODW = 6 * D;
constexpr float EPS = 1e-6f;
constexpr float LOG2E = 1.4426950408889634f;
constexpr float C2 = 0.125f * LOG2E;
constexpr int SKEYS = PAST + ST;

constexpr size_t OFF_Y = 0;
constexpr size_t OFF_KP = (size_t)M * D;
constexpr size_t OFF_VP = OFF_KP + (size_t)2 * MP * AW;
constexpr size_t OFF_FP = OFF_VP + (size_t)2 * MP * AW;
constexpr size_t OFF_PP = OFF_FP + (size_t)2 * MP * NH;
constexpr size_t OFF_KS = OFF_PP + (size_t)2 * NBP * 15 * PW;
constexpr size_t OFF_VS = OFF_KS + (size_t)2 * MS * AW;
constexpr size_t OFF_FS = OFF_VS + (size_t)2 * MS * AW;
constexpr size_t OFF_PS = OFF_FS + (size_t)2 * MS * NH;
constexpr size_t OUT_TOTAL = OFF_PS + (size_t)2 * SB * 15 * PW;

constexpr size_t MiB = 1u << 20;
constexpr size_t WS_CTL = 0;
constexpr size_t WS_MOD = 1 * MiB;
constexpr size_t WS_WIN = 2 * MiB;
constexpr size_t WS_WOUT = 12 * MiB;
constexpr size_t WS_WUP = 16 * MiB;
constexpr size_t WS_WDN = 32 * MiB;
constexpr size_t WS_HN = 48 * MiB;
constexpr size_t WS_Q = 82 * MiB;
constexpr size_t WS_K = 108 * MiB;
constexpr size_t WS_V = 134 * MiB;
constexpr size_t WS_U = 160 * MiB;
constexpr size_t WS_MIX = 178 * MiB;
constexpr size_t WS_FP = 212 * MiB;
constexpr size_t WS_FS = 213 * MiB;
constexpr size_t WS_SS = 217 * MiB;
constexpr size_t WS_BIAS2 = WS_SS + 128 * 1024;
constexpr size_t WS_SH2 = WS_BIAS2 + 640 * 1024;
constexpr size_t WS_XA = 218 * MiB;
constexpr size_t WS_XB = 284 * MiB;
constexpr size_t WS_HID = 350 * MiB;
constexpr size_t WS_END = 482 * MiB;

constexpr int LDS_BYTES = 147456;
#ifndef DUP
#define DUP 0
#endif
#define NREP(k) (1 + ((DUP >> (k)) & 1))
#ifndef ATT_DUP_MODE
#define ATT_DUP_MODE 0
#endif

__device__ __forceinline__ unsigned f2bf(float f) { unsigned u = __builtin_bit_cast(unsigned, f); return (u + 0x7fffu + ((u >> 16) & 1u)) >> 16; }
typedef __bf16 bf16x2_t __attribute__((ext_vector_type(2)));
__device__ __forceinline__ unsigned pk2(float lo, float hi) { const f32x2 v = {lo, hi}; const bf16x2_t b = __builtin_convertvector(v, bf16x2_t); return __builtin_bit_cast(unsigned, b); }
template <int CTRL> __device__ __forceinline__ float dpp_f(float v) { return __builtin_bit_cast(float, __builtin_amdgcn_update_dpp(0, __builtin_bit_cast(int, v), CTRL, 0xF, 0xF, false)); }
__device__ __forceinline__ float quad_sum(float v) {
    auto a = __builtin_amdgcn_permlane16_swap(__float_as_uint(v), __float_as_uint(v), false, false);
    const float s = __uint_as_float(a[0]) + __uint_as_float(a[1]);
    auto b = __builtin_amdgcn_permlane32_swap(__float_as_uint(s), __float_as_uint(s), false, false);
    return __uint_as_float(b[0]) + __uint_as_float(b[1]);
}
__device__ __forceinline__ float wave_sum(float v) {
    v += dpp_f<0x128>(v); v += dpp_f<0x124>(v); v += dpp_f<0x122>(v); v += dpp_f<0x121>(v);
    return quad_sum(v);
}

__device__ __forceinline__ int vzero() { int z = 0; asm volatile("" : "+v"(z)); return z; }
__device__ __forceinline__ int fresh_tid() { int t = threadIdx.x; asm volatile("" : "+v"(t)); return t; }
namespace pg8 {
constexpr int BM = 256, BK = 64, HALF = 128, HTB = HALF * BK * 2, NXCD = 8, WGM = 8;
__host__ __device__ __forceinline__ int lds_byte(int r, int c) { const int st = (r >> 4) * 2 + (c >> 5), rr = r & 15, cc = c & 31, ob = rr * 64 + cc * 2; return st * 1024 + (ob ^ (((ob >> 9) & 1) << 5)); }
__host__ __device__ __forceinline__ void stage_rc(int b, int& R, int& C) { const int st = b / 1024, sb = b % 1024, swz = sb ^ (((sb >> 9) & 1) << 5); R = (st >> 1) * 16 + swz / 64; C = (st & 1) * 32 + (swz % 64) / 2; }
__host__ __device__ __forceinline__ int perm32(int rho) { const int n = rho >> 4, i = rho & 15; return 8 * (i >> 2) + 4 * n + (i & 3); }

struct Unit { int pm, pn; };
struct Gemm { const bf16_t* A; const bf16_t* Bt; int M, N, K; };

struct StaticOrder {
    int nM, nN, nwg, G, c;
    __device__ void init(int M_, int N_, int G_, int c_) { nM = M_ / BM; nN = N_ / BM; nwg = nM * nN; G = G_; c = c_; }
    __device__ bool next(int i, Unit& u) const {
        const long L = (long)i * G + c; if (L >= nwg) return false;
        int wgid = (int)L; { const int q = nwg / NXCD, r = nwg % NXCD, xcd = wgid % NXCD, off = wgid / NXCD; wgid = (xcd < r ? xcd * (q + 1) : r * (q + 1) + (xcd - r) * q) + off; }
        const int nig = WGM * nN, gid = wgid / nig, fm = gid * WGM, gsz = (nM - fm) < WGM ? (nM - fm) : WGM;
        u.pm = fm + ((wgid % nig) % gsz); u.pn = (wgid % nig) / gsz; return true;
    }
};

template <class Epi, bool ALIGN_EPI, bool SP2>
__device__ __forceinline__ void gemm_phase(LAS unsigned char* lds, const Gemm g, const StaticOrder& S, const Epi& E, const int tid) {
    const int wid = __builtin_amdgcn_readfirstlane(tid >> 6), lane = tid & 63, wr = wid >> 2, wc = wid & 3, fr = lane & 15, fq = lane >> 4;
    const int K = g.K, nt = K / BK;
    unsigned voffA[2], voffB[2];
#pragma unroll
    for (int i = 0; i < 2; ++i) { int R, C; stage_rc(tid * 16 + i * 8192, R, C); const int Rb = 64 * (R >> 5) + perm32(R & 31);
        voffA[i] = (unsigned)(R * K + C) * 2u; voffB[i] = (unsigned)(Rb * K + C) * 2u; }
    const size_t kstep = (size_t)(BK * 2);
    const size_t hstep = (size_t)HALF * K * 2;
    const size_t hstepB = (size_t)32 * K * 2;
    const size_t tstep = 2 * hstep;
    const unsigned ldsw = (unsigned)wid * 1024u;
    const int aoff = lds_byte(wr * 64 + fr, fq * 8), boff = lds_byte(wc * 32 + fr, fq * 8);
#define PG8_SA(b, h) (((b) * 2 + (h)) * HTB)
#define PG8_SB(b, h) ((4 + (b) * 2 + (h)) * HTB)
#define PG8_STAGE(bufoff, gbase, voff) do { _Pragma("unroll") for (int _i = 0; _i < 2; ++_i) \
        __builtin_amdgcn_global_load_lds((const unsigned*)((const char*)(gbase) + (voff)[_i]), (LAS unsigned*)(lds + (bufoff) + ldsw + _i * 8192), 16, 0, 0); } while (0)
#define PG8_LDA(dst, b, h) do { _Pragma("unroll") for (int m = 0; m < 4; ++m) _Pragma("unroll") for (int k = 0; k < 2; ++k) dst[m][k] = *(const LAS bf16x8*)(lds + PG8_SA(b, h) + aoff + m * 2048 + k * 1024); } while (0)
#define PG8_LDB(dst, b, h) do { _Pragma("unroll") for (int n = 0; n < 2; ++n) _Pragma("unroll") for (int k = 0; k < 2; ++k) dst[n][k] = *(const LAS bf16x8*)(lds + PG8_SB(b, h) + boff + n * 2048 + k * 1024); } while (0)
#define PG8_MMA(ai, bj, At, Bt) do { __builtin_amdgcn_s_setprio(1); _Pragma("unroll") for (int m = 0; m < 4; ++m) _Pragma("unroll") for (int n = 0; n < 2; ++n) _Pragma("unroll") for (int k = 0; k < 2; ++k) \
        acc[ai][bj][m][n] = __builtin_amdgcn_mfma_f32_16x16x32_bf16(Bt[n][k], At[m][k], acc[ai][bj][m][n], 0, 0, 0); __builtin_amdgcn_s_setprio(0); } while (0)
#define PG8_WAIT_V(n) asm volatile("s_waitcnt vmcnt(" #n ")" ::: "memory")
#define PG8_WAIT_L(n) asm volatile("s_waitcnt lgkmcnt(" #n ")" ::: "memory")
#define PG8_BAR __builtin_amdgcn_s_barrier()
#define PG8_SCHED __builtin_amdgcn_sched_barrier(0)
    Unit cur, nxt; int ui = 0;
    if (!S.next(0, cur)) return;
    f32x4 acc[2][2][4][2];
#pragma unroll
    for (int a = 0; a < 2; ++a)
#pragma unroll
        for (int b = 0; b < 2; ++b)
#pragma unroll
            for (int m = 0; m < 4; ++m)
#pragma unroll
                for (int n = 0; n < 2; ++n) acc[a][b][m][n] = (f32x4){0.f, 0.f, 0.f, 0.f};
    bf16x8 At[4][2], B0[2][2], B1[2][2];
    const char* cA = (const char*)g.A + (size_t)cur.pm * tstep; const char* cB = (const char*)g.Bt + (size_t)cur.pn * tstep;
    if constexpr (SP2) {
        PG8_STAGE(PG8_SB(0, 0), cB, voffB); PG8_STAGE(PG8_SB(0, 1), cB + hstepB, voffB); PG8_STAGE(PG8_SA(0, 0), cA, voffA); PG8_STAGE(PG8_SA(0, 1), cA + hstep, voffA);
        if (wr == 1) PG8_BAR;
        PG8_WAIT_V(2); PG8_BAR;
        PG8_STAGE(PG8_SB(1, 0), cB + kstep, voffB); PG8_STAGE(PG8_SA(1, 0), cA + kstep, voffA); PG8_STAGE(PG8_SB(1, 1), cB + hstepB + kstep, voffB);
        PG8_WAIT_V(6); PG8_BAR;
    } else {
    PG8_STAGE(PG8_SB(0, 0), cB, voffB); PG8_STAGE(PG8_SA(0, 0), cA, voffA); PG8_STAGE(PG8_SB(0, 1), cB + hstepB, voffB); PG8_STAGE(PG8_SA(0, 1), cA + hstep, voffA);
    if (wr == 1) PG8_BAR;
    PG8_WAIT_V(4); PG8_BAR;
    PG8_STAGE(PG8_SB(1, 0), cB + kstep, voffB); PG8_STAGE(PG8_SA(1, 0), cA + kstep, voffA); PG8_STAGE(PG8_SB(1, 1), cB + hstepB + kstep, voffB);
    PG8_WAIT_V(6); PG8_BAR;
    }
    for (;;) {
        const bool has_next = S.next(ui + 1, nxt);
        const char* nA = has_next ? (const char*)g.A + (size_t)nxt.pm * tstep : cA; const char* nB = has_next ? (const char*)g.Bt + (size_t)nxt.pn * tstep : cB;
        for (int t = 0; t < nt; t += 2) {
            const bool last = (t == nt - 2);
            const char* a1 = cA + (size_t)(t + 1) * kstep;
            const char* a2 = last ? nA : cA + (size_t)(t + 2) * kstep; const char* b2 = last ? nB : cB + (size_t)(t + 2) * kstep;
            const char* a3 = a2 + kstep; const char* b3 = b2 + kstep;
            if constexpr (SP2) {
            PG8_LDB(B0, 0, 0); PG8_LDB(B1, 0, 1); PG8_SCHED; PG8_LDA(At, 0, 0); PG8_STAGE(PG8_SA(1, 1), a1 + hstep, voffA);
            PG8_WAIT_V(8); PG8_WAIT_L(0); PG8_BAR; PG8_MMA(0, 0, At, B0); PG8_MMA(0, 1, At, B1); PG8_BAR; PG8_SCHED;
            PG8_LDA(At, 0, 1); PG8_STAGE(PG8_SB(0, 0), b2, voffB); PG8_STAGE(PG8_SB(0, 1), b2 + hstepB, voffB); PG8_STAGE(PG8_SA(0, 0), a2, voffA);
            PG8_WAIT_V(8); PG8_WAIT_L(0); PG8_BAR; PG8_MMA(1, 0, At, B0); PG8_MMA(1, 1, At, B1); PG8_BAR; PG8_SCHED;
            PG8_LDB(B0, 1, 0); PG8_LDB(B1, 1, 1); PG8_SCHED; PG8_LDA(At, 1, 0); PG8_STAGE(PG8_SA(0, 1), a2 + hstep, voffA);
            PG8_WAIT_V(8); PG8_WAIT_L(0); PG8_BAR; PG8_MMA(0, 0, At, B0); PG8_MMA(0, 1, At, B1); PG8_BAR; PG8_SCHED;
            PG8_LDA(At, 1, 1); PG8_STAGE(PG8_SB(1, 0), b3, voffB); PG8_STAGE(PG8_SB(1, 1), b3 + hstepB, voffB); PG8_STAGE(PG8_SA(1, 0), a3, voffA);
            PG8_WAIT_V(8); PG8_WAIT_L(0); PG8_BAR; PG8_MMA(1, 0, At, B0); PG8_MMA(1, 1, At, B1); PG8_BAR; PG8_SCHED;
            } else {
            PG8_LDB(B0, 0, 0); PG8_SCHED; PG8_LDA(At, 0, 0); PG8_STAGE(PG8_SA(1, 1), a1 + hstep, voffA);
            PG8_WAIT_L(8); PG8_BAR; PG8_WAIT_L(0); PG8_MMA(0, 0, At, B0); PG8_BAR; PG8_SCHED;
            PG8_LDB(B1, 0, 1); PG8_STAGE(PG8_SB(0, 0), b2, voffB);
            PG8_BAR; PG8_WAIT_L(0); PG8_MMA(0, 1, At, B1); PG8_BAR;
            PG8_LDA(At, 0, 1); PG8_STAGE(PG8_SA(0, 0), a2, voffA);
            PG8_BAR; PG8_WAIT_L(0); PG8_MMA(1, 0, At, B0); PG8_BAR; PG8_SCHED;
            PG8_STAGE(PG8_SB(0, 1), b2 + hstepB, voffB);
            PG8_WAIT_V(6); PG8_BAR; PG8_MMA(1, 1, At, B1); PG8_BAR;
            PG8_LDB(B0, 1, 0); PG8_SCHED; PG8_LDA(At, 1, 0); PG8_STAGE(PG8_SA(0, 1), a2 + hstep, voffA);
            PG8_WAIT_L(8); PG8_BAR; PG8_WAIT_L(0); PG8_MMA(0, 0, At, B0); PG8_BAR; PG8_SCHED;
            PG8_LDB(B1, 1, 1); PG8_STAGE(PG8_SB(1, 0), b3, voffB);
            PG8_BAR; PG8_WAIT_L(0); PG8_MMA(0, 1, At, B1); PG8_BAR;
            PG8_LDA(At, 1, 1); PG8_STAGE(PG8_SA(1, 0), a3, voffA);
            PG8_BAR; PG8_WAIT_L(0); PG8_MMA(1, 0, At, B0); PG8_BAR; PG8_SCHED;
            PG8_STAGE(PG8_SB(1, 1), b3 + hstepB, voffB);
            PG8_WAIT_V(6); PG8_BAR; PG8_MMA(1, 1, At, B1); PG8_BAR;
            }
        }
        if constexpr (ALIGN_EPI) { if (wr == 0) PG8_BAR; }
        E(acc, cur, wr, wc, fr, fq);
        if (!has_next) break;
#pragma unroll
        for (int a = 0; a < 2; ++a)
#pragma unroll
            for (int b = 0; b < 2; ++b)
#pragma unroll
                for (int m = 0; m < 4; ++m)
#pragma unroll
                    for (int n = 0; n < 2; ++n) acc[a][b][m][n] = (f32x4){0.f, 0.f, 0.f, 0.f};
        cur = nxt; cA = nA; cB = nB; ++ui;
        if constexpr (ALIGN_EPI) { if (wr == 1) PG8_BAR; }
    }
    PG8_WAIT_V(0);
    if constexpr (!ALIGN_EPI) { if (wr == 0) PG8_BAR; }
    PG8_BAR;
#undef PG8_SA
#undef PG8_SB
#undef PG8_STAGE
#undef PG8_LDA
#undef PG8_LDB
#undef PG8_MMA
#undef PG8_WAIT_V
#undef PG8_WAIT_L
#undef PG8_BAR
#undef PG8_SCHED
}
}

__device__ __forceinline__ void st_bf16x8(bf16_t* p, f32x4 a, f32x4 b) {
    u32x4 w; w.x = pk2(a[0], a[1]); w.y = pk2(a[2], a[3]); w.z = pk2(b[0], b[1]); w.w = pk2(b[2], b[3]);
    *(u32x4*)p = w;
}
__device__ __forceinline__ int brow_of(int r) { return r < MP ? (r >> 13) : 2 + ((r - MP) >> 4); }

struct EpiIn {
    int l; float* out; bf16_t* qb; bf16_t* kb; bf16_t* vb; float* ub; const float* qg; const float* kg;
    __device__ __forceinline__ void operator()(const f32x4 (&acc)[2][2][4][2], const pg8::Unit& u, int wr, int wc, int fr, int fq) const {
        const int pn = u.pn, rbase = u.pm * 256 + wr * 64 + fr;
        if (pn == 0) {
            const int cb = 64 * wc + 8 * fq;
#pragma unroll
            for (int ai = 0; ai < 2; ++ai)
#pragma unroll
                for (int m = 0; m < 4; ++m) {
                    const int r = rbase + ai * 128 + m * 16;
                    float* up = ub + (size_t)r * PW + cb;
                    float* sp = nullptr;
                    if (r < MP) { const int t = r & (T - 1); if (t >= T - 15) sp = out + OFF_PP + ((size_t)((l * NBP + (r >> 13)) * 15 + (t - (T - 15)))) * PW + cb; }
                    else { const int rr = r - MP, t = rr & 15; if (t >= 1) sp = out + OFF_PS + ((size_t)((l * SB + (rr >> 4)) * 15 + (t - 1))) * PW + cb; }
#pragma unroll
                    for (int bj = 0; bj < 2; ++bj) {
                        *(f32x4*)(up + 32 * bj) = acc[ai][bj][m][0]; *(f32x4*)(up + 32 * bj + 4) = acc[ai][bj][m][1];
                        if (sp) { *(f32x4*)(sp + 32 * bj) = acc[ai][bj][m][0]; *(f32x4*)(sp + 32 * bj + 4) = acc[ai][bj][m][1]; }
                    }
                }
        } else if (pn <= 6) {
            const bool isq = pn <= 3;
            const int head = ((pn - 1) % 3) * 4 + wc;
            const float* gp = (isq ? qg : kg) + 8 * fq;
            f32x4 gv[2][2];
#pragma unroll
            for (int bj = 0; bj < 2; ++bj)
#pragma unroll
                for (int n = 0; n < 2; ++n) gv[bj][n] = *(const f32x4*)(gp + 32 * bj + 4 * n);
            bf16_t* dst = isq ? qb : kb;
#pragma unroll
            for (int ai = 0; ai < 2; ++ai)
#pragma unroll
                for (int m = 0; m < 4; ++m) {
                    const int r = rbase + ai * 128 + m * 16;
                    float ss = 0.f;
#pragma unroll
                    for (int bj = 0; bj < 2; ++bj)
#pragma unroll
                        for (int n = 0; n < 2; ++n) { const f32x4 a = acc[ai][bj][m][n]; ss += (a[0] * a[0] + a[1] * a[1]) + (a[2] * a[2] + a[3] * a[3]); }
                    ss = quad_sum(ss);
                    float rinv = 1.0f / sqrtf(ss * (1.f / 64.f) + EPS);
                    const float rq = isq ? rinv * C2 : rinv;
                    float* ko = nullptr;
                    if (!isq) ko = out + (r < MP ? OFF_KP + ((size_t)l * MP + r) * AW : OFF_KS + ((size_t)l * MS + (r - MP)) * AW) + head * 64 + 8 * fq;
#pragma unroll
                    for (int bj = 0; bj < 2; ++bj) {
                        const f32x4 n0 = acc[ai][bj][m][0] * rinv * gv[bj][0], n1 = acc[ai][bj][m][1] * rinv * gv[bj][1];
                        if (isq) { const f32x4 s0 = acc[ai][bj][m][0] * rq * gv[bj][0], s1 = acc[ai][bj][m][1] * rq * gv[bj][1];
                            st_bf16x8(dst + (size_t)r * AW + head * 64 + 32 * bj + 8 * fq, s0, s1); }
                        else { st_bf16x8(dst + (size_t)r * AW + head * 64 + 32 * bj + 8 * fq, n0, n1);
                            *(f32x4*)(ko + 32 * bj) = n0; *(f32x4*)(ko + 32 * bj + 4) = n1; }
                    }
                }
        } else {
            const int head = (pn - 7) * 4 + wc;
#pragma unroll
            for (int ai = 0; ai < 2; ++ai)
#pragma unroll
                for (int m = 0; m < 4; ++m) {
                    const int r = rbase + ai * 128 + m * 16;
                    float* vo = out + (r < MP ? OFF_VP + ((size_t)l * MP + r) * AW : OFF_VS + ((size_t)l * MS + (r - MP)) * AW) + head * 64 + 8 * fq;
#pragma unroll
                    for (int bj = 0; bj < 2; ++bj) {
                        st_bf16x8(vb + (size_t)r * AW + head * 64 + 32 * bj + 8 * fq, acc[ai][bj][m][0], acc[ai][bj][m][1]);
                        *(f32x4*)(vo + 32 * bj) = acc[ai][bj][m][0]; *(f32x4*)(vo + 32 * bj + 4) = acc[ai][bj][m][1];
                    }
                }
        }
    }
};

struct EpiRes {
    const float* xip; const float* xis; float* xop; float* xos; const float* gate;
    __device__ __forceinline__ void operator()(const f32x4 (&acc)[2][2][4][2], const pg8::Unit& u, int wr, int wc, int fr, int fq) const {
        const int rbase = u.pm * 256 + wr * 64 + fr, cb = u.pn * 256 + 64 * wc + 8 * fq;
        const float* gp = gate + (size_t)((u.pm * 256) >> 13) * MODW + cb;
        constexpr int DEPTH = 3;
        f32x4 gg[2][2], xq[DEPTH][2][2];
#pragma unroll
        for (int bj = 0; bj < 2; ++bj)
#pragma unroll
            for (int n = 0; n < 2; ++n) gg[bj][n] = *(const f32x4*)(gp + 32 * bj + 4 * n);
#pragma unroll
        for (int d = 0; d < DEPTH; ++d) { const int r2 = rbase + (d >> 2) * 128 + (d & 3) * 16;
#pragma unroll
            for (int bj = 0; bj < 2; ++bj)
#pragma unroll
                for (int n = 0; n < 2; ++n) xq[d][bj][n] = *(const f32x4*)(xip + (size_t)r2 * D + cb + 32 * bj + 4 * n); }
#pragma unroll
        for (int it = 0; it < 8; ++it) {
            const int ai = it >> 2, m = it & 3, r = rbase + ai * 128 + m * 16;
            f32x4 xc[2][2];
#pragma unroll
            for (int bj = 0; bj < 2; ++bj)
#pragma unroll
                for (int n = 0; n < 2; ++n) xc[bj][n] = xq[it % DEPTH][bj][n];
            if (it + DEPTH < 8) { const int r2 = rbase + ((it + DEPTH) >> 2) * 128 + ((it + DEPTH) & 3) * 16;
#pragma unroll
                for (int bj = 0; bj < 2; ++bj)
#pragma unroll
                    for (int n = 0; n < 2; ++n) xq[it % DEPTH][bj][n] = *(const f32x4*)(xip + (size_t)r2 * D + cb + 32 * bj + 4 * n); }
            float* xo = xop + (size_t)r * D + cb;
#pragma unroll
            for (int bj = 0; bj < 2; ++bj)
#pragma unroll
                for (int n = 0; n < 2; ++n) *(f32x4*)(xo + 32 * bj + 4 * n) = xc[bj][n] + gg[bj][n] * acc[ai][bj][m][n];
            __builtin_amdgcn_sched_barrier(0);
        }
    }
};

struct EpiUp {
    bf16_t* hid;
    __device__ __forceinline__ void operator()(const f32x4 (&acc)[2][2][4][2], const pg8::Unit& u, int wr, int wc, int fr, int fq) const {
        const int rbase = u.pm * 256 + wr * 64 + fr, cb = u.pn * 256 + 64 * wc + 8 * fq;
#pragma unroll
        for (int ai = 0; ai < 2; ++ai)
#pragma unroll
            for (int m = 0; m < 4; ++m) {
                const int r = rbase + ai * 128 + m * 16;
#pragma unroll
                for (int bj = 0; bj < 2; ++bj) {
                    f32x4 a = acc[ai][bj][m][0], b = acc[ai][bj][m][1];
#pragma unroll
                    for (int j = 0; j < 4; ++j) { const float x = fmaxf(a[j], 0.f), y = fmaxf(b[j], 0.f); a[j] = x * x; b[j] = y * y; }
                    st_bf16x8(hid + (size_t)r * FF + cb + 32 * bj, a, b);
                }
            }
    }
};

template <class SEpi, int NG = 2>
__device__ __forceinline__ void skinny_phase(LAS unsigned char* lds, const bf16_t* A, const bf16_t* Bt, int N, int K, const SEpi& E, int tid, int lane, int wave, int row0 = MP, int nrg = 16) {
    const int l16 = lane & 15, quad = lane >> 4;
    const int nr2 = nrg / NG, nitems = nr2 * (N / 64);
    LAS float* red = (LAS float*)lds;
    const int kw = K / 8;
    for (int it = (int)(gridDim.x - 1 - blockIdx.x); it < nitems; it += gridDim.x) {
        const int rg2 = it % nr2, cg = it / nr2;
        const bf16_t* ap = A + (size_t)(row0 + 16 * NG * rg2 + l16) * K + wave * kw + quad * 8;
        const bf16_t* bp = Bt + (size_t)(cg * 64 + l16) * K + wave * kw + quad * 8;
        f32x4 acc[NG][4];
#pragma unroll
        for (int h = 0; h < NG; ++h)
#pragma unroll
            for (int nt = 0; nt < 4; ++nt) acc[h][nt] = (f32x4){0.f, 0.f, 0.f, 0.f};
        for (int k0 = 0; k0 < kw; k0 += 128) {
            bf16x8 a[NG][4], b[4][4];
#pragma unroll
            for (int s = 0; s < 4; ++s) {
#pragma unroll
                for (int h = 0; h < NG; ++h) a[h][s] = *(const bf16x8*)(ap + (size_t)16 * h * K + k0 + 32 * s);
#pragma unroll
                for (int nt = 0; nt < 4; ++nt) b[s][nt] = *(const bf16x8*)(bp + (size_t)nt * 16 * K + k0 + 32 * s);
            }
#pragma unroll
            for (int s = 0; s < 4; ++s)
#pragma unroll
                for (int nt = 0; nt < 4; ++nt)
#pragma unroll
                    for (int h = 0; h < NG; ++h) acc[h][nt] = __builtin_amdgcn_mfma_f32_16x16x32_bf16(a[h][s], b[s][nt], acc[h][nt], 0, 0, 0);
        }
#pragma unroll
        for (int h = 0; h < NG; ++h)
#pragma unroll
            for (int nt = 0; nt < 4; ++nt)
#pragma unroll
                for (int r = 0; r < 4; ++r) red[(wave * 16 * NG + 16 * h + quad * 4 + r) * 64 + 16 * nt + l16] = acc[h][nt][r];
        __syncthreads();
        const int row = tid >> 5, c2 = (tid & 31) * 2;
#pragma unroll
        for (int h = 0; h < NG; ++h) {
            float v0 = 0.f, v1 = 0.f;
#pragma unroll
            for (int w = 0; w < 8; ++w) { const f32x2 t = *(const LAS f32x2*)(red + (w * 16 * NG + 16 * h + row) * 64 + c2); v0 += t.x; v1 += t.y; }
            E(NG * rg2 + h, row, cg, c2, v0, v1);
        }
        __syncthreads();
    }
}

struct SEpiIn {
    int l; float* out; bf16_t* qb; bf16_t* kb; bf16_t* vb; float* ub; const float* qg; const float* kg;
    __device__ __forceinline__ void operator()(int b, int t, int cg, int c2, float v0, float v1) const {
        const int rr = 16 * b + t; const size_t r = (size_t)MP + rr;
        if (cg < 4) {
            const int c = cg * 64 + c2;
            *(f32x2*)(ub + r * PW + c) = (f32x2){v0, v1};
            if (t >= 1) *(f32x2*)(out + OFF_PS + ((size_t)((l * SB + b) * 15 + (t - 1))) * PW + c) = (f32x2){v0, v1};
        } else if (cg < 28) {
            const bool isq = cg < 16; const int head = isq ? cg - 4 : cg - 16;
            float ss = v0 * v0 + v1 * v1;
#pragma unroll
            for (int o = 1; o < 32; o <<= 1) ss += __shfl_xor(ss, o);
            const float rinv = 1.0f / sqrtf(ss * (1.f / 64.f) + EPS);
            const float* gp = (isq ? qg : kg) + c2;
            const float n0 = v0 * rinv * gp[0], n1 = v1 * rinv * gp[1];
            if (isq) *(unsigned*)(qb + r * AW + head * 64 + c2) = pk2(n0 * C2, n1 * C2);
            else { *(unsigned*)(kb + r * AW + head * 64 + c2) = pk2(n0, n1); *(f32x2*)(out + OFF_KS + ((size_t)l * MS + rr) * AW + head * 64 + c2) = (f32x2){n0, n1}; }
        } else {
            const int head = cg - 28;
            *(unsigned*)(vb + r * AW + head * 64 + c2) = pk2(v0, v1);
            *(f32x2*)(out + OFF_VS + ((size_t)l * MS + rr) * AW + head * 64 + c2) = (f32x2){v0, v1};
        }
    }
};
struct SEpiRes {
    const float* xis; float* xos; const float* gate;
    __device__ __forceinline__ void operator()(int b, int t, int cg, int c2, float v0, float v1) const {
        const size_t o = (size_t)(16 * b + t) * D + cg * 64 + c2;
        const f32x2 xv = *(const f32x2*)(xis + o), gg = *(const f32x2*)(gate + (size_t)(2 + b) * MODW + cg * 64 + c2);
        *(f32x2*)(xos + o) = (f32x2){xv.x + gg.x * v0, xv.y + gg.y * v1};
    }
};
struct SEpiUp {
    bf16_t* hid;
    __device__ __forceinline__ void operator()(int b, int t, int cg, int c2, float v0, float v1) const {
        const float x = fmaxf(v0, 0.f), y = fmaxf(v1, 0.f);
        *(unsigned*)(hid + ((size_t)MP + 16 * b + t) * FF + cg * 64 + c2) = pk2(x * x, y * y);
    }
};


struct EpiResN {
    const float* xip; float* xop; const float* gate; const float* sc2; bf16_t* xt; float* ss;
    __device__ __forceinline__ void operator()(const f32x4 (&acc)[2][2][4][2], const pg8::Unit& u, int wr, int wc, int fr, int fq) const {
        const int rbase = u.pm * 256 + wr * 64 + fr, cb = u.pn * 256 + 64 * wc + 8 * fq;
        const int brow = (u.pm * 256) >> 13;
        const float* gp = gate + (size_t)brow * MODW + cb; const float* sp = sc2 + (size_t)brow * MODW + cb;
        constexpr int DEPTH = 2;
        f32x4 gg[2][2], sv[2][2], xq[DEPTH][2][2];
#pragma unroll
        for (int bj = 0; bj < 2; ++bj)
#pragma unroll
            for (int n = 0; n < 2; ++n) { gg[bj][n] = *(const f32x4*)(gp + 32 * bj + 4 * n); sv[bj][n] = *(const f32x4*)(sp + 32 * bj + 4 * n) + 1.0f; }
#pragma unroll
        for (int d = 0; d < DEPTH; ++d) { const int r2 = rbase + (d >> 2) * 128 + (d & 3) * 16;
#pragma unroll
            for (int bj = 0; bj < 2; ++bj)
#pragma unroll
                for (int n = 0; n < 2; ++n) xq[d][bj][n] = *(const f32x4*)(xip + (size_t)r2 * D + cb + 32 * bj + 4 * n); }
#pragma unroll
        for (int it = 0; it < 8; ++it) {
            const int ai = it >> 2, m = it & 3, r = rbase + ai * 128 + m * 16;
            f32x4 xc[2][2];
#pragma unroll
            for (int bj = 0; bj < 2; ++bj)
#pragma unroll
                for (int n = 0; n < 2; ++n) xc[bj][n] = xq[it % DEPTH][bj][n];
            if (it + DEPTH < 8) { const int r2 = rbase + ((it + DEPTH) >> 2) * 128 + ((it + DEPTH) & 3) * 16;
#pragma unroll
                for (int bj = 0; bj < 2; ++bj)
#pragma unroll
                    for (int n = 0; n < 2; ++n) xq[it % DEPTH][bj][n] = *(const f32x4*)(xip + (size_t)r2 * D + cb + 32 * bj + 4 * n); }
            float* xo = xop + (size_t)r * D + cb;
            float s = 0.f;
#pragma unroll
            for (int bj = 0; bj < 2; ++bj) {
                f32x4 t[2];
#pragma unroll
                for (int n = 0; n < 2; ++n) {
                    const f32x4 x1 = xc[bj][n] + gg[bj][n] * acc[ai][bj][m][n];
                    *(f32x4*)(xo + 32 * bj + 4 * n) = x1;
                    s += (x1[0] * x1[0] + x1[1] * x1[1]) + (x1[2] * x1[2] + x1[3] * x1[3]);
                    t[n] = x1 * sv[bj][n];
                }
                st_bf16x8(xt + (size_t)r * D + cb + 32 * bj, t[0], t[1]);
            }
            s = quad_sum(s);
            if (fq == 0) atomicAdd(ss + r, s);
            __builtin_amdgcn_sched_barrier(0);
        }
    }
};
struct SEpiResN {
    const float* xis; float* xos; const float* gate; const float* sc2; bf16_t* xt; float* ss;
    __device__ __forceinline__ void operator()(int b, int t, int cg, int c2, float v0, float v1) const {
        const int rr = 16 * b + t; const size_t o = (size_t)rr * D + cg * 64 + c2;
        const f32x2 xv = *(const f32x2*)(xis + o), gg = *(const f32x2*)(gate + (size_t)(2 + b) * MODW + cg * 64 + c2), sv = *(const f32x2*)(sc2 + (size_t)(2 + b) * MODW + cg * 64 + c2);
        const float a0 = xv.x + gg.x * v0, a1 = xv.y + gg.y * v1;
        *(f32x2*)(xos + o) = (f32x2){a0, a1};
        *(unsigned*)(xt + ((size_t)MP + rr) * D + cg * 64 + c2) = pk2(a0 * (sv.x + 1.0f), a1 * (sv.y + 1.0f));
        float s = a0 * a0 + a1 * a1;
#pragma unroll
        for (int q = 1; q < 32; q <<= 1) s += __shfl_xor(s, q);
        if ((c2 >> 1) == 0) atomicAdd(ss + MP + rr, s);
    }
};
struct EpiUpN {
    bf16_t* hid; const float* ss; const float* bias;
    __device__ __forceinline__ void operator()(const f32x4 (&acc)[2][2][4][2], const pg8::Unit& u, int wr, int wc, int fr, int fq) const {
        const int rbase = u.pm * 256 + wr * 64 + fr, cb = u.pn * 256 + 64 * wc + 8 * fq;
        const float* bp = bias + (size_t)((u.pm * 256) >> 13) * FF + cb;
        f32x4 bv[2][2];
#pragma unroll
        for (int bj = 0; bj < 2; ++bj)
#pragma unroll
            for (int n = 0; n < 2; ++n) bv[bj][n] = *(const f32x4*)(bp + 32 * bj + 4 * n);
#pragma unroll
        for (int ai = 0; ai < 2; ++ai)
#pragma unroll
            for (int m = 0; m < 4; ++m) {
                const int r = rbase + ai * 128 + m * 16;
                const float rinv = 1.0f / sqrtf(ss[r] * (1.f / D) + EPS);
#pragma unroll
                for (int bj = 0; bj < 2; ++bj) {
                    f32x4 a = acc[ai][bj][m][0] * rinv + bv[bj][0], b = acc[ai][bj][m][1] * rinv + bv[bj][1];
#pragma unroll
                    for (int j = 0; j < 4; ++j) { const float x = fmaxf(a[j], 0.f), y = fmaxf(b[j], 0.f); a[j] = x * x; b[j] = y * y; }
                    st_bf16x8(hid + (size_t)r * FF + cb + 32 * bj, a, b);
                }
            }
    }
};
struct SEpiUpN {
    bf16_t* hid; const float* ss; const float* bias;
    __device__ __forceinline__ void operator()(int b, int t, int cg, int c2, float v0, float v1) const {
        const int r = MP + 16 * b + t;
        const float rinv = 1.0f / sqrtf(ss[r] * (1.f / D) + EPS);
        const f32x2 bb = *(const f32x2*)(bias + (size_t)(2 + b) * FF + cg * 64 + c2);
        const float x = fmaxf(v0 * rinv + bb.x, 0.f), y = fmaxf(v1 * rinv + bb.y, 0.f);
        *(unsigned*)(hid + (size_t)r * FF + cg * 64 + c2) = pk2(x * x, y * y);
    }
};
struct SEpiBias {
    float* bias;
    __device__ __forceinline__ void operator()(int rg, int t, int cg, int c2, float v0, float v1) const {
        const int row = 16 * rg + t;
        if (row < NMODROW) *(f32x2*)(bias + (size_t)row * FF + cg * 64 + c2) = (f32x2){v0, v1};
    }
};

struct Params { const float* in[19]; float* out; unsigned char* ws; };

__device__ __forceinline__ void transpose_item(const float* W, int ldw, int K, int nblk, bf16_t* WT, LAS float* scr, int item, int lane) {
    const int kb = item / nblk, nb = item % nblk, k0 = 64 * kb, n0 = 32 * nb;
    float tv[32];
#pragma unroll
    for (int i = 0; i < 32; ++i) tv[i] = W[(size_t)(k0 + 2 * i + (lane >> 5)) * ldw + n0 + (lane & 31)];
#pragma unroll
    for (int i = 0; i < 32; ++i) scr[(2 * i + (lane >> 5)) * 33 + (lane & 31)] = tv[i];
    asm volatile("s_waitcnt lgkmcnt(0)" ::: "memory");
    const int c = lane & 7;
#pragma unroll
    for (int j = 0; j < 4; ++j) { const int n = (lane >> 3) + 8 * j; const LAS float* s = scr + (8 * c) * 33 + n;
        u32x4 o; o.x = pk2(s[0 * 33], s[1 * 33]); o.y = pk2(s[2 * 33], s[3 * 33]); o.z = pk2(s[4 * 33], s[5 * 33]); o.w = pk2(s[6 * 33], s[7 * 33]);
        *(u32x4*)(WT + (size_t)(n0 + n) * K + k0 + 8 * c) = o; }
    asm volatile("s_waitcnt lgkmcnt(0)" ::: "memory");
}

__device__ __forceinline__ void phase_prologue(const Params& p, LAS unsigned char* lds, int tid, int lane, int wave) {
    LAS float* sc = (LAS float*)lds;
    LAS float* red = (LAS float*)(lds + 73728);
    for (int idx = tid; idx < NMODROW * D; idx += 512) {
        const int r = idx >> 10, k = idx & 1023;
        const float c = (r < 2) ? p.in[2][r * D + k] : p.in[3][(r - 2) * D + k];
        sc[k * 18 + r] = c / (1.f + __expf(-c));
    }
    __syncthreads();
    float* modw = (float*)(p.ws + WS_MOD);
    for (int it = blockIdx.x; it < 256; it += gridDim.x) {
        const int l = it >> 7, col0 = (it & 127) * 48;
        const int cl = lane < 48 ? lane : 47;
        const float* W = p.in[8] + (size_t)l * D * MODW + col0 + cl;
        float acc[18];
#pragma unroll
        for (int r = 0; r < 18; ++r) acc[r] = 0.f;
        const int kb = wave * 128;
#pragma unroll 16
        for (int kk = 0; kk < 128; ++kk) {
            const int k = kb + kk;
            const float wv = W[(size_t)k * MODW];
            const LAS f32x2* s2 = (const LAS f32x2*)(sc + k * 18);
#pragma unroll
            for (int r2 = 0; r2 < 9; ++r2) { const f32x2 s = s2[r2]; acc[2 * r2] += s.x * wv; acc[2 * r2 + 1] += s.y * wv; }
        }
#pragma unroll
        for (int r = 0; r < 18; ++r) red[(wave * 18 + r) * 64 + lane] = acc[r];
        __syncthreads();
        for (int idx = tid; idx < 18 * 48; idx += 512) {
            const int r = idx / 48, c = idx % 48;
            float s = p.in[9][l * MODW + col0 + c];
#pragma unroll
            for (int w = 0; w < 8; ++w) s += red[(w * 18 + r) * 64 + c];
            modw[((size_t)l * NMODROW + r) * MODW + col0 + c] = s;
        }
        __syncthreads();
    }
    LAS float* scr = (LAS float*)(lds + 73728 + wave * 8448);
    const int gw = blockIdx.x * 8 + wave, NGW = gridDim.x * 8;
    constexpr int I_IN = 16 * 80, I_OUT = 16 * 32, I_UP = 16 * 128, I_DN = 64 * 32, I_L = I_IN + I_OUT + I_UP + I_DN;
    for (int it = gw; it < 2 * I_L; it += NGW) {
        const int l = it / I_L; int r = it % I_L;
        if (r < I_IN) { transpose_item(p.in[10] + (size_t)l * D * INC, INC, D, 80, (bf16_t*)(p.ws + WS_WIN) + (size_t)l * NMAIN * D, scr, r, lane); continue; } r -= I_IN;
        if (r < I_OUT) { transpose_item(p.in[16] + (size_t)l * D * D, D, D, 32, (bf16_t*)(p.ws + WS_WOUT) + (size_t)l * D * D, scr, r, lane); continue; } r -= I_OUT;
        if (r < I_UP) { transpose_item(p.in[17] + (size_t)l * D * FF, FF, D, 128, (bf16_t*)(p.ws + WS_WUP) + (size_t)l * FF * D, scr, r, lane); continue; } r -= I_UP;
        transpose_item(p.in[18] + (size_t)l * FF * D, D, FF, 32, (bf16_t*)(p.ws + WS_WDN) + (size_t)l * D * FF, scr, r, lane);
    }
}

__device__ __forceinline__ void phase_norm(const Params& p, LAS unsigned char* lds, int l, int stage, const float* xp, const float* xs, int tid, int lane, int wave) {
    constexpr int HP = 1032;
    LAS bf16_t* wfb = (LAS bf16_t*)lds;
    LAS bf16_t* ht = (LAS bf16_t*)(lds + 33280);
    LAS float* pc = (LAS float*)(lds + 66560);
    {
        const float* W = p.in[10] + (size_t)l * D * INC + NMAIN;
        for (int idx = tid; idx < 16 * D; idx += 512) { const int k = idx >> 4, hh = idx & 15; wfb[hh * HP + k] = (bf16_t)f2bf(hh < NH ? W[(size_t)k * INC + hh] : 0.f); }
        float* SS = (float*)(p.ws + WS_SS);
        for (int i = blockIdx.x * 512 + tid; i < M; i += gridDim.x * 512) SS[i] = 0.f;
        if (l == 0) {
            bf16_t* s2 = (bf16_t*)(p.ws + WS_SH2); const float* modall = (const float*)(p.ws + WS_MOD);
            for (int i = blockIdx.x * 512 + tid; i < 2 * 32 * D; i += gridDim.x * 512) { const int ll = i >> 15, row = (i >> 10) & 31, k = i & 1023;
                s2[i] = (bf16_t)f2bf(row < NMODROW ? modall[((size_t)ll * NMODROW + row) * MODW + 3 * D + k] : 0.f); }
        }
    }
    __syncthreads();
    const float* modl = (const float*)(p.ws + WS_MOD) + (size_t)l * NMODROW * MODW;
    bf16_t* hn = (bf16_t*)(p.ws + WS_HN);
    const int l16 = lane & 15, quad = lane >> 4;
    const int rpb = (M + (int)gridDim.x - 1) / (int)gridDim.x, R0 = (int)blockIdx.x * rpb, R1 = (R0 + rpb < M) ? R0 + rpb : M;
    for (int g0 = R0; g0 < R1; g0 += 16) {
#pragma unroll
        for (int rr = 0; rr < 2; ++rr) {
            const int lr = 2 * wave + rr, m = g0 + lr;
            LAS unsigned long long* h8 = (LAS unsigned long long*)(ht + lr * HP) + lane;
            if (m < R1) {
                const f32x4* xr = (const f32x4*)(m < MP ? xp + (size_t)m * D : xs + (size_t)(m - MP) * D) + lane;
                f32x4 v[4]; float ss = 0.f;
#pragma unroll
                for (int j = 0; j < 4; ++j) { v[j] = xr[64 * j]; ss += (v[j].x * v[j].x + v[j].y * v[j].y) + (v[j].z * v[j].z + v[j].w * v[j].w); }
                ss = wave_sum(ss);
                const float rinv = 1.0f / sqrtf(ss * (1.f / D) + EPS);
                const float* mrow = modl + (size_t)brow_of(m) * MODW;
                const f32x4* sh4 = (const f32x4*)mrow + lane; const f32x4* sc4 = (const f32x4*)(mrow + D) + lane;
                unsigned long long* o8 = (unsigned long long*)(hn + (size_t)m * D) + lane;
#pragma unroll
                for (int j = 0; j < 4; ++j) {
                    const f32x4 shv = sh4[64 * j], scv = sc4[64 * j];
                    v[j] = v[j] * rinv * (scv + 1.0f) + shv;
                    const unsigned long long w = (unsigned long long)pk2(v[j].x, v[j].y) | ((unsigned long long)pk2(v[j].z, v[j].w) << 32);
                    o8[64 * j] = w; h8[64 * j] = w;
                }
            } else {
#pragma unroll
                for (int j = 0; j < 4; ++j) h8[64 * j] = 0ull;
            }
        }
        __syncthreads();
        {
            f32x4 c = (f32x4){0.f, 0.f, 0.f, 0.f};
#pragma unroll
            for (int s = 0; s < 4; ++s) {
                const int k0 = 32 * (4 * wave + s) + 8 * quad;
                const bf16x8 a = *(const LAS bf16x8*)(ht + l16 * HP + k0), b = *(const LAS bf16x8*)(wfb + l16 * HP + k0);
                c = __builtin_amdgcn_mfma_f32_16x16x32_bf16(a, b, c, 0, 0, 0);
            }
#pragma unroll
            for (int r = 0; r < 4; ++r) pc[(wave * 16 + quad * 4 + r) * 16 + l16] = c[r];
        }
        __syncthreads();
        if (tid < 16 * NH) {
            const int row = tid / NH, hh = tid % NH, m = g0 + row;
            if (m < R1) {
                float x = p.in[11][l * NH + hh];
#pragma unroll
                for (int w = 0; w < 8; ++w) x += pc[(w * 16 + row) * 16 + hh];
                const float lf = fminf(x, 0.f) - log1pf(expf(-fabsf(x)));
                float* o = p.out + (m < MP ? OFF_FP + ((size_t)l * MP + m) * NH : OFF_FS + ((size_t)l * MS + (m - MP)) * NH);
                o[hh] = lf;
            }
        }
    }
}

__device__ __forceinline__ float block_scan_offset(float total, LAS float* sm, int lane, int wave) {
    float x = total;
#pragma unroll
    for (int o = 1; o < 64; o <<= 1) { const float n = __shfl_up(x, o); if (lane >= o) x += n; }
    __syncthreads();
    if (lane == 63) sm[wave] = x;
    __syncthreads();
    float off = x - total;
    for (int w = 0; w < wave; ++w) off += sm[w];
    return off;
}

__device__ __forceinline__ void scan_items(const Params& p, LAS unsigned char* lds, int l, int tid, int lane, int wave) {
    LAS float* sm = (LAS float*)(lds + 65536);
    float* Fp = (float*)(p.ws + WS_FP); float* Fs = (float*)(p.ws + WS_FS);
    const int nb = (int)gridDim.x / 2;
    if ((int)blockIdx.x < (int)gridDim.x - nb) return;
    for (int it = (int)(gridDim.x - 1 - blockIdx.x); it < 24 + 192; it += nb) {
        if (it < 24) {
            const int b = it / NH, h = it % NH;
            const float* src = p.out + OFF_FP + ((size_t)(l * NBP + b) * T) * NH + h;
            const int t0 = tid * 16;
            float v[16]; float run = 0.f;
#pragma unroll
            for (int e = 0; e < 16; ++e) { run += src[(size_t)(t0 + e) * NH]; v[e] = run; }
            const float off = block_scan_offset(run, sm, lane, wave);
            float* dst = Fp + (size_t)it * T + t0;
#pragma unroll
            for (int e = 0; e < 16; e += 4) *(f32x4*)(dst + e) = (f32x4){(off + v[e]) * LOG2E, (off + v[e + 1]) * LOG2E, (off + v[e + 2]) * LOG2E, (off + v[e + 3]) * LOG2E};
        } else {
            const int bh = it - 24, b = bh / NH, h = bh % NH;
            const float* src = p.in[6] + ((size_t)(l * SB + b) * PAST) * NH + h;
            const int t0 = tid * 8;
            float v[8]; float run = 0.f;
#pragma unroll
            for (int e = 0; e < 8; ++e) { run += src[(size_t)(t0 + e) * NH]; v[e] = run; }
            const float off = block_scan_offset(run, sm, lane, wave);
            float* dst = Fs + (size_t)bh * SKEYS + t0;
#pragma unroll
            for (int e = 0; e < 8; e += 4) *(f32x4*)(dst + e) = (f32x4){(off + v[e]) * LOG2E, (off + v[e + 1]) * LOG2E, (off + v[e + 2]) * LOG2E, (off + v[e + 3]) * LOG2E};
            if (tid == 511) sm[8] = off + run;
            __syncthreads();
            if (tid < ST) {
                const float* ns = p.out + OFF_FS + ((size_t)(l * SB + b) * ST) * NH + h;
                float s = sm[8];
                for (int e = 0; e <= tid; ++e) s += ns[e * NH];
                Fs[(size_t)bh * SKEYS + PAST + tid] = s * LOG2E;
            }
        }
        __syncthreads();
    }
}

__device__ __forceinline__ void pool_items(const Params& p, LAS unsigned char* lds, int l, unsigned* ctr, LAS unsigned* slot, int tid, int lane, int wave) {
    LAS float* z = (LAS float*)lds;
    LAS bf16_t* am = (LAS bf16_t*)(lds + 32768);
    const float* ub = (const float*)(p.ws + WS_U);
    bf16_t* mix = (bf16_t*)(p.ws + WS_MIX);
    const int g = wave >> 1, ntp = (wave & 1) * 2, l16 = lane & 15, quad = lane >> 4;
    bf16x8 bw[2][2];
    {
        const float* wp = p.in[14] + ((size_t)(l * 4 + g) * 64) * 64;
#pragma unroll
        for (int nt = 0; nt < 2; ++nt)
#pragma unroll
            for (int ks = 0; ks < 2; ++ks) {
                bf16x8 t;
#pragma unroll
                for (int j = 0; j < 8; ++j) t[j] = (short)f2bf(wp[(size_t)(32 * ks + 8 * quad + j) * 64 + 16 * (ntp + nt) + l16]);
                bw[nt][ks] = t;
            }
    }
    for (;;) {
      if (tid == 0) *slot = atomicAdd(ctr, 1u);
      __syncthreads();
      const int ent = (int)*slot;
      __syncthreads();
      if (ent >= M / 32) break;
      for (int it = ent * 2; it < ent * 2 + 2; ++it) {
        const int row0 = it * 16;
        const bool prm = row0 < MP;
        const int t0 = prm ? (row0 & (T - 1)) : 0;
        for (int idx = tid; idx < 31 * 64; idx += 512) {
            const int zr = idx >> 6, c4 = (idx & 63) * 4;
            f32x4 val = (f32x4){0.f, 0.f, 0.f, 0.f};
            if (zr >= 15) val = *(const f32x4*)(ub + (size_t)(row0 + zr - 15) * PW + c4);
            else if (prm) { if (t0 > 0) val = *(const f32x4*)(ub + (size_t)(row0 + zr - 15) * PW + c4); }
            else val = *(const f32x4*)(p.in[7] + ((size_t)(l * SB + ((row0 - MP) >> 4)) * 15 + zr) * PW + c4);
            *(LAS f32x4*)(z + zr * 256 + c4) = val;
        }
        __syncthreads();
        {
            const int row = tid >> 5, c0 = (tid & 31) * 8, gg = c0 >> 6, w = 2 << gg;
            f32x4 s0 = (f32x4){0.f, 0.f, 0.f, 0.f}, s1 = s0;
            for (int j = 0; j < w; ++j) { s0 += *(const LAS f32x4*)(z + (15 + row - j) * 256 + c0); s1 += *(const LAS f32x4*)(z + (15 + row - j) * 256 + c0 + 4); }
            float cnt = (float)w;
            if (prm) { const float pos1 = (float)(t0 + row + 1); cnt = fminf(pos1, cnt); }
            const float ic = 1.0f / cnt;
            const f32x4 u0 = *(const LAS f32x4*)(z + (15 + row) * 256 + c0), u1 = *(const LAS f32x4*)(z + (15 + row) * 256 + c0 + 4);
            s0 = s0 * ic - u0; s1 = s1 * ic - u1;
            u32x4 o; o.x = pk2(s0[0], s0[1]); o.y = pk2(s0[2], s0[3]); o.z = pk2(s1[0], s1[1]); o.w = pk2(s1[2], s1[3]);
            *(LAS u32x4*)(am + row * 264 + c0) = o;
        }
        __syncthreads();
        {
            f32x4 c[2] = {(f32x4){0.f, 0.f, 0.f, 0.f}, (f32x4){0.f, 0.f, 0.f, 0.f}};
#pragma unroll
            for (int ks = 0; ks < 2; ++ks) {
                const bf16x8 a = *(const LAS bf16x8*)(am + l16 * 264 + g * 64 + 32 * ks + 8 * quad);
#pragma unroll
                for (int nt = 0; nt < 2; ++nt) c[nt] = __builtin_amdgcn_mfma_f32_16x16x32_bf16(a, bw[nt][ks], c[nt], 0, 0, 0);
            }
#pragma unroll
            for (int nt = 0; nt < 2; ++nt) {
                const int col = g * 64 + 16 * (ntp + nt) + l16;
                const float ps = p.in[15][l * PW + col];
#pragma unroll
                for (int r = 0; r < 4; ++r) mix[(size_t)(row0 + quad * 4 + r) * D + col] = (bf16_t)f2bf(c[nt][r] * ps);
            }
        }
        __syncthreads();
      }
    }
}

__device__ __forceinline__ s16x4 vtr(const LAS unsigned char* ptr) { return __builtin_bit_cast(s16x4, __builtin_amdgcn_ds_read_tr16_b64_v4i16((LAS s16x4*)ptr)); }
constexpr int KP = 144;

__device__ __forceinline__ float xmax_q(float v) {
    auto a = __builtin_amdgcn_permlane16_swap(__float_as_uint(v), __float_as_uint(v), false, false);
    const float m = __builtin_fmaxf(__uint_as_float(a[0]), __uint_as_float(a[1]));
    auto b = __builtin_amdgcn_permlane32_swap(__float_as_uint(m), __float_as_uint(m), false, false);
    return __builtin_fmaxf(__uint_as_float(b[0]), __uint_as_float(b[1]));
}
__device__ __forceinline__ void attn_tile64(const LAS unsigned char* Kt, const LAS unsigned char* Vt, const LAS float* Ft, int key0, int Qw, bool diag,
                                            const bf16x8 (&qf)[2][2], const float (&fq)[2], float (&fqm)[2], float (&mrun)[2], float (&lrun)[2], f32x4 (&o)[4][2], int l16, int quad) {
    f32x4 s[4][2];
    bf16x8 kf[2][4]; f32x4 fk[4];
#pragma unroll
    for (int ks = 0; ks < 2; ++ks)
#pragma unroll
        for (int kt = 0; kt < 4; ++kt) kf[ks][kt] = *(const LAS bf16x8*)(Kt + (16 * kt + l16) * KP + ks * 64 + quad * 16);
#pragma unroll
    for (int kt = 0; kt < 4; ++kt) fk[kt] = *(const LAS f32x4*)(Ft + 16 * kt + 4 * quad);
    __builtin_amdgcn_sched_barrier(0);
#pragma unroll
    for (int kt = 0; kt < 4; ++kt)
#pragma unroll
        for (int qt = 0; qt < 2; ++qt) s[kt][qt] = (f32x4){fqm[qt] - fk[kt][0], fqm[qt] - fk[kt][1], fqm[qt] - fk[kt][2], fqm[qt] - fk[kt][3]};
#pragma unroll
    for (int ks = 0; ks < 2; ++ks)
#pragma unroll
        for (int kt = 0; kt < 4; ++kt)
#pragma unroll
            for (int qt = 0; qt < 2; ++qt) s[kt][qt] = __builtin_amdgcn_mfma_f32_16x16x32_bf16(kf[ks][kt], qf[qt][ks], s[kt][qt], 0, 0, 0);
    s16x4 va[2][4][2];
    {
        const LAS unsigned char* vb0 = Vt + (4 * quad + (l16 >> 2)) * KP + 8 * (l16 & 3);
#pragma unroll
        for (int k2 = 0; k2 < 2; ++k2)
#pragma unroll
            for (int dt = 0; dt < 4; ++dt) { va[k2][dt][0] = vtr(vb0 + 32 * k2 * KP + 32 * dt); va[k2][dt][1] = vtr(vb0 + (32 * k2 + 16) * KP + 32 * dt); }
    }
    __builtin_amdgcn_sched_barrier(0);
    if (diag) {
#pragma unroll
        for (int kt = 0; kt < 4; ++kt)
#pragma unroll
            for (int qt = 0; qt < 2; ++qt)
#pragma unroll
                for (int r = 0; r < 4; ++r) { const int key = key0 + 16 * kt + 4 * quad + r, qq = Qw + 16 * qt + l16; if (key > qq) s[kt][qt][r] = -INFINITY; }
    }
    float mx[2];
#pragma unroll
    for (int qt = 0; qt < 2; ++qt) {
        float a = __builtin_fmaxf(__builtin_fmaxf(s[0][qt][0], s[0][qt][1]), s[0][qt][2]), c = __builtin_fmaxf(__builtin_fmaxf(s[0][qt][3], s[1][qt][0]), s[1][qt][1]);
        a = __builtin_fmaxf(__builtin_fmaxf(a, s[1][qt][2]), s[1][qt][3]); c = __builtin_fmaxf(__builtin_fmaxf(c, s[2][qt][0]), s[2][qt][1]);
        a = __builtin_fmaxf(__builtin_fmaxf(a, s[2][qt][2]), s[2][qt][3]); c = __builtin_fmaxf(__builtin_fmaxf(c, s[3][qt][0]), s[3][qt][1]);
        a = __builtin_fmaxf(__builtin_fmaxf(a, s[3][qt][2]), s[3][qt][3]);
        float m_ = __builtin_fmaxf(a, c);
        mx[qt] = xmax_q(m_);
    }
    if (__any((mx[0] > 8.f) || (mx[1] > 8.f))) {
#pragma unroll
        for (int qt = 0; qt < 2; ++qt) {
            const float dl = __builtin_fmaxf(mx[qt], 0.f);
            mrun[qt] += dl; fqm[qt] = fq[qt] - mrun[qt];
            const float al = __builtin_amdgcn_exp2f(-dl);
            lrun[qt] *= al;
#pragma unroll
            for (int kt = 0; kt < 4; ++kt) s[kt][qt] -= dl;
#pragma unroll
            for (int dt = 0; dt < 4; ++dt) o[dt][qt] *= al;
        }
    }
#pragma unroll
    for (int qt = 0; qt < 2; ++qt) {
        float ps = 0.f;
#pragma unroll
        for (int kt = 0; kt < 4; ++kt)
#pragma unroll
            for (int r = 0; r < 4; ++r) { const float e = __builtin_amdgcn_exp2f(s[kt][qt][r]); s[kt][qt][r] = e; ps += e; }
        lrun[qt] += ps;
    }
#pragma unroll
    for (int k2 = 0; k2 < 2; ++k2) {
        bf16x8 pb[2];
#pragma unroll
        for (int qt = 0; qt < 2; ++qt) {
            u32x4 w; w.x = pk2(s[2 * k2][qt][0], s[2 * k2][qt][1]); w.y = pk2(s[2 * k2][qt][2], s[2 * k2][qt][3]);
            w.z = pk2(s[2 * k2 + 1][qt][0], s[2 * k2 + 1][qt][1]); w.w = pk2(s[2 * k2 + 1][qt][2], s[2 * k2 + 1][qt][3]);
            pb[qt] = __builtin_bit_cast(bf16x8, w);
        }
#pragma unroll
        for (int dt = 0; dt < 4; ++dt) {
            const s16x4 a0 = va[k2][dt][0], a1 = va[k2][dt][1];
            const bf16x8 vf = (bf16x8){a0[0], a0[1], a0[2], a0[3], a1[0], a1[1], a1[2], a1[3]};
#pragma unroll
            for (int qt = 0; qt < 2; ++qt) o[dt][qt] = __builtin_amdgcn_mfma_f32_16x16x32_bf16(vf, pb[qt], o[dt][qt], 0, 0, 0);
        }
    }
}

constexpr int TB = 128 * KP;
__device__ __forceinline__ void attn_prompt_unit(int b, int h, int qb, const bf16_t* Q, const bf16_t* Kb, const bf16_t* Vb, const float* F2, bf16_t* mix,
                                                 LAS unsigned char* lds, int tid, int lane, int wave) {
    const int l16 = lane & 15, quad = lane >> 4;
    const size_t rowbase = (size_t)b * T;
    const int Qw = qb * 256 + wave * 32;
    const float* Fh = F2 + (size_t)(b * NH + h) * T;
    bf16x8 qf[2][2]; float fq[2];
#pragma unroll
    for (int qt = 0; qt < 2; ++qt) {
#pragma unroll
        for (int ks = 0; ks < 2; ++ks) qf[qt][ks] = *(const bf16x8*)(Q + (rowbase + Qw + 16 * qt + l16) * AW + h * HD + 32 * ks + 8 * quad);
        fq[qt] = Fh[Qw + 16 * qt + l16];
    }
    f32x4 o[4][2];
#pragma unroll
    for (int dt = 0; dt < 4; ++dt) { o[dt][0] = (f32x4){0.f, 0.f, 0.f, 0.f}; o[dt][1] = o[dt][0]; }
    float mrun[2] = {0.f, 0.f}, lrun[2] = {0.f, 0.f}, fqm[2] = {fq[0], fq[1]};
    const int NT = 2 * qb + 2;
    LAS unsigned char* Kl = lds; LAS unsigned char* Vl = lds + 2 * TB; LAS float* Fl = (LAS float*)(lds + 4 * TB);
    const int skey = tid >> 3, sch = tid & 7;
    const bf16_t* kg = Kb + (rowbase + skey) * AW + h * HD + sch * 8;
    const bf16_t* vg = Vb + (rowbase + skey) * AW + h * HD + sch * 8;
    u32x4 kreg0 = *(const u32x4*)kg, kreg1 = *(const u32x4*)(kg + (size_t)64 * AW), vreg0 = *(const u32x4*)vg, vreg1 = *(const u32x4*)(vg + (size_t)64 * AW);
    f32x4 freg = (f32x4){0.f, 0.f, 0.f, 0.f};
    if (tid < 32) freg = *(const f32x4*)(Fh + tid * 4);
    const int soff = skey * KP + sch * 16;
    *(LAS u32x4*)(Kl + soff) = kreg0; *(LAS u32x4*)(Kl + 64 * KP + soff) = kreg1; *(LAS u32x4*)(Vl + soff) = vreg0; *(LAS u32x4*)(Vl + 64 * KP + soff) = vreg1;
    if (tid < 32) *(LAS f32x4*)(Fl + tid * 4) = freg;
    __syncthreads();
    for (int t = 0; t < NT; ++t) {
        const int buf = t & 1;
        if (t + 1 < NT) {
            const size_t go = (size_t)(t + 1) * 128 * AW;
            kreg0 = *(const u32x4*)(kg + go); kreg1 = *(const u32x4*)(kg + go + (size_t)64 * AW); vreg0 = *(const u32x4*)(vg + go); vreg1 = *(const u32x4*)(vg + go + (size_t)64 * AW);
            if (tid < 32) freg = *(const f32x4*)(Fh + (t + 1) * 128 + tid * 4);
        }
#pragma unroll
        for (int sub = 0; sub < 2; ++sub) {
            const int key0 = t * 128 + sub * 64;
            if (key0 <= Qw)
                attn_tile64(Kl + buf * TB + sub * 64 * KP, Vl + buf * TB + sub * 64 * KP, Fl + buf * 128 + sub * 64, key0, Qw, key0 + 63 > Qw, qf, fq, fqm, mrun, lrun, o, l16, quad);
        }
        if (t + 1 < NT) {
            const int nb = buf ^ 1;
            *(LAS u32x4*)(Kl + nb * TB + soff) = kreg0; *(LAS u32x4*)(Kl + nb * TB + 64 * KP + soff) = kreg1;
            *(LAS u32x4*)(Vl + nb * TB + soff) = vreg0; *(LAS u32x4*)(Vl + nb * TB + 64 * KP + soff) = vreg1;
            if (tid < 32) *(LAS f32x4*)(Fl + nb * 128 + tid * 4) = freg;
        }
        __syncthreads();
    }
#pragma unroll
    for (int qt = 0; qt < 2; ++qt) {
        float lt = lrun[qt]; lt += __shfl_xor(lt, 16); lt += __shfl_xor(lt, 32);
        const float il = 1.0f / lt;
        bf16_t* op = mix + (rowbase + Qw + 16 * qt + l16) * D + PW + h * HD + 4 * quad;
#pragma unroll
        for (int dt = 0; dt < 4; ++dt) {
            u32x2 w; w.x = pk2(o[dt][qt][0] * il, o[dt][qt][1] * il); w.y = pk2(o[dt][qt][2] * il, o[dt][qt][3] * il);
            *(u32x2*)(op + 16 * dt) = w;
        }
    }
}


namespace fa {
using f32x16 = __attribute__((ext_vector_type(16))) float;
constexpr int SEQ = T, DH = 64, DM = AW;
constexpr int NW = 8, QBLK = 32, QB = QBLK * NW, KVBLK = 64;
__device__ __forceinline__ int crow(int r, int hi) { return (r & 3) + 8 * (r >> 2) + 4 * hi; }
#define SBAR() __builtin_amdgcn_sched_barrier(0)
__device__ __forceinline__ void cmask(f32x16& p0, f32x16& p1, int jb, int qrel, int hi) {
    const float NEG = -INFINITY; int kb = 64 * jb + 4 * hi;
#pragma unroll
    for (int r = 0; r < 16; ++r) { int kv = kb + (r & 3) + 8 * (r >> 2); if (kv > qrel) p0[r] = NEG; if (kv + 32 > qrel) p1[r] = NEG; }
}
constexpr int NSLOT = 3, SLOTB = 8192;
constexpr int LDS_K = 0, LDS_V = NSLOT * SLOTB, LDS_WS = 2 * NSLOT * SLOTB, LDS_OST = LDS_WS + NW * 64 * 4, LDS_FK = LDS_OST + NW * 4096, LDS_END = LDS_FK + SEQ * 4;
__device__ __forceinline__ void glds16(const void* gsrc, unsigned lds_dst) { unsigned keep;
    asm volatile("s_mov_b32 %0, m0\n\ts_mov_b32 m0, %2\n\ts_nop 0\n\tglobal_load_lds_dwordx4 %1, off\n\ts_mov_b32 m0, %0" : "=&s"(keep) : "v"(gsrc), "s"(lds_dst) : "memory"); }
__device__ __forceinline__ float max3f(float a, float b, float c) { float r; asm("v_max3_f32 %0, %1, %2, %3" : "=v"(r) : "v"(a), "v"(b), "v"(c)); return r; }
__device__ __forceinline__ float max2f(float a, float b) { float r; asm("v_max_f32_e32 %0, %1, %2" : "=v"(r) : "v"(a), "v"(b)); return r; }
__device__ __forceinline__ float fadd_s(float a, float b) { float r; asm("v_add_f32_e32 %0, %1, %2" : "=v"(r) : "v"(a), "v"(b)); return r; }
__device__ __forceinline__ float fsub_s(float a, float b) { float r; asm("v_sub_f32_e32 %0, %1, %2" : "=v"(r) : "v"(a), "v"(b)); return r; }
__device__ __forceinline__ unsigned cvtpk_s(float lo, float hi) { return pk2(lo, hi); }
#define WAIT_BAR(N) asm volatile("s_waitcnt vmcnt(" #N ") lgkmcnt(0)\n\ts_barrier" ::: "memory")
typedef __attribute__((address_space(3))) const char* lds_cptr;
__device__ __forceinline__ void bias_half(f32x16& c, lds_cptr fkt, float cq, int hi) {
#pragma unroll
    for (int g = 0; g < 4; ++g) {
        const f32x4 a = *(const LAS f32x4*)(fkt + (8 * g + 4 * hi) * 4);
#pragma unroll
        for (int j = 0; j < 4; ++j) c[4 * g + j] = cq - a[j];
    }
}
__device__ __forceinline__ void bias_init(f32x16& c0, f32x16& c1, lds_cptr fkt, float cq, int hi) {
#pragma unroll
    for (int g = 0; g < 4; ++g) {
        const f32x4 a = *(const LAS f32x4*)(fkt + (8 * g + 4 * hi) * 4), b = *(const LAS f32x4*)(fkt + (32 + 8 * g + 4 * hi) * 4);
#pragma unroll
        for (int j = 0; j < 4; ++j) { c0[4 * g + j] = cq - a[j]; c1[4 * g + j] = cq - b[j]; }
    }
}
__device__ __forceinline__ void qkt(f32x16& p0, f32x16& p1, const char* Kslot, const bf16x8* qr, int r32, int hi) {
    const char* kb = Kslot + hi * 1024 + r32 * 16;
#pragma unroll
    for (int d0 = 0; d0 < 4; ++d0) {
        const bf16x8 b0 = *reinterpret_cast<const bf16x8*>(kb + d0 * 2048);
        const bf16x8 b1 = *reinterpret_cast<const bf16x8*>(kb + d0 * 2048 + 512);
        p0 = __builtin_amdgcn_mfma_f32_32x32x16_bf16(b0, qr[d0], p0, 0, 0, 0); p1 = __builtin_amdgcn_mfma_f32_32x32x16_bf16(b1, qr[d0], p1, 0, 0, 0); }
}
__device__ __forceinline__ void kload8(bf16x8* kf, lds_cptr kp) {
    kf[0] = *(const LAS bf16x8*)(kp);        kf[1] = *(const LAS bf16x8*)(kp + 512);
    kf[2] = *(const LAS bf16x8*)(kp + 2048); kf[3] = *(const LAS bf16x8*)(kp + 2560);
    kf[4] = *(const LAS bf16x8*)(kp + 4096); kf[5] = *(const LAS bf16x8*)(kp + 4608);
    kf[6] = *(const LAS bf16x8*)(kp + 6144); kf[7] = *(const LAS bf16x8*)(kp + 6656);
}
__device__ __forceinline__ void kload2(bf16x8* kf, lds_cptr kp, int j) { kf[2 * j] = *(const LAS bf16x8*)(kp + j * 2048); kf[2 * j + 1] = *(const LAS bf16x8*)(kp + j * 2048 + 512); }
__device__ __forceinline__ s16x4 vtr2(lds_cptr p) { return __builtin_bit_cast(s16x4, __builtin_amdgcn_ds_read_tr16_b64_v4i16((LAS s16x4*)p)); }
__device__ __forceinline__ float rowmax(const f32x16& p0, const f32x16& p1) {
    float a = max3f(p0[0], p0[1], p1[0]), b = max3f(p0[2], p0[3], p1[1]); a = max3f(a, p1[2], p1[3]);
#pragma unroll
    for (int r = 4; r < 16; r += 4) { a = max3f(a, p0[r], p0[r + 1]); b = max3f(b, p0[r + 2], p0[r + 3]); a = max3f(a, p1[r], p1[r + 1]); b = max3f(b, p1[r + 2], p1[r + 3]); }
    const float m = max2f(a, b);
    auto rr = __builtin_amdgcn_permlane32_swap(__float_as_uint(m), __float_as_uint(m), false, false);
    return max2f(__uint_as_float(rr[0]), __uint_as_float(rr[1]));
}
__device__ __forceinline__ void pv(f32x16* o, int vb, bf16x8 pa0, bf16x8 pa1, bf16x8 pa2, bf16x8 pa3) {
#pragma unroll
    for (int d0 = 0; d0 < 2; ++d0) { s16x4 lo[4], hi[4];
#pragma unroll
        for (int ks = 0; ks < 4; ++ks) {
            asm volatile("ds_read_b64_tr_b16 %0,%1 offset:%c2" : "=&v"(lo[ks]) : "v"(vb), "i"(d0 * 4096 + ks * 1024) : "memory");
            asm volatile("ds_read_b64_tr_b16 %0,%1 offset:%c2" : "=&v"(hi[ks]) : "v"(vb), "i"(d0 * 4096 + ks * 1024 + 512) : "memory"); }
        asm volatile("s_waitcnt lgkmcnt(0)" ::: "memory"); SBAR();
#define PK(k) (bf16x8){lo[k][0], lo[k][1], lo[k][2], lo[k][3], hi[k][0], hi[k][1], hi[k][2], hi[k][3]}
        o[d0] = __builtin_amdgcn_mfma_f32_32x32x16_bf16(pa0, PK(0), o[d0], 0, 0, 0);
        o[d0] = __builtin_amdgcn_mfma_f32_32x32x16_bf16(pa1, PK(1), o[d0], 0, 0, 0);
        o[d0] = __builtin_amdgcn_mfma_f32_32x32x16_bf16(pa2, PK(2), o[d0], 0, 0, 0);
        o[d0] = __builtin_amdgcn_mfma_f32_32x32x16_bf16(pa3, PK(3), o[d0], 0, 0, 0);
#undef PK
    }
}

template <int THRL> __device__ __forceinline__ void attn_unit(int b, int h, int qb, const bf16_t* Q, const bf16_t* __restrict__ K, const bf16_t* __restrict__ V, const float* F2, bf16_t* mix, char* shm, const int tid, const int t0) {
    const int lane = tid & 63, r32 = lane & 31, hi = lane >> 5; const int wid = __builtin_amdgcn_readfirstlane(tid >> 6);
    const long rowbase = (long)b * SEQ; const int q0 = qb * QB;
    const bf16_t* Qw = Q + (rowbase + q0 + wid * QBLK) * DM + h * DH;
    const bf16_t* Kh = K + (rowbase + t0 * KVBLK) * DM + h * DH, *Vh = V + (rowbase + t0 * KVBLK) * DM + h * DH;
    const float* Fh = F2 + (long)(b * NH + h) * SEQ;
    const unsigned lds0 = (unsigned)(uintptr_t)shm;
    float* wsf = (float*)(shm + LDS_WS) + wid * 64;
    { float* fl = (float*)(shm + LDS_FK); for (int i = t0 * KVBLK + tid * 4; i < q0 + QB; i += 2048) *(f32x4*)(fl + i - t0 * KVBLK) = *(const f32x4*)(Fh + i); }
    const float fq = Fh[q0 + wid * QBLK + r32];
    const bf16_t* ksrc = Kh + (long)lane * DM + wid * 8;
    const bf16_t* vsrc = Vh + (long)(16 * (wid & 3) + (lane >> 2)) * DM + (wid >> 2) * 32 + (lane & 3) * 8;
    const unsigned kdst = lds0 + LDS_K + wid * 1024, vdst = lds0 + LDS_V + wid * 1024;
#define DMA_K(t, slot) glds16(ksrc + (long)(t) * KVBLK * DM, (unsigned)__builtin_amdgcn_readfirstlane(kdst + (slot)))
#define DMA_V(t, slot) glds16(vsrc + (long)(t) * KVBLK * DM, (unsigned)__builtin_amdgcn_readfirstlane(vdst + (slot)))
    const int vb0 = (int)(lds0 + LDS_V) + ((lane >> 4) & 1) * 32 + (lane & 3) * 8 + (4 * hi + ((lane & 15) >> 2)) * 64;
    const char* Kbase = shm + LDS_K; bf16x8 kf[8];
    const lds_cptr shm3 = (lds_cptr)shm; const lds_cptr kp0 = shm3 + LDS_K + hi * 1024 + r32 * 16; const lds_cptr vp0 = shm3 + LDS_V + ((lane >> 4) & 1) * 32 + (lane & 3) * 8 + (4 * hi + ((lane & 15) >> 2)) * 64;
    const lds_cptr fk0 = shm3 + LDS_FK;
    const int NT = (q0 + QB) / KVBLK - t0;
    DMA_K(0, 0); DMA_V(0, 0); DMA_K(1, SLOTB);
    bf16x8 qr[4];
#pragma unroll
    for (int d0 = 0; d0 < 4; ++d0) qr[d0] = *reinterpret_cast<const bf16x8*>(&Qw[(long)r32 * DM + d0 * 16 + hi * 8]);
    float mhat = 0.f, l_reg = 0.f, cq = fq; f32x16 o[2]; o[0] = f32x16{}; o[1] = f32x16{};
    const int qrel = wid * QBLK + r32;
#define CMASK(P0, P1, t) do { int jb_ = (t) - (NT - 4); if (jb_ >= 0) cmask(P0, P1, jb_, qrel, hi); } while (0)
    bool resc = false;
#define START(P0, P1) do { const float rm = rowmax(P0, P1); resc = false; \
    { const float dl = rm; mhat = fadd_s(mhat, dl); \
      _Pragma("unroll") for (int r = 0; r < 16; ++r) { P0[r] = fsub_s(P0[r], dl); P1[r] = fsub_s(P1[r], dl); } \
      cq = fq - mhat; } \
    _Pragma("unroll") for (int r = 0; r < 16; ++r) P0[r] = __builtin_amdgcn_exp2f(P0[r]); } while (0)
#define RESC() do { if (resc) { asm volatile("s_waitcnt lgkmcnt(0)" ::: "memory"); \
      _Pragma("unroll") for (int d_ = 0; d_ < 2; ++d_) _Pragma("unroll") for (int r = 0; r < 16; ++r) o[d_][r] *= wsf[crow(r, hi)]; } } while (0)
    f32x16 pA0, pA1, pB0, pB1;
    int sl_prev = 0, sl_cur = 0, sl_next = SLOTB;
#define ROT() do { sl_prev = sl_cur; sl_cur = sl_next; sl_next = (sl_next == (NSLOT - 1) * SLOTB) ? 0 : sl_next + SLOTB; } while (0)
    DMA_K(2, 2 * SLOTB);
    WAIT_BAR(3);
    bias_init(pA0, pA1, fk0, cq, hi);
    qkt(pA0, pA1, Kbase, qr, r32, hi); asm volatile("s_nop 15\n\ts_nop 7" : "+v"(pA0), "+v"(pA1)); CMASK(pA0, pA1, 0);
    START(pA0, pA1);
    _Pragma("unroll") for (int r = 0; r < 16; ++r) pA1[r] = __builtin_amdgcn_exp2f(pA1[r]);
    WAIT_BAR(0);
    DMA_K(3, 0); DMA_V(1, SLOTB);
    ROT();
    kload8(kf, kp0 + sl_cur);
    WAIT_BAR(2);
    s16x4 vlo[8], vhi[8]; u32x4 pw0, pw1, pw2, pw3;
#define PKW(P, B) cvtpk_s(P[B], P[B + 1])
#define PAF(k) __builtin_bit_cast(bf16x8, pw##k)
#define VFR(i) (bf16x8){vlo[i][0], vlo[i][1], vlo[i][2], vlo[i][3], vhi[i][0], vhi[i][1], vhi[i][2], vhi[i][3]}
#define PIN(x) asm volatile("" : "+v"(x))
#define MX3(a, b, c) __builtin_fmaxf(__builtin_fmaxf((a), (b)), (c))
#define GAPA(MF, A0, A1, A2, A3, W0, W1, PW) do { MF; sacc += A0; sacc += A1; sacc += A2; sacc += A3; PIN(sacc); W0; W1; PIN(PW); SBAR(); } while (0)
#define EX(v) __builtin_amdgcn_exp2f(v)
#define GAPB(MF, X, B) do { MF; X[B] = EX(X[B]); X[B + 1] = EX(X[B + 1]); X[B + 2] = EX(X[B + 2]); X[B + 3] = EX(X[B + 3]); PIN(X); SBAR(); } while (0)
#define VRD(i) do { vlo[i] = vtr2(vp_ + (((i) >> 2) * 4096 + ((i) & 3) * 1024)); vhi[i] = vtr2(vp_ + (((i) >> 2) * 4096 + ((i) & 3) * 1024 + 512)); } while (0)
#define KRD(G, j) do { if (G) { kload2(kf, kp0 + sl_next, j); SBAR(); } } while (0)
#define STEP(C0, C1, P0, P1, t, GK, GV, GL) do { SBAR(); \
    bias_half(C0, fk0 + (t) * 256, cq, hi); SBAR(); \
    const lds_cptr vp_ = vp0 + sl_prev; \
    VRD(0); SBAR(); float sacc = (P0[0] + P0[1]); \
    GAPA(C0 = __builtin_amdgcn_mfma_f32_32x32x16_bf16(kf[0], qr[0], C0, 0, 0, 0), P0[2], P0[3], P0[4], P0[5],     pw0[0] = PKW(P0, 0), pw0[1] = PKW(P0, 2), pw0); \
    bias_half(C1, fk0 + (t) * 256 + 128, cq, hi); SBAR(); \
    VRD(4); SBAR(); GAPA(C1 = __builtin_amdgcn_mfma_f32_32x32x16_bf16(kf[1], qr[0], C1, 0, 0, 0), P0[6], P0[7], P0[8], P0[9],     pw0[2] = PKW(P0, 4), pw0[3] = PKW(P0, 6), pw0); \
    VRD(1); SBAR(); GAPA(C0 = __builtin_amdgcn_mfma_f32_32x32x16_bf16(kf[2], qr[1], C0, 0, 0, 0),   P0[10], P0[11], P0[12], P0[13], pw1[0] = PKW(P0, 8), pw1[1] = PKW(P0, 10), pw1); \
    VRD(5); SBAR(); GAPA(C1 = __builtin_amdgcn_mfma_f32_32x32x16_bf16(kf[3], qr[1], C1, 0, 0, 0),   P0[14], P0[15], P1[0], P1[1],   pw1[2] = PKW(P0, 12), pw1[3] = PKW(P0, 14), pw1); \
    VRD(2); SBAR(); GAPA(C0 = __builtin_amdgcn_mfma_f32_32x32x16_bf16(kf[4], qr[2], C0, 0, 0, 0),   P1[2], P1[3], P1[4], P1[5],     pw2[0] = PKW(P1, 0), pw2[1] = PKW(P1, 2), pw2); \
    VRD(6); SBAR(); GAPA(C1 = __builtin_amdgcn_mfma_f32_32x32x16_bf16(kf[5], qr[2], C1, 0, 0, 0),   P1[6], P1[7], P1[8], P1[9],     pw2[2] = PKW(P1, 4), pw2[3] = PKW(P1, 6), pw2); \
    VRD(3); SBAR(); GAPA(C0 = __builtin_amdgcn_mfma_f32_32x32x16_bf16(kf[6], qr[3], C0, 0, 0, 0),   P1[10], P1[11], P1[12], P1[13], pw3[0] = PKW(P1, 8), pw3[1] = PKW(P1, 10), pw3); \
    VRD(7); SBAR(); GAPA(C1 = __builtin_amdgcn_mfma_f32_32x32x16_bf16(kf[7], qr[3], C1, 0, 0, 0),   P1[14], P1[15], 0.f, 0.f,       pw3[2] = PKW(P1, 12), pw3[3] = PKW(P1, 14), pw3); \
    l_reg += sacc; \
    if (GK) { DMA_K((t) + 3, sl_cur); } if (GV) { DMA_V((t) + 1, sl_next); } \
    CMASK(C0, C1, t); \
    { float a = MX3(C0[0], C0[1], C1[0]), b = MX3(C0[2], C0[3], C1[1]); a = MX3(a, C1[2], C1[3]); \
      _Pragma("unroll") for (int r = 4; r < 16; r += 4) { a = MX3(a, C0[r], C0[r + 1]); b = MX3(b, C0[r + 2], C0[r + 3]); a = MX3(a, C1[r], C1[r + 1]); b = MX3(b, C1[r + 2], C1[r + 3]); } \
      float rm = __builtin_fmaxf(a, b); { auto rr = __builtin_amdgcn_permlane32_swap(__float_as_uint(rm), __float_as_uint(rm), false, false); rm = __builtin_fmaxf(__uint_as_float(rr[0]), __uint_as_float(rr[1])); } \
      resc = false; \
      if (__builtin_expect(__any(rm > (float)THRL), 0)) { const float dl = __builtin_fmaxf(rm, 0.f); mhat += dl; \
        _Pragma("unroll") for (int r = 0; r < 16; ++r) { C0[r] -= dl; C1[r] -= dl; } \
        cq = fq - mhat; \
        const float f = __builtin_amdgcn_exp2f(-dl); l_reg *= f; if (hi == 0) wsf[r32] = f; resc = true; } } \
    SBAR(); \
    GAPB(o[0] = __builtin_amdgcn_mfma_f32_32x32x16_bf16(PAF(0), VFR(0), o[0], 0, 0, 0), C0, 0); \
    GAPB(o[1] = __builtin_amdgcn_mfma_f32_32x32x16_bf16(PAF(0), VFR(4), o[1], 0, 0, 0), C0, 4); \
    KRD(GL, 0); GAPB(o[0] = __builtin_amdgcn_mfma_f32_32x32x16_bf16(PAF(1), VFR(1), o[0], 0, 0, 0), C0, 8); \
    KRD(GL, 1); GAPB(o[1] = __builtin_amdgcn_mfma_f32_32x32x16_bf16(PAF(1), VFR(5), o[1], 0, 0, 0), C0, 12); \
    KRD(GL, 2); GAPB(o[0] = __builtin_amdgcn_mfma_f32_32x32x16_bf16(PAF(2), VFR(2), o[0], 0, 0, 0), C1, 0); \
    KRD(GL, 3); GAPB(o[1] = __builtin_amdgcn_mfma_f32_32x32x16_bf16(PAF(2), VFR(6), o[1], 0, 0, 0), C1, 4); \
    GAPB(o[0] = __builtin_amdgcn_mfma_f32_32x32x16_bf16(PAF(3), VFR(3), o[0], 0, 0, 0), C1, 8); \
    GAPB(o[1] = __builtin_amdgcn_mfma_f32_32x32x16_bf16(PAF(3), VFR(7), o[1], 0, 0, 0), C1, 12); \
    } while (0)
    int t = 1;
#undef CMASK
#define CMASK(P0, P1, t) do { } while (0)
    for (; t + 5 < NT; t += 2) {
        STEP(pB0, pB1, pA0, pA1, t, true, true, true);     WAIT_BAR(2); RESC(); ROT();
        STEP(pA0, pA1, pB0, pB1, t + 1, true, true, true); WAIT_BAR(2); RESC(); ROT();
    }
#undef CMASK
#define CMASK(P0, P1, t) do { int jb_ = (t) - (NT - 4); if (jb_ >= 0) cmask(P0, P1, jb_, qrel, hi); } while (0)
#define ENDW(tt) do { if ((tt) + 3 < NT) { WAIT_BAR(2); } else if ((tt) + 2 < NT) { WAIT_BAR(1); } else { WAIT_BAR(0); } } while (0)
    for (; t + 1 < NT; t += 2) {
        STEP(pB0, pB1, pA0, pA1, t, (t + 3 < NT), (t + 1 < NT), (t + 1 < NT));       ENDW(t);     RESC(); ROT();
        STEP(pA0, pA1, pB0, pB1, t + 1, (t + 4 < NT), (t + 2 < NT), (t + 2 < NT)); ENDW(t + 1); RESC(); ROT();
    }
    STEP(pB0, pB1, pA0, pA1, NT - 1, false, false, false); RESC();
    { float sacc = pB0[0] + pB0[1]; _Pragma("unroll") for (int r = 2; r < 16; ++r) sacc += pB0[r]; _Pragma("unroll") for (int r = 0; r < 16; ++r) sacc += pB1[r]; l_reg += sacc;
      pw0 = (u32x4){PKW(pB0, 0), PKW(pB0, 2), PKW(pB0, 4), PKW(pB0, 6)}; pw1 = (u32x4){PKW(pB0, 8), PKW(pB0, 10), PKW(pB0, 12), PKW(pB0, 14)}; pw2 = (u32x4){PKW(pB1, 0), PKW(pB1, 2), PKW(pB1, 4), PKW(pB1, 6)}; pw3 = (u32x4){PKW(pB1, 8), PKW(pB1, 10), PKW(pB1, 12), PKW(pB1, 14)};
      SBAR(); pv(o, vb0 + sl_cur, PAF(0), PAF(1), PAF(2), PAF(3)); }
#undef PKW
#undef PAF
#undef VFR
#undef PIN
#undef MX3
#undef GAPA
#undef GAPB
#undef EX
#undef VRD
#undef KRD
#undef STEP
#undef ENDW
    { auto rr = __builtin_amdgcn_permlane32_swap(__float_as_uint(l_reg), __float_as_uint(l_reg), false, false); l_reg = __uint_as_float(rr[0]) + __uint_as_float(rr[1]); }
    if (hi == 0) wsf[32 + r32] = l_reg; asm volatile("s_waitcnt lgkmcnt(0)" ::: "memory");
    float rli[16];
#pragma unroll
    for (int r = 0; r < 16; ++r) rli[r] = __builtin_amdgcn_rcpf(wsf[32 + crow(r, hi)]);
    bf16_t* Ow = mix + (rowbase + q0 + wid * QBLK) * D + PW + h * DH;
    { bf16_t* stg = (bf16_t*)(shm + LDS_OST) + wid * 2048;
#pragma unroll
      for (int r = 0; r < 16; ++r) { const int orow = crow(r, hi);
#pragma unroll
        for (int d0 = 0; d0 < 2; ++d0) stg[orow * 64 + d0 * 32 + r32] = (bf16_t)f2bf(o[d0][r] * rli[r]); }
      asm volatile("s_waitcnt lgkmcnt(0)" ::: "memory");
#pragma unroll
      for (int i = 0; i < 4; ++i) { const int row = i * 8 + (lane >> 3), ch = lane & 7; const u32x4 v = *(const u32x4*)(stg + row * 64 + ch * 8); *(u32x4*)(Ow + (long)row * D + ch * 8) = v; } }
    asm volatile("s_waitcnt lgkmcnt(0)\n\ts_barrier" ::: "memory");
#undef DMA_K
#undef DMA_V
#undef CMASK
#undef START
#undef RESC
#undef ROT
}
#undef SBAR
#undef WAIT_BAR
}

__device__ __forceinline__ void attn_sample_unit(int l, int b, int h, const Params& p, LAS unsigned char* lds, int tid, int lane, int wave, float thr) {
    const int l16 = lane & 15, quad = lane >> 4;
    const bf16_t* Q = (const bf16_t*)(p.ws + WS_Q); const bf16_t* Kb = (const bf16_t*)(p.ws + WS_K); const bf16_t* Vb = (const bf16_t*)(p.ws + WS_V);
    bf16_t* mix = (bf16_t*)(p.ws + WS_MIX);
    const size_t row0 = (size_t)MP + b * ST;
    const float* Fh = (const float*)(p.ws + WS_FS) + (size_t)(b * NH + h) * SKEYS;
    bf16x8 qf[2];
#pragma unroll
    for (int ks = 0; ks < 2; ++ks) qf[ks] = *(const bf16x8*)(Q + (row0 + l16) * AW + h * HD + 32 * ks + 8 * quad);
    const float fq = Fh[PAST + l16];
    f32x4 o[4];
#pragma unroll
    for (int dt = 0; dt < 4; ++dt) o[dt] = (f32x4){0.f, 0.f, 0.f, 0.f};
    float mrun = -INFINITY, lrun = 0.f;
    const float* Kc = p.in[4] + ((size_t)(l * SB + b) * PAST) * AW + h * HD;
    const float* Vc = p.in[5] + ((size_t)(l * SB + b) * PAST) * AW + h * HD;
    LAS unsigned char* Vw = lds + wave * (64 * KP);
    f32x4 rk[2][2][2], rv[8], rf[2];
#define SAMPLE_LOAD(key0_) do { \
        _Pragma("unroll") for (int kt = 0; kt < 2; ++kt) _Pragma("unroll") for (int ks = 0; ks < 2; ++ks) { \
            const float* kp = Kc + (size_t)((key0_) + 16 * kt + l16) * AW + 32 * ks + 8 * quad; rk[kt][ks][0] = __builtin_nontemporal_load((const f32x4*)kp); rk[kt][ks][1] = __builtin_nontemporal_load((const f32x4*)(kp + 4)); } \
        _Pragma("unroll") for (int j = 0; j < 8; ++j) rv[j] = __builtin_nontemporal_load((const f32x4*)(Vc + (size_t)((key0_) + 4 * j + quad) * AW + 4 * l16)); \
        _Pragma("unroll") for (int kt = 0; kt < 2; ++kt) rf[kt] = *(const f32x4*)(Fh + (key0_) + 16 * kt + 4 * quad); } while (0)
    int ks;
    { const int j = lane & 15; const bool c = (j >= 1) && (Fh[256 * (j >= 1 ? j : 1) - 1] - Fh[PAST + vzero()] >= thr); ks = 256 * __popcll(__ballot(c && lane < 16)); }
    const int nst = (PAST - ks) >> 8;
    const int kbeg = ks + wave * nst * 32;
    SAMPLE_LOAD(kbeg);
    const int nsteps = nst + (wave == 7 ? 1 : 0);
    for (int step = 0; step < nsteps; ++step) {
        const bool isnew = step == nst;
        f32x4 s[2];
        bf16x8 kf[2][2];
        asm volatile("s_waitcnt lgkmcnt(0)" ::: "memory");
        if (!isnew) {
#pragma unroll
            for (int kt = 0; kt < 2; ++kt)
#pragma unroll
                for (int ks = 0; ks < 2; ++ks) {
                    const f32x4 a = rk[kt][ks][0], c = rk[kt][ks][1];
                    u32x4 w; w.x = pk2(a[0], a[1]); w.y = pk2(a[2], a[3]); w.z = pk2(c[0], c[1]); w.w = pk2(c[2], c[3]);
                    kf[kt][ks] = __builtin_bit_cast(bf16x8, w);
                }
#pragma unroll
            for (int j = 0; j < 8; ++j) {
                const int kr = 4 * j + quad;
                u32x2 w; w.x = pk2(rv[j][0], rv[j][1]); w.y = pk2(rv[j][2], rv[j][3]);
                *(LAS u32x2*)(Vw + kr * KP + 8 * l16) = w;
            }
#pragma unroll
            for (int kt = 0; kt < 2; ++kt) s[kt] = (f32x4){fq - rf[kt][0], fq - rf[kt][1], fq - rf[kt][2], fq - rf[kt][3]};
            if (step + 1 < nst) SAMPLE_LOAD(kbeg + (step + 1) * 32);
        } else {
#pragma unroll
            for (int ks = 0; ks < 2; ++ks) { kf[0][ks] = *(const bf16x8*)(Kb + (row0 + l16) * AW + h * HD + 32 * ks + 8 * quad); kf[1][ks] = (bf16x8){0, 0, 0, 0, 0, 0, 0, 0}; }
            {
                const int kr = lane >> 2, ch = lane & 3;
                const u32x4 a = *(const u32x4*)(Vb + (row0 + kr) * AW + h * HD + 16 * ch), c = *(const u32x4*)(Vb + (row0 + kr) * AW + h * HD + 16 * ch + 8);
                *(LAS u32x4*)(Vw + kr * KP + 32 * ch) = a; *(LAS u32x4*)(Vw + kr * KP + 32 * ch + 16) = c;
                *(LAS u32x4*)(Vw + (16 + kr) * KP + 32 * ch) = (u32x4){0u, 0u, 0u, 0u}; *(LAS u32x4*)(Vw + (16 + kr) * KP + 32 * ch + 16) = (u32x4){0u, 0u, 0u, 0u};
            }
            const f32x4 fk = *(const f32x4*)(Fh + PAST + 4 * quad);
            s[0] = (f32x4){fq - fk[0], fq - fk[1], fq - fk[2], fq - fk[3]};
            s[1] = (f32x4){-INFINITY, -INFINITY, -INFINITY, -INFINITY};
        }
#pragma unroll
        for (int ks = 0; ks < 2; ++ks) {
            s[0] = __builtin_amdgcn_mfma_f32_16x16x32_bf16(kf[0][ks], qf[ks], s[0], 0, 0, 0);
            if (!isnew) s[1] = __builtin_amdgcn_mfma_f32_16x16x32_bf16(kf[1][ks], qf[ks], s[1], 0, 0, 0);
        }
        if (isnew) {
#pragma unroll
            for (int r = 0; r < 4; ++r) if (4 * quad + r > l16) s[0][r] = -INFINITY;
        }
        float mx = fmaxf(fmaxf(s[0][0], s[0][1]), fmaxf(s[0][2], s[0][3]));
        mx = fmaxf(mx, fmaxf(fmaxf(s[1][0], s[1][1]), fmaxf(s[1][2], s[1][3])));
        mx = fmaxf(mx, __shfl_xor(mx, 16)); mx = fmaxf(mx, __shfl_xor(mx, 32));
        const float mnew = fmaxf(mrun, mx);
        const float alpha = __builtin_amdgcn_exp2f(mrun - mnew);
        mrun = mnew;
        float ps = 0.f;
#pragma unroll
        for (int kt = 0; kt < 2; ++kt)
#pragma unroll
            for (int r = 0; r < 4; ++r) { const float e = __builtin_amdgcn_exp2f(s[kt][r] - mnew); s[kt][r] = e; ps += e; }
        lrun = lrun * alpha + ps;
        u32x4 w; w.x = pk2(s[0][0], s[0][1]); w.y = pk2(s[0][2], s[0][3]); w.z = pk2(s[1][0], s[1][1]); w.w = pk2(s[1][2], s[1][3]);
        const bf16x8 pb = __builtin_bit_cast(bf16x8, w);
        asm volatile("s_waitcnt lgkmcnt(0)" ::: "memory");
        const LAS unsigned char* vb0 = Vw + (4 * quad + (l16 >> 2)) * KP + 8 * (l16 & 3);
#pragma unroll
        for (int dt = 0; dt < 4; ++dt) {
            const s16x4 a0 = vtr(vb0 + 32 * dt), a1 = vtr(vb0 + 16 * KP + 32 * dt);
            const bf16x8 vf = (bf16x8){a0[0], a0[1], a0[2], a0[3], a1[0], a1[1], a1[2], a1[3]};
            o[dt] = o[dt] * alpha;
            o[dt] = __builtin_amdgcn_mfma_f32_16x16x32_bf16(vf, pb, o[dt], 0, 0, 0);
        }
    }
#undef SAMPLE_LOAD
    float lt = lrun; lt += __shfl_xor(lt, 16); lt += __shfl_xor(lt, 32);
    LAS float* cm = (LAS float*)(lds + 8 * 64 * KP);
    LAS float* cl = cm + 128; LAS float* co = cl + 128;
    if (quad == 0) { cm[wave * 16 + l16] = mrun; cl[wave * 16 + l16] = lt; }
#pragma unroll
    for (int dt = 0; dt < 4; ++dt)
#pragma unroll
        for (int r = 0; r < 4; ++r) co[(wave * 16 + l16) * 64 + 16 * dt + 4 * quad + r] = o[dt][r];
    __syncthreads();
    {
        const int q = tid >> 5, d0 = (tid & 31) * 2;
        float mm = cm[q];
#pragma unroll
        for (int w = 1; w < 8; ++w) mm = fmaxf(mm, cm[w * 16 + q]);
        float L = 0.f, a0 = 0.f, a1 = 0.f;
#pragma unroll
        for (int w = 0; w < 8; ++w) { const float f = __builtin_amdgcn_exp2f(cm[w * 16 + q] - mm); L += cl[w * 16 + q] * f; a0 += co[(w * 16 + q) * 64 + d0] * f; a1 += co[(w * 16 + q) * 64 + d0 + 1] * f; }
        const float il = 1.0f / L;
        *(unsigned*)(mix + (row0 + q) * D + PW + h * HD + d0) = pk2(a0 * il, a1 * il);
    }
    __syncthreads();
}

__device__ __forceinline__ void phase_attn(const Params& p, LAS unsigned char* lds, int l, int ci, int mode, int tid, int lane, int wave) {
    unsigned* ctr = (unsigned*)(p.ws + WS_CTL) + 64 * ci;
    LAS unsigned* slot = (LAS unsigned*)(lds + LDS_BYTES - 64);
    char* lds_generic = (char*)lds;
    const bf16_t* Q = (const bf16_t*)(p.ws + WS_Q); const bf16_t* Kb = (const bf16_t*)(p.ws + WS_K); const bf16_t* Vb = (const bf16_t*)(p.ws + WS_V);
    const float* Fp = (const float*)(p.ws + WS_FP); bf16_t* mix = (bf16_t*)(p.ws + WS_MIX);
    float thr;
    {
        const float gq = fabsf(p.in[12][l * HD + lane]), gk = fabsf(p.in[13][l * HD + lane]);
        float mq = gq, mk = gk;
#pragma unroll
        for (int o = 1; o < 64; o <<= 1) { mq = fmaxf(mq, __shfl_xor(mq, o)); mk = fmaxf(mk, __shfl_xor(mk, o)); }
        thr = 53.f + 2.f * (64.f * mq * mk * C2 + 0.5f);
    }
    LAS unsigned* cnt = (LAS unsigned*)lds;
    LAS unsigned* keys = (LAS unsigned*)(lds + 1024);
    LAS unsigned short* order = (LAS unsigned short*)(lds + fa::LDS_END);
    const float* Fs = (const float*)(p.ws + WS_FS);
    for (int i = tid; i < 216; i += 512) cnt[i] = 0u;
    __syncthreads();
    for (int i = tid; i < 24 * 124; i += 512) { const int bh = i / 124, j = i % 124 + 1; const float* Fh = Fp + (size_t)bh * T; if (Fh[64 * j - 1] - Fh[31 * 256] >= thr) atomicAdd((unsigned*)(cnt + bh), 1u); }
    for (int i = tid; i < 192 * 15; i += 512) { const int si = i / 15, j = i % 15 + 1; const float* Fh = Fs + (size_t)si * SKEYS; if (Fh[256 * j - 1] - Fh[PAST] >= thr) atomicAdd((unsigned*)(cnt + 24 + si), 1u); }
    __syncthreads();
    for (int id = tid; id < 1024; id += 512) {
        unsigned key = 0u;
        if (id < 768) { const int bh = id >> 5, qb = id & 31, w = 124 - (int)(cnt[bh] & ~1u); int t0a = 4 * qb - w; t0a = t0a > 0 ? (t0a & ~1) : 0;
            key = ((unsigned)(4 * (qb + 1) - t0a + 3) << 10) | (unsigned)(1023 - id); }
        else if (id < 960) { const int nst = 16 - (int)cnt[24 + id - 768]; key = ((unsigned)(5 + (10 * nst) / 3) << 10) | (unsigned)(1023 - id); }
        keys[id] = key;
    }
    __syncthreads();
    {
        const unsigned k0 = keys[tid], k1 = keys[tid + 512]; unsigned p0 = 0u, p1 = 0u;
        for (int k = 0; k < 1024; k += 4) { const u32x4 v = *(const LAS u32x4*)(keys + k);
            p0 += (v.x > k0) + (v.y > k0) + (v.z > k0) + (v.w > k0); p1 += (v.x > k1) + (v.y > k1) + (v.z > k1) + (v.w > k1); }
        order[p0] = (unsigned short)tid;
        if (tid + 512 < 960) order[p1] = (unsigned short)(tid + 512);
    }
    __syncthreads();
    for (;;) {
        if (tid == 0) *slot = atomicAdd(ctr, 1u);
        __syncthreads();
        const int idx = (int)*slot;
        __syncthreads();
        if (idx >= 960) break;
        const int id = (int)order[idx];
        const int tf = fresh_tid(), lf = tf & 63, wf = __builtin_amdgcn_readfirstlane(tf >> 6);
        if (id >= 768) { if (mode == 1) continue; const int si = id - 768; attn_sample_unit(l, si / NH, si % NH, p, lds, tf, lf, wf, thr); }
        else { if (mode == 2) continue; const int bh = id >> 5, qb = id & 31;
            int t0;
            { const float* Fh = Fp + (size_t)bh * T; const float f0 = Fh[qb * 256 + vzero()];
              const int ja = lf + 1, jb2 = lf + 65, jmax = 4 * qb;
              const bool ca = (ja <= jmax) && (Fh[64 * (ja <= jmax ? ja : 1) - 1] - f0 >= thr), cb = (jb2 <= jmax) && (Fh[64 * (jb2 <= jmax ? jb2 : 1) - 1] - f0 >= thr);
              t0 = (__popcll(__ballot(ca)) + __popcll(__ballot(cb))) & ~1; }
            fa::attn_unit<8>(bh / NH, bh % NH, qb, Q, Kb, Vb, Fp, mix, lds_generic, tf, t0);
        }
    }
    if (mode == 0) { const int tf = fresh_tid(); pool_items(p, lds, l, ctr + 8, slot, tf, tf & 63, __builtin_amdgcn_readfirstlane(tf >> 6)); }
}

#define XB_XCNT(j) (1024 + 64 * (j))
#define XB_XSUB(j) (2048 + 64 * (j))
#define XB_XGEN(j) (3072 + 64 * (j))
#define XB_TOP 4096
#define XB_TOPGEN 4160
__device__ __forceinline__ unsigned xb_ld(unsigned* p) { return __hip_atomic_load(p, __ATOMIC_RELAXED, __HIP_MEMORY_SCOPE_AGENT); }
__device__ __forceinline__ unsigned xb_add(unsigned* p, unsigned v) { return __hip_atomic_fetch_add(p, v, __ATOMIC_RELAXED, __HIP_MEMORY_SCOPE_AGENT); }
__device__ __forceinline__ unsigned xcc_id() { return (unsigned)__builtin_amdgcn_s_getreg((3 << 11) | 20) & 0xFu; }
__device__ __forceinline__ void grid_bar(unsigned* bar, volatile LAS unsigned* st) {
    asm volatile("s_waitcnt vmcnt(0)" ::: "memory");
    __syncthreads();
    if (threadIdx.x == 0) {
        __builtin_amdgcn_s_waitcnt(0);
        const unsigned x = xcc_id(), nloc = st[0], nx = st[1];
        const unsigned old = xb_add(&bar[XB_XSUB(x)], 1u);
        const unsigned gen = old / nloc;
        if (old + 1u == (gen + 1u) * nloc) {
            __builtin_amdgcn_fence(__ATOMIC_RELEASE, "agent");
            asm volatile("s_waitcnt vmcnt(0)" ::: "memory");
            const unsigned og = xb_add(&bar[XB_TOP], 1u);
            const unsigned tg = og / nx;
            if (og + 1u == (tg + 1u) * nx) xb_add(&bar[XB_TOPGEN], 1u);
            else { while (xb_ld(&bar[XB_TOPGEN]) == tg) __builtin_amdgcn_s_sleep(1); }
            __builtin_amdgcn_fence(__ATOMIC_ACQUIRE, "agent");
            xb_add(&bar[XB_XGEN(x)], 1u);
            asm volatile("s_waitcnt vmcnt(0)" ::: "memory");
        } else {
            while (xb_ld(&bar[XB_XGEN(x)]) == gen) __builtin_amdgcn_s_sleep(1);
            __builtin_amdgcn_fence(__ATOMIC_ACQUIRE, "agent");
            asm volatile("s_waitcnt vmcnt(0)" ::: "memory");
        }
    }
    __syncthreads();
}
#define FRESH_TID() fresh_tid()
#define TLW(t) (t), ((t) & 63), __builtin_amdgcn_readfirstlane((t) >> 6)
__global__ void __launch_bounds__(512, 2) fwd_megakernel(Params p) {
    extern __shared__ __attribute__((aligned(16))) unsigned char lds_raw[];
    LAS unsigned char* lds = (LAS unsigned char*)lds_raw;
    cg::grid_group grid = cg::this_grid();
    const int G = gridDim.x;

    unsigned* bar_w = (unsigned*)(p.ws + WS_CTL);
    if (threadIdx.x == 0) (void)xb_add(&bar_w[XB_XCNT(xcc_id())], 1u);
    { const int t_ = FRESH_TID(); phase_prologue(p, lds, TLW(t_)); }

#ifdef XSYNC
    for (int i = 0; i < XSYNC; ++i) grid.sync();
#endif
    volatile LAS unsigned* bar_st = (volatile LAS unsigned*)(lds + LDS_BYTES - 32);
    if (threadIdx.x == 0) {
        unsigned mine, cnt, sum; const unsigned x = xcc_id();
        for (;;) {
            mine = 0u; cnt = 0u; sum = 0u;
            for (unsigned j = 0; j < 16; ++j) { const unsigned c = xb_ld(&bar_w[XB_XCNT(j)]); sum += c; cnt += (c > 0u) ? 1u : 0u; mine = (j == x) ? c : mine; }
            if (sum == (unsigned)G) break;
            __builtin_amdgcn_s_sleep(1);
        }
        bar_st[0] = mine; bar_st[1] = cnt;
    }
    __syncthreads();
#define GB() grid_bar(bar_w, bar_st)
    if (G == 0x7fffffff) grid.sync();
    GB();
    float* xa = (float*)(p.ws + WS_XA); float* xb = (float*)(p.ws + WS_XB);
    bf16_t* hn = (bf16_t*)(p.ws + WS_HN);
    for (int l = 0; l < 2; ++l) {
        const float* xp = (l == 0) ? p.in[0] : xb; const float* xs = (l == 0) ? p.in[1] : xb + (size_t)MP * D;
        float* yp = (l == 0) ? xb : p.out; float* ys = yp + (size_t)MP * D;
        const float* modl = (const float*)(p.ws + WS_MOD) + (size_t)l * NMODROW * MODW;
        for (int rep = 0; rep < NREP(0); ++rep) {
            { const int t_ = FRESH_TID(); phase_norm(p, lds, l, 1, xp, xs, TLW(t_)); }
            GB();
        }
        for (int rep = 0; rep < NREP(1); ++rep) {
            pg8::Gemm g{hn, (const bf16_t*)(p.ws + WS_WIN) + (size_t)l * NMAIN * D, M, NMAIN, D};
            pg8::StaticOrder S; S.init(MP, NMAIN, G, (int)blockIdx.x);
            EpiIn E{l, p.out, (bf16_t*)(p.ws + WS_Q), (bf16_t*)(p.ws + WS_K), (bf16_t*)(p.ws + WS_V), (float*)(p.ws + WS_U), p.in[12] + l * HD, p.in[13] + l * HD};
            pg8::gemm_phase<EpiIn, true, true>(lds, g, S, E, FRESH_TID());
            { SEpiIn SE{l, p.out, (bf16_t*)(p.ws + WS_Q), (bf16_t*)(p.ws + WS_K), (bf16_t*)(p.ws + WS_V), (float*)(p.ws + WS_U), p.in[12] + l * HD, p.in[13] + l * HD};
              const int t_ = FRESH_TID(); skinny_phase<SEpiIn>(lds, g.A, g.Bt, NMAIN, D, SE, TLW(t_)); }
            { const int t_ = FRESH_TID(); scan_items(p, lds, l, TLW(t_)); }
            if (l == 0 && rep == 0) {
                for (int ll = 0; ll < 2; ++ll) { SEpiBias SE{(float*)(p.ws + WS_BIAS2) + (size_t)ll * NMODROW * FF}; const int t_ = FRESH_TID();
                    skinny_phase<SEpiBias>(lds, (const bf16_t*)(p.ws + WS_SH2) + (size_t)ll * 32 * D, (const bf16_t*)(p.ws + WS_WUP) + (size_t)ll * FF * D, FF, D, SE, TLW(t_), 0, 2); }
            }
            GB();
        }
        for (int rep = 0; rep < NREP(3); ++rep) {
            { const int t_ = FRESH_TID(); phase_attn(p, lds, l, l * 2 + rep, rep == 0 ? 0 : ATT_DUP_MODE, TLW(t_)); }
            GB();
        }
        for (int rep = 0; rep < NREP(4); ++rep) {
            pg8::Gemm g{(const bf16_t*)(p.ws + WS_MIX), (const bf16_t*)(p.ws + WS_WOUT) + (size_t)l * D * D, M, D, D};
            pg8::StaticOrder S; S.init(MP, D, G, (int)blockIdx.x);
            EpiResN E{xp, xa, modl + 2 * D, modl + 4 * D, hn, (float*)(p.ws + WS_SS)};
            pg8::gemm_phase<EpiResN, false, true>(lds, g, S, E, FRESH_TID());
            { SEpiResN SE{xs, xa + (size_t)MP * D, modl + 2 * D, modl + 4 * D, hn, (float*)(p.ws + WS_SS)}; const int t_ = FRESH_TID(); skinny_phase<SEpiResN>(lds, g.A, g.Bt, D, D, SE, TLW(t_)); }
            GB();
        }
        for (int rep = 0; rep < NREP(6); ++rep) {
            pg8::Gemm g{hn, (const bf16_t*)(p.ws + WS_WUP) + (size_t)l * FF * D, M, FF, D};
            pg8::StaticOrder S; S.init(MP, FF, G, (int)blockIdx.x);
            const float* bias_l = (const float*)(p.ws + WS_BIAS2) + (size_t)l * NMODROW * FF;
            EpiUpN E{(bf16_t*)(p.ws + WS_HID), (const float*)(p.ws + WS_SS), bias_l};
            pg8::gemm_phase<EpiUpN, true, true>(lds, g, S, E, FRESH_TID());
            { SEpiUpN SE{(bf16_t*)(p.ws + WS_HID), (const float*)(p.ws + WS_SS), bias_l}; const int t_ = FRESH_TID(); skinny_phase<SEpiUpN, 4>(lds, g.A, g.Bt, FF, D, SE, TLW(t_)); }
            GB();
        }
        for (int rep = 0; rep < NREP(7); ++rep) {
            pg8::Gemm g{(const bf16_t*)(p.ws + WS_HID), (const bf16_t*)(p.ws + WS_WDN) + (size_t)l * D * FF, M, D, FF};
            pg8::StaticOrder S; S.init(MP, D, G, (int)blockIdx.x);
            EpiRes E{xa, xa + (size_t)MP * D, yp, ys, modl + 5 * D};
            pg8::gemm_phase<EpiRes, false, true>(lds, g, S, E, FRESH_TID());
            { SEpiRes SE{xa + (size_t)MP * D, ys, modl + 5 * D}; const int t_ = FRESH_TID(); skinny_phase<SEpiRes>(lds, g.A, g.Bt, D, FF, SE, TLW(t_)); }
            if (l == 0 || rep + 1 < NREP(7)) GB();
        }
    }
}

extern "C" void kernel_launch(void* const* d_in, const int* in_sizes, int n_in, void* d_out, int out_size, void* d_ws, size_t ws_size, hipStream_t stream) {
    static int grid = 0;
    if (grid == 0) {
        if (n_in != 19 || (size_t)out_size != OUT_TOTAL || ws_size < WS_END) { fprintf(stderr, "kernel_launch: unexpected shapes (n_in %d out %d ws %zu)\n", n_in, out_size, ws_size); grid = -1; return; }
        int dev = 0, cus = 0, per_cu = 0;
        hipGetDevice(&dev);
        hipDeviceGetAttribute(&cus, hipDeviceAttributeMultiprocessorCount, dev);
        hipFuncSetAttribute((const void*)fwd_megakernel, hipFuncAttributeMaxDynamicSharedMemorySize, LDS_BYTES);
        hipOccupancyMaxActiveBlocksPerMultiprocessor(&per_cu, (const void*)fwd_megakernel, 512, LDS_BYTES);
        if (per_cu < 1) { fprintf(stderr, "kernel_launch: occupancy query says %d blocks per CU\n", per_cu); per_cu = 1; }
        grid = cus;
    }
    if (grid < 0) return;
    hipMemsetAsync((char*)d_ws + WS_CTL, 0, 20480, stream);
    Params p{};
    for (int i = 0; i < 19; ++i) p.in[i] = (const float*)d_in[i];
    p.out = (float*)d_out; p.ws = (unsigned char*)d_ws;
    void* args[] = {&p};
    hipError_t e = hipLaunchCooperativeKernel((const void*)fwd_megakernel, dim3(grid), dim3(512), args, LDS_BYTES, stream);
    if (e != hipSuccess) fprintf(stderr, "cooperative launch failed: %s (grid %d)\n", hipGetErrorString(e), grid);
}
```

```cpp
#include <hip/hip_runtime.h>
#include <hip/hip_cooperative_groups.h>
#include <cstdio>
#include <cstdint>
namespace cg = cooperative_groups;

#define LAS __attribute__((address_space(3)))
typedef unsigned short bf16_t;
typedef short bf16x8 __attribute__((ext_vector_type(8)));
typedef short s16x4 __attribute__((ext_vector_type(4)));
typedef float f32x4 __attribute__((ext_vector_type(4)));
typedef float f32x2 __attribute__((ext_vector_type(2)));
typedef unsigned u32x4 __attribute__((ext_vector_type(4)));
typedef unsigned u32x2 __attribute__((ext_vector_type(2)));

constexpr int D = 1024, T = 8192, NBP = 2, SB = 16, ST = 16, PAST = 4096;
constexpr int MP = NBP * T, MS = SB * ST, M = MP + MS;
constexpr int NH = 12, HD = 64, AW = 768, PW = 256, INC = 2572, NMAIN = 2560, FF = 4096;
constexpr int NMODROW = 18, MODW = 6 * D;
constexpr float EPS = 1e-6f;
constexpr float LOG2E = 1.4426950408889634f;
constexpr float C2 = 0.125f * LOG2E;
constexpr int SKEYS = PAST + ST;

constexpr size_t OFF_Y = 0;
constexpr size_t OFF_KP = (size_t)M * D;
constexpr size_t OFF_VP = OFF_KP + (size_t)2 * MP * AW;
constexpr size_t OFF_FP = OFF_VP + (size_t)2 * MP * AW;
constexpr size_t OFF_PP = OFF_FP + (size_t)2 * MP * NH;
constexpr size_t OFF_KS = OFF_PP + (size_t)2 * NBP * 15 * PW;
constexpr size_t OFF_VS = OFF_KS + (size_t)2 * MS * AW;
constexpr size_t OFF_FS = OFF_VS + (size_t)2 * MS * AW;
constexpr size_t OFF_PS = OFF_FS + (size_t)2 * MS * NH;
constexpr size_t OUT_TOTAL = OFF_PS + (size_t)2 * SB * 15 * PW;

constexpr size_t MiB = 1u << 20;
constexpr size_t WS_CTL = 0;
constexpr size_t WS_MOD = 1 * MiB;
constexpr size_t WS_WIN = 2 * MiB;
constexpr size_t WS_WOUT = 12 * MiB;
constexpr size_t WS_WUP = 16 * MiB;
constexpr size_t WS_WDN = 32 * MiB;
constexpr size_t WS_HN = 48 * MiB;
constexpr size_t WS_Q = 82 * MiB;
constexpr size_t WS_K = 108 * MiB;
constexpr size_t WS_V = 134 * MiB;
constexpr size_t WS_U = 160 * MiB;
constexpr size_t WS_MIX = 178 * MiB;
constexpr size_t WS_FP = 212 * MiB;
constexpr size_t WS_FS = 213 * MiB;
constexpr size_t WS_SS = 217 * MiB;
constexpr size_t WS_BIAS2 = WS_SS + 128 * 1024;
constexpr size_t WS_SH2 = WS_BIAS2 + 640 * 1024;
constexpr size_t WS_XA = 218 * MiB;
constexpr size_t WS_XB = 284 * MiB;
constexpr size_t WS_HID = 350 * MiB;
constexpr size_t WS_END = 482 * MiB;

constexpr int LDS_BYTES = 147456;
#ifndef DUP
#define DUP 0
#endif
#define NREP(k) (1 + ((DUP >> (k)) & 1))
#ifndef ATT_DUP_MODE
#define ATT_DUP_MODE 0
#endif

__device__ __forceinline__ unsigned f2bf(float f) { unsigned u = __builtin_bit_cast(unsigned, f); return (u + 0x7fffu + ((u >> 16) & 1u)) >> 16; }
typedef __bf16 bf16x2_t __attribute__((ext_vector_type(2)));
__device__ __forceinline__ unsigned pk2(float lo, float hi) { const f32x2 v = {lo, hi}; const bf16x2_t b = __builtin_convertvector(v, bf16x2_t); return __builtin_bit_cast(unsigned, b); }
template <int CTRL> __device__ __forceinline__ float dpp_f(float v) { return __builtin_bit_cast(float, __builtin_amdgcn_update_dpp(0, __builtin_bit_cast(int, v), CTRL, 0xF, 0xF, false)); }
__device__ __forceinline__ float quad_sum(float v) {
    auto a = __builtin_amdgcn_permlane16_swap(__float_as_uint(v), __float_as_uint(v), false, false);
    const float s = __uint_as_float(a[0]) + __uint_as_float(a[1]);
    auto b = __builtin_amdgcn_permlane32_swap(__float_as_uint(s), __float_as_uint(s), false, false);
    return __uint_as_float(b[0]) + __uint_as_float(b[1]);
}
__device__ __forceinline__ float wave_sum(float v) {
    v += dpp_f<0x128>(v); v += dpp_f<0x124>(v); v += dpp_f<0x122>(v); v += dpp_f<0x121>(v);
    return quad_sum(v);
}

__device__ __forceinline__ int vzero() { int z = 0; asm volatile("" : "+v"(z)); return z; }
__device__ __forceinline__ int fresh_tid() { int t = threadIdx.x; asm volatile("" : "+v"(t)); return t; }
namespace pg8 {
constexpr int BM = 256, BK = 64, HALF = 128, HTB = HALF * BK * 2, NXCD = 8, WGM = 8;
__host__ __device__ __forceinline__ int lds_byte(int r, int c) { const int st = (r >> 4) * 2 + (c >> 5), rr = r & 15, cc = c & 31, ob = rr * 64 + cc * 2; return st * 1024 + (ob ^ (((ob >> 9) & 1) << 5)); }
__host__ __device__ __forceinline__ void stage_rc(int b, int& R, int& C) { const int st = b / 1024, sb = b % 1024, swz = sb ^ (((sb >> 9) & 1) << 5); R = (st >> 1) * 16 + swz / 64; C = (st & 1) * 32 + (swz % 64) / 2; }
__host__ __device__ __forceinline__ int perm32(int rho) { const int n = rho >> 4, i = rho & 15; return 8 * (i >> 2) + 4 * n + (i & 3); }

struct Unit { int pm, pn; };
struct Gemm { const bf16_t* A; const bf16_t* Bt; int M, N, K; };

struct StaticOrder {
    int nM, nN, nwg, G, c;
    __device__ void init(int M_, int N_, int G_, int c_) { nM = M_ / BM; nN = N_ / BM; nwg = nM * nN; G = G_; c = c_; }
    __device__ bool next(int i, Unit& u) const {
        const long L = (long)i * G + c; if (L >= nwg) return false;
        int wgid = (int)L; { const int q = nwg / NXCD, r = nwg % NXCD, xcd = wgid % NXCD, off = wgid / NXCD; wgid = (xcd < r ? xcd * (q + 1) : r * (q + 1) + (xcd - r) * q) + off; }
        const int nig = WGM * nN, gid = wgid / nig, fm = gid * WGM, gsz = (nM - fm) < WGM ? (nM - fm) : WGM;
        u.pm = fm + ((wgid % nig) % gsz); u.pn = (wgid % nig) / gsz; return true;
    }
};

template <class Epi, bool ALIGN_EPI, bool SP2>
__device__ __forceinline__ void gemm_phase(LAS unsigned char* lds, const Gemm g, const StaticOrder& S, const Epi& E, const int tid) {
    const int wid = __builtin_amdgcn_readfirstlane(tid >> 6), lane = tid & 63, wr = wid >> 2, wc = wid & 3, fr = lane & 15, fq = lane >> 4;
    const int K = g.K, nt = K / BK;
    unsigned voffA[2], voffB[2];
#pragma unroll
    for (int i = 0; i < 2; ++i) { int R, C; stage_rc(tid * 16 + i * 8192, R, C); const int Rb = 64 * (R >> 5) + perm32(R & 31);
        voffA[i] = (unsigned)(R * K + C) * 2u; voffB[i] = (unsigned)(Rb * K + C) * 2u; }
    const size_t kstep = (size_t)(BK * 2);
    const size_t hstep = (size_t)HALF * K * 2;
    const size_t hstepB = (size_t)32 * K * 2;
    const size_t tstep = 2 * hstep;
    const unsigned ldsw = (unsigned)wid * 1024u;
    const int aoff = lds_byte(wr * 64 + fr, fq * 8), boff = lds_byte(wc * 32 + fr, fq * 8);
#define PG8_SA(b, h) (((b) * 2 + (h)) * HTB)
#define PG8_SB(b, h) ((4 + (b) * 2 + (h)) * HTB)
#define PG8_STAGE(bufoff, gbase, voff) do { _Pragma("unroll") for (int _i = 0; _i < 2; ++_i) \
        __builtin_amdgcn_global_load_lds((const unsigned*)((const char*)(gbase) + (voff)[_i]), (LAS unsigned*)(lds + (bufoff) + ldsw + _i * 8192), 16, 0, 0); } while (0)
#define PG8_LDA(dst, b, h) do { _Pragma("unroll") for (int m = 0; m < 4; ++m) _Pragma("unroll") for (int k = 0; k < 2; ++k) dst[m][k] = *(const LAS bf16x8*)(lds + PG8_SA(b, h) + aoff + m * 2048 + k * 1024); } while (0)
#define PG8_LDB(dst, b, h) do { _Pragma("unroll") for (int n = 0; n < 2; ++n) _Pragma("unroll") for (int k = 0; k < 2; ++k) dst[n][k] = *(const LAS bf16x8*)(lds + PG8_SB(b, h) + boff + n * 2048 + k * 1024); } while (0)
#define PG8_MMA(ai, bj, At, Bt) do { __builtin_amdgcn_s_setprio(1); _Pragma("unroll") for (int m = 0; m < 4; ++m) _Pragma("unroll") for (int n = 0; n < 2; ++n) _Pragma("unroll") for (int k = 0; k < 2; ++k) \
        acc[ai][bj][m][n] = __builtin_amdgcn_mfma_f32_16x16x32_bf16(Bt[n][k], At[m][k], acc[ai][bj][m][n], 0, 0, 0); __builtin_amdgcn_s_setprio(0); } while (0)
#define PG8_WAIT_V(n) asm volatile("s_waitcnt vmcnt(" #n ")" ::: "memory")
#define PG8_WAIT_L(n) asm volatile("s_waitcnt lgkmcnt(" #n ")" ::: "memory")
#define PG8_BAR __builtin_amdgcn_s_barrier()
#define PG8_SCHED __builtin_amdgcn_sched_barrier(0)
    Unit cur, nxt; int ui = 0;
    if (!S.next(0, cur)) return;
    f32x4 acc[2][2][4][2];
#pragma unroll
    for (int a = 0; a < 2; ++a)
#pragma unroll
        for (int b = 0; b < 2; ++b)
#pragma unroll
            for (int m = 0; m < 4; ++m)
#pragma unroll
                for (int n = 0; n < 2; ++n) acc[a][b][m][n] = (f32x4){0.f, 0.f, 0.f, 0.f};
    bf16x8 At[4][2], B0[2][2], B1[2][2];
    const char* cA = (const char*)g.A + (size_t)cur.pm * tstep; const char* cB = (const char*)g.Bt + (size_t)cur.pn * tstep;
    if constexpr (SP2) {
        PG8_STAGE(PG8_SB(0, 0), cB, voffB); PG8_STAGE(PG8_SB(0, 1), cB + hstepB, voffB); PG8_STAGE(PG8_SA(0, 0), cA, voffA); PG8_STAGE(PG8_SA(0, 1), cA + hstep, voffA);
        if (wr == 1) PG8_BAR;
        PG8_WAIT_V(2); PG8_BAR;
        PG8_STAGE(PG8_SB(1, 0), cB + kstep, voffB); PG8_STAGE(PG8_SA(1, 0), cA + kstep, voffA); PG8_STAGE(PG8_SB(1, 1), cB + hstepB + kstep, voffB);
        PG8_WAIT_V(6); PG8_BAR;
    } else {
    PG8_STAGE(PG8_SB(0, 0), cB, voffB); PG8_STAGE(PG8_SA(0, 0), cA, voffA); PG8_STAGE(PG8_SB(0, 1), cB + hstepB, voffB); PG8_STAGE(PG8_SA(0, 1), cA + hstep, voffA);
    if (wr == 1) PG8_BAR;
    PG8_WAIT_V(4); PG8_BAR;
    PG8_STAGE(PG8_SB(1, 0), cB + kstep, voffB); PG8_STAGE(PG8_SA(1, 0), cA + kstep, voffA); PG8_STAGE(PG8_SB(1, 1), cB + hstepB + kstep, voffB);
    PG8_WAIT_V(6); PG8_BAR;
    }
    for (;;) {
        const bool has_next = S.next(ui + 1, nxt);
        const char* nA = has_next ? (const char*)g.A + (size_t)nxt.pm * tstep : cA; const char* nB = has_next ? (const char*)g.Bt + (size_t)nxt.pn * tstep : cB;
        for (int t = 0; t < nt; t += 2) {
            const bool last = (t == nt - 2);
            const char* a1 = cA + (size_t)(t + 1) * kstep;
            const char* a2 = last ? nA : cA + (size_t)(t + 2) * kstep; const char* b2 = last ? nB : cB + (size_t)(t + 2) * kstep;
            const char* a3 = a2 + kstep; const char* b3 = b2 + kstep;
            if constexpr (SP2) {
            PG8_LDB(B0, 0, 0); PG8_LDB(B1, 0, 1); PG8_SCHED; PG8_LDA(At, 0, 0); PG8_STAGE(PG8_SA(1, 1), a1 + hstep, voffA);
            PG8_WAIT_V(8); PG8_WAIT_L(0); PG8_BAR; PG8_MMA(0, 0, At, B0); PG8_MMA(0, 1, At, B1); PG8_BAR; PG8_SCHED;
            PG8_LDA(At, 0, 1); PG8_STAGE(PG8_SB(0, 0), b2, voffB); PG8_STAGE(PG8_SB(0, 1), b2 + hstepB, voffB); PG8_STAGE(PG8_SA(0, 0), a2, voffA);
            PG8_WAIT_V(8); PG8_WAIT_L(0); PG8_BAR; PG8_MMA(1, 0, At, B0); PG8_MMA(1, 1, At, B1); PG8_BAR; PG8_SCHED;
            PG8_LDB(B0, 1, 0); PG8_LDB(B1, 1, 1); PG8_SCHED; PG8_LDA(At, 1, 0); PG8_STAGE(PG8_SA(0, 1), a2 + hstep, voffA);
            PG8_WAIT_V(8); PG8_WAIT_L(0); PG8_BAR; PG8_MMA(0, 0, At, B0); PG8_MMA(0, 1, At, B1); PG8_BAR; PG8_SCHED;
            PG8_LDA(At, 1, 1); PG8_STAGE(PG8_SB(1, 0), b3, voffB); PG8_STAGE(PG8_SB(1, 1), b3 + hstepB, voffB); PG8_STAGE(PG8_SA(1, 0), a3, voffA);
            PG8_WAIT_V(8); PG8_WAIT_L(0); PG8_BAR; PG8_MMA(1, 0, At, B0); PG8_MMA(1, 1, At, B1); PG8_BAR; PG8_SCHED;
            } else {
            PG8_LDB(B0, 0, 0); PG8_SCHED; PG8_LDA(At, 0, 0); PG8_STAGE(PG8_SA(1, 1), a1 + hstep, voffA);
            PG8_WAIT_L(8); PG8_BAR; PG8_WAIT_L(0); PG8_MMA(0, 0, At, B0); PG8_BAR; PG8_SCHED;
            PG8_LDB(B1, 0, 1); PG8_STAGE(PG8_SB(0, 0), b2, voffB);
            PG8_BAR; PG8_WAIT_L(0); PG8_MMA(0, 1, At, B1); PG8_BAR;
            PG8_LDA(At, 0, 1); PG8_STAGE(PG8_SA(0, 0), a2, voffA);
            PG8_BAR; PG8_WAIT_L(0); PG8_MMA(1, 0, At, B0); PG8_BAR; PG8_SCHED;
            PG8_STAGE(PG8_SB(0, 1), b2 + hstepB, voffB);
            PG8_WAIT_V(6); PG8_BAR; PG8_MMA(1, 1, At, B1); PG8_BAR;
            PG8_LDB(B0, 1, 0); PG8_SCHED; PG8_LDA(At, 1, 0); PG8_STAGE(PG8_SA(0, 1), a2 + hstep, voffA);
            PG8_WAIT_L(8); PG8_BAR; PG8_WAIT_L(0); PG8_MMA(0, 0, At, B0); PG8_BAR; PG8_SCHED;
            PG8_LDB(B1, 1, 1); PG8_STAGE(PG8_SB(1, 0), b3, voffB);
            PG8_BAR; PG8_WAIT_L(0); PG8_MMA(0, 1, At, B1); PG8_BAR;
            PG8_LDA(At, 1, 1); PG8_STAGE(PG8_SA(1, 0), a3, voffA);
            PG8_BAR; PG8_WAIT_L(0); PG8_MMA(1, 0, At, B0); PG8_BAR; PG8_SCHED;
            PG8_STAGE(PG8_SB(1, 1), b3 + hstepB, voffB);
            PG8_WAIT_V(6); PG8_BAR; PG8_MMA(1, 1, At, B1); PG8_BAR;
            }
        }
        if constexpr (ALIGN_EPI) { if (wr == 0) PG8_BAR; }
        E(acc, cur, wr, wc, fr, fq);
        if (!has_next) break;
#pragma unroll
        for (int a = 0; a < 2; ++a)
#pragma unroll
            for (int b = 0; b < 2; ++b)
#pragma unroll
                for (int m = 0; m < 4; ++m)
#pragma unroll
                    for (int n = 0; n < 2; ++n) acc[a][b][m][n] = (f32x4){0.f, 0.f, 0.f, 0.f};
        cur = nxt; cA = nA; cB = nB; ++ui;
        if constexpr (ALIGN_EPI) { if (wr == 1) PG8_BAR; }
    }
    PG8_WAIT_V(0);
    if constexpr (!ALIGN_EPI) { if (wr == 0) PG8_BAR; }
    PG8_BAR;
#undef PG8_SA
#undef PG8_SB
#undef PG8_STAGE
#undef PG8_LDA
#undef PG8_LDB
#undef PG8_MMA
#undef PG8_WAIT_V
#undef PG8_WAIT_L
#undef PG8_BAR
#undef PG8_SCHED
}
}

__device__ __forceinline__ void st_bf16x8(bf16_t* p, f32x4 a, f32x4 b) {
    u32x4 w; w.x = pk2(a[0], a[1]); w.y = pk2(a[2], a[3]); w.z = pk2(b[0], b[1]); w.w = pk2(b[2], b[3]);
    *(u32x4*)p = w;
}
__device__ __forceinline__ int brow_of(int r) { return r < MP ? (r >> 13) : 2 + ((r - MP) >> 4); }

struct EpiIn {
    int l; float* out; bf16_t* qb; bf16_t* kb; bf16_t* vb; float* ub; const float* qg; const float* kg;
    __device__ __forceinline__ void operator()(const f32x4 (&acc)[2][2][4][2], const pg8::Unit& u, int wr, int wc, int fr, int fq) const {
        const int pn = u.pn, rbase = u.pm * 256 + wr * 64 + fr;
        if (pn == 0) {
            const int cb = 64 * wc + 8 * fq;
#pragma unroll
            for (int ai = 0; ai < 2; ++ai)
#pragma unroll
                for (int m = 0; m < 4; ++m) {
                    const int r = rbase + ai * 128 + m * 16;
                    float* up = ub + (size_t)r * PW + cb;
                    float* sp = nullptr;
                    if (r < MP) { const int t = r & (T - 1); if (t >= T - 15) sp = out + OFF_PP + ((size_t)((l * NBP + (r >> 13)) * 15 + (t - (T - 15)))) * PW + cb; }
                    else { const int rr = r - MP, t = rr & 15; if (t >= 1) sp = out + OFF_PS + ((size_t)((l * SB + (rr >> 4)) * 15 + (t - 1))) * PW + cb; }
#pragma unroll
                    for (int bj = 0; bj < 2; ++bj) {
                        *(f32x4*)(up + 32 * bj) = acc[ai][bj][m][0]; *(f32x4*)(up + 32 * bj + 4) = acc[ai][bj][m][1];
                        if (sp) { *(f32x4*)(sp + 32 * bj) = acc[ai][bj][m][0]; *(f32x4*)(sp + 32 * bj + 4) = acc[ai][bj][m][1]; }
                    }
                }
        } else if (pn <= 6) {
            const bool isq = pn <= 3;
            const int head = ((pn - 1) % 3) * 4 + wc;
            const float* gp = (isq ? qg : kg) + 8 * fq;
            f32x4 gv[2][2];
#pragma unroll
            for (int bj = 0; bj < 2; ++bj)
#pragma unroll
                for (int n = 0; n < 2; ++n) gv[bj][n] = *(const f32x4*)(gp + 32 * bj + 4 * n);
            bf16_t* dst = isq ? qb : kb;
#pragma unroll
            for (int ai = 0; ai < 2; ++ai)
#pragma unroll
                for (int m = 0; m < 4; ++m) {
                    const int r = rbase + ai * 128 + m * 16;
                    float ss = 0.f;
#pragma unroll
                    for (int bj = 0; bj < 2; ++bj)
#pragma unroll
                        for (int n = 0; n < 2; ++n) { const f32x4 a = acc[ai][bj][m][n]; ss += (a[0] * a[0] + a[1] * a[1]) + (a[2] * a[2] + a[3] * a[3]); }
                    ss = quad_sum(ss);
                    float rinv = 1.0f / sqrtf(ss * (1.f / 64.f) + EPS);
                    const float rq = isq ? rinv * C2 : rinv;
                    float* ko = nullptr;
                    if (!isq) ko = out + (r < MP ? OFF_KP + ((size_t)l * MP + r) * AW : OFF_KS + ((size_t)l * MS + (r - MP)) * AW) + head * 64 + 8 * fq;
#pragma unroll
                    for (int bj = 0; bj < 2; ++bj) {
                        const f32x4 n0 = acc[ai][bj][m][0] * rinv * gv[bj][0], n1 = acc[ai][bj][m][1] * rinv * gv[bj][1];
                        if (isq) { const f32x4 s0 = acc[ai][bj][m][0] * rq * gv[bj][0], s1 = acc[ai][bj][m][1] * rq * gv[bj][1];
                            st_bf16x8(dst + (size_t)r * AW + head * 64 + 32 * bj + 8 * fq, s0, s1); }
                        else { st_bf16x8(dst + (size_t)r * AW + head * 64 + 32 * bj + 8 * fq, n0, n1);
                            *(f32x4*)(ko + 32 * bj) = n0; *(f32x4*)(ko + 32 * bj + 4) = n1; }
                    }
                }
        } else {
            const int head = (pn - 7) * 4 + wc;
#pragma unroll
            for (int ai = 0; ai < 2; ++ai)
#pragma unroll
                for (int m = 0; m < 4; ++m) {
                    const int r = rbase + ai * 128 + m * 16;
                    float* vo = out + (r < MP ? OFF_VP + ((size_t)l * MP + r) * AW : OFF_VS + ((size_t)l * MS + (r - MP)) * AW) + head * 64 + 8 * fq;
#pragma unroll
                    for (int bj = 0; bj < 2; ++bj) {
                        st_bf16x8(vb + (size_t)r * AW + head * 64 + 32 * bj + 8 * fq, acc[ai][bj][m][0], acc[ai][bj][m][1]);
                        *(f32x4*)(vo + 32 * bj) = acc[ai][bj][m][0]; *(f32x4*)(vo + 32 * bj + 4) = acc[ai][bj][m][1];
                    }
                }
        }
    }
};

struct EpiRes {
    const float* xip; const float* xis; float* xop; float* xos; const float* gate;
    __device__ __forceinline__ void operator()(const f32x4 (&acc)[2][2][4][2], const pg8::Unit& u, int wr, int wc, int fr, int fq) const {
        const int rbase = u.pm * 256 + wr * 64 + fr, cb = u.pn * 256 + 64 * wc + 8 * fq;
        const float* gp = gate + (size_t)((u.pm * 256) >> 13) * MODW + cb;
        constexpr int DEPTH = 3;
        f32x4 gg[2][2], xq[DEPTH][2][2];
#pragma unroll
        for (int bj = 0; bj < 2; ++bj)
#pragma unroll
            for (int n = 0; n < 2; ++n) gg[bj][n] = *(const f32x4*)(gp + 32 * bj + 4 * n);
#pragma unroll
        for (int d = 0; d < DEPTH; ++d) { const int r2 = rbase + (d >> 2) * 128 + (d & 3) * 16;
#pragma unroll
            for (int bj = 0; bj < 2; ++bj)
#pragma unroll
                for (int n = 0; n < 2; ++n) xq[d][bj][n] = *(const f32x4*)(xip + (size_t)r2 * D + cb + 32 * bj + 4 * n); }
#pragma unroll
        for (int it = 0; it < 8; ++it) {
            const int ai = it >> 2, m = it & 3, r = rbase + ai * 128 + m * 16;
            f32x4 xc[2][2];
#pragma unroll
            for (int bj = 0; bj < 2; ++bj)
#pragma unroll
                for (int n = 0; n < 2; ++n) xc[bj][n] = xq[it % DEPTH][bj][n];
            if (it + DEPTH < 8) { const int r2 = rbase + ((it + DEPTH) >> 2) * 128 + ((it + DEPTH) & 3) * 16;
#pragma unroll
                for (int bj = 0; bj < 2; ++bj)
#pragma unroll
                    for (int n = 0; n < 2; ++n) xq[it % DEPTH][bj][n] = *(const f32x4*)(xip + (size_t)r2 * D + cb + 32 * bj + 4 * n); }
            float* xo = xop + (size_t)r * D + cb;
#pragma unroll
            for (int bj = 0; bj < 2; ++bj)
#pragma unroll
                for (int n = 0; n < 2; ++n) *(f32x4*)(xo + 32 * bj + 4 * n) = xc[bj][n] + gg[bj][n] * acc[ai][bj][m][n];
            __builtin_amdgcn_sched_barrier(0);
        }
    }
};

struct EpiUp {
    bf16_t* hid;
    __device__ __forceinline__ void operator()(const f32x4 (&acc)[2][2][4][2], const pg8::Unit& u, int wr, int wc, int fr, int fq) const {
        const int rbase = u.pm * 256 + wr * 64 + fr, cb = u.pn * 256 + 64 * wc + 8 * fq;
#pragma unroll
        for (int ai = 0; ai < 2; ++ai)
#pragma unroll
            for (int m = 0; m < 4; ++m) {
                const int r = rbase + ai * 128 + m * 16;
#pragma unroll
                for (int bj = 0; bj < 2; ++bj) {
                    f32x4 a = acc[ai][bj][m][0], b = acc[ai][bj][m][1];
#pragma unroll
                    for (int j = 0; j < 4; ++j) { const float x = fmaxf(a[j], 0.f), y = fmaxf(b[j], 0.f); a[j] = x * x; b[j] = y * y; }
                    st_bf16x8(hid + (size_t)r * FF + cb + 32 * bj, a, b);
                }
            }
    }
};

template <class SEpi>
__device__ __forceinline__ void skinny_phase(LAS unsigned char* lds, const bf16_t* A, const bf16_t* Bt, int N, int K, const SEpi& E, int tid, int lane, int wave, int row0 = MP, int nrg = 16) {
    const int l16 = lane & 15, quad = lane >> 4;
    const int nr2 = nrg >> 1, nitems = nr2 * (N / 64);
    LAS float* red = (LAS float*)lds;
    const int kw = K / 8;
    const int G_ = (int)gridDim.x, b_ = (int)blockIdx.x;
    const int vb = (G_ % 8 == 0 && nr2 == 8 && nitems <= 2 * G_ && nitems != 320) ? (b_ % 8) * (G_ / 8) + b_ / 8 : G_ - 1 - b_;
    for (int it = vb; it < nitems; it += G_) {
        const int rg2 = it % nr2, cg = it / nr2;
        const bf16_t* ap = A + (size_t)(row0 + 32 * rg2 + l16) * K + wave * kw + quad * 8;
        const bf16_t* bp = Bt + (size_t)(cg * 64 + l16) * K + wave * kw + quad * 8;
        f32x4 acc[2][4];
#pragma unroll
        for (int h = 0; h < 2; ++h)
#pragma unroll
            for (int nt = 0; nt < 4; ++nt) acc[h][nt] = (f32x4){0.f, 0.f, 0.f, 0.f};
        for (int k0 = 0; k0 < kw; k0 += 128) {
            bf16x8 a0[4], a1[4], b[4][4];
#pragma unroll
            for (int s = 0; s < 4; ++s) {
                a0[s] = *(const bf16x8*)(ap + k0 + 32 * s); a1[s] = *(const bf16x8*)(ap + (size_t)16 * K + k0 + 32 * s);
#pragma unroll
                for (int nt = 0; nt < 4; ++nt) b[s][nt] = *(const bf16x8*)(bp + (size_t)nt * 16 * K + k0 + 32 * s);
            }
#pragma unroll
            for (int s = 0; s < 4; ++s)
#pragma unroll
                for (int nt = 0; nt < 4; ++nt) { acc[0][nt] = __builtin_amdgcn_mfma_f32_16x16x32_bf16(a0[s], b[s][nt], acc[0][nt], 0, 0, 0);
                    acc[1][nt] = __builtin_amdgcn_mfma_f32_16x16x32_bf16(a1[s], b[s][nt], acc[1][nt], 0, 0, 0); }
        }
#pragma unroll
        for (int h = 0; h < 2; ++h)
#pragma unroll
            for (int nt = 0; nt < 4; ++nt)
#pragma unroll
                for (int r = 0; r < 4; ++r) red[(wave * 32 + 16 * h + quad * 4 + r) * 64 + 16 * nt + l16] = acc[h][nt][r];
        __syncthreads();
        const int row = tid >> 5, c2 = (tid & 31) * 2;
#pragma unroll
        for (int h = 0; h < 2; ++h) {
            float v0 = 0.f, v1 = 0.f;
#pragma unroll
            for (int w = 0; w < 8; ++w) { const f32x2 t = *(const LAS f32x2*)(red + (w * 32 + 16 * h + row) * 64 + c2); v0 += t.x; v1 += t.y; }
            E(2 * rg2 + h, row, cg, c2, v0, v1);
        }
        __syncthreads();
    }
}

struct SEpiIn {
    int l; float* out; bf16_t* qb; bf16_t* kb; bf16_t* vb; float* ub; const float* qg; const float* kg;
    __device__ __forceinline__ void operator()(int b, int t, int cg, int c2, float v0, float v1) const {
        const int rr = 16 * b + t; const size_t r = (size_t)MP + rr;
        if (cg < 4) {
            const int c = cg * 64 + c2;
            *(f32x2*)(ub + r * PW + c) = (f32x2){v0, v1};
            if (t >= 1) *(f32x2*)(out + OFF_PS + ((size_t)((l * SB + b) * 15 + (t - 1))) * PW + c) = (f32x2){v0, v1};
        } else if (cg < 28) {
            const bool isq = cg < 16; const int head = isq ? cg - 4 : cg - 16;
            float ss = v0 * v0 + v1 * v1;
#pragma unroll
            for (int o = 1; o < 32; o <<= 1) ss += __shfl_xor(ss, o);
            const float rinv = 1.0f / sqrtf(ss * (1.f / 64.f) + EPS);
            const float* gp = (isq ? qg : kg) + c2;
            const float n0 = v0 * rinv * gp[0], n1 = v1 * rinv * gp[1];
            if (isq) *(unsigned*)(qb + r * AW + head * 64 + c2) = pk2(n0 * C2, n1 * C2);
            else { *(unsigned*)(kb + r * AW + head * 64 + c2) = pk2(n0, n1); *(f32x2*)(out + OFF_KS + ((size_t)l * MS + rr) * AW + head * 64 + c2) = (f32x2){n0, n1}; }
        } else {
            const int head = cg - 28;
            *(unsigned*)(vb + r * AW + head * 64 + c2) = pk2(v0, v1);
            *(f32x2*)(out + OFF_VS + ((size_t)l * MS + rr) * AW + head * 64 + c2) = (f32x2){v0, v1};
        }
    }
};
struct SEpiRes {
    const float* xis; float* xos; const float* gate;
    __device__ __forceinline__ void operator()(int b, int t, int cg, int c2, float v0, float v1) const {
        const size_t o = (size_t)(16 * b + t) * D + cg * 64 + c2;
        const f32x2 xv = *(const f32x2*)(xis + o), gg = *(const f32x2*)(gate + (size_t)(2 + b) * MODW + cg * 64 + c2);
        *(f32x2*)(xos + o) = (f32x2){xv.x + gg.x * v0, xv.y + gg.y * v1};
    }
};
struct SEpiUp {
    bf16_t* hid;
    __device__ __forceinline__ void operator()(int b, int t, int cg, int c2, float v0, float v1) const {
        const float x = fmaxf(v0, 0.f), y = fmaxf(v1, 0.f);
        *(unsigned*)(hid + ((size_t)MP + 16 * b + t) * FF + cg * 64 + c2) = pk2(x * x, y * y);
    }
};


struct EpiResN {
    const float* xip; float* xop; const float* gate; const float* sc2; bf16_t* xt; float* ss;
    __device__ __forceinline__ void operator()(const f32x4 (&acc)[2][2][4][2], const pg8::Unit& u, int wr, int wc, int fr, int fq) const {
        const int rbase = u.pm * 256 + wr * 64 + fr, cb = u.pn * 256 + 64 * wc + 8 * fq;
        const int brow = (u.pm * 256) >> 13;
        const float* gp = gate + (size_t)brow * MODW + cb; const float* sp = sc2 + (size_t)brow * MODW + cb;
        constexpr int DEPTH = 2;
        f32x4 gg[2][2], sv[2][2], xq[DEPTH][2][2];
#pragma unroll
        for (int bj = 0; bj < 2; ++bj)
#pragma unroll
            for (int n = 0; n < 2; ++n) { gg[bj][n] = *(const f32x4*)(gp + 32 * bj + 4 * n); sv[bj][n] = *(const f32x4*)(sp + 32 * bj + 4 * n) + 1.0f; }
#pragma unroll
        for (int d = 0; d < DEPTH; ++d) { const int r2 = rbase + (d >> 2) * 128 + (d & 3) * 16;
#pragma unroll
            for (int bj = 0; bj < 2; ++bj)
#pragma unroll
                for (int n = 0; n < 2; ++n) xq[d][bj][n] = *(const f32x4*)(xip + (size_t)r2 * D + cb + 32 * bj + 4 * n); }
#pragma unroll
        for (int it = 0; it < 8; ++it) {
            const int ai = it >> 2, m = it & 3, r = rbase + ai * 128 + m * 16;
            f32x4 xc[2][2];
#pragma unroll
            for (int bj = 0; bj < 2; ++bj)
#pragma unroll
                for (int n = 0; n < 2; ++n) xc[bj][n] = xq[it % DEPTH][bj][n];
            if (it + DEPTH < 8) { const int r2 = rbase + ((it + DEPTH) >> 2) * 128 + ((it + DEPTH) & 3) * 16;
#pragma unroll
                for (int bj = 0; bj < 2; ++bj)
#pragma unroll
                    for (int n = 0; n < 2; ++n) xq[it % DEPTH][bj][n] = *(const f32x4*)(xip + (size_t)r2 * D + cb + 32 * bj + 4 * n); }
            float* xo = xop + (size_t)r * D + cb;
            float s = 0.f;
#pragma unroll
            for (int bj = 0; bj < 2; ++bj) {
                f32x4 t[2];
#pragma unroll
                for (int n = 0; n < 2; ++n) {
                    const f32x4 x1 = xc[bj][n] + gg[bj][n] * acc[ai][bj][m][n];
                    *(f32x4*)(xo + 32 * bj + 4 * n) = x1;
                    s += (x1[0] * x1[0] + x1[1] * x1[1]) + (x1[2] * x1[2] + x1[3] * x1[3]);
                    t[n] = x1 * sv[bj][n];
                }
                st_bf16x8(xt + (size_t)r * D + cb + 32 * bj, t[0], t[1]);
            }
            s = quad_sum(s);
            if (fq == 0) atomicAdd(ss + r, s);
            __builtin_amdgcn_sched_barrier(0);
        }
    }
};
struct SEpiResN {
    const float* xis; float* xos; const float* gate; const float* sc2; bf16_t* xt; float* ss;
    __device__ __forceinline__ void operator()(int b, int t, int cg, int c2, float v0, float v1) const {
        const int rr = 16 * b + t; const size_t o = (size_t)rr * D + cg * 64 + c2;
        const f32x2 xv = *(const f32x2*)(xis + o), gg = *(const f32x2*)(gate + (size_t)(2 + b) * MODW + cg * 64 + c2), sv = *(const f32x2*)(sc2 + (size_t)(2 + b) * MODW + cg * 64 + c2);
        const float a0 = xv.x + gg.x * v0, a1 = xv.y + gg.y * v1;
        *(f32x2*)(xos + o) = (f32x2){a0, a1};
        *(unsigned*)(xt + ((size_t)MP + rr) * D + cg * 64 + c2) = pk2(a0 * (sv.x + 1.0f), a1 * (sv.y + 1.0f));
        float s = a0 * a0 + a1 * a1;
#pragma unroll
        for (int q = 1; q < 32; q <<= 1) s += __shfl_xor(s, q);
        if ((c2 >> 1) == 0) atomicAdd(ss + MP + rr, s);
    }
};
struct EpiUpN {
    bf16_t* hid; const float* ss; const float* bias;
    __device__ __forceinline__ void operator()(const f32x4 (&acc)[2][2][4][2], const pg8::Unit& u, int wr, int wc, int fr, int fq) const {
        const int rbase = u.pm * 256 + wr * 64 + fr, cb = u.pn * 256 + 64 * wc + 8 * fq;
        const float* bp = bias + (size_t)((u.pm * 256) >> 13) * FF + cb;
        f32x4 bv[2][2];
#pragma unroll
        for (int bj = 0; bj < 2; ++bj)
#pragma unroll
            for (int n = 0; n < 2; ++n) bv[bj][n] = *(const f32x4*)(bp + 32 * bj + 4 * n);
#pragma unroll
        for (int ai = 0; ai < 2; ++ai)
#pragma unroll
            for (int m = 0; m < 4; ++m) {
                const int r = rbase + ai * 128 + m * 16;
                const float rinv = 1.0f / sqrtf(ss[r] * (1.f / D) + EPS);
#pragma unroll
                for (int bj = 0; bj < 2; ++bj) {
                    f32x4 a = acc[ai][bj][m][0] * rinv + bv[bj][0], b = acc[ai][bj][m][1] * rinv + bv[bj][1];
#pragma unroll
                    for (int j = 0; j < 4; ++j) { const float x = fmaxf(a[j], 0.f), y = fmaxf(b[j], 0.f); a[j] = x * x; b[j] = y * y; }
                    st_bf16x8(hid + (size_t)r * FF + cb + 32 * bj, a, b);
                }
            }
    }
};
struct SEpiUpN {
    bf16_t* hid; const float* ss; const float* bias;
    __device__ __forceinline__ void operator()(int b, int t, int cg, int c2, float v0, float v1) const {
        const int r = MP + 16 * b + t;
        const float rinv = 1.0f / sqrtf(ss[r] * (1.f / D) + EPS);
        const f32x2 bb = *(const f32x2*)(bias + (size_t)(2 + b) * FF + cg * 64 + c2);
        const float x = fmaxf(v0 * rinv + bb.x, 0.f), y = fmaxf(v1 * rinv + bb.y, 0.f);
        *(unsigned*)(hid + (size_t)r * FF + cg * 64 + c2) = pk2(x * x, y * y);
    }
};
struct SEpiBias {
    float* bias;
    __device__ __forceinline__ void operator()(int rg, int t, int cg, int c2, float v0, float v1) const {
        const int row = 16 * rg + t;
        if (row < NMODROW) *(f32x2*)(bias + (size_t)row * FF + cg * 64 + c2) = (f32x2){v0, v1};
    }
};

struct Params { const float* in[19]; float* out; unsigned char* ws; };

__device__ __forceinline__ void transpose_item(const float* W, int ldw, int K, int nblk, bf16_t* WT, LAS float* scr, int item, int lane) {
    const int kb = item / nblk, nb = item % nblk, k0 = 64 * kb, n0 = 32 * nb;
    float tv[32];
#pragma unroll
    for (int i = 0; i < 32; ++i) tv[i] = W[(size_t)(k0 + 2 * i + (lane >> 5)) * ldw + n0 + (lane & 31)];
#pragma unroll
    for (int i = 0; i < 32; ++i) scr[(2 * i + (lane >> 5)) * 33 + (lane & 31)] = tv[i];
    asm volatile("s_waitcnt lgkmcnt(0)" ::: "memory");
    const int c = lane & 7;
#pragma unroll
    for (int j = 0; j < 4; ++j) { const int n = (lane >> 3) + 8 * j; const LAS float* s = scr + (8 * c) * 33 + n;
        u32x4 o; o.x = pk2(s[0 * 33], s[1 * 33]); o.y = pk2(s[2 * 33], s[3 * 33]); o.z = pk2(s[4 * 33], s[5 * 33]); o.w = pk2(s[6 * 33], s[7 * 33]);
        *(u32x4*)(WT + (size_t)(n0 + n) * K + k0 + 8 * c) = o; }
    asm volatile("s_waitcnt lgkmcnt(0)" ::: "memory");
}

__device__ __forceinline__ void phase_prologue(const Params& p, LAS unsigned char* lds, int tid, int lane, int wave) {
    LAS float* sc = (LAS float*)lds;
    LAS float* red = (LAS float*)(lds + 73728);
    for (int idx = tid; idx < NMODROW * D; idx += 512) {
        const int r = idx >> 10, k = idx & 1023;
        const float c = (r < 2) ? p.in[2][r * D + k] : p.in[3][(r - 2) * D + k];
        sc[k * 18 + r] = c / (1.f + __expf(-c));
    }
    __syncthreads();
    float* modw = (float*)(p.ws + WS_MOD);
    for (int it = blockIdx.x; it < 256; it += gridDim.x) {
        const int l = it >> 7, col0 = (it & 127) * 48;
        const int cl = lane < 48 ? lane : 47;
        const float* W = p.in[8] + (size_t)l * D * MODW + col0 + cl;
        float acc[18];
#pragma unroll
        for (int r = 0; r < 18; ++r) acc[r] = 0.f;
        const int kb = wave * 128;
#pragma unroll 16
        for (int kk = 0; kk < 128; ++kk) {
            const int k = kb + kk;
            const float wv = W[(size_t)k * MODW];
            const LAS f32x2* s2 = (const LAS f32x2*)(sc + k * 18);
#pragma unroll
            for (int r2 = 0; r2 < 9; ++r2) { const f32x2 s = s2[r2]; acc[2 * r2] += s.x * wv; acc[2 * r2 + 1] += s.y * wv; }
        }
#pragma unroll
        for (int r = 0; r < 18; ++r) red[(wave * 18 + r) * 64 + lane] = acc[r];
        __syncthreads();
        for (int idx = tid; idx < 18 * 48; idx += 512) {
            const int r = idx / 48, c = idx % 48;
            float s = p.in[9][l * MODW + col0 + c];
#pragma unroll
            for (int w = 0; w < 8; ++w) s += red[(w * 18 + r) * 64 + c];
            modw[((size_t)l * NMODROW + r) * MODW + col0 + c] = s;
        }
        __syncthreads();
    }
    LAS float* scr = (LAS float*)(lds + 73728 + wave * 8448);
    const int gw = blockIdx.x * 8 + wave, NGW = gridDim.x * 8;
    constexpr int I_IN = 16 * 80, I_OUT = 16 * 32, I_UP = 16 * 128, I_DN = 64 * 32, I_L = I_IN + I_OUT + I_UP + I_DN;
    for (int it = gw; it < 2 * I_L; it += NGW) {
        const int l = it / I_L; int r = it % I_L;
        if (r < I_IN) { transpose_item(p.in[10] + (size_t)l * D * INC, INC, D, 80, (bf16_t*)(p.ws + WS_WIN) + (size_t)l * NMAIN * D, scr, r, lane); continue; } r -= I_IN;
        if (r < I_OUT) { transpose_item(p.in[16] + (size_t)l * D * D, D, D, 32, (bf16_t*)(p.ws + WS_WOUT) + (size_t)l * D * D, scr, r, lane); continue; } r -= I_OUT;
        if (r < I_UP) { transpose_item(p.in[17] + (size_t)l * D * FF, FF, D, 128, (bf16_t*)(p.ws + WS_WUP) + (size_t)l * FF * D, scr, r, lane); continue; } r -= I_UP;
        transpose_item(p.in[18] + (size_t)l * FF * D, D, FF, 32, (bf16_t*)(p.ws + WS_WDN) + (size_t)l * D * FF, scr, r, lane);
    }
}

__device__ __forceinline__ void phase_norm(const Params& p, LAS unsigned char* lds, int l, int stage, const float* xp, const float* xs, int tid, int lane, int wave) {
    constexpr int HP = 1032;
    LAS bf16_t* wfb = (LAS bf16_t*)lds;
    LAS bf16_t* ht = (LAS bf16_t*)(lds + 33280);
    LAS float* pc = (LAS float*)(lds + 66560);
    {
        const float* W = p.in[10] + (size_t)l * D * INC + NMAIN;
        for (int idx = tid; idx < 16 * D; idx += 512) { const int k = idx >> 4, hh = idx & 15; wfb[hh * HP + k] = (bf16_t)f2bf(hh < NH ? W[(size_t)k * INC + hh] : 0.f); }
        float* SS = (float*)(p.ws + WS_SS);
        for (int i = blockIdx.x * 512 + tid; i < M; i += gridDim.x * 512) SS[i] = 0.f;
        if (l == 0) {
            bf16_t* s2 = (bf16_t*)(p.ws + WS_SH2); const float* modall = (const float*)(p.ws + WS_MOD);
            for (int i = blockIdx.x * 512 + tid; i < 2 * 32 * D; i += gridDim.x * 512) { const int ll = i >> 15, row = (i >> 10) & 31, k = i & 1023;
                s2[i] = (bf16_t)f2bf(row < NMODROW ? modall[((size_t)ll * NMODROW + row) * MODW + 3 * D + k] : 0.f); }
        }
    }
    __syncthreads();
    const float* modl = (const float*)(p.ws + WS_MOD) + (size_t)l * NMODROW * MODW;
    bf16_t* hn = (bf16_t*)(p.ws + WS_HN);
    const int l16 = lane & 15, quad = lane >> 4;
    const int rpb = (M + (int)gridDim.x - 1) / (int)gridDim.x, R0 = (int)blockIdx.x * rpb, R1 = (R0 + rpb < M) ? R0 + rpb : M;
    for (int g0 = R0; g0 < R1; g0 += 16) {
#pragma unroll
        for (int rr = 0; rr < 2; ++rr) {
            const int lr = 2 * wave + rr, m = g0 + lr;
            LAS unsigned long long* h8 = (LAS unsigned long long*)(ht + lr * HP) + lane;
            if (m < R1) {
                const f32x4* xr = (const f32x4*)(m < MP ? xp + (size_t)m * D : xs + (size_t)(m - MP) * D) + lane;
                f32x4 v[4]; float ss = 0.f;
#pragma unroll
                for (int j = 0; j < 4; ++j) { v[j] = xr[64 * j]; ss += (v[j].x * v[j].x + v[j].y * v[j].y) + (v[j].z * v[j].z + v[j].w * v[j].w); }
                ss = wave_sum(ss);
                const float rinv = 1.0f / sqrtf(ss * (1.f / D) + EPS);
                const float* mrow = modl + (size_t)brow_of(m) * MODW;
                const f32x4* sh4 = (const f32x4*)mrow + lane; const f32x4* sc4 = (const f32x4*)(mrow + D) + lane;
                unsigned long long* o8 = (unsigned long long*)(hn + (size_t)m * D) + lane;
#pragma unroll
                for (int j = 0; j < 4; ++j) {
                    const f32x4 shv = sh4[64 * j], scv = sc4[64 * j];
                    v[j] = v[j] * rinv * (scv + 1.0f) + shv;
                    const unsigned long long w = (unsigned long long)pk2(v[j].x, v[j].y) | ((unsigned long long)pk2(v[j].z, v[j].w) << 32);
                    o8[64 * j] = w; h8[64 * j] = w;
                }
            } else {
#pragma unroll
                for (int j = 0; j < 4; ++j) h8[64 * j] = 0ull;
            }
        }
        __syncthreads();
        {
            f32x4 c = (f32x4){0.f, 0.f, 0.f, 0.f};
#pragma unroll
            for (int s = 0; s < 4; ++s) {
                const int k0 = 32 * (4 * wave + s) + 8 * quad;
                const bf16x8 a = *(const LAS bf16x8*)(ht + l16 * HP + k0), b = *(const LAS bf16x8*)(wfb + l16 * HP + k0);
                c = __builtin_amdgcn_mfma_f32_16x16x32_bf16(a, b, c, 0, 0, 0);
            }
#pragma unroll
            for (int r = 0; r < 4; ++r) pc[(wave * 16 + quad * 4 + r) * 16 + l16] = c[r];
        }
        __syncthreads();
        if (tid < 16 * NH) {
            const int row = tid / NH, hh = tid % NH, m = g0 + row;
            if (m < R1) {
                float x = p.in[11][l * NH + hh];
#pragma unroll
                for (int w = 0; w < 8; ++w) x += pc[(w * 16 + row) * 16 + hh];
                const float lf = fminf(x, 0.f) - log1pf(expf(-fabsf(x)));
                float* o = p.out + (m < MP ? OFF_FP + ((size_t)l * MP + m) * NH : OFF_FS + ((size_t)l * MS + (m - MP)) * NH);
                o[hh] = lf;
            }
        }
    }
}

__device__ __forceinline__ float block_scan_offset(float total, LAS float* sm, int lane, int wave) {
    float x = total;
#pragma unroll
    for (int o = 1; o < 64; o <<= 1) { const float n = __shfl_up(x, o); if (lane >= o) x += n; }
    __syncthreads();
    if (lane == 63) sm[wave] = x;
    __syncthreads();
    float off = x - total;
    for (int w = 0; w < wave; ++w) off += sm[w];
    return off;
}

__device__ __forceinline__ void scan_items(const Params& p, LAS unsigned char* lds, int l, int tid, int lane, int wave) {
    LAS float* sm = (LAS float*)(lds + 65536);
    float* Fp = (float*)(p.ws + WS_FP); float* Fs = (float*)(p.ws + WS_FS);
    const int nb = (int)gridDim.x / 2;
    if ((int)blockIdx.x < (int)gridDim.x - nb) return;
    for (int it = (int)(gridDim.x - 1 - blockIdx.x); it < 24 + 192; it += nb) {
        if (it < 24) {
            const int b = it / NH, h = it % NH;
            const float* src = p.out + OFF_FP + ((size_t)(l * NBP + b) * T) * NH + h;
            const int t0 = tid * 16;
            float v[16]; float run = 0.f;
#pragma unroll
            for (int e = 0; e < 16; ++e) { run += src[(size_t)(t0 + e) * NH]; v[e] = run; }
            const float off = block_scan_offset(run, sm, lane, wave);
            float* dst = Fp + (size_t)it * T + t0;
#pragma unroll
            for (int e = 0; e < 16; e += 4) *(f32x4*)(dst + e) = (f32x4){(off + v[e]) * LOG2E, (off + v[e + 1]) * LOG2E, (off + v[e + 2]) * LOG2E, (off + v[e + 3]) * LOG2E};
        } else {
            const int bh = it - 24, b = bh / NH, h = bh % NH;
            const float* src = p.in[6] + ((size_t)(l * SB + b) * PAST) * NH + h;
            const int t0 = tid * 8;
            float v[8]; float run = 0.f;
#pragma unroll
            for (int e = 0; e < 8; ++e) { run += src[(size_t)(t0 + e) * NH]; v[e] = run; }
            const float off = block_scan_offset(run, sm, lane, wave);
            float* dst = Fs + (size_t)bh * SKEYS + t0;
#pragma unroll
            for (int e = 0; e < 8; e += 4) *(f32x4*)(dst + e) = (f32x4){(off + v[e]) * LOG2E, (off + v[e + 1]) * LOG2E, (off + v[e + 2]) * LOG2E, (off + v[e + 3]) * LOG2E};
            if (tid == 511) sm[8] = off + run;
            __syncthreads();
            if (tid < ST) {
                const float* ns = p.out + OFF_FS + ((size_t)(l * SB + b) * ST) * NH + h;
                float s = sm[8];
                for (int e = 0; e <= tid; ++e) s += ns[e * NH];
                Fs[(size_t)bh * SKEYS + PAST + tid] = s * LOG2E;
            }
        }
        __syncthreads();
    }
}

__device__ __forceinline__ void pool_items(const Params& p, LAS unsigned char* lds, int l, unsigned* ctr, LAS unsigned* slot, int tid, int lane, int wave) {
    LAS float* z = (LAS float*)lds;
    LAS bf16_t* am = (LAS bf16_t*)(lds + 32768);
    const float* ub = (const float*)(p.ws + WS_U);
    bf16_t* mix = (bf16_t*)(p.ws + WS_MIX);
    const int g = wave >> 1, ntp = (wave & 1) * 2, l16 = lane & 15, quad = lane >> 4;
    bf16x8 bw[2][2];
    {
        const float* wp = p.in[14] + ((size_t)(l * 4 + g) * 64) * 64;
#pragma unroll
        for (int nt = 0; nt < 2; ++nt)
#pragma unroll
            for (int ks = 0; ks < 2; ++ks) {
                bf16x8 t;
#pragma unroll
                for (int j = 0; j < 8; ++j) t[j] = (short)f2bf(wp[(size_t)(32 * ks + 8 * quad + j) * 64 + 16 * (ntp + nt) + l16]);
                bw[nt][ks] = t;
            }
    }
    for (;;) {
      if (tid == 0) *slot = atomicAdd(ctr, 1u);
      __syncthreads();
      const int ent = (int)*slot;
      __syncthreads();
      if (ent >= M / 32) break;
      for (int it = ent * 2; it < ent * 2 + 2; ++it) {
        const int row0 = it * 16;
        const bool prm = row0 < MP;
        const int t0 = prm ? (row0 & (T - 1)) : 0;
        for (int idx = tid; idx < 31 * 64; idx += 512) {
            const int zr = idx >> 6, c4 = (idx & 63) * 4;
            f32x4 val = (f32x4){0.f, 0.f, 0.f, 0.f};
            if (zr >= 15) val = *(const f32x4*)(ub + (size_t)(row0 + zr - 15) * PW + c4);
            else if (prm) { if (t0 > 0) val = *(const f32x4*)(ub + (size_t)(row0 + zr - 15) * PW + c4); }
            else val = *(const f32x4*)(p.in[7] + ((size_t)(l * SB + ((row0 - MP) >> 4)) * 15 + zr) * PW + c4);
            *(LAS f32x4*)(z + zr * 256 + c4) = val;
        }
        __syncthreads();
        {
            const int row = tid >> 5, c0 = (tid & 31) * 8, gg = c0 >> 6, w = 2 << gg;
            f32x4 s0 = (f32x4){0.f, 0.f, 0.f, 0.f}, s1 = s0;
            for (int j = 0; j < w; ++j) { s0 += *(const LAS f32x4*)(z + (15 + row - j) * 256 + c0); s1 += *(const LAS f32x4*)(z + (15 + row - j) * 256 + c0 + 4); }
            float cnt = (float)w;
            if (prm) { const float pos1 = (float)(t0 + row + 1); cnt = fminf(pos1, cnt); }
            const float ic = 1.0f / cnt;
            const f32x4 u0 = *(const LAS f32x4*)(z + (15 + row) * 256 + c0), u1 = *(const LAS f32x4*)(z + (15 + row) * 256 + c0 + 4);
            s0 = s0 * ic - u0; s1 = s1 * ic - u1;
            u32x4 o; o.x = pk2(s0[0], s0[1]); o.y = pk2(s0[2], s0[3]); o.z = pk2(s1[0], s1[1]); o.w = pk2(s1[2], s1[3]);
            *(LAS u32x4*)(am + row * 264 + c0) = o;
        }
        __syncthreads();
        {
            f32x4 c[2] = {(f32x4){0.f, 0.f, 0.f, 0.f}, (f32x4){0.f, 0.f, 0.f, 0.f}};
#pragma unroll
            for (int ks = 0; ks < 2; ++ks) {
                const bf16x8 a = *(const LAS bf16x8*)(am + l16 * 264 + g * 64 + 32 * ks + 8 * quad);
#pragma unroll
                for (int nt = 0; nt < 2; ++nt) c[nt] = __builtin_amdgcn_mfma_f32_16x16x32_bf16(a, bw[nt][ks], c[nt], 0, 0, 0);
            }
#pragma unroll
            for (int nt = 0; nt < 2; ++nt) {
                const int col = g * 64 + 16 * (ntp + nt) + l16;
                const float ps = p.in[15][l * PW + col];
#pragma unroll
                for (int r = 0; r < 4; ++r) mix[(size_t)(row0 + quad * 4 + r) * D + col] = (bf16_t)f2bf(c[nt][r] * ps);
            }
        }
        __syncthreads();
      }
    }
}

__device__ __forceinline__ s16x4 vtr(const LAS unsigned char* ptr) { return __builtin_bit_cast(s16x4, __builtin_amdgcn_ds_read_tr16_b64_v4i16((LAS s16x4*)ptr)); }
constexpr int KP = 144;

__device__ __forceinline__ float xmax_q(float v) {
    auto a = __builtin_amdgcn_permlane16_swap(__float_as_uint(v), __float_as_uint(v), false, false);
    const float m = __builtin_fmaxf(__uint_as_float(a[0]), __uint_as_float(a[1]));
    auto b = __builtin_amdgcn_permlane32_swap(__float_as_uint(m), __float_as_uint(m), false, false);
    return __builtin_fmaxf(__uint_as_float(b[0]), __uint_as_float(b[1]));
}
__device__ __forceinline__ void attn_tile64(const LAS unsigned char* Kt, const LAS unsigned char* Vt, const LAS float* Ft, int key0, int Qw, bool diag,
                                            const bf16x8 (&qf)[2][2], const float (&fq)[2], float (&fqm)[2], float (&mrun)[2], float (&lrun)[2], f32x4 (&o)[4][2], int l16, int quad) {
    f32x4 s[4][2];
    bf16x8 kf[2][4]; f32x4 fk[4];
#pragma unroll
    for (int ks = 0; ks < 2; ++ks)
#pragma unroll
        for (int kt = 0; kt < 4; ++kt) kf[ks][kt] = *(const LAS bf16x8*)(Kt + (16 * kt + l16) * KP + ks * 64 + quad * 16);
#pragma unroll
    for (int kt = 0; kt < 4; ++kt) fk[kt] = *(const LAS f32x4*)(Ft + 16 * kt + 4 * quad);
    __builtin_amdgcn_sched_barrier(0);
#pragma unroll
    for (int kt = 0; kt < 4; ++kt)
#pragma unroll
        for (int qt = 0; qt < 2; ++qt) s[kt][qt] = (f32x4){fqm[qt] - fk[kt][0], fqm[qt] - fk[kt][1], fqm[qt] - fk[kt][2], fqm[qt] - fk[kt][3]};
#pragma unroll
    for (int ks = 0; ks < 2; ++ks)
#pragma unroll
        for (int kt = 0; kt < 4; ++kt)
#pragma unroll
            for (int qt = 0; qt < 2; ++qt) s[kt][qt] = __builtin_amdgcn_mfma_f32_16x16x32_bf16(kf[ks][kt], qf[qt][ks], s[kt][qt], 0, 0, 0);
    s16x4 va[2][4][2];
    {
        const LAS unsigned char* vb0 = Vt + (4 * quad + (l16 >> 2)) * KP + 8 * (l16 & 3);
#pragma unroll
        for (int k2 = 0; k2 < 2; ++k2)
#pragma unroll
            for (int dt = 0; dt < 4; ++dt) { va[k2][dt][0] = vtr(vb0 + 32 * k2 * KP + 32 * dt); va[k2][dt][1] = vtr(vb0 + (32 * k2 + 16) * KP + 32 * dt); }
    }
    __builtin_amdgcn_sched_barrier(0);
    if (diag) {
#pragma unroll
        for (int kt = 0; kt < 4; ++kt)
#pragma unroll
            for (int qt = 0; qt < 2; ++qt)
#pragma unroll
                for (int r = 0; r < 4; ++r) { const int key = key0 + 16 * kt + 4 * quad + r, qq = Qw + 16 * qt + l16; if (key > qq) s[kt][qt][r] = -INFINITY; }
    }
    float mx[2];
#pragma unroll
    for (int qt = 0; qt < 2; ++qt) {
        float a = __builtin_fmaxf(__builtin_fmaxf(s[0][qt][0], s[0][qt][1]), s[0][qt][2]), c = __builtin_fmaxf(__builtin_fmaxf(s[0][qt][3], s[1][qt][0]), s[1][qt][1]);
        a = __builtin_fmaxf(__builtin_fmaxf(a, s[1][qt][2]), s[1][qt][3]); c = __builtin_fmaxf(__builtin_fmaxf(c, s[2][qt][0]), s[2][qt][1]);
        a = __builtin_fmaxf(__builtin_fmaxf(a, s[2][qt][2]), s[2][qt][3]); c = __builtin_fmaxf(__builtin_fmaxf(c, s[3][qt][0]), s[3][qt][1]);
        a = __builtin_fmaxf(__builtin_fmaxf(a, s[3][qt][2]), s[3][qt][3]);
        float m_ = __builtin_fmaxf(a, c);
        mx[qt] = xmax_q(m_);
    }
    if (__any((mx[0] > 8.f) || (mx[1] > 8.f))) {
#pragma unroll
        for (int qt = 0; qt < 2; ++qt) {
            const float dl = __builtin_fmaxf(mx[qt], 0.f);
            mrun[qt] += dl; fqm[qt] = fq[qt] - mrun[qt];
            const float al = __builtin_amdgcn_exp2f(-dl);
            lrun[qt] *= al;
#pragma unroll
            for (int kt = 0; kt < 4; ++kt) s[kt][qt] -= dl;
#pragma unroll
            for (int dt = 0; dt < 4; ++dt) o[dt][qt] *= al;
        }
    }
#pragma unroll
    for (int qt = 0; qt < 2; ++qt) {
        float ps = 0.f;
#pragma unroll
        for (int kt = 0; kt < 4; ++kt)
#pragma unroll
            for (int r = 0; r < 4; ++r) { const float e = __builtin_amdgcn_exp2f(s[kt][qt][r]); s[kt][qt][r] = e; ps += e; }
        lrun[qt] += ps;
    }
#pragma unroll
    for (int k2 = 0; k2 < 2; ++k2) {
        bf16x8 pb[2];
#pragma unroll
        for (int qt = 0; qt < 2; ++qt) {
            u32x4 w; w.x = pk2(s[2 * k2][qt][0], s[2 * k2][qt][1]); w.y = pk2(s[2 * k2][qt][2], s[2 * k2][qt][3]);
            w.z = pk2(s[2 * k2 + 1][qt][0], s[2 * k2 + 1][qt][1]); w.w = pk2(s[2 * k2 + 1][qt][2], s[2 * k2 + 1][qt][3]);
            pb[qt] = __builtin_bit_cast(bf16x8, w);
        }
#pragma unroll
        for (int dt = 0; dt < 4; ++dt) {
            const s16x4 a0 = va[k2][dt][0], a1 = va[k2][dt][1];
            const bf16x8 vf = (bf16x8){a0[0], a0[1], a0[2], a0[3], a1[0], a1[1], a1[2], a1[3]};
#pragma unroll
            for (int qt = 0; qt < 2; ++qt) o[dt][qt] = __builtin_amdgcn_mfma_f32_16x16x32_bf16(vf, pb[qt], o[dt][qt], 0, 0, 0);
        }
    }
}

constexpr int TB = 128 * KP;
__device__ __forceinline__ void attn_prompt_unit(int b, int h, int qb, const bf16_t* Q, const bf16_t* Kb, const bf16_t* Vb, const float* F2, bf16_t* mix,
                                                 LAS unsigned char* lds, int tid, int lane, int wave) {
    const int l16 = lane & 15, quad = lane >> 4;
    const size_t rowbase = (size_t)b * T;
    const int Qw = qb * 256 + wave * 32;
    const float* Fh = F2 + (size_t)(b * NH + h) * T;
    bf16x8 qf[2][2]; float fq[2];
#pragma unroll
    for (int qt = 0; qt < 2; ++qt) {
#pragma unroll
        for (int ks = 0; ks < 2; ++ks) qf[qt][ks] = *(const bf16x8*)(Q + (rowbase + Qw + 16 * qt + l16) * AW + h * HD + 32 * ks + 8 * quad);
        fq[qt] = Fh[Qw + 16 * qt + l16];
    }
    f32x4 o[4][2];
#pragma unroll
    for (int dt = 0; dt < 4; ++dt) { o[dt][0] = (f32x4){0.f, 0.f, 0.f, 0.f}; o[dt][1] = o[dt][0]; }
    float mrun[2] = {0.f, 0.f}, lrun[2] = {0.f, 0.f}, fqm[2] = {fq[0], fq[1]};
    const int NT = 2 * qb + 2;
    LAS unsigned char* Kl = lds; LAS unsigned char* Vl = lds + 2 * TB; LAS float* Fl = (LAS float*)(lds + 4 * TB);
    const int skey = tid >> 3, sch = tid & 7;
    const bf16_t* kg = Kb + (rowbase + skey) * AW + h * HD + sch * 8;
    const bf16_t* vg = Vb + (rowbase + skey) * AW + h * HD + sch * 8;
    u32x4 kreg0 = *(const u32x4*)kg, kreg1 = *(const u32x4*)(kg + (size_t)64 * AW), vreg0 = *(const u32x4*)vg, vreg1 = *(const u32x4*)(vg + (size_t)64 * AW);
    f32x4 freg = (f32x4){0.f, 0.f, 0.f, 0.f};
    if (tid < 32) freg = *(const f32x4*)(Fh + tid * 4);
    const int soff = skey * KP + sch * 16;
    *(LAS u32x4*)(Kl + soff) = kreg0; *(LAS u32x4*)(Kl + 64 * KP + soff) = kreg1; *(LAS u32x4*)(Vl + soff) = vreg0; *(LAS u32x4*)(Vl + 64 * KP + soff) = vreg1;
    if (tid < 32) *(LAS f32x4*)(Fl + tid * 4) = freg;
    __syncthreads();
    for (int t = 0; t < NT; ++t) {
        const int buf = t & 1;
        if (t + 1 < NT) {
            const size_t go = (size_t)(t + 1) * 128 * AW;
            kreg0 = *(const u32x4*)(kg + go); kreg1 = *(const u32x4*)(kg + go + (size_t)64 * AW); vreg0 = *(const u32x4*)(vg + go); vreg1 = *(const u32x4*)(vg + go + (size_t)64 * AW);
            if (tid < 32) freg = *(const f32x4*)(Fh + (t + 1) * 128 + tid * 4);
        }
#pragma unroll
        for (int sub = 0; sub < 2; ++sub) {
            const int key0 = t * 128 + sub * 64;
            if (key0 <= Qw)
                attn_tile64(Kl + buf * TB + sub * 64 * KP, Vl + buf * TB + sub * 64 * KP, Fl + buf * 128 + sub * 64, key0, Qw, key0 + 63 > Qw, qf, fq, fqm, mrun, lrun, o, l16, quad);
        }
        if (t + 1 < NT) {
            const int nb = buf ^ 1;
            *(LAS u32x4*)(Kl + nb * TB + soff) = kreg0; *(LAS u32x4*)(Kl + nb * TB + 64 * KP + soff) = kreg1;
            *(LAS u32x4*)(Vl + nb * TB + soff) = vreg0; *(LAS u32x4*)(Vl + nb * TB + 64 * KP + soff) = vreg1;
            if (tid < 32) *(LAS f32x4*)(Fl + nb * 128 + tid * 4) = freg;
        }
        __syncthreads();
    }
#pragma unroll
    for (int qt = 0; qt < 2; ++qt) {
        float lt = lrun[qt]; lt += __shfl_xor(lt, 16); lt += __shfl_xor(lt, 32);
        const float il = 1.0f / lt;
        bf16_t* op = mix + (rowbase + Qw + 16 * qt + l16) * D + PW + h * HD + 4 * quad;
#pragma unroll
        for (int dt = 0; dt < 4; ++dt) {
            u32x2 w; w.x = pk2(o[dt][qt][0] * il, o[dt][qt][1] * il); w.y = pk2(o[dt][qt][2] * il, o[dt][qt][3] * il);
            *(u32x2*)(op + 16 * dt) = w;
        }
    }
}


namespace fa {
using f32x16 = __attribute__((ext_vector_type(16))) float;
constexpr int SEQ = T, DH = 64, DM = AW;
constexpr int NW = 8, QBLK = 32, QB = QBLK * NW, KVBLK = 64;
__device__ __forceinline__ int crow(int r, int hi) { return (r & 3) + 8 * (r >> 2) + 4 * hi; }
#define SBAR() __builtin_amdgcn_sched_barrier(0)
__device__ __forceinline__ void cmask(f32x16& p0, f32x16& p1, int jb, int qrel, int hi) {
    const float NEG = -INFINITY; int kb = 64 * jb + 4 * hi;
#pragma unroll
    for (int r = 0; r < 16; ++r) { int kv = kb + (r & 3) + 8 * (r >> 2); if (kv > qrel) p0[r] = NEG; if (kv + 32 > qrel) p1[r] = NEG; }
}
constexpr int NSLOT = 3, SLOTB = 8192;
constexpr int LDS_K = 0, LDS_V = NSLOT * SLOTB, LDS_WS = 2 * NSLOT * SLOTB, LDS_OST = LDS_WS + NW * 64 * 4, LDS_FK = LDS_OST + NW * 4096, LDS_END = LDS_FK + SEQ * 4;
__device__ __forceinline__ void glds16(const void* gsrc, unsigned lds_dst) { unsigned keep;
    asm volatile("s_mov_b32 %0, m0\n\ts_mov_b32 m0, %2\n\ts_nop 0\n\tglobal_load_lds_dwordx4 %1, off\n\ts_mov_b32 m0, %0" : "=&s"(keep) : "v"(gsrc), "s"(lds_dst) : "memory"); }
__device__ __forceinline__ float max3f(float a, float b, float c) { float r; asm("v_max3_f32 %0, %1, %2, %3" : "=v"(r) : "v"(a), "v"(b), "v"(c)); return r; }
__device__ __forceinline__ float max2f(float a, float b) { float r; asm("v_max_f32_e32 %0, %1, %2" : "=v"(r) : "v"(a), "v"(b)); return r; }
__device__ __forceinline__ float fadd_s(float a, float b) { float r; asm("v_add_f32_e32 %0, %1, %2" : "=v"(r) : "v"(a), "v"(b)); return r; }
__device__ __forceinline__ float fsub_s(float a, float b) { float r; asm("v_sub_f32_e32 %0, %1, %2" : "=v"(r) : "v"(a), "v"(b)); return r; }
__device__ __forceinline__ unsigned cvtpk_s(float lo, float hi) { return pk2(lo, hi); }
#define WAIT_BAR(N) asm volatile("s_waitcnt vmcnt(" #N ") lgkmcnt(0)\n\ts_barrier" ::: "memory")
typedef __attribute__((address_space(3))) const char* lds_cptr;
__device__ __forceinline__ void bias_half(f32x16& c, lds_cptr fkt, float cq, int hi) {
#pragma unroll
    for (int g = 0; g < 4; ++g) {
        const f32x4 a = *(const LAS f32x4*)(fkt + (8 * g + 4 * hi) * 4);
#pragma unroll
        for (int j = 0; j < 4; ++j) c[4 * g + j] = cq - a[j];
    }
}
__device__ __forceinline__ void bias_init(f32x16& c0, f32x16& c1, lds_cptr fkt, float cq, int hi) {
#pragma unroll
    for (int g = 0; g < 4; ++g) {
        const f32x4 a = *(const LAS f32x4*)(fkt + (8 * g + 4 * hi) * 4), b = *(const LAS f32x4*)(fkt + (32 + 8 * g + 4 * hi) * 4);
#pragma unroll
        for (int j = 0; j < 4; ++j) { c0[4 * g + j] = cq - a[j]; c1[4 * g + j] = cq - b[j]; }
    }
}
__device__ __forceinline__ void qkt(f32x16& p0, f32x16& p1, const char* Kslot, const bf16x8* qr, int r32, int hi) {
    const char* kb = Kslot + hi * 1024 + r32 * 16;
#pragma unroll
    for (int d0 = 0; d0 < 4; ++d0) {
        const bf16x8 b0 = *reinterpret_cast<const bf16x8*>(kb + d0 * 2048);
        const bf16x8 b1 = *reinterpret_cast<const bf16x8*>(kb + d0 * 2048 + 512);
        p0 = __builtin_amdgcn_mfma_f32_32x32x16_bf16(b0, qr[d0], p0, 0, 0, 0); p1 = __builtin_amdgcn_mfma_f32_32x32x16_bf16(b1, qr[d0], p1, 0, 0, 0); }
}
__device__ __forceinline__ void kload8(bf16x8* kf, lds_cptr kp) {
    kf[0] = *(const LAS bf16x8*)(kp);        kf[1] = *(const LAS bf16x8*)(kp + 512);
    kf[2] = *(const LAS bf16x8*)(kp + 2048); kf[3] = *(const LAS bf16x8*)(kp + 2560);
    kf[4] = *(const LAS bf16x8*)(kp + 4096); kf[5] = *(const LAS bf16x8*)(kp + 4608);
    kf[6] = *(const LAS bf16x8*)(kp + 6144); kf[7] = *(const LAS bf16x8*)(kp + 6656);
}
__device__ __forceinline__ void kload2(bf16x8* kf, lds_cptr kp, int j) { kf[2 * j] = *(const LAS bf16x8*)(kp + j * 2048); kf[2 * j + 1] = *(const LAS bf16x8*)(kp + j * 2048 + 512); }
__device__ __forceinline__ s16x4 vtr2(lds_cptr p) { return __builtin_bit_cast(s16x4, __builtin_amdgcn_ds_read_tr16_b64_v4i16((LAS s16x4*)p)); }
__device__ __forceinline__ float rowmax(const f32x16& p0, const f32x16& p1) {
    float a = max3f(p0[0], p0[1], p1[0]), b = max3f(p0[2], p0[3], p1[1]); a = max3f(a, p1[2], p1[3]);
#pragma unroll
    for (int r = 4; r < 16; r += 4) { a = max3f(a, p0[r], p0[r + 1]); b = max3f(b, p0[r + 2], p0[r + 3]); a = max3f(a, p1[r], p1[r + 1]); b = max3f(b, p1[r + 2], p1[r + 3]); }
    const float m = max2f(a, b);
    auto rr = __builtin_amdgcn_permlane32_swap(__float_as_uint(m), __float_as_uint(m), false, false);
    return max2f(__uint_as_float(rr[0]), __uint_as_float(rr[1]));
}
__device__ __forceinline__ void pv(f32x16* o, int vb, bf16x8 pa0, bf16x8 pa1, bf16x8 pa2, bf16x8 pa3) {
#pragma unroll
    for (int d0 = 0; d0 < 2; ++d0) { s16x4 lo[4], hi[4];
#pragma unroll
        for (int ks = 0; ks < 4; ++ks) {
            asm volatile("ds_read_b64_tr_b16 %0,%1 offset:%c2" : "=&v"(lo[ks]) : "v"(vb), "i"(d0 * 4096 + ks * 1024) : "memory");
            asm volatile("ds_read_b64_tr_b16 %0,%1 offset:%c2" : "=&v"(hi[ks]) : "v"(vb), "i"(d0 * 4096 + ks * 1024 + 512) : "memory"); }
        asm volatile("s_waitcnt lgkmcnt(0)" ::: "memory"); SBAR();
#define PK(k) (bf16x8){lo[k][0], lo[k][1], lo[k][2], lo[k][3], hi[k][0], hi[k][1], hi[k][2], hi[k][3]}
        o[d0] = __builtin_amdgcn_mfma_f32_32x32x16_bf16(pa0, PK(0), o[d0], 0, 0, 0);
        o[d0] = __builtin_amdgcn_mfma_f32_32x32x16_bf16(pa1, PK(1), o[d0], 0, 0, 0);
        o[d0] = __builtin_amdgcn_mfma_f32_32x32x16_bf16(pa2, PK(2), o[d0], 0, 0, 0);
        o[d0] = __builtin_amdgcn_mfma_f32_32x32x16_bf16(pa3, PK(3), o[d0], 0, 0, 0);
#undef PK
    }
}

template <int THRL> __device__ __forceinline__ void attn_unit(int b, int h, int qb, const bf16_t* Q, const bf16_t* __restrict__ K, const bf16_t* __restrict__ V, const float* F2, bf16_t* mix, char* shm, const int tid, const int t0) {
    const int lane = tid & 63, r32 = lane & 31, hi = lane >> 5; const int wid = __builtin_amdgcn_readfirstlane(tid >> 6);
    const long rowbase = (long)b * SEQ; const int q0 = qb * QB;
    const bf16_t* Qw = Q + (rowbase + q0 + wid * QBLK) * DM + h * DH;
    const bf16_t* Kh = K + (rowbase + t0 * KVBLK) * DM + h * DH, *Vh = V + (rowbase + t0 * KVBLK) * DM + h * DH;
    const float* Fh = F2 + (long)(b * NH + h) * SEQ;
    const unsigned lds0 = (unsigned)(uintptr_t)shm;
    float* wsf = (float*)(shm + LDS_WS) + wid * 64;
    { float* fl = (float*)(shm + LDS_FK); for (int i = t0 * KVBLK + tid * 4; i < q0 + QB; i += 2048) *(f32x4*)(fl + i - t0 * KVBLK) = *(const f32x4*)(Fh + i); }
    const float fq = Fh[q0 + wid * QBLK + r32];
    const bf16_t* ksrc = Kh + (long)lane * DM + wid * 8;
    const bf16_t* vsrc = Vh + (long)(16 * (wid & 3) + (lane >> 2)) * DM + (wid >> 2) * 32 + (lane & 3) * 8;
    const unsigned kdst = lds0 + LDS_K + wid * 1024, vdst = lds0 + LDS_V + wid * 1024;
#define DMA_K(t, slot) glds16(ksrc + (long)(t) * KVBLK * DM, (unsigned)__builtin_amdgcn_readfirstlane(kdst + (slot)))
#define DMA_V(t, slot) glds16(vsrc + (long)(t) * KVBLK * DM, (unsigned)__builtin_amdgcn_readfirstlane(vdst + (slot)))
    const int vb0 = (int)(lds0 + LDS_V) + ((lane >> 4) & 1) * 32 + (lane & 3) * 8 + (4 * hi + ((lane & 15) >> 2)) * 64;
    const char* Kbase = shm + LDS_K; bf16x8 kf[8];
    const lds_cptr shm3 = (lds_cptr)shm; const lds_cptr kp0 = shm3 + LDS_K + hi * 1024 + r32 * 16; const lds_cptr vp0 = shm3 + LDS_V + ((lane >> 4) & 1) * 32 + (lane & 3) * 8 + (4 * hi + ((lane & 15) >> 2)) * 64;
    const lds_cptr fk0 = shm3 + LDS_FK;
    const int NT = (q0 + QB) / KVBLK - t0;
    DMA_K(0, 0); DMA_V(0, 0); DMA_K(1, SLOTB);
    bf16x8 qr[4];
#pragma unroll
    for (int d0 = 0; d0 < 4; ++d0) qr[d0] = *reinterpret_cast<const bf16x8*>(&Qw[(long)r32 * DM + d0 * 16 + hi * 8]);
    float mhat = 0.f, l_reg = 0.f, cq = fq; f32x16 o[2]; o[0] = f32x16{}; o[1] = f32x16{};
    const int qrel = wid * QBLK + r32;
#define CMASK(P0, P1, t) do { int jb_ = (t) - (NT - 4); if (jb_ >= 0) cmask(P0, P1, jb_, qrel, hi); } while (0)
    bool resc = false;
#define START(P0, P1) do { const float rm = rowmax(P0, P1); resc = false; \
    { const float dl = rm; mhat = fadd_s(mhat, dl); \
      _Pragma("unroll") for (int r = 0; r < 16; ++r) { P0[r] = fsub_s(P0[r], dl); P1[r] = fsub_s(P1[r], dl); } \
      cq = fq - mhat; } \
    _Pragma("unroll") for (int r = 0; r < 16; ++r) P0[r] = __builtin_amdgcn_exp2f(P0[r]); } while (0)
#define RESC() do { if (resc) { asm volatile("s_waitcnt lgkmcnt(0)" ::: "memory"); \
      _Pragma("unroll") for (int d_ = 0; d_ < 2; ++d_) _Pragma("unroll") for (int r = 0; r < 16; ++r) o[d_][r] *= wsf[crow(r, hi)]; } } while (0)
    f32x16 pA0, pA1, pB0, pB1;
    int sl_prev = 0, sl_cur = 0, sl_next = SLOTB;
#define ROT() do { sl_prev = sl_cur; sl_cur = sl_next; sl_next = (sl_next == (NSLOT - 1) * SLOTB) ? 0 : sl_next + SLOTB; } while (0)
    DMA_K(2, 2 * SLOTB);
    WAIT_BAR(3);
    bias_init(pA0, pA1, fk0, cq, hi);
    qkt(pA0, pA1, Kbase, qr, r32, hi); asm volatile("s_nop 15\n\ts_nop 7" : "+v"(pA0), "+v"(pA1)); CMASK(pA0, pA1, 0);
    START(pA0, pA1);
    _Pragma("unroll") for (int r = 0; r < 16; ++r) pA1[r] = __builtin_amdgcn_exp2f(pA1[r]);
    WAIT_BAR(0);
    DMA_K(3, 0); DMA_V(1, SLOTB);
    ROT();
    kload8(kf, kp0 + sl_cur);
    WAIT_BAR(2);
    s16x4 vlo[8], vhi[8]; u32x4 pw0, pw1, pw2, pw3;
#define PKW(P, B) cvtpk_s(P[B], P[B + 1])
#define PAF(k) __builtin_bit_cast(bf16x8, pw##k)
#define VFR(i) (bf16x8){vlo[i][0], vlo[i][1], vlo[i][2], vlo[i][3], vhi[i][0], vhi[i][1], vhi[i][2], vhi[i][3]}
#define PIN(x) asm volatile("" : "+v"(x))
#define MX3(a, b, c) __builtin_fmaxf(__builtin_fmaxf((a), (b)), (c))
#define GAPA(MF, A0, A1, A2, A3, W0, W1, PW) do { MF; sacc += A0; sacc += A1; sacc += A2; sacc += A3; PIN(sacc); W0; W1; PIN(PW); SBAR(); } while (0)
#define EX(v) __builtin_amdgcn_exp2f(v)
#define GAPB(MF, X, B) do { MF; X[B] = EX(X[B]); X[B + 1] = EX(X[B + 1]); X[B + 2] = EX(X[B + 2]); X[B + 3] = EX(X[B + 3]); PIN(X); SBAR(); } while (0)
#define VRD(i) do { vlo[i] = vtr2(vp_ + (((i) >> 2) * 4096 + ((i) & 3) * 1024)); vhi[i] = vtr2(vp_ + (((i) >> 2) * 4096 + ((i) & 3) * 1024 + 512)); } while (0)
#define KRD(G, j) do { if (G) { kload2(kf, kp0 + sl_next, j); SBAR(); } } while (0)
#define STEP(C0, C1, P0, P1, t, GK, GV, GL) do { SBAR(); \
    bias_half(C0, fk0 + (t) * 256, cq, hi); SBAR(); \
    const lds_cptr vp_ = vp0 + sl_prev; \
    VRD(0); SBAR(); float sacc = (P0[0] + P0[1]); \
    GAPA(C0 = __builtin_amdgcn_mfma_f32_32x32x16_bf16(kf[0], qr[0], C0, 0, 0, 0), P0[2], P0[3], P0[4], P0[5],     pw0[0] = PKW(P0, 0), pw0[1] = PKW(P0, 2), pw0); \
    bias_half(C1, fk0 + (t) * 256 + 128, cq, hi); SBAR(); \
    VRD(4); SBAR(); GAPA(C1 = __builtin_amdgcn_mfma_f32_32x32x16_bf16(kf[1], qr[0], C1, 0, 0, 0), P0[6], P0[7], P0[8], P0[9],     pw0[2] = PKW(P0, 4), pw0[3] = PKW(P0, 6), pw0); \
    VRD(1); SBAR(); GAPA(C0 = __builtin_amdgcn_mfma_f32_32x32x16_bf16(kf[2], qr[1], C0, 0, 0, 0),   P0[10], P0[11], P0[12], P0[13], pw1[0] = PKW(P0, 8), pw1[1] = PKW(P0, 10), pw1); \
    VRD(5); SBAR(); GAPA(C1 = __builtin_amdgcn_mfma_f32_32x32x16_bf16(kf[3], qr[1], C1, 0, 0, 0),   P0[14], P0[15], P1[0], P1[1],   pw1[2] = PKW(P0, 12), pw1[3] = PKW(P0, 14), pw1); \
    VRD(2); SBAR(); GAPA(C0 = __builtin_amdgcn_mfma_f32_32x32x16_bf16(kf[4], qr[2], C0, 0, 0, 0),   P1[2], P1[3], P1[4], P1[5],     pw2[0] = PKW(P1, 0), pw2[1] = PKW(P1, 2), pw2); \
    VRD(6); SBAR(); GAPA(C1 = __builtin_amdgcn_mfma_f32_32x32x16_bf16(kf[5], qr[2], C1, 0, 0, 0),   P1[6], P1[7], P1[8], P1[9],     pw2[2] = PKW(P1, 4), pw2[3] = PKW(P1, 6), pw2); \
    VRD(3); SBAR(); GAPA(C0 = __builtin_amdgcn_mfma_f32_32x32x16_bf16(kf[6], qr[3], C0, 0, 0, 0),   P1[10], P1[11], P1[12], P1[13], pw3[0] = PKW(P1, 8), pw3[1] = PKW(P1, 10), pw3); \
    VRD(7); SBAR(); GAPA(C1 = __builtin_amdgcn_mfma_f32_32x32x16_bf16(kf[7], qr[3], C1, 0, 0, 0),   P1[14], P1[15], 0.f, 0.f,       pw3[2] = PKW(P1, 12), pw3[3] = PKW(P1, 14), pw3); \
    l_reg += sacc; \
    if (GK) { DMA_K((t) + 3, sl_cur); } if (GV) { DMA_V((t) + 1, sl_next); } \
    CMASK(C0, C1, t); \
    { float a = MX3(C0[0], C0[1], C1[0]), b = MX3(C0[2], C0[3], C1[1]); a = MX3(a, C1[2], C1[3]); \
      _Pragma("unroll") for (int r = 4; r < 16; r += 4) { a = MX3(a, C0[r], C0[r + 1]); b = MX3(b, C0[r + 2], C0[r + 3]); a = MX3(a, C1[r], C1[r + 1]); b = MX3(b, C1[r + 2], C1[r + 3]); } \
      float rm = __builtin_fmaxf(a, b); { auto rr = __builtin_amdgcn_permlane32_swap(__float_as_uint(rm), __float_as_uint(rm), false, false); rm = __builtin_fmaxf(__uint_as_float(rr[0]), __uint_as_float(rr[1])); } \
      resc = false; \
      if (__builtin_expect(__any(rm > (float)THRL), 0)) { const float dl = __builtin_fmaxf(rm, 0.f); mhat += dl; \
        _Pragma("unroll") for (int r = 0; r < 16; ++r) { C0[r] -= dl; C1[r] -= dl; } \
        cq = fq - mhat; \
        const float f = __builtin_amdgcn_exp2f(-dl); l_reg *= f; if (hi == 0) wsf[r32] = f; resc = true; } } \
    SBAR(); \
    GAPB(o[0] = __builtin_amdgcn_mfma_f32_32x32x16_bf16(PAF(0), VFR(0), o[0], 0, 0, 0), C0, 0); \
    GAPB(o[1] = __builtin_amdgcn_mfma_f32_32x32x16_bf16(PAF(0), VFR(4), o[1], 0, 0, 0), C0, 4); \
    KRD(GL, 0); GAPB(o[0] = __builtin_amdgcn_mfma_f32_32x32x16_bf16(PAF(1), VFR(1), o[0], 0, 0, 0), C0, 8); \
    KRD(GL, 1); GAPB(o[1] = __builtin_amdgcn_mfma_f32_32x32x16_bf16(PAF(1), VFR(5), o[1], 0, 0, 0), C0, 12); \
    KRD(GL, 2); GAPB(o[0] = __builtin_amdgcn_mfma_f32_32x32x16_bf16(PAF(2), VFR(2), o[0], 0, 0, 0), C1, 0); \
    KRD(GL, 3); GAPB(o[1] = __builtin_amdgcn_mfma_f32_32x32x16_bf16(PAF(2), VFR(6), o[1], 0, 0, 0), C1, 4); \
    GAPB(o[0] = __builtin_amdgcn_mfma_f32_32x32x16_bf16(PAF(3), VFR(3), o[0], 0, 0, 0), C1, 8); \
    GAPB(o[1] = __builtin_amdgcn_mfma_f32_32x32x16_bf16(PAF(3), VFR(7), o[1], 0, 0, 0), C1, 12); \
    } while (0)
    int t = 1;
#undef CMASK
#define CMASK(P0, P1, t) do { } while (0)
    for (; t + 5 < NT; t += 2) {
        STEP(pB0, pB1, pA0, pA1, t, true, true, true);     WAIT_BAR(2); RESC(); ROT();
        STEP(pA0, pA1, pB0, pB1, t + 1, true, true, true); WAIT_BAR(2); RESC(); ROT();
    }
#undef CMASK
#define CMASK(P0, P1, t) do { int jb_ = (t) - (NT - 4); if (jb_ >= 0) cmask(P0, P1, jb_, qrel, hi); } while (0)
#define ENDW(tt) do { if ((tt) + 3 < NT) { WAIT_BAR(2); } else if ((tt) + 2 < NT) { WAIT_BAR(1); } else { WAIT_BAR(0); } } while (0)
    for (; t + 1 < NT; t += 2) {
        STEP(pB0, pB1, pA0, pA1, t, (t + 3 < NT), (t + 1 < NT), (t + 1 < NT));       ENDW(t);     RESC(); ROT();
        STEP(pA0, pA1, pB0, pB1, t + 1, (t + 4 < NT), (t + 2 < NT), (t + 2 < NT)); ENDW(t + 1); RESC(); ROT();
    }
    STEP(pB0, pB1, pA0, pA1, NT - 1, false, false, false); RESC();
    { float sacc = pB0[0] + pB0[1]; _Pragma("unroll") for (int r = 2; r < 16; ++r) sacc += pB0[r]; _Pragma("unroll") for (int r = 0; r < 16; ++r) sacc += pB1[r]; l_reg += sacc;
      pw0 = (u32x4){PKW(pB0, 0), PKW(pB0, 2), PKW(pB0, 4), PKW(pB0, 6)}; pw1 = (u32x4){PKW(pB0, 8), PKW(pB0, 10), PKW(pB0, 12), PKW(pB0, 14)}; pw2 = (u32x4){PKW(pB1, 0), PKW(pB1, 2), PKW(pB1, 4), PKW(pB1, 6)}; pw3 = (u32x4){PKW(pB1, 8), PKW(pB1, 10), PKW(pB1, 12), PKW(pB1, 14)};
      SBAR(); pv(o, vb0 + sl_cur, PAF(0), PAF(1), PAF(2), PAF(3)); }
#undef PKW
#undef PAF
#undef VFR
#undef PIN
#undef MX3
#undef GAPA
#undef GAPB
#undef EX
#undef VRD
#undef KRD
#undef STEP
#undef ENDW
    { auto rr = __builtin_amdgcn_permlane32_swap(__float_as_uint(l_reg), __float_as_uint(l_reg), false, false); l_reg = __uint_as_float(rr[0]) + __uint_as_float(rr[1]); }
    if (hi == 0) wsf[32 + r32] = l_reg; asm volatile("s_waitcnt lgkmcnt(0)" ::: "memory");
    float rli[16];
#pragma unroll
    for (int r = 0; r < 16; ++r) rli[r] = __builtin_amdgcn_rcpf(wsf[32 + crow(r, hi)]);
    bf16_t* Ow = mix + (rowbase + q0 + wid * QBLK) * D + PW + h * DH;
    { bf16_t* stg = (bf16_t*)(shm + LDS_OST) + wid * 2048;
#pragma unroll
      for (int r = 0; r < 16; ++r) { const int orow = crow(r, hi);
#pragma unroll
        for (int d0 = 0; d0 < 2; ++d0) stg[orow * 64 + d0 * 32 + r32] = (bf16_t)f2bf(o[d0][r] * rli[r]); }
      asm volatile("s_waitcnt lgkmcnt(0)" ::: "memory");
#pragma unroll
      for (int i = 0; i < 4; ++i) { const int row = i * 8 + (lane >> 3), ch = lane & 7; const u32x4 v = *(const u32x4*)(stg + row * 64 + ch * 8); *(u32x4*)(Ow + (long)row * D + ch * 8) = v; } }
    asm volatile("s_waitcnt lgkmcnt(0)\n\ts_barrier" ::: "memory");
#undef DMA_K
#undef DMA_V
#undef CMASK
#undef START
#undef RESC
#undef ROT
}
#undef SBAR
#undef WAIT_BAR
}

__device__ __forceinline__ void attn_sample_unit(int l, int b, int h, const Params& p, LAS unsigned char* lds, int tid, int lane, int wave, float thr) {
    const int l16 = lane & 15, quad = lane >> 4;
    const bf16_t* Q = (const bf16_t*)(p.ws + WS_Q); const bf16_t* Kb = (const bf16_t*)(p.ws + WS_K); const bf16_t* Vb = (const bf16_t*)(p.ws + WS_V);
    bf16_t* mix = (bf16_t*)(p.ws + WS_MIX);
    const size_t row0 = (size_t)MP + b * ST;
    const float* Fh = (const float*)(p.ws + WS_FS) + (size_t)(b * NH + h) * SKEYS;
    bf16x8 qf[2];
#pragma unroll
    for (int ks = 0; ks < 2; ++ks) qf[ks] = *(const bf16x8*)(Q + (row0 + l16) * AW + h * HD + 32 * ks + 8 * quad);
    const float fq = Fh[PAST + l16];
    f32x4 o[4];
#pragma unroll
    for (int dt = 0; dt < 4; ++dt) o[dt] = (f32x4){0.f, 0.f, 0.f, 0.f};
    float mrun = -INFINITY, lrun = 0.f;
    const float* Kc = p.in[4] + ((size_t)(l * SB + b) * PAST) * AW + h * HD;
    const float* Vc = p.in[5] + ((size_t)(l * SB + b) * PAST) * AW + h * HD;
    LAS unsigned char* Vw = lds + wave * (64 * KP);
    f32x4 rk[2][2][2], rv[8], rf[2];
#define SAMPLE_LOAD(key0_) do { \
        _Pragma("unroll") for (int kt = 0; kt < 2; ++kt) _Pragma("unroll") for (int ks = 0; ks < 2; ++ks) { \
            const float* kp = Kc + (size_t)((key0_) + 16 * kt + l16) * AW + 32 * ks + 8 * quad; rk[kt][ks][0] = __builtin_nontemporal_load((const f32x4*)kp); rk[kt][ks][1] = __builtin_nontemporal_load((const f32x4*)(kp + 4)); } \
        _Pragma("unroll") for (int j = 0; j < 8; ++j) rv[j] = __builtin_nontemporal_load((const f32x4*)(Vc + (size_t)((key0_) + 4 * j + quad) * AW + 4 * l16)); \
        _Pragma("unroll") for (int kt = 0; kt < 2; ++kt) rf[kt] = *(const f32x4*)(Fh + (key0_) + 16 * kt + 4 * quad); } while (0)
    int ks;
    { const int j = lane & 15; const bool c = (j >= 1) && (Fh[256 * (j >= 1 ? j : 1) - 1] - Fh[PAST + vzero()] >= thr); ks = 256 * __popcll(__ballot(c && lane < 16)); }
    const int nst = (PAST - ks) >> 8;
    const int kbeg = ks + wave * nst * 32;
    SAMPLE_LOAD(kbeg);
    const int nsteps = nst + (wave == 7 ? 1 : 0);
    for (int step = 0; step < nsteps; ++step) {
        const bool isnew = step == nst;
        f32x4 s[2];
        bf16x8 kf[2][2];
        asm volatile("s_waitcnt lgkmcnt(0)" ::: "memory");
        if (!isnew) {
#pragma unroll
            for (int kt = 0; kt < 2; ++kt)
#pragma unroll
                for (int ks = 0; ks < 2; ++ks) {
                    const f32x4 a = rk[kt][ks][0], c = rk[kt][ks][1];
                    u32x4 w; w.x = pk2(a[0], a[1]); w.y = pk2(a[2], a[3]); w.z = pk2(c[0], c[1]); w.w = pk2(c[2], c[3]);
                    kf[kt][ks] = __builtin_bit_cast(bf16x8, w);
                }
#pragma unroll
            for (int j = 0; j < 8; ++j) {
                const int kr = 4 * j + quad;
                u32x2 w; w.x = pk2(rv[j][0], rv[j][1]); w.y = pk2(rv[j][2], rv[j][3]);
                *(LAS u32x2*)(Vw + kr * KP + 8 * l16) = w;
            }
#pragma unroll
            for (int kt = 0; kt < 2; ++kt) s[kt] = (f32x4){fq - rf[kt][0], fq - rf[kt][1], fq - rf[kt][2], fq - rf[kt][3]};
            if (step + 1 < nst) SAMPLE_LOAD(kbeg + (step + 1) * 32);
        } else {
#pragma unroll
            for (int ks = 0; ks < 2; ++ks) { kf[0][ks] = *(const bf16x8*)(Kb + (row0 + l16) * AW + h * HD + 32 * ks + 8 * quad); kf[1][ks] = (bf16x8){0, 0, 0, 0, 0, 0, 0, 0}; }
            {
                const int kr = lane >> 2, ch = lane & 3;
                const u32x4 a = *(const u32x4*)(Vb + (row0 + kr) * AW + h * HD + 16 * ch), c = *(const u32x4*)(Vb + (row0 + kr) * AW + h * HD + 16 * ch + 8);
                *(LAS u32x4*)(Vw + kr * KP + 32 * ch) = a; *(LAS u32x4*)(Vw + kr * KP + 32 * ch + 16) = c;
                *(LAS u32x4*)(Vw + (16 + kr) * KP + 32 * ch) = (u32x4){0u, 0u, 0u, 0u}; *(LAS u32x4*)(Vw + (16 + kr) * KP + 32 * ch + 16) = (u32x4){0u, 0u, 0u, 0u};
            }
            const f32x4 fk = *(const f32x4*)(Fh + PAST + 4 * quad);
            s[0] = (f32x4){fq - fk[0], fq - fk[1], fq - fk[2], fq - fk[3]};
            s[1] = (f32x4){-INFINITY, -INFINITY, -INFINITY, -INFINITY};
        }
#pragma unroll
        for (int ks = 0; ks < 2; ++ks) {
            s[0] = __builtin_amdgcn_mfma_f32_16x16x32_bf16(kf[0][ks], qf[ks], s[0], 0, 0, 0);
            if (!isnew) s[1] = __builtin_amdgcn_mfma_f32_16x16x32_bf16(kf[1][ks], qf[ks], s[1], 0, 0, 0);
        }
        if (isnew) {
#pragma unroll
            for (int r = 0; r < 4; ++r) if (4 * quad + r > l16) s[0][r] = -INFINITY;
        }
        float mx = fmaxf(fmaxf(s[0][0], s[0][1]), fmaxf(s[0][2], s[0][3]));
        mx = fmaxf(mx, fmaxf(fmaxf(s[1][0], s[1][1]), fmaxf(s[1][2], s[1][3])));
        mx = fmaxf(mx, __shfl_xor(mx, 16)); mx = fmaxf(mx, __shfl_xor(mx, 32));
        const float mnew = fmaxf(mrun, mx);
        const float alpha = __builtin_amdgcn_exp2f(mrun - mnew);
        mrun = mnew;
        float ps = 0.f;
#pragma unroll
        for (int kt = 0; kt < 2; ++kt)
#pragma unroll
            for (int r = 0; r < 4; ++r) { const float e = __builtin_amdgcn_exp2f(s[kt][r] - mnew); s[kt][r] = e; ps += e; }
        lrun = lrun * alpha + ps;
        u32x4 w; w.x = pk2(s[0][0], s[0][1]); w.y = pk2(s[0][2], s[0][3]); w.z = pk2(s[1][0], s[1][1]); w.w = pk2(s[1][2], s[1][3]);
        const bf16x8 pb = __builtin_bit_cast(bf16x8, w);
        asm volatile("s_waitcnt lgkmcnt(0)" ::: "memory");
        const LAS unsigned char* vb0 = Vw + (4 * quad + (l16 >> 2)) * KP + 8 * (l16 & 3);
#pragma unroll
        for (int dt = 0; dt < 4; ++dt) {
            const s16x4 a0 = vtr(vb0 + 32 * dt), a1 = vtr(vb0 + 16 * KP + 32 * dt);
            const bf16x8 vf = (bf16x8){a0[0], a0[1], a0[2], a0[3], a1[0], a1[1], a1[2], a1[3]};
            o[dt] = o[dt] * alpha;
            o[dt] = __builtin_amdgcn_mfma_f32_16x16x32_bf16(vf, pb, o[dt], 0, 0, 0);
        }
    }
#undef SAMPLE_LOAD
    float lt = lrun; lt += __shfl_xor(lt, 16); lt += __shfl_xor(lt, 32);
    LAS float* cm = (LAS float*)(lds + 8 * 64 * KP);
    LAS float* cl = cm + 128; LAS float* co = cl + 128;
    if (quad == 0) { cm[wave * 16 + l16] = mrun; cl[wave * 16 + l16] = lt; }
#pragma unroll
    for (int dt = 0; dt < 4; ++dt)
#pragma unroll
        for (int r = 0; r < 4; ++r) co[(wave * 16 + l16) * 64 + 16 * dt + 4 * quad + r] = o[dt][r];
    __syncthreads();
    {
        const int q = tid >> 5, d0 = (tid & 31) * 2;
        float mm = cm[q];
#pragma unroll
        for (int w = 1; w < 8; ++w) mm = fmaxf(mm, cm[w * 16 + q]);
        float L = 0.f, a0 = 0.f, a1 = 0.f;
#pragma unroll
        for (int w = 0; w < 8; ++w) { const float f = __builtin_amdgcn_exp2f(cm[w * 16 + q] - mm); L += cl[w * 16 + q] * f; a0 += co[(w * 16 + q) * 64 + d0] * f; a1 += co[(w * 16 + q) * 64 + d0 + 1] * f; }
        const float il = 1.0f / L;
        *(unsigned*)(mix + (row0 + q) * D + PW + h * HD + d0) = pk2(a0 * il, a1 * il);
    }
    __syncthreads();
}

__device__ __forceinline__ void phase_attn(const Params& p, LAS unsigned char* lds, int l, int ci, int mode, int tid, int lane, int wave) {
    unsigned* ctr = (unsigned*)(p.ws + WS_CTL) + 64 * ci;
    LAS unsigned* slot = (LAS unsigned*)(lds + LDS_BYTES - 64);
    char* lds_generic = (char*)lds;
    const bf16_t* Q = (const bf16_t*)(p.ws + WS_Q); const bf16_t* Kb = (const bf16_t*)(p.ws + WS_K); const bf16_t* Vb = (const bf16_t*)(p.ws + WS_V);
    const float* Fp = (const float*)(p.ws + WS_FP); bf16_t* mix = (bf16_t*)(p.ws + WS_MIX);
    float thr;
    {
        const float gq = fabsf(p.in[12][l * HD + lane]), gk = fabsf(p.in[13][l * HD + lane]);
        float mq = gq, mk = gk;
#pragma unroll
        for (int o = 1; o < 64; o <<= 1) { mq = fmaxf(mq, __shfl_xor(mq, o)); mk = fmaxf(mk, __shfl_xor(mk, o)); }
        thr = 53.f + 2.f * (64.f * mq * mk * C2 + 0.5f);
    }
    LAS unsigned* cnt = (LAS unsigned*)lds;
    LAS unsigned* keys = (LAS unsigned*)(lds + 1024);
    LAS unsigned short* order = (LAS unsigned short*)(lds + fa::LDS_END);
    const float* Fs = (const float*)(p.ws + WS_FS);
    for (int i = tid; i < 216; i += 512) cnt[i] = 0u;
    __syncthreads();
    for (int i = tid; i < 24 * 124; i += 512) { const int bh = i / 124, j = i % 124 + 1; const float* Fh = Fp + (size_t)bh * T; if (Fh[64 * j - 1] - Fh[31 * 256] >= thr) atomicAdd((unsigned*)(cnt + bh), 1u); }
    for (int i = tid; i < 192 * 15; i += 512) { const int si = i / 15, j = i % 15 + 1; const float* Fh = Fs + (size_t)si * SKEYS; if (Fh[256 * j - 1] - Fh[PAST] >= thr) atomicAdd((unsigned*)(cnt + 24 + si), 1u); }
    __syncthreads();
    for (int id = tid; id < 1024; id += 512) {
        unsigned key = 0u;
        if (id < 768) { const int bh = id >> 5, qb = id & 31, w = 124 - (int)(cnt[bh] & ~1u); int t0a = 4 * qb - w; t0a = t0a > 0 ? (t0a & ~1) : 0;
            key = ((unsigned)(4 * (qb + 1) - t0a + 3) << 10) | (unsigned)(1023 - id); }
        else if (id < 960) { const int nst = 16 - (int)cnt[24 + id - 768]; key = ((unsigned)(5 + (10 * nst) / 3) << 10) | (unsigned)(1023 - id); }
        keys[id] = key;
    }
    __syncthreads();
    {
        const unsigned k0 = keys[tid], k1 = keys[tid + 512]; unsigned p0 = 0u, p1 = 0u;
        for (int k = 0; k < 1024; k += 4) { const u32x4 v = *(const LAS u32x4*)(keys + k);
            p0 += (v.x > k0) + (v.y > k0) + (v.z > k0) + (v.w > k0); p1 += (v.x > k1) + (v.y > k1) + (v.z > k1) + (v.w > k1); }
        order[p0] = (unsigned short)tid;
        if (tid + 512 < 960) order[p1] = (unsigned short)(tid + 512);
    }
    __syncthreads();
    for (;;) {
        if (tid == 0) *slot = atomicAdd(ctr, 1u);
        __syncthreads();
        const int idx = (int)*slot;
        __syncthreads();
        if (idx >= 960) break;
        const int id = (int)order[idx];
        const int tf = fresh_tid(), lf = tf & 63, wf = __builtin_amdgcn_readfirstlane(tf >> 6);
        if (id >= 768) { if (mode == 1) continue; const int si = id - 768; attn_sample_unit(l, si / NH, si % NH, p, lds, tf, lf, wf, thr); }
        else { if (mode == 2) continue; const int bh = id >> 5, qb = id & 31;
            int t0;
            { const float* Fh = Fp + (size_t)bh * T; const float f0 = Fh[qb * 256 + vzero()];
              const int ja = lf + 1, jb2 = lf + 65, jmax = 4 * qb;
              const bool ca = (ja <= jmax) && (Fh[64 * (ja <= jmax ? ja : 1) - 1] - f0 >= thr), cb = (jb2 <= jmax) && (Fh[64 * (jb2 <= jmax ? jb2 : 1) - 1] - f0 >= thr);
              t0 = (__popcll(__ballot(ca)) + __popcll(__ballot(cb))) & ~1; }
            fa::attn_unit<8>(bh / NH, bh % NH, qb, Q, Kb, Vb, Fp, mix, lds_generic, tf, t0);
        }
    }
    if (mode == 0) { const int tf = fresh_tid(); pool_items(p, lds, l, ctr + 8, slot, tf, tf & 63, __builtin_amdgcn_readfirstlane(tf >> 6)); }
}

#define XB_XCNT(j) (1024 + 64 * (j))
#define XB_XSUB(j) (2048 + 64 * (j))
#define XB_XGEN(j) (3072 + 64 * (j))
#define XB_TOP 4096
#define XB_TOPGEN 4160
__device__ __forceinline__ unsigned xb_ld(unsigned* p) { return __hip_atomic_load(p, __ATOMIC_RELAXED, __HIP_MEMORY_SCOPE_AGENT); }
__device__ __forceinline__ unsigned xb_add(unsigned* p, unsigned v) { return __hip_atomic_fetch_add(p, v, __ATOMIC_RELAXED, __HIP_MEMORY_SCOPE_AGENT); }
__device__ __forceinline__ unsigned xcc_id() { return (unsigned)__builtin_amdgcn_s_getreg((3 << 11) | 20) & 0xFu; }
__device__ __forceinline__ void grid_bar(unsigned* bar, volatile LAS unsigned* st) {
    asm volatile("s_waitcnt vmcnt(0)" ::: "memory");
    __syncthreads();
    if (threadIdx.x == 0) {
        __builtin_amdgcn_s_waitcnt(0);
        const unsigned x = xcc_id(), nloc = st[0], nx = st[1];
        const unsigned old = xb_add(&bar[XB_XSUB(x)], 1u);
        const unsigned gen = old / nloc;
        if (old + 1u == (gen + 1u) * nloc) {
            __builtin_amdgcn_fence(__ATOMIC_RELEASE, "agent");
            asm volatile("s_waitcnt vmcnt(0)" ::: "memory");
            const unsigned og = xb_add(&bar[XB_TOP], 1u);
            const unsigned tg = og / nx;
            if (og + 1u == (tg + 1u) * nx) xb_add(&bar[XB_TOPGEN], 1u);
            else { while (xb_ld(&bar[XB_TOPGEN]) == tg) __builtin_amdgcn_s_sleep(1); }
            __builtin_amdgcn_fence(__ATOMIC_ACQUIRE, "agent");
            xb_add(&bar[XB_XGEN(x)], 1u);
            asm volatile("s_waitcnt vmcnt(0)" ::: "memory");
        } else {
            while (xb_ld(&bar[XB_XGEN(x)]) == gen) __builtin_amdgcn_s_sleep(1);
            __builtin_amdgcn_fence(__ATOMIC_ACQUIRE, "agent");
            asm volatile("s_waitcnt vmcnt(0)" ::: "memory");
        }
    }
    __syncthreads();
}
#define FRESH_TID() fresh_tid()
#define TLW(t) (t), ((t) & 63), __builtin_amdgcn_readfirstlane((t) >> 6)
__global__ void __launch_bounds__(512, 2) fwd_megakernel(Params p) {
    extern __shared__ __attribute__((aligned(16))) unsigned char lds_raw[];
    LAS unsigned char* lds = (LAS unsigned char*)lds_raw;
    cg::grid_group grid = cg::this_grid();
    const int G = gridDim.x;

    unsigned* bar_w = (unsigned*)(p.ws + WS_CTL);
    if (threadIdx.x == 0) (void)xb_add(&bar_w[XB_XCNT(xcc_id())], 1u);
    { const int t_ = FRESH_TID(); phase_prologue(p, lds, TLW(t_)); }

#ifdef XSYNC
    for (int i = 0; i < XSYNC; ++i) grid.sync();
#endif
    volatile LAS unsigned* bar_st = (volatile LAS unsigned*)(lds + LDS_BYTES - 32);
    if (threadIdx.x == 0) {
        unsigned mine, cnt, sum; const unsigned x = xcc_id();
        for (;;) {
            mine = 0u; cnt = 0u; sum = 0u;
            for (unsigned j = 0; j < 16; ++j) { const unsigned c = xb_ld(&bar_w[XB_XCNT(j)]); sum += c; cnt += (c > 0u) ? 1u : 0u; mine = (j == x) ? c : mine; }
            if (sum == (unsigned)G) break;
            __builtin_amdgcn_s_sleep(1);
        }
        bar_st[0] = mine; bar_st[1] = cnt;
    }
    __syncthreads();
#define GB() grid_bar(bar_w, bar_st)
    if (G == 0x7fffffff) grid.sync();
    GB();
    float* xa = (float*)(p.ws + WS_XA); float* xb = (float*)(p.ws + WS_XB);
    bf16_t* hn = (bf16_t*)(p.ws + WS_HN);
    for (int l = 0; l < 2; ++l) {
        const float* xp = (l == 0) ? p.in[0] : xb; const float* xs = (l == 0) ? p.in[1] : xb + (size_t)MP * D;
        float* yp = (l == 0) ? xb : p.out; float* ys = yp + (size_t)MP * D;
        const float* modl = (const float*)(p.ws + WS_MOD) + (size_t)l * NMODROW * MODW;
        for (int rep = 0; rep < NREP(0); ++rep) {
            { const int t_ = FRESH_TID(); phase_norm(p, lds, l, 1, xp, xs, TLW(t_)); }
            GB();
        }
        for (int rep = 0; rep < NREP(1); ++rep) {
            pg8::Gemm g{hn, (const bf16_t*)(p.ws + WS_WIN) + (size_t)l * NMAIN * D, M, NMAIN, D};
            pg8::StaticOrder S; S.init(MP, NMAIN, G, (int)blockIdx.x);
            EpiIn E{l, p.out, (bf16_t*)(p.ws + WS_Q), (bf16_t*)(p.ws + WS_K), (bf16_t*)(p.ws + WS_V), (float*)(p.ws + WS_U), p.in[12] + l * HD, p.in[13] + l * HD};
            pg8::gemm_phase<EpiIn, true, true>(lds, g, S, E, FRESH_TID());
            { SEpiIn SE{l, p.out, (bf16_t*)(p.ws + WS_Q), (bf16_t*)(p.ws + WS_K), (bf16_t*)(p.ws + WS_V), (float*)(p.ws + WS_U), p.in[12] + l * HD, p.in[13] + l * HD};
              const int t_ = FRESH_TID(); skinny_phase<SEpiIn>(lds, g.A, g.Bt, NMAIN, D, SE, TLW(t_)); }
            { const int t_ = FRESH_TID(); scan_items(p, lds, l, TLW(t_)); }
            if (l == 0 && rep == 0) {
                for (int ll = 0; ll < 2; ++ll) { SEpiBias SE{(float*)(p.ws + WS_BIAS2) + (size_t)ll * NMODROW * FF}; const int t_ = FRESH_TID();
                    skinny_phase<SEpiBias>(lds, (const bf16_t*)(p.ws + WS_SH2) + (size_t)ll * 32 * D, (const bf16_t*)(p.ws + WS_WUP) + (size_t)ll * FF * D, FF, D, SE, TLW(t_), 0, 2); }
            }
            GB();
        }
        for (int rep = 0; rep < NREP(3); ++rep) {
            { const int t_ = FRESH_TID(); phase_attn(p, lds, l, l * 2 + rep, rep == 0 ? 0 : ATT_DUP_MODE, TLW(t_)); }
            GB();
        }
        for (int rep = 0; rep < NREP(4); ++rep) {
            pg8::Gemm g{(const bf16_t*)(p.ws + WS_MIX), (const bf16_t*)(p.ws + WS_WOUT) + (size_t)l * D * D, M, D, D};
            pg8::StaticOrder S; S.init(MP, D, G, (int)blockIdx.x);
            EpiResN E{xp, xa, modl + 2 * D, modl + 4 * D, hn, (float*)(p.ws + WS_SS)};
            pg8::gemm_phase<EpiResN, false, true>(lds, g, S, E, FRESH_TID());
            { SEpiResN SE{xs, xa + (size_t)MP * D, modl + 2 * D, modl + 4 * D, hn, (float*)(p.ws + WS_SS)}; const int t_ = FRESH_TID(); skinny_phase<SEpiResN>(lds, g.A, g.Bt, D, D, SE, TLW(t_)); }
            GB();
        }
        for (int rep = 0; rep < NREP(6); ++rep) {
            pg8::Gemm g{hn, (const bf16_t*)(p.ws + WS_WUP) + (size_t)l * FF * D, M, FF, D};
            pg8::StaticOrder S; S.init(MP, FF, G, (int)blockIdx.x);
            const float* bias_l = (const float*)(p.ws + WS_BIAS2) + (size_t)l * NMODROW * FF;
            EpiUpN E{(bf16_t*)(p.ws + WS_HID), (const float*)(p.ws + WS_SS), bias_l};
            pg8::gemm_phase<EpiUpN, true, true>(lds, g, S, E, FRESH_TID());
            { SEpiUpN SE{(bf16_t*)(p.ws + WS_HID), (const float*)(p.ws + WS_SS), bias_l}; const int t_ = FRESH_TID(); skinny_phase<SEpiUpN>(lds, g.A, g.Bt, FF, D, SE, TLW(t_)); }
            GB();
        }
        for (int rep = 0; rep < NREP(7); ++rep) {
            pg8::Gemm g{(const bf16_t*)(p.ws + WS_HID), (const bf16_t*)(p.ws + WS_WDN) + (size_t)l * D * FF, M, D, FF};
            pg8::StaticOrder S; S.init(MP, D, G, (int)blockIdx.x);
            EpiRes E{xa, xa + (size_t)MP * D, yp, ys, modl + 5 * D};
            pg8::gemm_phase<EpiRes, false, true>(lds, g, S, E, FRESH_TID());
            { SEpiRes SE{xa + (size_t)MP * D, ys, modl + 5 * D}; const int t_ = FRESH_TID(); skinny_phase<SEpiRes>(lds, g.A, g.Bt, D, FF, SE, TLW(t_)); }
            if (l == 0 || rep + 1 < NREP(7)) GB();
        }
    }
}

extern "C" void kernel_launch(void* const* d_in, const int* in_sizes, int n_in, void* d_out, int out_size, void* d_ws, size_t ws_size, hipStream_t stream) {
    static int grid = 0;
    if (grid == 0) {
        if (n_in != 19 || (size_t)out_size != OUT_TOTAL || ws_size < WS_END) { fprintf(stderr, "kernel_launch: unexpected shapes (n_in %d out %d ws %zu)\n", n_in, out_size, ws_size); grid = -1; return; }
        int dev = 0, cus = 0, per_cu = 0;
        hipGetDevice(&dev);
        hipDeviceGetAttribute(&cus, hipDeviceAttributeMultiprocessorCount, dev);
        hipFuncSetAttribute((const void*)fwd_megakernel, hipFuncAttributeMaxDynamicSharedMemorySize, LDS_BYTES);
        hipOccupancyMaxActiveBlocksPerMultiprocessor(&per_cu, (const void*)fwd_megakernel, 512, LDS_BYTES);
        if (per_cu < 1) { fprintf(stderr, "kernel_launch: occupancy query says %d blocks per CU\n", per_cu); per_cu = 1; }
        grid = cus;
    }
    if (grid < 0) return;
    hipMemsetAsync((char*)d_ws + WS_CTL, 0, 20480, stream);
    Params p{};
    for (int i = 0; i < 19; ++i) p.in[i] = (const float*)d_in[i];
    p.out = (float*)d_out; p.ws = (unsigned char*)d_ws;
    void* args[] = {&p};
    hipError_t e = hipLaunchCooperativeKernel((const void*)fwd_megakernel, dim3(grid), dim3(512), args, LDS_BYTES, stream);
    if (e != hipSuccess) fprintf(stderr, "cooperative launch failed: %s (grid %d)\n", hipGetErrorString(e), grid);
}
```

```cpp
#include <hip/hip_runtime.h>
#include <hip/hip_cooperative_groups.h>
#include <cstdio>
#include <cstdint>
namespace cg = cooperative_groups;

#define LAS __attribute__((address_space(3)))
typedef unsigned short bf16_t;
typedef short bf16x8 __attribute__((ext_vector_type(8)));
typedef short s16x4 __attribute__((ext_vector_type(4)));
typedef float f32x4 __attribute__((ext_vector_type(4)));
typedef float f32x2 __attribute__((ext_vector_type(2)));
typedef unsigned u32x4 __attribute__((ext_vector_type(4)));
typedef unsigned u32x2 __attribute__((ext_vector_type(2)));

constexpr int D = 1024, T = 8192, NBP = 2, SB = 16, ST = 16, PAST = 4096;
constexpr int MP = NBP * T, MS = SB * ST, M = MP + MS;
constexpr int NH = 12, HD = 64, AW = 768, PW = 256, INC = 2572, NMAIN = 2560, FF = 4096;
constexpr int NMODROW = 18, MODW = 6 * D;
constexpr float EPS = 1e-6f;
constexpr float LOG2E = 1.4426950408889634f;
constexpr float C2 = 0.125f * LOG2E;
constexpr int SKEYS = PAST + ST;

constexpr size_t OFF_Y = 0;
constexpr size_t OFF_KP = (size_t)M * D;
constexpr size_t OFF_VP = OFF_KP + (size_t)2 * MP * AW;
constexpr size_t OFF_FP = OFF_VP + (size_t)2 * MP * AW;
constexpr size_t OFF_PP = OFF_FP + (size_t)2 * MP * NH;
constexpr size_t OFF_KS = OFF_PP + (size_t)2 * NBP * 15 * PW;
constexpr size_t OFF_VS = OFF_KS + (size_t)2 * MS * AW;
constexpr size_t OFF_FS = OFF_VS + (size_t)2 * MS * AW;
constexpr size_t OFF_PS = OFF_FS + (size_t)2 * MS * NH;
constexpr size_t OUT_TOTAL = OFF_PS + (size_t)2 * SB * 15 * PW;

constexpr size_t MiB = 1u << 20;
constexpr size_t WS_CTL = 0;
constexpr size_t WS_MOD = 1 * MiB;
constexpr size_t WS_WIN = 2 * MiB;
constexpr size_t WS_WOUT = 12 * MiB;
constexpr size_t WS_WUP = 16 * MiB;
constexpr size_t WS_WDN = 32 * MiB;
constexpr size_t WS_HN = 48 * MiB;
constexpr size_t WS_Q = 82 * MiB;
constexpr size_t WS_K = 108 * MiB;
constexpr size_t WS_V = 134 * MiB;
constexpr size_t WS_U = 160 * MiB;
constexpr size_t WS_MIX = 178 * MiB;
constexpr size_t WS_FP = 212 * MiB;
constexpr size_t WS_FS = 213 * MiB;
constexpr size_t WS_SS = 217 * MiB;
constexpr size_t WS_BIAS2 = WS_SS + 128 * 1024;
constexpr size_t WS_SH2 = WS_BIAS2 + 640 * 1024;
constexpr size_t WS_XA = 218 * MiB;
constexpr size_t WS_XB = 284 * MiB;
constexpr size_t WS_HID = 350 * MiB;
constexpr size_t WS_END = 482 * MiB;

constexpr int LDS_BYTES = 147456;
#ifndef DUP
#define DUP 0
#endif
#define NREP(k) (1 + ((DUP >> (k)) & 1))
#ifndef ATT_DUP_MODE
#define ATT_DUP_MODE 0
#endif

__device__ __forceinline__ unsigned f2bf(float f) { unsigned u = __builtin_bit_cast(unsigned, f); return (u + 0x7fffu + ((u >> 16) & 1u)) >> 16; }
typedef __bf16 bf16x2_t __attribute__((ext_vector_type(2)));
__device__ __forceinline__ unsigned pk2(float lo, float hi) { const f32x2 v = {lo, hi}; const bf16x2_t b = __builtin_convertvector(v, bf16x2_t); return __builtin_bit_cast(unsigned, b); }
template <int CTRL> __device__ __forceinline__ float dpp_f(float v) { return __builtin_bit_cast(float, __builtin_amdgcn_update_dpp(0, __builtin_bit_cast(int, v), CTRL, 0xF, 0xF, false)); }
__device__ __forceinline__ float quad_sum(float v) {
    auto a = __builtin_amdgcn_permlane16_swap(__float_as_uint(v), __float_as_uint(v), false, false);
    const float s = __uint_as_float(a[0]) + __uint_as_float(a[1]);
    auto b = __builtin_amdgcn_permlane32_swap(__float_as_uint(s), __float_as_uint(s), false, false);
    return __uint_as_float(b[0]) + __uint_as_float(b[1]);
}
__device__ __forceinline__ float wave_sum(float v) {
    v += dpp_f<0x128>(v); v += dpp_f<0x124>(v); v += dpp_f<0x122>(v); v += dpp_f<0x121>(v);
    return quad_sum(v);
}

__device__ __forceinline__ int vzero() { int z = 0; asm volatile("" : "+v"(z)); return z; }
__device__ __forceinline__ int fresh_tid() { int t = threadIdx.x; asm volatile("" : "+v"(t)); return t; }
namespace pg8 {
constexpr int BM = 256, BK = 64, HALF = 128, HTB = HALF * BK * 2, NXCD = 8, WGM = 8;
__host__ __device__ __forceinline__ int lds_byte(int r, int c) { const int st = (r >> 4) * 2 + (c >> 5), rr = r & 15, cc = c & 31, ob = rr * 64 + cc * 2; return st * 1024 + (ob ^ (((ob >> 9) & 1) << 5)); }
__host__ __device__ __forceinline__ void stage_rc(int b, int& R, int& C) { const int st = b / 1024, sb = b % 1024, swz = sb ^ (((sb >> 9) & 1) << 5); R = (st >> 1) * 16 + swz / 64; C = (st & 1) * 32 + (swz % 64) / 2; }
__host__ __device__ __forceinline__ int perm32(int rho) { const int n = rho >> 4, i = rho & 15; return 8 * (i >> 2) + 4 * n + (i & 3); }

struct Unit { int pm, pn; };
struct Gemm { const bf16_t* A; const bf16_t* Bt; int M, N, K; };

struct StaticOrder {
    int nM, nN, nwg, G, c;
    __device__ void init(int M_, int N_, int G_, int c_) { nM = M_ / BM; nN = N_ / BM; nwg = nM * nN; G = G_; c = c_; }
    __device__ bool next(int i, Unit& u) const {
        const long L = (long)i * G + c; if (L >= nwg) return false;
        int wgid = (int)L; { const int q = nwg / NXCD, r = nwg % NXCD, xcd = wgid % NXCD, off = wgid / NXCD; wgid = (xcd < r ? xcd * (q + 1) : r * (q + 1) + (xcd - r) * q) + off; }
        const int nig = WGM * nN, gid = wgid / nig, fm = gid * WGM, gsz = (nM - fm) < WGM ? (nM - fm) : WGM;
        u.pm = fm + ((wgid % nig) % gsz); u.pn = (wgid % nig) / gsz; return true;
    }
};

template <class Epi, bool ALIGN_EPI, bool SP2>
__device__ __forceinline__ void gemm_phase(LAS unsigned char* lds, const Gemm g, const StaticOrder& S, const Epi& E, const int tid) {
    const int wid = __builtin_amdgcn_readfirstlane(tid >> 6), lane = tid & 63, wr = wid >> 2, wc = wid & 3, fr = lane & 15, fq = lane >> 4;
    const int K = g.K, nt = K / BK;
    unsigned voffA[2], voffB[2];
#pragma unroll
    for (int i = 0; i < 2; ++i) { int R, C; stage_rc(tid * 16 + i * 8192, R, C); const int Rb = 64 * (R >> 5) + perm32(R & 31);
        voffA[i] = (unsigned)(R * K + C) * 2u; voffB[i] = (unsigned)(Rb * K + C) * 2u; }
    const size_t kstep = (size_t)(BK * 2);
    const size_t hstep = (size_t)HALF * K * 2;
    const size_t hstepB = (size_t)32 * K * 2;
    const size_t tstep = 2 * hstep;
    const unsigned ldsw = (unsigned)wid * 1024u;
    const int aoff = lds_byte(wr * 64 + fr, fq * 8), boff = lds_byte(wc * 32 + fr, fq * 8);
#define PG8_SA(b, h) (((b) * 2 + (h)) * HTB)
#define PG8_SB(b, h) ((4 + (b) * 2 + (h)) * HTB)
#define PG8_STAGE(bufoff, gbase, voff) do { _Pragma("unroll") for (int _i = 0; _i < 2; ++_i) \
        __builtin_amdgcn_global_load_lds((const unsigned*)((const char*)(gbase) + (voff)[_i]), (LAS unsigned*)(lds + (bufoff) + ldsw + _i * 8192), 16, 0, 0); } while (0)
#define PG8_LDA(dst, b, h) do { _Pragma("unroll") for (int m = 0; m < 4; ++m) _Pragma("unroll") for (int k = 0; k < 2; ++k) dst[m][k] = *(const LAS bf16x8*)(lds + PG8_SA(b, h) + aoff + m * 2048 + k * 1024); } while (0)
#define PG8_LDB(dst, b, h) do { _Pragma("unroll") for (int n = 0; n < 2; ++n) _Pragma("unroll") for (int k = 0; k < 2; ++k) dst[n][k] = *(const LAS bf16x8*)(lds + PG8_SB(b, h) + boff + n * 2048 + k * 1024); } while (0)
#define PG8_MMA(ai, bj, At, Bt) do { __builtin_amdgcn_s_setprio(1); _Pragma("unroll") for (int m = 0; m < 4; ++m) _Pragma("unroll") for (int n = 0; n < 2; ++n) _Pragma("unroll") for (int k = 0; k < 2; ++k) \
        acc[ai][bj][m][n] = __builtin_amdgcn_mfma_f32_16x16x32_bf16(Bt[n][k], At[m][k], acc[ai][bj][m][n], 0, 0, 0); __builtin_amdgcn_s_setprio(0); } while (0)
#define PG8_WAIT_V(n) asm volatile("s_waitcnt vmcnt(" #n ")" ::: "memory")
#define PG8_WAIT_L(n) asm volatile("s_waitcnt lgkmcnt(" #n ")" ::: "memory")
#define PG8_BAR __builtin_amdgcn_s_barrier()
#define PG8_SCHED __builtin_amdgcn_sched_barrier(0)
    Unit cur, nxt; int ui = 0;
    if (!S.next(0, cur)) return;
    f32x4 acc[2][2][4][2];
#pragma unroll
    for (int a = 0; a < 2; ++a)
#pragma unroll
        for (int b = 0; b < 2; ++b)
#pragma unroll
            for (int m = 0; m < 4; ++m)
#pragma unroll
                for (int n = 0; n < 2; ++n) acc[a][b][m][n] = (f32x4){0.f, 0.f, 0.f, 0.f};
    bf16x8 At[4][2], B0[2][2], B1[2][2];
    const char* cA = (const char*)g.A + (size_t)cur.pm * tstep; const char* cB = (const char*)g.Bt + (size_t)cur.pn * tstep;
    if constexpr (SP2) {
        PG8_STAGE(PG8_SB(0, 0), cB, voffB); PG8_STAGE(PG8_SB(0, 1), cB + hstepB, voffB); PG8_STAGE(PG8_SA(0, 0), cA, voffA); PG8_STAGE(PG8_SA(0, 1), cA + hstep, voffA);
        if (wr == 1) PG8_BAR;
        PG8_WAIT_V(2); PG8_BAR;
        PG8_STAGE(PG8_SB(1, 0), cB + kstep, voffB); PG8_STAGE(PG8_SA(1, 0), cA + kstep, voffA); PG8_STAGE(PG8_SB(1, 1), cB + hstepB + kstep, voffB);
        PG8_WAIT_V(6); PG8_BAR;
    } else {
    PG8_STAGE(PG8_SB(0, 0), cB, voffB); PG8_STAGE(PG8_SA(0, 0), cA, voffA); PG8_STAGE(PG8_SB(0, 1), cB + hstepB, voffB); PG8_STAGE(PG8_SA(0, 1), cA + hstep, voffA);
    if (wr == 1) PG8_BAR;
    PG8_WAIT_V(4); PG8_BAR;
    PG8_STAGE(PG8_SB(1, 0), cB + kstep, voffB); PG8_STAGE(PG8_SA(1, 0), cA + kstep, voffA); PG8_STAGE(PG8_SB(1, 1), cB + hstepB + kstep, voffB);
    PG8_WAIT_V(6); PG8_BAR;
    }
    for (;;) {
        const bool has_next = S.next(ui + 1, nxt);
        const char* nA = has_next ? (const char*)g.A + (size_t)nxt.pm * tstep : cA; const char* nB = has_next ? (const char*)g.Bt + (size_t)nxt.pn * tstep : cB;
        for (int t = 0; t < nt; t += 2) {
            const bool last = (t == nt - 2);
            const char* a1 = cA + (size_t)(t + 1) * kstep;
            const char* a2 = last ? nA : cA + (size_t)(t + 2) * kstep; const char* b2 = last ? nB : cB + (size_t)(t + 2) * kstep;
            const char* a3 = a2 + kstep; const char* b3 = b2 + kstep;
            if constexpr (SP2) {
            PG8_LDB(B0, 0, 0); PG8_LDB(B1, 0, 1); PG8_SCHED; PG8_LDA(At, 0, 0); PG8_STAGE(PG8_SA(1, 1), a1 + hstep, voffA);
            PG8_WAIT_V(8); PG8_WAIT_L(0); PG8_BAR; PG8_MMA(0, 0, At, B0); PG8_MMA(0, 1, At, B1); PG8_BAR; PG8_SCHED;
            PG8_LDA(At, 0, 1); PG8_STAGE(PG8_SB(0, 0), b2, voffB); PG8_STAGE(PG8_SB(0, 1), b2 + hstepB, voffB); PG8_STAGE(PG8_SA(0, 0), a2, voffA);
            PG8_WAIT_V(8); PG8_WAIT_L(0); PG8_BAR; PG8_MMA(1, 0, At, B0); PG8_MMA(1, 1, At, B1); PG8_BAR; PG8_SCHED;
            PG8_LDB(B0, 1, 0); PG8_LDB(B1, 1, 1); PG8_SCHED; PG8_LDA(At, 1, 0); PG8_STAGE(PG8_SA(0, 1), a2 + hstep, voffA);
            PG8_WAIT_V(8); PG8_WAIT_L(0); PG8_BAR; PG8_MMA(0, 0, At, B0); PG8_MMA(0, 1, At, B1); PG8_BAR; PG8_SCHED;
            PG8_LDA(At, 1, 1); PG8_STAGE(PG8_SB(1, 0), b3, voffB); PG8_STAGE(PG8_SB(1, 1), b3 + hstepB, voffB); PG8_STAGE(PG8_SA(1, 0), a3, voffA);
            PG8_WAIT_V(8); PG8_WAIT_L(0); PG8_BAR; PG8_MMA(1, 0, At, B0); PG8_MMA(1, 1, At, B1); PG8_BAR; PG8_SCHED;
            } else {
            PG8_LDB(B0, 0, 0); PG8_SCHED; PG8_LDA(At, 0, 0); PG8_STAGE(PG8_SA(1, 1), a1 + hstep, voffA);
            PG8_WAIT_L(8); PG8_BAR; PG8_WAIT_L(0); PG8_MMA(0, 0, At, B0); PG8_BAR; PG8_SCHED;
            PG8_LDB(B1, 0, 1); PG8_STAGE(PG8_SB(0, 0), b2, voffB);
            PG8_BAR; PG8_WAIT_L(0); PG8_MMA(0, 1, At, B1); PG8_BAR;
            PG8_LDA(At, 0, 1); PG8_STAGE(PG8_SA(0, 0), a2, voffA);
            PG8_BAR; PG8_WAIT_L(0); PG8_MMA(1, 0, At, B0); PG8_BAR; PG8_SCHED;
            PG8_STAGE(PG8_SB(0, 1), b2 + hstepB, voffB);
            PG8_WAIT_V(6); PG8_BAR; PG8_MMA(1, 1, At, B1); PG8_BAR;
            PG8_LDB(B0, 1, 0); PG8_SCHED; PG8_LDA(At, 1, 0); PG8_STAGE(PG8_SA(0, 1), a2 + hstep, voffA);
            PG8_WAIT_L(8); PG8_BAR; PG8_WAIT_L(0); PG8_MMA(0, 0, At, B0); PG8_BAR; PG8_SCHED;
            PG8_LDB(B1, 1, 1); PG8_STAGE(PG8_SB(1, 0), b3, voffB);
            PG8_BAR; PG8_WAIT_L(0); PG8_MMA(0, 1, At, B1); PG8_BAR;
            PG8_LDA(At, 1, 1); PG8_STAGE(PG8_SA(1, 0), a3, voffA);
            PG8_BAR; PG8_WAIT_L(0); PG8_MMA(1, 0, At, B0); PG8_BAR; PG8_SCHED;
            PG8_STAGE(PG8_SB(1, 1), b3 + hstepB, voffB);
            PG8_WAIT_V(6); PG8_BAR; PG8_MMA(1, 1, At, B1); PG8_BAR;
            }
        }
        if constexpr (ALIGN_EPI) { if (wr == 0) PG8_BAR; }
        E(acc, cur, wr, wc, fr, fq);
        if (!has_next) break;
#pragma unroll
        for (int a = 0; a < 2; ++a)
#pragma unroll
            for (int b = 0; b < 2; ++b)
#pragma unroll
                for (int m = 0; m < 4; ++m)
#pragma unroll
                    for (int n = 0; n < 2; ++n) acc[a][b][m][n] = (f32x4){0.f, 0.f, 0.f, 0.f};
        cur = nxt; cA = nA; cB = nB; ++ui;
        if constexpr (ALIGN_EPI) { if (wr == 1) PG8_BAR; }
    }
    PG8_WAIT_V(0);
    if constexpr (!ALIGN_EPI) { if (wr == 0) PG8_BAR; }
    PG8_BAR;
#undef PG8_SA
#undef PG8_SB
#undef PG8_STAGE
#undef PG8_LDA
#undef PG8_LDB
#undef PG8_MMA
#undef PG8_WAIT_V
#undef PG8_WAIT_L
#undef PG8_BAR
#undef PG8_SCHED
}
}

__device__ __forceinline__ void st_bf16x8(bf16_t* p, f32x4 a, f32x4 b) {
    u32x4 w; w.x = pk2(a[0], a[1]); w.y = pk2(a[2], a[3]); w.z = pk2(b[0], b[1]); w.w = pk2(b[2], b[3]);
    *(u32x4*)p = w;
}
__device__ __forceinline__ int brow_of(int r) { return r < MP ? (r >> 13) : 2 + ((r - MP) >> 4); }

struct EpiIn {
    int l; float* out; bf16_t* qb; bf16_t* kb; bf16_t* vb; float* ub; const float* qg; const float* kg;
    __device__ __forceinline__ void operator()(const f32x4 (&acc)[2][2][4][2], const pg8::Unit& u, int wr, int wc, int fr, int fq) const {
        const int pn = u.pn, rbase = u.pm * 256 + wr * 64 + fr;
        if (pn == 0) {
            const int cb = 64 * wc + 8 * fq;
#pragma unroll
            for (int ai = 0; ai < 2; ++ai)
#pragma unroll
                for (int m = 0; m < 4; ++m) {
                    const int r = rbase + ai * 128 + m * 16;
                    float* up = ub + (size_t)r * PW + cb;
                    float* sp = nullptr;
                    if (r < MP) { const int t = r & (T - 1); if (t >= T - 15) sp = out + OFF_PP + ((size_t)((l * NBP + (r >> 13)) * 15 + (t - (T - 15)))) * PW + cb; }
                    else { const int rr = r - MP, t = rr & 15; if (t >= 1) sp = out + OFF_PS + ((size_t)((l * SB + (rr >> 4)) * 15 + (t - 1))) * PW + cb; }
#pragma unroll
                    for (int bj = 0; bj < 2; ++bj) {
                        *(f32x4*)(up + 32 * bj) = acc[ai][bj][m][0]; *(f32x4*)(up + 32 * bj + 4) = acc[ai][bj][m][1];
                        if (sp) { *(f32x4*)(sp + 32 * bj) = acc[ai][bj][m][0]; *(f32x4*)(sp + 32 * bj + 4) = acc[ai][bj][m][1]; }
                    }
                }
        } else if (pn <= 6) {
            const bool isq = pn <= 3;
            const int head = ((pn - 1) % 3) * 4 + wc;
            const float* gp = (isq ? qg : kg) + 8 * fq;
            f32x4 gv[2][2];
#pragma unroll
            for (int bj = 0; bj < 2; ++bj)
#pragma unroll
                for (int n = 0; n < 2; ++n) gv[bj][n] = *(const f32x4*)(gp + 32 * bj + 4 * n);
            bf16_t* dst = isq ? qb : kb;
#pragma unroll
            for (int ai = 0; ai < 2; ++ai)
#pragma unroll
                for (int m = 0; m < 4; ++m) {
                    const int r = rbase + ai * 128 + m * 16;
                    float ss = 0.f;
#pragma unroll
                    for (int bj = 0; bj < 2; ++bj)
#pragma unroll
                        for (int n = 0; n < 2; ++n) { const f32x4 a = acc[ai][bj][m][n]; ss += (a[0] * a[0] + a[1] * a[1]) + (a[2] * a[2] + a[3] * a[3]); }
                    ss = quad_sum(ss);
                    float rinv = 1.0f / sqrtf(ss * (1.f / 64.f) + EPS);
                    const float rq = isq ? rinv * C2 : rinv;
                    float* ko = nullptr;
                    if (!isq) ko = out + (r < MP ? OFF_KP + ((size_t)l * MP + r) * AW : OFF_KS + ((size_t)l * MS + (r - MP)) * AW) + head * 64 + 8 * fq;
#pragma unroll
                    for (int bj = 0; bj < 2; ++bj) {
                        const f32x4 n0 = acc[ai][bj][m][0] * rinv * gv[bj][0], n1 = acc[ai][bj][m][1] * rinv * gv[bj][1];
                        if (isq) { const f32x4 s0 = acc[ai][bj][m][0] * rq * gv[bj][0], s1 = acc[ai][bj][m][1] * rq * gv[bj][1];
                            st_bf16x8(dst + (size_t)r * AW + head * 64 + 32 * bj + 8 * fq, s0, s1); }
                        else { st_bf16x8(dst + (size_t)r * AW + head * 64 + 32 * bj + 8 * fq, n0, n1);
                            *(f32x4*)(ko + 32 * bj) = n0; *(f32x4*)(ko + 32 * bj + 4) = n1; }
                    }
                }
        } else {
            const int head = (pn - 7) * 4 + wc;
#pragma unroll
            for (int ai = 0; ai < 2; ++ai)
#pragma unroll
                for (int m = 0; m < 4; ++m) {
                    const int r = rbase + ai * 128 + m * 16;
                    float* vo = out + (r < MP ? OFF_VP + ((size_t)l * MP + r) * AW : OFF_VS + ((size_t)l * MS + (r - MP)) * AW) + head * 64 + 8 * fq;
#pragma unroll
                    for (int bj = 0; bj < 2; ++bj) {
                        st_bf16x8(vb + (size_t)r * AW + head * 64 + 32 * bj + 8 * fq, acc[ai][bj][m][0], acc[ai][bj][m][1]);
                        *(f32x4*)(vo + 32 * bj) = acc[ai][bj][m][0]; *(f32x4*)(vo + 32 * bj + 4) = acc[ai][bj][m][1];
                    }
                }
        }
    }
};

struct EpiRes {
    const float* xip; const float* xis; float* xop; float* xos; const float* gate;
    __device__ __forceinline__ void operator()(const f32x4 (&acc)[2][2][4][2], const pg8::Unit& u, int wr, int wc, int fr, int fq) const {
        const int rbase = u.pm * 256 + wr * 64 + fr, cb = u.pn * 256 + 64 * wc + 8 * fq;
        const float* gp = gate + (size_t)((u.pm * 256) >> 13) * MODW + cb;
        constexpr int DEPTH = 3;
        f32x4 gg[2][2], xq[DEPTH][2][2];
#pragma unroll
        for (int bj = 0; bj < 2; ++bj)
#pragma unroll
            for (int n = 0; n < 2; ++n) gg[bj][n] = *(const f32x4*)(gp + 32 * bj + 4 * n);
#pragma unroll
        for (int d = 0; d < DEPTH; ++d) { const int r2 = rbase + (d >> 2) * 128 + (d & 3) * 16;
#pragma unroll
            for (int bj = 0; bj < 2; ++bj)
#pragma unroll
                for (int n = 0; n < 2; ++n) xq[d][bj][n] = *(const f32x4*)(xip + (size_t)r2 * D + cb + 32 * bj + 4 * n); }
#pragma unroll
        for (int it = 0; it < 8; ++it) {
            const int ai = it >> 2, m = it & 3, r = rbase + ai * 128 + m * 16;
            f32x4 xc[2][2];
#pragma unroll
            for (int bj = 0; bj < 2; ++bj)
#pragma unroll
                for (int n = 0; n < 2; ++n) xc[bj][n] = xq[it % DEPTH][bj][n];
            if (it + DEPTH < 8) { const int r2 = rbase + ((it + DEPTH) >> 2) * 128 + ((it + DEPTH) & 3) * 16;
#pragma unroll
                for (int bj = 0; bj < 2; ++bj)
#pragma unroll
                    for (int n = 0; n < 2; ++n) xq[it % DEPTH][bj][n] = *(const f32x4*)(xip + (size_t)r2 * D + cb + 32 * bj + 4 * n); }
            float* xo = xop + (size_t)r * D + cb;
#pragma unroll
            for (int bj = 0; bj < 2; ++bj)
#pragma unroll
                for (int n = 0; n < 2; ++n) *(f32x4*)(xo + 32 * bj + 4 * n) = xc[bj][n] + gg[bj][n] * acc[ai][bj][m][n];
            __builtin_amdgcn_sched_barrier(0);
        }
    }
};

struct EpiUp {
    bf16_t* hid;
    __device__ __forceinline__ void operator()(const f32x4 (&acc)[2][2][4][2], const pg8::Unit& u, int wr, int wc, int fr, int fq) const {
        const int rbase = u.pm * 256 + wr * 64 + fr, cb = u.pn * 256 + 64 * wc + 8 * fq;
#pragma unroll
        for (int ai = 0; ai < 2; ++ai)
#pragma unroll
            for (int m = 0; m < 4; ++m) {
                const int r = rbase + ai * 128 + m * 16;
#pragma unroll
                for (int bj = 0; bj < 2; ++bj) {
                    f32x4 a = acc[ai][bj][m][0], b = acc[ai][bj][m][1];
#pragma unroll
                    for (int j = 0; j < 4; ++j) { const float x = fmaxf(a[j], 0.f), y = fmaxf(b[j], 0.f); a[j] = x * x; b[j] = y * y; }
                    st_bf16x8(hid + (size_t)r * FF + cb + 32 * bj, a, b);
                }
            }
    }
};

template <class SEpi>
__device__ __forceinline__ void skinny_phase(LAS unsigned char* lds, const bf16_t* A, const bf16_t* Bt, int N, int K, const SEpi& E, int tid, int lane, int wave, int row0 = MP, int nrg = 16) {
    const int l16 = lane & 15, quad = lane >> 4;
    const int nr2 = nrg >> 1, nitems = nr2 * (N / 64);
    LAS float* red = (LAS float*)lds;
    const int kw = K / 8;
    const int G_ = (int)gridDim.x, b_ = (int)blockIdx.x;
    const int vb = (G_ % 8 == 0 && nr2 == 8 && nitems <= 2 * G_ && nitems != 320) ? (b_ % 8) * (G_ / 8) + b_ / 8 : G_ - 1 - b_;
    for (int it = vb; it < nitems; it += G_) {
        const int rg2 = it % nr2, cg = it / nr2;
        const bf16_t* ap = A + (size_t)(row0 + 32 * rg2 + l16) * K + wave * kw + quad * 8;
        const bf16_t* bp = Bt + (size_t)(cg * 64 + l16) * K + wave * kw + quad * 8;
        f32x4 acc[2][4];
#pragma unroll
        for (int h = 0; h < 2; ++h)
#pragma unroll
            for (int nt = 0; nt < 4; ++nt) acc[h][nt] = (f32x4){0.f, 0.f, 0.f, 0.f};
        for (int k0 = 0; k0 < kw; k0 += 128) {
            bf16x8 a0[4], a1[4], b[4][4];
#pragma unroll
            for (int s = 0; s < 4; ++s) {
                a0[s] = *(const bf16x8*)(ap + k0 + 32 * s); a1[s] = *(const bf16x8*)(ap + (size_t)16 * K + k0 + 32 * s);
#pragma unroll
                for (int nt = 0; nt < 4; ++nt) b[s][nt] = *(const bf16x8*)(bp + (size_t)nt * 16 * K + k0 + 32 * s);
            }
#pragma unroll
            for (int s = 0; s < 4; ++s)
#pragma unroll
                for (int nt = 0; nt < 4; ++nt) { acc[0][nt] = __builtin_amdgcn_mfma_f32_16x16x32_bf16(a0[s], b[s][nt], acc[0][nt], 0, 0, 0);
                    acc[1][nt] = __builtin_amdgcn_mfma_f32_16x16x32_bf16(a1[s], b[s][nt], acc[1][nt], 0, 0, 0); }
        }
#pragma unroll
        for (int h = 0; h < 2; ++h)
#pragma unroll
            for (int nt = 0; nt < 4; ++nt)
#pragma unroll
                for (int r = 0; r < 4; ++r) red[(wave * 32 + 16 * h + quad * 4 + r) * 64 + 16 * nt + l16] = acc[h][nt][r];
        __syncthreads();
        const int row = tid >> 5, c2 = (tid & 31) * 2;
#pragma unroll
        for (int h = 0; h < 2; ++h) {
            float v0 = 0.f, v1 = 0.f;
#pragma unroll
            for (int w = 0; w < 8; ++w) { const f32x2 t = *(const LAS f32x2*)(red + (w * 32 + 16 * h + row) * 64 + c2); v0 += t.x; v1 += t.y; }
            E(2 * rg2 + h, row, cg, c2, v0, v1);
        }
        __syncthreads();
    }
}

struct SEpiIn {
    int l; float* out; bf16_t* qb; bf16_t* kb; bf16_t* vb; float* ub; const float* qg; const float* kg;
    __device__ __forceinline__ void operator()(int b, int t, int cg, int c2, float v0, float v1) const {
        const int rr = 16 * b + t; const size_t r = (size_t)MP + rr;
        if (cg < 4) {
            const int c = cg * 64 + c2;
            *(f32x2*)(ub + r * PW + c) = (f32x2){v0, v1};
            if (t >= 1) *(f32x2*)(out + OFF_PS + ((size_t)((l * SB + b) * 15 + (t - 1))) * PW + c) = (f32x2){v0, v1};
        } else if (cg < 28) {
            const bool isq = cg < 16; const int head = isq ? cg - 4 : cg - 16;
            float ss = v0 * v0 + v1 * v1;
#pragma unroll
            for (int o = 1; o < 32; o <<= 1) ss += __shfl_xor(ss, o);
            const float rinv = 1.0f / sqrtf(ss * (1.f / 64.f) + EPS);
            const float* gp = (isq ? qg : kg) + c2;
            const float n0 = v0 * rinv * gp[0], n1 = v1 * rinv * gp[1];
            if (isq) *(unsigned*)(qb + r * AW + head * 64 + c2) = pk2(n0 * C2, n1 * C2);
            else { *(unsigned*)(kb + r * AW + head * 64 + c2) = pk2(n0, n1); *(f32x2*)(out + OFF_KS + ((size_t)l * MS + rr) * AW + head * 64 + c2) = (f32x2){n0, n1}; }
        } else {
            const int head = cg - 28;
            *(unsigned*)(vb + r * AW + head * 64 + c2) = pk2(v0, v1);
            *(f32x2*)(out + OFF_VS + ((size_t)l * MS + rr) * AW + head * 64 + c2) = (f32x2){v0, v1};
        }
    }
};
struct SEpiRes {
    const float* xis; float* xos; const float* gate;
    __device__ __forceinline__ void operator()(int b, int t, int cg, int c2, float v0, float v1) const {
        const size_t o = (size_t)(16 * b + t) * D + cg * 64 + c2;
        const f32x2 xv = *(const f32x2*)(xis + o), gg = *(const f32x2*)(gate + (size_t)(2 + b) * MODW + cg * 64 + c2);
        *(f32x2*)(xos + o) = (f32x2){xv.x + gg.x * v0, xv.y + gg.y * v1};
    }
};
struct SEpiUp {
    bf16_t* hid;
    __device__ __forceinline__ void operator()(int b, int t, int cg, int c2, float v0, float v1) const {
        const float x = fmaxf(v0, 0.f), y = fmaxf(v1, 0.f);
        *(unsigned*)(hid + ((size_t)MP + 16 * b + t) * FF + cg * 64 + c2) = pk2(x * x, y * y);
    }
};


struct EpiResN {
    const float* xip; float* xop; const float* gate; const float* sc2; bf16_t* xt; float* ss;
    __device__ __forceinline__ void operator()(const f32x4 (&acc)[2][2][4][2], const pg8::Unit& u, int wr, int wc, int fr, int fq) const {
        const int rbase = u.pm * 256 + wr * 64 + fr, cb = u.pn * 256 + 64 * wc + 8 * fq;
        const int brow = (u.pm * 256) >> 13;
        const float* gp = gate + (size_t)brow * MODW + cb; const float* sp = sc2 + (size_t)brow * MODW + cb;
        constexpr int DEPTH = 2;
        f32x4 gg[2][2], sv[2][2], xq[DEPTH][2][2];
#pragma unroll
        for (int bj = 0; bj < 2; ++bj)
#pragma unroll
            for (int n = 0; n < 2; ++n) { gg[bj][n] = *(const f32x4*)(gp + 32 * bj + 4 * n); sv[bj][n] = *(const f32x4*)(sp + 32 * bj + 4 * n) + 1.0f; }
#pragma unroll
        for (int d = 0; d < DEPTH; ++d) { const int r2 = rbase + (d >> 2) * 128 + (d & 3) * 16;
#pragma unroll
            for (int bj = 0; bj < 2; ++bj)
#pragma unroll
                for (int n = 0; n < 2; ++n) xq[d][bj][n] = *(const f32x4*)(xip + (size_t)r2 * D + cb + 32 * bj + 4 * n); }
#pragma unroll
        for (int it = 0; it < 8; ++it) {
            const int ai = it >> 2, m = it & 3, r = rbase + ai * 128 + m * 16;
            f32x4 xc[2][2];
#pragma unroll
            for (int bj = 0; bj < 2; ++bj)
#pragma unroll
                for (int n = 0; n < 2; ++n) xc[bj][n] = xq[it % DEPTH][bj][n];
            if (it + DEPTH < 8) { const int r2 = rbase + ((it + DEPTH) >> 2) * 128 + ((it + DEPTH) & 3) * 16;
#pragma unroll
                for (int bj = 0; bj < 2; ++bj)
#pragma unroll
                    for (int n = 0; n < 2; ++n) xq[it % DEPTH][bj][n] = *(const f32x4*)(xip + (size_t)r2 * D + cb + 32 * bj + 4 * n); }
            float* xo = xop + (size_t)r * D + cb;
            float s = 0.f;
#pragma unroll
            for (int bj = 0; bj < 2; ++bj) {
                f32x4 t[2];
#pragma unroll
                for (int n = 0; n < 2; ++n) {
                    const f32x4 x1 = xc[bj][n] + gg[bj][n] * acc[ai][bj][m][n];
                    *(f32x4*)(xo + 32 * bj + 4 * n) = x1;
                    s += (x1[0] * x1[0] + x1[1] * x1[1]) + (x1[2] * x1[2] + x1[3] * x1[3]);
                    t[n] = x1 * sv[bj][n];
                }
                st_bf16x8(xt + (size_t)r * D + cb + 32 * bj, t[0], t[1]);
            }
            s = quad_sum(s);
            if (fq == 0) atomicAdd(ss + r, s);
            __builtin_amdgcn_sched_barrier(0);
        }
    }
};
struct SEpiResN {
    const float* xis; float* xos; const float* gate; const float* sc2; bf16_t* xt; float* ss;
    __device__ __forceinline__ void operator()(int b, int t, int cg, int c2, float v0, float v1) const {
        const int rr = 16 * b + t; const size_t o = (size_t)rr * D + cg * 64 + c2;
        const f32x2 xv = *(const f32x2*)(xis + o), gg = *(const f32x2*)(gate + (size_t)(2 + b) * MODW + cg * 64 + c2), sv = *(const f32x2*)(sc2 + (size_t)(2 + b) * MODW + cg * 64 + c2);
        const float a0 = xv.x + gg.x * v0, a1 = xv.y + gg.y * v1;
        *(f32x2*)(xos + o) = (f32x2){a0, a1};
        *(unsigned*)(xt + ((size_t)MP + rr) * D + cg * 64 + c2) = pk2(a0 * (sv.x + 1.0f), a1 * (sv.y + 1.0f));
        float s = a0 * a0 + a1 * a1;
#pragma unroll
        for (int q = 1; q < 32; q <<= 1) s += __shfl_xor(s, q);
        if ((c2 >> 1) == 0) atomicAdd(ss + MP + rr, s);
    }
};
struct EpiUpN {
    bf16_t* hid; const float* ss; const float* bias;
    __device__ __forceinline__ void operator()(const f32x4 (&acc)[2][2][4][2], const pg8::Unit& u, int wr, int wc, int fr, int fq) const {
        const int rbase = u.pm * 256 + wr * 64 + fr, cb = u.pn * 256 + 64 * wc + 8 * fq;
        const float* bp = bias + (size_t)((u.pm * 256) >> 13) * FF + cb;
        f32x4 bv[2][2];
#pragma unroll
        for (int bj = 0; bj < 2; ++bj)
#pragma unroll
            for (int n = 0; n < 2; ++n) bv[bj][n] = *(const f32x4*)(bp + 32 * bj + 4 * n);
#pragma unroll
        for (int ai = 0; ai < 2; ++ai)
#pragma unroll
            for (int m = 0; m < 4; ++m) {
                const int r = rbase + ai * 128 + m * 16;
                const float rinv = 1.0f / sqrtf(ss[r] * (1.f / D) + EPS);
#pragma unroll
                for (int bj = 0; bj < 2; ++bj) {
                    f32x4 a = acc[ai][bj][m][0] * rinv + bv[bj][0], b = acc[ai][bj][m][1] * rinv + bv[bj][1];
#pragma unroll
                    for (int j = 0; j < 4; ++j) { const float x = fmaxf(a[j], 0.f), y = fmaxf(b[j], 0.f); a[j] = x * x; b[j] = y * y; }
                    st_bf16x8(hid + (size_t)r * FF + cb + 32 * bj, a, b);
                }
            }
    }
};
struct SEpiUpN {
    bf16_t* hid; const float* ss; const float* bias;
    __device__ __forceinline__ void operator()(int b, int t, int cg, int c2, float v0, float v1) const {
        const int r = MP + 16 * b + t;
        const float rinv = 1.0f / sqrtf(ss[r] * (1.f / D) + EPS);
        const f32x2 bb = *(const f32x2*)(bias + (size_t)(2 + b) * FF + cg * 64 + c2);
        const float x = fmaxf(v0 * rinv + bb.x, 0.f), y = fmaxf(v1 * rinv + bb.y, 0.f);
        *(unsigned*)(hid + (size_t)r * FF + cg * 64 + c2) = pk2(x * x, y * y);
    }
};
struct SEpiBias {
    float* bias;
    __device__ __forceinline__ void operator()(int rg, int t, int cg, int c2, float v0, float v1) const {
        const int row = 16 * rg + t;
        if (row < NMODROW) *(f32x2*)(bias + (size_t)row * FF + cg * 64 + c2) = (f32x2){v0, v1};
    }
};

struct Params { const float* in[19]; float* out; unsigned char* ws; };

__device__ __forceinline__ void transpose_item(const float* W, int ldw, int K, int nblk, bf16_t* WT, LAS float* scr, int item, int lane) {
    const int kb = item / nblk, nb = item % nblk, k0 = 64 * kb, n0 = 32 * nb;
    float tv[32];
#pragma unroll
    for (int i = 0; i < 32; ++i) tv[i] = W[(size_t)(k0 + 2 * i + (lane >> 5)) * ldw + n0 + (lane & 31)];
#pragma unroll
    for (int i = 0; i < 32; ++i) scr[(2 * i + (lane >> 5)) * 33 + (lane & 31)] = tv[i];
    asm volatile("s_waitcnt lgkmcnt(0)" ::: "memory");
    const int c = lane & 7;
#pragma unroll
    for (int j = 0; j < 4; ++j) { const int n = (lane >> 3) + 8 * j; const LAS float* s = scr + (8 * c) * 33 + n;
        u32x4 o; o.x = pk2(s[0 * 33], s[1 * 33]); o.y = pk2(s[2 * 33], s[3 * 33]); o.z = pk2(s[4 * 33], s[5 * 33]); o.w = pk2(s[6 * 33], s[7 * 33]);
        *(u32x4*)(WT + (size_t)(n0 + n) * K + k0 + 8 * c) = o; }
    asm volatile("s_waitcnt lgkmcnt(0)" ::: "memory");
}

__device__ __forceinline__ void phase_prologue(const Params& p, LAS unsigned char* lds, int tid, int lane, int wave) {
    LAS float* sc = (LAS float*)lds;
    LAS float* red = (LAS float*)(lds + 73728);
    for (int idx = tid; idx < NMODROW * D; idx += 512) {
        const int r = idx >> 10, k = idx & 1023;
        const float c = (r < 2) ? p.in[2][r * D + k] : p.in[3][(r - 2) * D + k];
        sc[k * 18 + r] = c / (1.f + __expf(-c));
    }
    __syncthreads();
    float* modw = (float*)(p.ws + WS_MOD);
    for (int it = blockIdx.x; it < 256; it += gridDim.x) {
        const int l = it >> 7, col0 = (it & 127) * 48;
        const int cl = lane < 48 ? lane : 47;
        const float* W = p.in[8] + (size_t)l * D * MODW + col0 + cl;
        float acc[18];
#pragma unroll
        for (int r = 0; r < 18; ++r) acc[r] = 0.f;
        const int kb = wave * 128;
#pragma unroll 16
        for (int kk = 0; kk < 128; ++kk) {
            const int k = kb + kk;
            const float wv = W[(size_t)k * MODW];
            const LAS f32x2* s2 = (const LAS f32x2*)(sc + k * 18);
#pragma unroll
            for (int r2 = 0; r2 < 9; ++r2) { const f32x2 s = s2[r2]; acc[2 * r2] += s.x * wv; acc[2 * r2 + 1] += s.y * wv; }
        }
#pragma unroll
        for (int r = 0; r < 18; ++r) red[(wave * 18 + r) * 64 + lane] = acc[r];
        __syncthreads();
        for (int idx = tid; idx < 18 * 48; idx += 512) {
            const int r = idx / 48, c = idx % 48;
            float s = p.in[9][l * MODW + col0 + c];
#pragma unroll
            for (int w = 0; w < 8; ++w) s += red[(w * 18 + r) * 64 + c];
            modw[((size_t)l * NMODROW + r) * MODW + col0 + c] = s;
        }
        __syncthreads();
    }
    LAS float* scr = (LAS float*)(lds + 73728 + wave * 8448);
    const int gw = blockIdx.x * 8 + wave, NGW = gridDim.x * 8;
    constexpr int I_IN = 16 * 80, I_OUT = 16 * 32, I_UP = 16 * 128, I_DN = 64 * 32, I_L = I_IN + I_OUT + I_UP + I_DN;
    for (int it = gw; it < 2 * I_L; it += NGW) {
        const int l = it / I_L; int r = it % I_L;
        if (r < I_IN) { transpose_item(p.in[10] + (size_t)l * D * INC, INC, D, 80, (bf16_t*)(p.ws + WS_WIN) + (size_t)l * NMAIN * D, scr, r, lane); continue; } r -= I_IN;
        if (r < I_OUT) { transpose_item(p.in[16] + (size_t)l * D * D, D, D, 32, (bf16_t*)(p.ws + WS_WOUT) + (size_t)l * D * D, scr, r, lane); continue; } r -= I_OUT;
        if (r < I_UP) { transpose_item(p.in[17] + (size_t)l * D * FF, FF, D, 128, (bf16_t*)(p.ws + WS_WUP) + (size_t)l * FF * D, scr, r, lane); continue; } r -= I_UP;
        transpose_item(p.in[18] + (size_t)l * FF * D, D, FF, 32, (bf16_t*)(p.ws + WS_WDN) + (size_t)l * D * FF, scr, r, lane);
    }
}

__device__ __forceinline__ void phase_norm(const Params& p, LAS unsigned char* lds, int l, int stage, const float* xp, const float* xs, int tid, int lane, int wave) {
    constexpr int HP = 1032;
    LAS bf16_t* wfb = (LAS bf16_t*)lds;
    LAS bf16_t* ht = (LAS bf16_t*)(lds + 33280);
    LAS float* pc = (LAS float*)(lds + 66560);
    {
        const float* W = p.in[10] + (size_t)l * D * INC + NMAIN;
        for (int idx = tid; idx < 16 * D; idx += 512) { const int k = idx >> 4, hh = idx & 15; wfb[hh * HP + k] = (bf16_t)f2bf(hh < NH ? W[(size_t)k * INC + hh] : 0.f); }
        float* SS = (float*)(p.ws + WS_SS);
        for (int i = blockIdx.x * 512 + tid; i < M; i += gridDim.x * 512) SS[i] = 0.f;
        if (l == 0) {
            bf16_t* s2 = (bf16_t*)(p.ws + WS_SH2); const float* modall = (const float*)(p.ws + WS_MOD);
            for (int i = blockIdx.x * 512 + tid; i < 2 * 32 * D; i += gridDim.x * 512) { const int ll = i >> 15, row = (i >> 10) & 31, k = i & 1023;
                s2[i] = (bf16_t)f2bf(row < NMODROW ? modall[((size_t)ll * NMODROW + row) * MODW + 3 * D + k] : 0.f); }
        }
    }
    __syncthreads();
    const float* modl = (const float*)(p.ws + WS_MOD) + (size_t)l * NMODROW * MODW;
    bf16_t* hn = (bf16_t*)(p.ws + WS_HN);
    const int l16 = lane & 15, quad = lane >> 4;
    const int rpb = (M + (int)gridDim.x - 1) / (int)gridDim.x, R0 = (int)blockIdx.x * rpb, R1 = (R0 + rpb < M) ? R0 + rpb : M;
    for (int g0 = R0; g0 < R1; g0 += 16) {
#pragma unroll
        for (int rr = 0; rr < 2; ++rr) {
            const int lr = 2 * wave + rr, m = g0 + lr;
            LAS unsigned long long* h8 = (LAS unsigned long long*)(ht + lr * HP) + lane;
            if (m < R1) {
                const f32x4* xr = (const f32x4*)(m < MP ? xp + (size_t)m * D : xs + (size_t)(m - MP) * D) + lane;
                f32x4 v[4]; float ss = 0.f;
#pragma unroll
                for (int j = 0; j < 4; ++j) { v[j] = xr[64 * j]; ss += (v[j].x * v[j].x + v[j].y * v[j].y) + (v[j].z * v[j].z + v[j].w * v[j].w); }
                ss = wave_sum(ss);
                const float rinv = 1.0f / sqrtf(ss * (1.f / D) + EPS);
                const float* mrow = modl + (size_t)brow_of(m) * MODW;
                const f32x4* sh4 = (const f32x4*)mrow + lane; const f32x4* sc4 = (const f32x4*)(mrow + D) + lane;
                unsigned long long* o8 = (unsigned long long*)(hn + (size_t)m * D) + lane;
#pragma unroll
                for (int j = 0; j < 4; ++j) {
                    const f32x4 shv = sh4[64 * j], scv = sc4[64 * j];
                    v[j] = v[j] * rinv * (scv + 1.0f) + shv;
                    const unsigned long long w = (unsigned long long)pk2(v[j].x, v[j].y) | ((unsigned long long)pk2(v[j].z, v[j].w) << 32);
                    o8[64 * j] = w; h8[64 * j] = w;
                }
            } else {
#pragma unroll
                for (int j = 0; j < 4; ++j) h8[64 * j] = 0ull;
            }
        }
        __syncthreads();
        {
            f32x4 c = (f32x4){0.f, 0.f, 0.f, 0.f};
#pragma unroll
            for (int s = 0; s < 4; ++s) {
                const int k0 = 32 * (4 * wave + s) + 8 * quad;
                const bf16x8 a = *(const LAS bf16x8*)(ht + l16 * HP + k0), b = *(const LAS bf16x8*)(wfb + l16 * HP + k0);
                c = __builtin_amdgcn_mfma_f32_16x16x32_bf16(a, b, c, 0, 0, 0);
            }
#pragma unroll
            for (int r = 0; r < 4; ++r) pc[(wave * 16 + quad * 4 + r) * 16 + l16] = c[r];
        }
        __syncthreads();
        if (tid < 16 * NH) {
            const int row = tid / NH, hh = tid % NH, m = g0 + row;
            if (m < R1) {
                float x = p.in[11][l * NH + hh];
#pragma unroll
                for (int w = 0; w < 8; ++w) x += pc[(w * 16 + row) * 16 + hh];
                const float lf = fminf(x, 0.f) - log1pf(expf(-fabsf(x)));
                float* o = p.out + (m < MP ? OFF_FP + ((size_t)l * MP + m) * NH : OFF_FS + ((size_t)l * MS + (m - MP)) * NH);
                o[hh] = lf;
            }
        }
    }
}

__device__ __forceinline__ float block_scan_offset(float total, LAS float* sm, int lane, int wave) {
    float x = total;
#pragma unroll
    for (int o = 1; o < 64; o <<= 1) { const float n = __shfl_up(x, o); if (lane >= o) x += n; }
    __syncthreads();
    if (lane == 63) sm[wave] = x;
    __syncthreads();
    float off = x - total;
    for (int w = 0; w < wave; ++w) off += sm[w];
    return off;
}

__device__ __forceinline__ void scan_items(const Params& p, LAS unsigned char* lds, int l, int tid, int lane, int wave) {
    LAS float* sm = (LAS float*)(lds + 65536);
    float* Fp = (float*)(p.ws + WS_FP); float* Fs = (float*)(p.ws + WS_FS);
    const int nb = (int)gridDim.x / 2;
    if ((int)blockIdx.x < (int)gridDim.x - nb) return;
    for (int it = (int)(gridDim.x - 1 - blockIdx.x); it < 24 + 192; it += nb) {
        if (it < 24) {
            const int b = it / NH, h = it % NH;
            const float* src = p.out + OFF_FP + ((size_t)(l * NBP + b) * T) * NH + h;
            const int t0 = tid * 16;
            float v[16]; float run = 0.f;
#pragma unroll
            for (int e = 0; e < 16; ++e) { run += src[(size_t)(t0 + e) * NH]; v[e] = run; }
            const float off = block_scan_offset(run, sm, lane, wave);
            float* dst = Fp + (size_t)it * T + t0;
#pragma unroll
            for (int e = 0; e < 16; e += 4) *(f32x4*)(dst + e) = (f32x4){(off + v[e]) * LOG2E, (off + v[e + 1]) * LOG2E, (off + v[e + 2]) * LOG2E, (off + v[e + 3]) * LOG2E};
        } else {
            const int bh = it - 24, b = bh / NH, h = bh % NH;
            const float* src = p.in[6] + ((size_t)(l * SB + b) * PAST) * NH + h;
            const int t0 = tid * 8;
            float v[8]; float run = 0.f;
#pragma unroll
            for (int e = 0; e < 8; ++e) { run += src[(size_t)(t0 + e) * NH]; v[e] = run; }
            const float off = block_scan_offset(run, sm, lane, wave);
            float* dst = Fs + (size_t)bh * SKEYS + t0;
#pragma unroll
            for (int e = 0; e < 8; e += 4) *(f32x4*)(dst + e) = (f32x4){(off + v[e]) * LOG2E, (off + v[e + 1]) * LOG2E, (off + v[e + 2]) * LOG2E, (off + v[e + 3]) * LOG2E};
            if (tid == 511) sm[8] = off + run;
            __syncthreads();
            if (tid < ST) {
                const float* ns = p.out + OFF_FS + ((size_t)(l * SB + b) * ST) * NH + h;
                float s = sm[8];
                for (int e = 0; e <= tid; ++e) s += ns[e * NH];
                Fs[(size_t)bh * SKEYS + PAST + tid] = s * LOG2E;
            }
        }
        __syncthreads();
    }
}

__device__ __forceinline__ void pool_items(const Params& p, LAS unsigned char* lds, int l, unsigned* ctr, LAS unsigned* slot, int tid, int lane, int wave) {
    LAS float* z = (LAS float*)lds;
    LAS bf16_t* am = (LAS bf16_t*)(lds + 81920);
    const float* ub = (const float*)(p.ws + WS_U);
    bf16_t* mix = (bf16_t*)(p.ws + WS_MIX);
    const int g = wave >> 1, ntp = (wave & 1) * 2, l16 = lane & 15, quad = lane >> 4;
    bf16x8 bw[2][2];
    {
        const float* wp = p.in[14] + ((size_t)(l * 4 + g) * 64) * 64;
#pragma unroll
        for (int nt = 0; nt < 2; ++nt)
#pragma unroll
            for (int ks = 0; ks < 2; ++ks) {
                bf16x8 t;
#pragma unroll
                for (int j = 0; j < 8; ++j) t[j] = (short)f2bf(wp[(size_t)(32 * ks + 8 * quad + j) * 64 + 16 * (ntp + nt) + l16]);
                bw[nt][ks] = t;
            }
    }
    for (;;) {
      if (tid == 0) *slot = atomicAdd(ctr, 1u);
      __syncthreads();
      const int ent = (int)*slot;
      __syncthreads();
      if (ent >= MP / 64 + MS / 16) break;
      const bool prm = ent < MP / 64;
      const int row0 = prm ? ent * 64 : MP + (ent - MP / 64) * 16;
      const int nr = prm ? 4 : 1, nz = 15 + 16 * nr;
      const int t0 = prm ? (row0 & (T - 1)) : 0;
      for (int idx = tid; idx < nz * 64; idx += 512) {
          const int zr = idx >> 6, c4 = (idx & 63) * 4;
          f32x4 val = (f32x4){0.f, 0.f, 0.f, 0.f};
          if (zr >= 15) val = *(const f32x4*)(ub + (size_t)(row0 + zr - 15) * PW + c4);
          else if (prm) { if (t0 > 0) val = *(const f32x4*)(ub + (size_t)(row0 + zr - 15) * PW + c4); }
          else val = *(const f32x4*)(p.in[7] + ((size_t)(l * SB + ((row0 - MP) >> 4)) * 15 + zr) * PW + c4);
          *(LAS f32x4*)(z + zr * 256 + c4) = val;
      }
      __syncthreads();
      for (int i = 0; i < nr; ++i) {
          const int row = (tid >> 5) + 16 * i, c0 = (tid & 31) * 8, gg = c0 >> 6, w = 2 << gg;
          f32x4 s0 = (f32x4){0.f, 0.f, 0.f, 0.f}, s1 = s0;
          for (int j = 0; j < w; ++j) { s0 += *(const LAS f32x4*)(z + (15 + row - j) * 256 + c0); s1 += *(const LAS f32x4*)(z + (15 + row - j) * 256 + c0 + 4); }
          float cnt = (float)w;
          if (prm) { const float pos1 = (float)(t0 + row + 1); cnt = fminf(pos1, cnt); }
          const float ic = 1.0f / cnt;
          const f32x4 u0 = *(const LAS f32x4*)(z + (15 + row) * 256 + c0), u1 = *(const LAS f32x4*)(z + (15 + row) * 256 + c0 + 4);
          s0 = s0 * ic - u0; s1 = s1 * ic - u1;
          u32x4 o; o.x = pk2(s0[0], s0[1]); o.y = pk2(s0[2], s0[3]); o.z = pk2(s1[0], s1[1]); o.w = pk2(s1[2], s1[3]);
          *(LAS u32x4*)(am + row * 264 + c0) = o;
      }
      __syncthreads();
      for (int i = 0; i < nr; ++i) {
          f32x4 c[2] = {(f32x4){0.f, 0.f, 0.f, 0.f}, (f32x4){0.f, 0.f, 0.f, 0.f}};
#pragma unroll
          for (int ks = 0; ks < 2; ++ks) {
              const bf16x8 a = *(const LAS bf16x8*)(am + (16 * i + l16) * 264 + g * 64 + 32 * ks + 8 * quad);
#pragma unroll
              for (int nt = 0; nt < 2; ++nt) c[nt] = __builtin_amdgcn_mfma_f32_16x16x32_bf16(a, bw[nt][ks], c[nt], 0, 0, 0);
          }
#pragma unroll
          for (int nt = 0; nt < 2; ++nt) {
              const int col = g * 64 + 16 * (ntp + nt) + l16;
              const float ps = p.in[15][l * PW + col];
#pragma unroll
              for (int r = 0; r < 4; ++r) mix[(size_t)(row0 + 16 * i + quad * 4 + r) * D + col] = (bf16_t)f2bf(c[nt][r] * ps);
          }
      }
      __syncthreads();
    }
}

__device__ __forceinline__ s16x4 vtr(const LAS unsigned char* ptr) { return __builtin_bit_cast(s16x4, __builtin_amdgcn_ds_read_tr16_b64_v4i16((LAS s16x4*)ptr)); }
constexpr int KP = 144;

__device__ __forceinline__ float xmax_q(float v) {
    auto a = __builtin_amdgcn_permlane16_swap(__float_as_uint(v), __float_as_uint(v), false, false);
    const float m = __builtin_fmaxf(__uint_as_float(a[0]), __uint_as_float(a[1]));
    auto b = __builtin_amdgcn_permlane32_swap(__float_as_uint(m), __float_as_uint(m), false, false);
    return __builtin_fmaxf(__uint_as_float(b[0]), __uint_as_float(b[1]));
}
__device__ __forceinline__ void attn_tile64(const LAS unsigned char* Kt, const LAS unsigned char* Vt, const LAS float* Ft, int key0, int Qw, bool diag,
                                            const bf16x8 (&qf)[2][2], const float (&fq)[2], float (&fqm)[2], float (&mrun)[2], float (&lrun)[2], f32x4 (&o)[4][2], int l16, int quad) {
    f32x4 s[4][2];
    bf16x8 kf[2][4]; f32x4 fk[4];
#pragma unroll
    for (int ks = 0; ks < 2; ++ks)
#pragma unroll
        for (int kt = 0; kt < 4; ++kt) kf[ks][kt] = *(const LAS bf16x8*)(Kt + (16 * kt + l16) * KP + ks * 64 + quad * 16);
#pragma unroll
    for (int kt = 0; kt < 4; ++kt) fk[kt] = *(const LAS f32x4*)(Ft + 16 * kt + 4 * quad);
    __builtin_amdgcn_sched_barrier(0);
#pragma unroll
    for (int kt = 0; kt < 4; ++kt)
#pragma unroll
        for (int qt = 0; qt < 2; ++qt) s[kt][qt] = (f32x4){fqm[qt] - fk[kt][0], fqm[qt] - fk[kt][1], fqm[qt] - fk[kt][2], fqm[qt] - fk[kt][3]};
#pragma unroll
    for (int ks = 0; ks < 2; ++ks)
#pragma unroll
        for (int kt = 0; kt < 4; ++kt)
#pragma unroll
            for (int qt = 0; qt < 2; ++qt) s[kt][qt] = __builtin_amdgcn_mfma_f32_16x16x32_bf16(kf[ks][kt], qf[qt][ks], s[kt][qt], 0, 0, 0);
    s16x4 va[2][4][2];
    {
        const LAS unsigned char* vb0 = Vt + (4 * quad + (l16 >> 2)) * KP + 8 * (l16 & 3);
#pragma unroll
        for (int k2 = 0; k2 < 2; ++k2)
#pragma unroll
            for (int dt = 0; dt < 4; ++dt) { va[k2][dt][0] = vtr(vb0 + 32 * k2 * KP + 32 * dt); va[k2][dt][1] = vtr(vb0 + (32 * k2 + 16) * KP + 32 * dt); }
    }
    __builtin_amdgcn_sched_barrier(0);
    if (diag) {
#pragma unroll
        for (int kt = 0; kt < 4; ++kt)
#pragma unroll
            for (int qt = 0; qt < 2; ++qt)
#pragma unroll
                for (int r = 0; r < 4; ++r) { const int key = key0 + 16 * kt + 4 * quad + r, qq = Qw + 16 * qt + l16; if (key > qq) s[kt][qt][r] = -INFINITY; }
    }
    float mx[2];
#pragma unroll
    for (int qt = 0; qt < 2; ++qt) {
        float a = __builtin_fmaxf(__builtin_fmaxf(s[0][qt][0], s[0][qt][1]), s[0][qt][2]), c = __builtin_fmaxf(__builtin_fmaxf(s[0][qt][3], s[1][qt][0]), s[1][qt][1]);
        a = __builtin_fmaxf(__builtin_fmaxf(a, s[1][qt][2]), s[1][qt][3]); c = __builtin_fmaxf(__builtin_fmaxf(c, s[2][qt][0]), s[2][qt][1]);
        a = __builtin_fmaxf(__builtin_fmaxf(a, s[2][qt][2]), s[2][qt][3]); c = __builtin_fmaxf(__builtin_fmaxf(c, s[3][qt][0]), s[3][qt][1]);
        a = __builtin_fmaxf(__builtin_fmaxf(a, s[3][qt][2]), s[3][qt][3]);
        float m_ = __builtin_fmaxf(a, c);
        mx[qt] = xmax_q(m_);
    }
    if (__any((mx[0] > 8.f) || (mx[1] > 8.f))) {
#pragma unroll
        for (int qt = 0; qt < 2; ++qt) {
            const float dl = __builtin_fmaxf(mx[qt], 0.f);
            mrun[qt] += dl; fqm[qt] = fq[qt] - mrun[qt];
            const float al = __builtin_amdgcn_exp2f(-dl);
            lrun[qt] *= al;
#pragma unroll
            for (int kt = 0; kt < 4; ++kt) s[kt][qt] -= dl;
#pragma unroll
            for (int dt = 0; dt < 4; ++dt) o[dt][qt] *= al;
        }
    }
#pragma unroll
    for (int qt = 0; qt < 2; ++qt) {
        float ps = 0.f;
#pragma unroll
        for (int kt = 0; kt < 4; ++kt)
#pragma unroll
            for (int r = 0; r < 4; ++r) { const float e = __builtin_amdgcn_exp2f(s[kt][qt][r]); s[kt][qt][r] = e; ps += e; }
        lrun[qt] += ps;
    }
#pragma unroll
    for (int k2 = 0; k2 < 2; ++k2) {
        bf16x8 pb[2];
#pragma unroll
        for (int qt = 0; qt < 2; ++qt) {
            u32x4 w; w.x = pk2(s[2 * k2][qt][0], s[2 * k2][qt][1]); w.y = pk2(s[2 * k2][qt][2], s[2 * k2][qt][3]);
            w.z = pk2(s[2 * k2 + 1][qt][0], s[2 * k2 + 1][qt][1]); w.w = pk2(s[2 * k2 + 1][qt][2], s[2 * k2 + 1][qt][3]);
            pb[qt] = __builtin_bit_cast(bf16x8, w);
        }
#pragma unroll
        for (int dt = 0; dt < 4; ++dt) {
            const s16x4 a0 = va[k2][dt][0], a1 = va[k2][dt][1];
            const bf16x8 vf = (bf16x8){a0[0], a0[1], a0[2], a0[3], a1[0], a1[1], a1[2], a1[3]};
#pragma unroll
            for (int qt = 0; qt < 2; ++qt) o[dt][qt] = __builtin_amdgcn_mfma_f32_16x16x32_bf16(vf, pb[qt], o[dt][qt], 0, 0, 0);
        }
    }
}

constexpr int TB = 128 * KP;
__device__ __forceinline__ void attn_prompt_unit(int b, int h, int qb, const bf16_t* Q, const bf16_t* Kb, const bf16_t* Vb, const float* F2, bf16_t* mix,
                                                 LAS unsigned char* lds, int tid, int lane, int wave) {
    const int l16 = lane & 15, quad = lane >> 4;
    const size_t rowbase = (size_t)b * T;
    const int Qw = qb * 256 + wave * 32;
    const float* Fh = F2 + (size_t)(b * NH + h) * T;
    bf16x8 qf[2][2]; float fq[2];
#pragma unroll
    for (int qt = 0; qt < 2; ++qt) {
#pragma unroll
        for (int ks = 0; ks < 2; ++ks) qf[qt][ks] = *(const bf16x8*)(Q + (rowbase + Qw + 16 * qt + l16) * AW + h * HD + 32 * ks + 8 * quad);
        fq[qt] = Fh[Qw + 16 * qt + l16];
    }
    f32x4 o[4][2];
#pragma unroll
    for (int dt = 0; dt < 4; ++dt) { o[dt][0] = (f32x4){0.f, 0.f, 0.f, 0.f}; o[dt][1] = o[dt][0]; }
    float mrun[2] = {0.f, 0.f}, lrun[2] = {0.f, 0.f}, fqm[2] = {fq[0], fq[1]};
    const int NT = 2 * qb + 2;
    LAS unsigned char* Kl = lds; LAS unsigned char* Vl = lds + 2 * TB; LAS float* Fl = (LAS float*)(lds + 4 * TB);
    const int skey = tid >> 3, sch = tid & 7;
    const bf16_t* kg = Kb + (rowbase + skey) * AW + h * HD + sch * 8;
    const bf16_t* vg = Vb + (rowbase + skey) * AW + h * HD + sch * 8;
    u32x4 kreg0 = *(const u32x4*)kg, kreg1 = *(const u32x4*)(kg + (size_t)64 * AW), vreg0 = *(const u32x4*)vg, vreg1 = *(const u32x4*)(vg + (size_t)64 * AW);
    f32x4 freg = (f32x4){0.f, 0.f, 0.f, 0.f};
    if (tid < 32) freg = *(const f32x4*)(Fh + tid * 4);
    const int soff = skey * KP + sch * 16;
    *(LAS u32x4*)(Kl + soff) = kreg0; *(LAS u32x4*)(Kl + 64 * KP + soff) = kreg1; *(LAS u32x4*)(Vl + soff) = vreg0; *(LAS u32x4*)(Vl + 64 * KP + soff) = vreg1;
    if (tid < 32) *(LAS f32x4*)(Fl + tid * 4) = freg;
    __syncthreads();
    for (int t = 0; t < NT; ++t) {
        const int buf = t & 1;
        if (t + 1 < NT) {
            const size_t go = (size_t)(t + 1) * 128 * AW;
            kreg0 = *(const u32x4*)(kg + go); kreg1 = *(const u32x4*)(kg + go + (size_t)64 * AW); vreg0 = *(const u32x4*)(vg + go); vreg1 = *(const u32x4*)(vg + go + (size_t)64 * AW);
            if (tid < 32) freg = *(const f32x4*)(Fh + (t + 1) * 128 + tid * 4);
        }
#pragma unroll
        for (int sub = 0; sub < 2; ++sub) {
            const int key0 = t * 128 + sub * 64;
            if (key0 <= Qw)
                attn_tile64(Kl + buf * TB + sub * 64 * KP, Vl + buf * TB + sub * 64 * KP, Fl + buf * 128 + sub * 64, key0, Qw, key0 + 63 > Qw, qf, fq, fqm, mrun, lrun, o, l16, quad);
        }
        if (t + 1 < NT) {
            const int nb = buf ^ 1;
            *(LAS u32x4*)(Kl + nb * TB + soff) = kreg0; *(LAS u32x4*)(Kl + nb * TB + 64 * KP + soff) = kreg1;
            *(LAS u32x4*)(Vl + nb * TB + soff) = vreg0; *(LAS u32x4*)(Vl + nb * TB + 64 * KP + soff) = vreg1;
            if (tid < 32) *(LAS f32x4*)(Fl + nb * 128 + tid * 4) = freg;
        }
        __syncthreads();
    }
#pragma unroll
    for (int qt = 0; qt < 2; ++qt) {
        float lt = lrun[qt]; lt += __shfl_xor(lt, 16); lt += __shfl_xor(lt, 32);
        const float il = 1.0f / lt;
        bf16_t* op = mix + (rowbase + Qw + 16 * qt + l16) * D + PW + h * HD + 4 * quad;
#pragma unroll
        for (int dt = 0; dt < 4; ++dt) {
            u32x2 w; w.x = pk2(o[dt][qt][0] * il, o[dt][qt][1] * il); w.y = pk2(o[dt][qt][2] * il, o[dt][qt][3] * il);
            *(u32x2*)(op + 16 * dt) = w;
        }
    }
}


namespace fa {
using f32x16 = __attribute__((ext_vector_type(16))) float;
constexpr int SEQ = T, DH = 64, DM = AW;
constexpr int NW = 8, QBLK = 32, QB = QBLK * NW, KVBLK = 64;
__device__ __forceinline__ int crow(int r, int hi) { return (r & 3) + 8 * (r >> 2) + 4 * hi; }
#define SBAR() __builtin_amdgcn_sched_barrier(0)
__device__ __forceinline__ void cmask(f32x16& p0, f32x16& p1, int jb, int qrel, int hi) {
    const float NEG = -INFINITY; int kb = 64 * jb + 4 * hi;
#pragma unroll
    for (int r = 0; r < 16; ++r) { int kv = kb + (r & 3) + 8 * (r >> 2); if (kv > qrel) p0[r] = NEG; if (kv + 32 > qrel) p1[r] = NEG; }
}
constexpr int NSLOT = 3, SLOTB = 8192;
constexpr int LDS_K = 0, LDS_V = NSLOT * SLOTB, LDS_WS = 2 * NSLOT * SLOTB, LDS_OST = LDS_WS + NW * 64 * 4, LDS_FK = LDS_OST + NW * 4096, LDS_END = LDS_FK + SEQ * 4;
__device__ __forceinline__ void glds16(const void* gsrc, unsigned lds_dst) { unsigned keep;
    asm volatile("s_mov_b32 %0, m0\n\ts_mov_b32 m0, %2\n\ts_nop 0\n\tglobal_load_lds_dwordx4 %1, off\n\ts_mov_b32 m0, %0" : "=&s"(keep) : "v"(gsrc), "s"(lds_dst) : "memory"); }
__device__ __forceinline__ float max3f(float a, float b, float c) { float r; asm("v_max3_f32 %0, %1, %2, %3" : "=v"(r) : "v"(a), "v"(b), "v"(c)); return r; }
__device__ __forceinline__ float max2f(float a, float b) { float r; asm("v_max_f32_e32 %0, %1, %2" : "=v"(r) : "v"(a), "v"(b)); return r; }
__device__ __forceinline__ float fadd_s(float a, float b) { float r; asm("v_add_f32_e32 %0, %1, %2" : "=v"(r) : "v"(a), "v"(b)); return r; }
__device__ __forceinline__ float fsub_s(float a, float b) { float r; asm("v_sub_f32_e32 %0, %1, %2" : "=v"(r) : "v"(a), "v"(b)); return r; }
__device__ __forceinline__ unsigned cvtpk_s(float lo, float hi) { return pk2(lo, hi); }
#define WAIT_BAR(N) asm volatile("s_waitcnt vmcnt(" #N ") lgkmcnt(0)\n\ts_barrier" ::: "memory")
typedef __attribute__((address_space(3))) const char* lds_cptr;
__device__ __forceinline__ void bias_half(f32x16& c, lds_cptr fkt, float cq, int hi) {
#pragma unroll
    for (int g = 0; g < 4; ++g) {
        const f32x4 a = *(const LAS f32x4*)(fkt + (8 * g + 4 * hi) * 4);
#pragma unroll
        for (int j = 0; j < 4; ++j) c[4 * g + j] = cq - a[j];
    }
}
__device__ __forceinline__ void bias_init(f32x16& c0, f32x16& c1, lds_cptr fkt, float cq, int hi) {
#pragma unroll
    for (int g = 0; g < 4; ++g) {
        const f32x4 a = *(const LAS f32x4*)(fkt + (8 * g + 4 * hi) * 4), b = *(const LAS f32x4*)(fkt + (32 + 8 * g + 4 * hi) * 4);
#pragma unroll
        for (int j = 0; j < 4; ++j) { c0[4 * g + j] = cq - a[j]; c1[4 * g + j] = cq - b[j]; }
    }
}
__device__ __forceinline__ void qkt(f32x16& p0, f32x16& p1, const char* Kslot, const bf16x8* qr, int r32, int hi) {
    const char* kb = Kslot + hi * 1024 + r32 * 16;
#pragma unroll
    for (int d0 = 0; d0 < 4; ++d0) {
        const bf16x8 b0 = *reinterpret_cast<const bf16x8*>(kb + d0 * 2048);
        const bf16x8 b1 = *reinterpret_cast<const bf16x8*>(kb + d0 * 2048 + 512);
        p0 = __builtin_amdgcn_mfma_f32_32x32x16_bf16(b0, qr[d0], p0, 0, 0, 0); p1 = __builtin_amdgcn_mfma_f32_32x32x16_bf16(b1, qr[d0], p1, 0, 0, 0); }
}
__device__ __forceinline__ void kload8(bf16x8* kf, lds_cptr kp) {
    kf[0] = *(const LAS bf16x8*)(kp);        kf[1] = *(const LAS bf16x8*)(kp + 512);
    kf[2] = *(const LAS bf16x8*)(kp + 2048); kf[3] = *(const LAS bf16x8*)(kp + 2560);
    kf[4] = *(const LAS bf16x8*)(kp + 4096); kf[5] = *(const LAS bf16x8*)(kp + 4608);
    kf[6] = *(const LAS bf16x8*)(kp + 6144); kf[7] = *(const LAS bf16x8*)(kp + 6656);
}
__device__ __forceinline__ void kload2(bf16x8* kf, lds_cptr kp, int j) { kf[2 * j] = *(const LAS bf16x8*)(kp + j * 2048); kf[2 * j + 1] = *(const LAS bf16x8*)(kp + j * 2048 + 512); }
__device__ __forceinline__ s16x4 vtr2(lds_cptr p) { return __builtin_bit_cast(s16x4, __builtin_amdgcn_ds_read_tr16_b64_v4i16((LAS s16x4*)p)); }
__device__ __forceinline__ float rowmax(const f32x16& p0, const f32x16& p1) {
    float a = max3f(p0[0], p0[1], p1[0]), b = max3f(p0[2], p0[3], p1[1]); a = max3f(a, p1[2], p1[3]);
#pragma unroll
    for (int r = 4; r < 16; r += 4) { a = max3f(a, p0[r], p0[r + 1]); b = max3f(b, p0[r + 2], p0[r + 3]); a = max3f(a, p1[r], p1[r + 1]); b = max3f(b, p1[r + 2], p1[r + 3]); }
    const float m = max2f(a, b);
    auto rr = __builtin_amdgcn_permlane32_swap(__float_as_uint(m), __float_as_uint(m), false, false);
    return max2f(__uint_as_float(rr[0]), __uint_as_float(rr[1]));
}
__device__ __forceinline__ void pv(f32x16* o, int vb, bf16x8 pa0, bf16x8 pa1, bf16x8 pa2, bf16x8 pa3) {
#pragma unroll
    for (int d0 = 0; d0 < 2; ++d0) { s16x4 lo[4], hi[4];
#pragma unroll
        for (int ks = 0; ks < 4; ++ks) {
            asm volatile("ds_read_b64_tr_b16 %0,%1 offset:%c2" : "=&v"(lo[ks]) : "v"(vb), "i"(d0 * 4096 + ks * 1024) : "memory");
            asm volatile("ds_read_b64_tr_b16 %0,%1 offset:%c2" : "=&v"(hi[ks]) : "v"(vb), "i"(d0 * 4096 + ks * 1024 + 512) : "memory"); }
        asm volatile("s_waitcnt lgkmcnt(0)" ::: "memory"); SBAR();
#define PK(k) (bf16x8){lo[k][0], lo[k][1], lo[k][2], lo[k][3], hi[k][0], hi[k][1], hi[k][2], hi[k][3]}
        o[d0] = __builtin_amdgcn_mfma_f32_32x32x16_bf16(pa0, PK(0), o[d0], 0, 0, 0);
        o[d0] = __builtin_amdgcn_mfma_f32_32x32x16_bf16(pa1, PK(1), o[d0], 0, 0, 0);
        o[d0] = __builtin_amdgcn_mfma_f32_32x32x16_bf16(pa2, PK(2), o[d0], 0, 0, 0);
        o[d0] = __builtin_amdgcn_mfma_f32_32x32x16_bf16(pa3, PK(3), o[d0], 0, 0, 0);
#undef PK
    }
}

template <int THRL> __device__ __forceinline__ void attn_unit(int b, int h, int qb, const bf16_t* Q, const bf16_t* __restrict__ K, const bf16_t* __restrict__ V, const float* F2, bf16_t* mix, char* shm, const int tid, const int t0) {
    const int lane = tid & 63, r32 = lane & 31, hi = lane >> 5; const int wid = __builtin_amdgcn_readfirstlane(tid >> 6);
    const long rowbase = (long)b * SEQ; const int q0 = qb * QB;
    const bf16_t* Qw = Q + (rowbase + q0 + wid * QBLK) * DM + h * DH;
    const bf16_t* Kh = K + (rowbase + t0 * KVBLK) * DM + h * DH, *Vh = V + (rowbase + t0 * KVBLK) * DM + h * DH;
    const float* Fh = F2 + (long)(b * NH + h) * SEQ;
    const unsigned lds0 = (unsigned)(uintptr_t)shm;
    float* wsf = (float*)(shm + LDS_WS) + wid * 64;
    { float* fl = (float*)(shm + LDS_FK); for (int i = t0 * KVBLK + tid * 4; i < q0 + QB; i += 2048) *(f32x4*)(fl + i - t0 * KVBLK) = *(const f32x4*)(Fh + i); }
    const float fq = Fh[q0 + wid * QBLK + r32];
    const bf16_t* ksrc = Kh + (long)lane * DM + wid * 8;
    const bf16_t* vsrc = Vh + (long)(16 * (wid & 3) + (lane >> 2)) * DM + (wid >> 2) * 32 + (lane & 3) * 8;
    const unsigned kdst = lds0 + LDS_K + wid * 1024, vdst = lds0 + LDS_V + wid * 1024;
#define DMA_K(t, slot) glds16(ksrc + (long)(t) * KVBLK * DM, (unsigned)__builtin_amdgcn_readfirstlane(kdst + (slot)))
#define DMA_V(t, slot) glds16(vsrc + (long)(t) * KVBLK * DM, (unsigned)__builtin_amdgcn_readfirstlane(vdst + (slot)))
    const int vb0 = (int)(lds0 + LDS_V) + ((lane >> 4) & 1) * 32 + (lane & 3) * 8 + (4 * hi + ((lane & 15) >> 2)) * 64;
    const char* Kbase = shm + LDS_K; bf16x8 kf[8];
    const lds_cptr shm3 = (lds_cptr)shm; const lds_cptr kp0 = shm3 + LDS_K + hi * 1024 + r32 * 16; const lds_cptr vp0 = shm3 + LDS_V + ((lane >> 4) & 1) * 32 + (lane & 3) * 8 + (4 * hi + ((lane & 15) >> 2)) * 64;
    const lds_cptr fk0 = shm3 + LDS_FK;
    const int NT = (q0 + QB) / KVBLK - t0;
    DMA_K(0, 0); DMA_V(0, 0); DMA_K(1, SLOTB);
    bf16x8 qr[4];
#pragma unroll
    for (int d0 = 0; d0 < 4; ++d0) qr[d0] = *reinterpret_cast<const bf16x8*>(&Qw[(long)r32 * DM + d0 * 16 + hi * 8]);
    float mhat = 0.f, l_reg = 0.f, cq = fq; f32x16 o[2]; o[0] = f32x16{}; o[1] = f32x16{};
    const int qrel = wid * QBLK + r32;
#define CMASK(P0, P1, t) do { int jb_ = (t) - (NT - 4); if (jb_ >= 0) cmask(P0, P1, jb_, qrel, hi); } while (0)
    bool resc = false;
#define START(P0, P1) do { const float rm = rowmax(P0, P1); resc = false; \
    { const float dl = rm; mhat = fadd_s(mhat, dl); \
      _Pragma("unroll") for (int r = 0; r < 16; ++r) { P0[r] = fsub_s(P0[r], dl); P1[r] = fsub_s(P1[r], dl); } \
      cq = fq - mhat; } \
    _Pragma("unroll") for (int r = 0; r < 16; ++r) P0[r] = __builtin_amdgcn_exp2f(P0[r]); } while (0)
#define RESC() do { if (resc) { asm volatile("s_waitcnt lgkmcnt(0)" ::: "memory"); \
      _Pragma("unroll") for (int d_ = 0; d_ < 2; ++d_) _Pragma("unroll") for (int r = 0; r < 16; ++r) o[d_][r] *= wsf[crow(r, hi)]; } } while (0)
    f32x16 pA0, pA1, pB0, pB1;
    int sl_prev = 0, sl_cur = 0, sl_next = SLOTB;
#define ROT() do { sl_prev = sl_cur; sl_cur = sl_next; sl_next = (sl_next == (NSLOT - 1) * SLOTB) ? 0 : sl_next + SLOTB; } while (0)
    DMA_K(2, 2 * SLOTB);
    WAIT_BAR(3);
    bias_init(pA0, pA1, fk0, cq, hi);
    qkt(pA0, pA1, Kbase, qr, r32, hi); asm volatile("s_nop 15\n\ts_nop 7" : "+v"(pA0), "+v"(pA1)); CMASK(pA0, pA1, 0);
    START(pA0, pA1);
    _Pragma("unroll") for (int r = 0; r < 16; ++r) pA1[r] = __builtin_amdgcn_exp2f(pA1[r]);
    WAIT_BAR(0);
    DMA_K(3, 0); DMA_V(1, SLOTB);
    ROT();
    kload8(kf, kp0 + sl_cur);
    WAIT_BAR(2);
    s16x4 vlo[8], vhi[8]; u32x4 pw0, pw1, pw2, pw3;
#define PKW(P, B) cvtpk_s(P[B], P[B + 1])
#define PAF(k) __builtin_bit_cast(bf16x8, pw##k)
#define VFR(i) (bf16x8){vlo[i][0], vlo[i][1], vlo[i][2], vlo[i][3], vhi[i][0], vhi[i][1], vhi[i][2], vhi[i][3]}
#define PIN(x) asm volatile("" : "+v"(x))
#define MX3(a, b, c) __builtin_fmaxf(__builtin_fmaxf((a), (b)), (c))
#define GAPA(MF, A0, A1, A2, A3, W0, W1, PW) do { MF; sacc += A0; sacc += A1; sacc += A2; sacc += A3; PIN(sacc); W0; W1; PIN(PW); SBAR(); } while (0)
#define EX(v) __builtin_amdgcn_exp2f(v)
#define GAPB(MF, X, B) do { MF; X[B] = EX(X[B]); X[B + 1] = EX(X[B + 1]); X[B + 2] = EX(X[B + 2]); X[B + 3] = EX(X[B + 3]); PIN(X); SBAR(); } while (0)
#define VRD(i) do { vlo[i] = vtr2(vp_ + (((i) >> 2) * 4096 + ((i) & 3) * 1024)); vhi[i] = vtr2(vp_ + (((i) >> 2) * 4096 + ((i) & 3) * 1024 + 512)); } while (0)
#define KRD(G, j) do { if (G) { kload2(kf, kp0 + sl_next, j); SBAR(); } } while (0)
#define STEP(C0, C1, P0, P1, t, GK, GV, GL) do { SBAR(); \
    bias_half(C0, fk0 + (t) * 256, cq, hi); SBAR(); \
    const lds_cptr vp_ = vp0 + sl_prev; \
    VRD(0); SBAR(); float sacc = (P0[0] + P0[1]); \
    GAPA(C0 = __builtin_amdgcn_mfma_f32_32x32x16_bf16(kf[0], qr[0], C0, 0, 0, 0), P0[2], P0[3], P0[4], P0[5],     pw0[0] = PKW(P0, 0), pw0[1] = PKW(P0, 2), pw0); \
    bias_half(C1, fk0 + (t) * 256 + 128, cq, hi); SBAR(); \
    VRD(4); SBAR(); GAPA(C1 = __builtin_amdgcn_mfma_f32_32x32x16_bf16(kf[1], qr[0], C1, 0, 0, 0), P0[6], P0[7], P0[8], P0[9],     pw0[2] = PKW(P0, 4), pw0[3] = PKW(P0, 6), pw0); \
    VRD(1); SBAR(); GAPA(C0 = __builtin_amdgcn_mfma_f32_32x32x16_bf16(kf[2], qr[1], C0, 0, 0, 0),   P0[10], P0[11], P0[12], P0[13], pw1[0] = PKW(P0, 8), pw1[1] = PKW(P0, 10), pw1); \
    VRD(5); SBAR(); GAPA(C1 = __builtin_amdgcn_mfma_f32_32x32x16_bf16(kf[3], qr[1], C1, 0, 0, 0),   P0[14], P0[15], P1[0], P1[1],   pw1[2] = PKW(P0, 12), pw1[3] = PKW(P0, 14), pw1); \
    VRD(2); SBAR(); GAPA(C0 = __builtin_amdgcn_mfma_f32_32x32x16_bf16(kf[4], qr[2], C0, 0, 0, 0),   P1[2], P1[3], P1[4], P1[5],     pw2[0] = PKW(P1, 0), pw2[1] = PKW(P1, 2), pw2); \
    VRD(6); SBAR(); GAPA(C1 = __builtin_amdgcn_mfma_f32_32x32x16_bf16(kf[5], qr[2], C1, 0, 0, 0),   P1[6], P1[7], P1[8], P1[9],     pw2[2] = PKW(P1, 4), pw2[3] = PKW(P1, 6), pw2); \
    VRD(3); SBAR(); GAPA(C0 = __builtin_amdgcn_mfma_f32_32x32x16_bf16(kf[6], qr[3], C0, 0, 0, 0),   P1[10], P1[11], P1[12], P1[13], pw3[0] = PKW(P1, 8), pw3[1] = PKW(P1, 10), pw3); \
    VRD(7); SBAR(); GAPA(C1 = __builtin_amdgcn_mfma_f32_32x32x16_bf16(kf[7], qr[3], C1, 0, 0, 0),   P1[14], P1[15], 0.f, 0.f,       pw3[2] = PKW(P1, 12), pw3[3] = PKW(P1, 14), pw3); \
    l_reg += sacc; \
    if (GK) { DMA_K((t) + 3, sl_cur); } if (GV) { DMA_V((t) + 1, sl_next); } \
    CMASK(C0, C1, t); \
    { float a = MX3(C0[0], C0[1], C1[0]), b = MX3(C0[2], C0[3], C1[1]); a = MX3(a, C1[2], C1[3]); \
      _Pragma("unroll") for (int r = 4; r < 16; r += 4) { a = MX3(a, C0[r], C0[r + 1]); b = MX3(b, C0[r + 2], C0[r + 3]); a = MX3(a, C1[r], C1[r + 1]); b = MX3(b, C1[r + 2], C1[r + 3]); } \
      float rm = __builtin_fmaxf(a, b); { auto rr = __builtin_amdgcn_permlane32_swap(__float_as_uint(rm), __float_as_uint(rm), false, false); rm = __builtin_fmaxf(__uint_as_float(rr[0]), __uint_as_float(rr[1])); } \
      resc = false; \
      if (__builtin_expect(__any(rm > (float)THRL), 0)) { const float dl = __builtin_fmaxf(rm, 0.f); mhat += dl; \
        _Pragma("unroll") for (int r = 0; r < 16; ++r) { C0[r] -= dl; C1[r] -= dl; } \
        cq = fq - mhat; \
        const float f = __builtin_amdgcn_exp2f(-dl); l_reg *= f; if (hi == 0) wsf[r32] = f; resc = true; } } \
    SBAR(); \
    GAPB(o[0] = __builtin_amdgcn_mfma_f32_32x32x16_bf16(PAF(0), VFR(0), o[0], 0, 0, 0), C0, 0); \
    GAPB(o[1] = __builtin_amdgcn_mfma_f32_32x32x16_bf16(PAF(0), VFR(4), o[1], 0, 0, 0), C0, 4); \
    KRD(GL, 0); GAPB(o[0] = __builtin_amdgcn_mfma_f32_32x32x16_bf16(PAF(1), VFR(1), o[0], 0, 0, 0), C0, 8); \
    KRD(GL, 1); GAPB(o[1] = __builtin_amdgcn_mfma_f32_32x32x16_bf16(PAF(1), VFR(5), o[1], 0, 0, 0), C0, 12); \
    KRD(GL, 2); GAPB(o[0] = __builtin_amdgcn_mfma_f32_32x32x16_bf16(PAF(2), VFR(2), o[0], 0, 0, 0), C1, 0); \
    KRD(GL, 3); GAPB(o[1] = __builtin_amdgcn_mfma_f32_32x32x16_bf16(PAF(2), VFR(6), o[1], 0, 0, 0), C1, 4); \
    GAPB(o[0] = __builtin_amdgcn_mfma_f32_32x32x16_bf16(PAF(3), VFR(3), o[0], 0, 0, 0), C1, 8); \
    GAPB(o[1] = __builtin_amdgcn_mfma_f32_32x32x16_bf16(PAF(3), VFR(7), o[1], 0, 0, 0), C1, 12); \
    } while (0)
    int t = 1;
#undef CMASK
#define CMASK(P0, P1, t) do { } while (0)
    for (; t + 5 < NT; t += 2) {
        STEP(pB0, pB1, pA0, pA1, t, true, true, true);     WAIT_BAR(2); RESC(); ROT();
        STEP(pA0, pA1, pB0, pB1, t + 1, true, true, true); WAIT_BAR(2); RESC(); ROT();
    }
#undef CMASK
#define CMASK(P0, P1, t) do { int jb_ = (t) - (NT - 4); if (jb_ >= 0) cmask(P0, P1, jb_, qrel, hi); } while (0)
#define ENDW(tt) do { if ((tt) + 3 < NT) { WAIT_BAR(2); } else if ((tt) + 2 < NT) { WAIT_BAR(1); } else { WAIT_BAR(0); } } while (0)
    for (; t + 1 < NT; t += 2) {
        STEP(pB0, pB1, pA0, pA1, t, (t + 3 < NT), (t + 1 < NT), (t + 1 < NT));       ENDW(t);     RESC(); ROT();
        STEP(pA0, pA1, pB0, pB1, t + 1, (t + 4 < NT), (t + 2 < NT), (t + 2 < NT)); ENDW(t + 1); RESC(); ROT();
    }
    STEP(pB0, pB1, pA0, pA1, NT - 1, false, false, false); RESC();
    { float sacc = pB0[0] + pB0[1]; _Pragma("unroll") for (int r = 2; r < 16; ++r) sacc += pB0[r]; _Pragma("unroll") for (int r = 0; r < 16; ++r) sacc += pB1[r]; l_reg += sacc;
      pw0 = (u32x4){PKW(pB0, 0), PKW(pB0, 2), PKW(pB0, 4), PKW(pB0, 6)}; pw1 = (u32x4){PKW(pB0, 8), PKW(pB0, 10), PKW(pB0, 12), PKW(pB0, 14)}; pw2 = (u32x4){PKW(pB1, 0), PKW(pB1, 2), PKW(pB1, 4), PKW(pB1, 6)}; pw3 = (u32x4){PKW(pB1, 8), PKW(pB1, 10), PKW(pB1, 12), PKW(pB1, 14)};
      SBAR(); pv(o, vb0 + sl_cur, PAF(0), PAF(1), PAF(2), PAF(3)); }
#undef PKW
#undef PAF
#undef VFR
#undef PIN
#undef MX3
#undef GAPA
#undef GAPB
#undef EX
#undef VRD
#undef KRD
#undef STEP
#undef ENDW
    { auto rr = __builtin_amdgcn_permlane32_swap(__float_as_uint(l_reg), __float_as_uint(l_reg), false, false); l_reg = __uint_as_float(rr[0]) + __uint_as_float(rr[1]); }
    if (hi == 0) wsf[32 + r32] = l_reg; asm volatile("s_waitcnt lgkmcnt(0)" ::: "memory");
    float rli[16];
#pragma unroll
    for (int r = 0; r < 16; ++r) rli[r] = __builtin_amdgcn_rcpf(wsf[32 + crow(r, hi)]);
    bf16_t* Ow = mix + (rowbase + q0 + wid * QBLK) * D + PW + h * DH;
    { bf16_t* stg = (bf16_t*)(shm + LDS_OST) + wid * 2048;
#pragma unroll
      for (int r = 0; r < 16; ++r) { const int orow = crow(r, hi);
#pragma unroll
        for (int d0 = 0; d0 < 2; ++d0) stg[orow * 64 + d0 * 32 + r32] = (bf16_t)f2bf(o[d0][r] * rli[r]); }
      asm volatile("s_waitcnt lgkmcnt(0)" ::: "memory");
#pragma unroll
      for (int i = 0; i < 4; ++i) { const int row = i * 8 + (lane >> 3), ch = lane & 7; const u32x4 v = *(const u32x4*)(stg + row * 64 + ch * 8); *(u32x4*)(Ow + (long)row * D + ch * 8) = v; } }
    asm volatile("s_waitcnt lgkmcnt(0)\n\ts_barrier" ::: "memory");
#undef DMA_K
#undef DMA_V
#undef CMASK
#undef START
#undef RESC
#undef ROT
}
#undef SBAR
#undef WAIT_BAR
}

__device__ __forceinline__ void attn_sample_unit(int l, int b, int h, const Params& p, LAS unsigned char* lds, int tid, int lane, int wave, float thr) {
    const int l16 = lane & 15, quad = lane >> 4;
    const bf16_t* Q = (const bf16_t*)(p.ws + WS_Q); const bf16_t* Kb = (const bf16_t*)(p.ws + WS_K); const bf16_t* Vb = (const bf16_t*)(p.ws + WS_V);
    bf16_t* mix = (bf16_t*)(p.ws + WS_MIX);
    const size_t row0 = (size_t)MP + b * ST;
    const float* Fh = (const float*)(p.ws + WS_FS) + (size_t)(b * NH + h) * SKEYS;
    bf16x8 qf[2];
#pragma unroll
    for (int ks = 0; ks < 2; ++ks) qf[ks] = *(const bf16x8*)(Q + (row0 + l16) * AW + h * HD + 32 * ks + 8 * quad);
    const float fq = Fh[PAST + l16];
    f32x4 o[4];
#pragma unroll
    for (int dt = 0; dt < 4; ++dt) o[dt] = (f32x4){0.f, 0.f, 0.f, 0.f};
    float mrun = -INFINITY, lrun = 0.f;
    const float* Kc = p.in[4] + ((size_t)(l * SB + b) * PAST) * AW + h * HD;
    const float* Vc = p.in[5] + ((size_t)(l * SB + b) * PAST) * AW + h * HD;
    LAS unsigned char* Vw = lds + wave * (64 * KP);
    f32x4 rk[2][2][2], rv[8], rf[2];
#define SAMPLE_LOAD(key0_) do { \
        _Pragma("unroll") for (int kt = 0; kt < 2; ++kt) _Pragma("unroll") for (int ks = 0; ks < 2; ++ks) { \
            const float* kp = Kc + (size_t)((key0_) + 16 * kt + l16) * AW + 32 * ks + 8 * quad; rk[kt][ks][0] = __builtin_nontemporal_load((const f32x4*)kp); rk[kt][ks][1] = __builtin_nontemporal_load((const f32x4*)(kp + 4)); } \
        _Pragma("unroll") for (int j = 0; j < 8; ++j) rv[j] = __builtin_nontemporal_load((const f32x4*)(Vc + (size_t)((key0_) + 4 * j + quad) * AW + 4 * l16)); \
        _Pragma("unroll") for (int kt = 0; kt < 2; ++kt) rf[kt] = *(const f32x4*)(Fh + (key0_) + 16 * kt + 4 * quad); } while (0)
    int ks;
    { const int j = lane & 15; const bool c = (j >= 1) && (Fh[256 * (j >= 1 ? j : 1) - 1] - Fh[PAST + vzero()] >= thr); ks = 256 * __popcll(__ballot(c && lane < 16)); }
    const int nst = (PAST - ks) >> 8;
    const int kbeg = ks + wave * nst * 32;
    SAMPLE_LOAD(kbeg);
    const int nsteps = nst + (wave == 7 ? 1 : 0);
    for (int step = 0; step < nsteps; ++step) {
        const bool isnew = step == nst;
        f32x4 s[2];
        bf16x8 kf[2][2];
        asm volatile("s_waitcnt lgkmcnt(0)" ::: "memory");
        if (!isnew) {
#pragma unroll
            for (int kt = 0; kt < 2; ++kt)
#pragma unroll
                for (int ks = 0; ks < 2; ++ks) {
                    const f32x4 a = rk[kt][ks][0], c = rk[kt][ks][1];
                    u32x4 w; w.x = pk2(a[0], a[1]); w.y = pk2(a[2], a[3]); w.z = pk2(c[0], c[1]); w.w = pk2(c[2], c[3]);
                    kf[kt][ks] = __builtin_bit_cast(bf16x8, w);
                }
#pragma unroll
            for (int j = 0; j < 8; ++j) {
                const int kr = 4 * j + quad;
                u32x2 w; w.x = pk2(rv[j][0], rv[j][1]); w.y = pk2(rv[j][2], rv[j][3]);
                *(LAS u32x2*)(Vw + kr * KP + 8 * l16) = w;
            }
#pragma unroll
            for (int kt = 0; kt < 2; ++kt) s[kt] = (f32x4){fq - rf[kt][0], fq - rf[kt][1], fq - rf[kt][2], fq - rf[kt][3]};
            if (step + 1 < nst) SAMPLE_LOAD(kbeg + (step + 1) * 32);
        } else {
#pragma unroll
            for (int ks = 0; ks < 2; ++ks) { kf[0][ks] = *(const bf16x8*)(Kb + (row0 + l16) * AW + h * HD + 32 * ks + 8 * quad); kf[1][ks] = (bf16x8){0, 0, 0, 0, 0, 0, 0, 0}; }
            {
                const int kr = lane >> 2, ch = lane & 3;
                const u32x4 a = *(const u32x4*)(Vb + (row0 + kr) * AW + h * HD + 16 * ch), c = *(const u32x4*)(Vb + (row0 + kr) * AW + h * HD + 16 * ch + 8);
                *(LAS u32x4*)(Vw + kr * KP + 32 * ch) = a; *(LAS u32x4*)(Vw + kr * KP + 32 * ch + 16) = c;
                *(LAS u32x4*)(Vw + (16 + kr) * KP + 32 * ch) = (u32x4){0u, 0u, 0u, 0u}; *(LAS u32x4*)(Vw + (16 + kr) * KP + 32 * ch + 16) = (u32x4){0u, 0u, 0u, 0u};
            }
            const f32x4 fk = *(const f32x4*)(Fh + PAST + 4 * quad);
            s[0] = (f32x4){fq - fk[0], fq - fk[1], fq - fk[2], fq - fk[3]};
            s[1] = (f32x4){-INFINITY, -INFINITY, -INFINITY, -INFINITY};
        }
#pragma unroll
        for (int ks = 0; ks < 2; ++ks) {
            s[0] = __builtin_amdgcn_mfma_f32_16x16x32_bf16(kf[0][ks], qf[ks], s[0], 0, 0, 0);
            if (!isnew) s[1] = __builtin_amdgcn_mfma_f32_16x16x32_bf16(kf[1][ks], qf[ks], s[1], 0, 0, 0);
        }
        if (isnew) {
#pragma unroll
            for (int r = 0; r < 4; ++r) if (4 * quad + r > l16) s[0][r] = -INFINITY;
        }
        float mx = fmaxf(fmaxf(s[0][0], s[0][1]), fmaxf(s[0][2], s[0][3]));
        mx = fmaxf(mx, fmaxf(fmaxf(s[1][0], s[1][1]), fmaxf(s[1][2], s[1][3])));
        mx = fmaxf(mx, __shfl_xor(mx, 16)); mx = fmaxf(mx, __shfl_xor(mx, 32));
        const float mnew = fmaxf(mrun, mx);
        const float alpha = __builtin_amdgcn_exp2f(mrun - mnew);
        mrun = mnew;
        float ps = 0.f;
#pragma unroll
        for (int kt = 0; kt < 2; ++kt)
#pragma unroll
            for (int r = 0; r < 4; ++r) { const float e = __builtin_amdgcn_exp2f(s[kt][r] - mnew); s[kt][r] = e; ps += e; }
        lrun = lrun * alpha + ps;
        u32x4 w; w.x = pk2(s[0][0], s[0][1]); w.y = pk2(s[0][2], s[0][3]); w.z = pk2(s[1][0], s[1][1]); w.w = pk2(s[1][2], s[1][3]);
        const bf16x8 pb = __builtin_bit_cast(bf16x8, w);
        asm volatile("s_waitcnt lgkmcnt(0)" ::: "memory");
        const LAS unsigned char* vb0 = Vw + (4 * quad + (l16 >> 2)) * KP + 8 * (l16 & 3);
#pragma unroll
        for (int dt = 0; dt < 4; ++dt) {
            const s16x4 a0 = vtr(vb0 + 32 * dt), a1 = vtr(vb0 + 16 * KP + 32 * dt);
            const bf16x8 vf = (bf16x8){a0[0], a0[1], a0[2], a0[3], a1[0], a1[1], a1[2], a1[3]};
            o[dt] = o[dt] * alpha;
            o[dt] = __builtin_amdgcn_mfma_f32_16x16x32_bf16(vf, pb, o[dt], 0, 0, 0);
        }
    }
#undef SAMPLE_LOAD
    float lt = lrun; lt += __shfl_xor(lt, 16); lt += __shfl_xor(lt, 32);
    LAS float* cm = (LAS float*)(lds + 8 * 64 * KP);
    LAS float* cl = cm + 128; LAS float* co = cl + 128;
    if (quad == 0) { cm[wave * 16 + l16] = mrun; cl[wave * 16 + l16] = lt; }
#pragma unroll
    for (int dt = 0; dt < 4; ++dt)
#pragma unroll
        for (int r = 0; r < 4; ++r) co[(wave * 16 + l16) * 64 + 16 * dt + 4 * quad + r] = o[dt][r];
    __syncthreads();
    {
        const int q = tid >> 5, d0 = (tid & 31) * 2;
        float mm = cm[q];
#pragma unroll
        for (int w = 1; w < 8; ++w) mm = fmaxf(mm, cm[w * 16 + q]);
        float L = 0.f, a0 = 0.f, a1 = 0.f;
#pragma unroll
        for (int w = 0; w < 8; ++w) { const float f = __builtin_amdgcn_exp2f(cm[w * 16 + q] - mm); L += cl[w * 16 + q] * f; a0 += co[(w * 16 + q) * 64 + d0] * f; a1 += co[(w * 16 + q) * 64 + d0 + 1] * f; }
        const float il = 1.0f / L;
        *(unsigned*)(mix + (row0 + q) * D + PW + h * HD + d0) = pk2(a0 * il, a1 * il);
    }
    __syncthreads();
}

__device__ __forceinline__ void phase_attn(const Params& p, LAS unsigned char* lds, int l, int ci, int mode, int tid, int lane, int wave) {
    unsigned* ctr = (unsigned*)(p.ws + WS_CTL) + 64 * ci;
    LAS unsigned* slot = (LAS unsigned*)(lds + LDS_BYTES - 64);
    char* lds_generic = (char*)lds;
    const bf16_t* Q = (const bf16_t*)(p.ws + WS_Q); const bf16_t* Kb = (const bf16_t*)(p.ws + WS_K); const bf16_t* Vb = (const bf16_t*)(p.ws + WS_V);
    const float* Fp = (const float*)(p.ws + WS_FP); bf16_t* mix = (bf16_t*)(p.ws + WS_MIX);
    float thr;
    {
        const float gq = fabsf(p.in[12][l * HD + lane]), gk = fabsf(p.in[13][l * HD + lane]);
        float mq = gq, mk = gk;
#pragma unroll
        for (int o = 1; o < 64; o <<= 1) { mq = fmaxf(mq, __shfl_xor(mq, o)); mk = fmaxf(mk, __shfl_xor(mk, o)); }
        thr = 53.f + 2.f * (64.f * mq * mk * C2 + 0.5f);
    }
    LAS unsigned* cnt = (LAS unsigned*)lds;
    LAS unsigned* keys = (LAS unsigned*)(lds + 1024);
    LAS unsigned short* order = (LAS unsigned short*)(lds + fa::LDS_END);
    const float* Fs = (const float*)(p.ws + WS_FS);
    for (int i = tid; i < 216; i += 512) cnt[i] = 0u;
    __syncthreads();
    for (int i = tid; i < 24 * 124; i += 512) { const int bh = i / 124, j = i % 124 + 1; const float* Fh = Fp + (size_t)bh * T; if (Fh[64 * j - 1] - Fh[31 * 256] >= thr) atomicAdd((unsigned*)(cnt + bh), 1u); }
    for (int i = tid; i < 192 * 15; i += 512) { const int si = i / 15, j = i % 15 + 1; const float* Fh = Fs + (size_t)si * SKEYS; if (Fh[256 * j - 1] - Fh[PAST] >= thr) atomicAdd((unsigned*)(cnt + 24 + si), 1u); }
    __syncthreads();
    for (int id = tid; id < 1024; id += 512) {
        unsigned key = 0u;
        if (id < 768) { const int bh = id >> 5, qb = id & 31, w = 124 - (int)(cnt[bh] & ~1u); int t0a = 4 * qb - w; t0a = t0a > 0 ? (t0a & ~1) : 0;
            key = ((unsigned)(4 * (qb + 1) - t0a + 3) << 10) | (unsigned)(1023 - id); }
        else if (id < 960) { const int nst = 16 - (int)cnt[24 + id - 768]; key = ((unsigned)(5 + (10 * nst) / 3) << 10) | (unsigned)(1023 - id); }
        keys[id] = key;
    }
    __syncthreads();
    {
        const unsigned k0 = keys[tid], k1 = keys[tid + 512]; unsigned p0 = 0u, p1 = 0u;
        for (int k = 0; k < 1024; k += 4) { const u32x4 v = *(const LAS u32x4*)(keys + k);
            p0 += (v.x > k0) + (v.y > k0) + (v.z > k0) + (v.w > k0); p1 += (v.x > k1) + (v.y > k1) + (v.z > k1) + (v.w > k1); }
        order[p0] = (unsigned short)tid;
        if (tid + 512 < 960) order[p1] = (unsigned short)(tid + 512);
    }
    __syncthreads();
    for (;;) {
        if (tid == 0) *slot = atomicAdd(ctr, 1u);
        __syncthreads();
        const int idx = (int)*slot;
        __syncthreads();
        if (idx >= 960) break;
        const int id = (int)order[idx];
        const int tf = fresh_tid(), lf = tf & 63, wf = __builtin_amdgcn_readfirstlane(tf >> 6);
        if (id >= 768) { if (mode == 1) continue; const int si = id - 768; attn_sample_unit(l, si / NH, si % NH, p, lds, tf, lf, wf, thr); }
        else { if (mode == 2) continue; const int bh = id >> 5, qb = id & 31;
            int t0;
            { const float* Fh = Fp + (size_t)bh * T; const float f0 = Fh[qb * 256 + vzero()];
              const int ja = lf + 1, jb2 = lf + 65, jmax = 4 * qb;
              const bool ca = (ja <= jmax) && (Fh[64 * (ja <= jmax ? ja : 1) - 1] - f0 >= thr), cb = (jb2 <= jmax) && (Fh[64 * (jb2 <= jmax ? jb2 : 1) - 1] - f0 >= thr);
              t0 = (__popcll(__ballot(ca)) + __popcll(__ballot(cb))) & ~1; }
            fa::attn_unit<8>(bh / NH, bh % NH, qb, Q, Kb, Vb, Fp, mix, lds_generic, tf, t0);
        }
    }
    if (mode == 0) { const int tf = fresh_tid(); pool_items(p, lds, l, ctr + 8, slot, tf, tf & 63, __builtin_amdgcn_readfirstlane(tf >> 6)); }
}

#define XB_XCNT(j) (1024 + 64 * (j))
#define XB_XSUB(j) (2048 + 64 * (j))
#define XB_XGEN(j) (3072 + 64 * (j))
#define XB_TOP 4096
#define XB_TOPGEN 4160
__device__ __forceinline__ unsigned xb_ld(unsigned* p) { return __hip_atomic_load(p, __ATOMIC_RELAXED, __HIP_MEMORY_SCOPE_AGENT); }
__device__ __forceinline__ unsigned xb_add(unsigned* p, unsigned v) { return __hip_atomic_fetch_add(p, v, __ATOMIC_RELAXED, __HIP_MEMORY_SCOPE_AGENT); }
__device__ __forceinline__ unsigned xcc_id() { return (unsigned)__builtin_amdgcn_s_getreg((3 << 11) | 20) & 0xFu; }
__device__ __forceinline__ void grid_bar(unsigned* bar, volatile LAS unsigned* st) {
    asm volatile("s_waitcnt vmcnt(0)" ::: "memory");
    __syncthreads();
    if (threadIdx.x == 0) {
        __builtin_amdgcn_s_waitcnt(0);
        const unsigned x = xcc_id(), nloc = st[0], nx = st[1];
        const unsigned old = xb_add(&bar[XB_XSUB(x)], 1u);
        const unsigned gen = old / nloc;
        if (old + 1u == (gen + 1u) * nloc) {
            __builtin_amdgcn_fence(__ATOMIC_RELEASE, "agent");
            asm volatile("s_waitcnt vmcnt(0)" ::: "memory");
            const unsigned og = xb_add(&bar[XB_TOP], 1u);
            const unsigned tg = og / nx;
            if (og + 1u == (tg + 1u) * nx) xb_add(&bar[XB_TOPGEN], 1u);
            else { while (xb_ld(&bar[XB_TOPGEN]) == tg) __builtin_amdgcn_s_sleep(1); }
            __builtin_amdgcn_fence(__ATOMIC_ACQUIRE, "agent");
            xb_add(&bar[XB_XGEN(x)], 1u);
            asm volatile("s_waitcnt vmcnt(0)" ::: "memory");
        } else {
            while (xb_ld(&bar[XB_XGEN(x)]) == gen) __builtin_amdgcn_s_sleep(1);
            __builtin_amdgcn_fence(__ATOMIC_ACQUIRE, "agent");
            asm volatile("s_waitcnt vmcnt(0)" ::: "memory");
        }
    }
    __syncthreads();
}
#define FRESH_TID() fresh_tid()
#define TLW(t) (t), ((t) & 63), __builtin_amdgcn_readfirstlane((t) >> 6)
__global__ void __launch_bounds__(512, 2) fwd_megakernel(Params p) {
    extern __shared__ __attribute__((aligned(16))) unsigned char lds_raw[];
    LAS unsigned char* lds = (LAS unsigned char*)lds_raw;
    cg::grid_group grid = cg::this_grid();
    const int G = gridDim.x;

    unsigned* bar_w = (unsigned*)(p.ws + WS_CTL);
    if (threadIdx.x == 0) (void)xb_add(&bar_w[XB_XCNT(xcc_id())], 1u);
    { const int t_ = FRESH_TID(); phase_prologue(p, lds, TLW(t_)); }

#ifdef XSYNC
    for (int i = 0; i < XSYNC; ++i) grid.sync();
#endif
    volatile LAS unsigned* bar_st = (volatile LAS unsigned*)(lds + LDS_BYTES - 32);
    if (threadIdx.x == 0) {
        unsigned mine, cnt, sum; const unsigned x = xcc_id();
        for (;;) {
            mine = 0u; cnt = 0u; sum = 0u;
            for (unsigned j = 0; j < 16; ++j) { const unsigned c = xb_ld(&bar_w[XB_XCNT(j)]); sum += c; cnt += (c > 0u) ? 1u : 0u; mine = (j == x) ? c : mine; }
            if (sum == (unsigned)G) break;
            __builtin_amdgcn_s_sleep(1);
        }
        bar_st[0] = mine; bar_st[1] = cnt;
    }
    __syncthreads();
#define GB() grid_bar(bar_w, bar_st)
    if (G == 0x7fffffff) grid.sync();
    GB();
    float* xa = (float*)(p.ws + WS_XA); float* xb = (float*)(p.ws + WS_XB);
    bf16_t* hn = (bf16_t*)(p.ws + WS_HN);
    for (int l = 0; l < 2; ++l) {
        const float* xp = (l == 0) ? p.in[0] : xb; const float* xs = (l == 0) ? p.in[1] : xb + (size_t)MP * D;
        float* yp = (l == 0) ? xb : p.out; float* ys = yp + (size_t)MP * D;
        const float* modl = (const float*)(p.ws + WS_MOD) + (size_t)l * NMODROW * MODW;
        for (int rep = 0; rep < NREP(0); ++rep) {
            { const int t_ = FRESH_TID(); phase_norm(p, lds, l, 1, xp, xs, TLW(t_)); }
            GB();
        }
        for (int rep = 0; rep < NREP(1); ++rep) {
            pg8::Gemm g{hn, (const bf16_t*)(p.ws + WS_WIN) + (size_t)l * NMAIN * D, M, NMAIN, D};
            pg8::StaticOrder S; S.init(MP, NMAIN, G, (int)blockIdx.x);
            EpiIn E{l, p.out, (bf16_t*)(p.ws + WS_Q), (bf16_t*)(p.ws + WS_K), (bf16_t*)(p.ws + WS_V), (float*)(p.ws + WS_U), p.in[12] + l * HD, p.in[13] + l * HD};
            pg8::gemm_phase<EpiIn, true, true>(lds, g, S, E, FRESH_TID());
            { SEpiIn SE{l, p.out, (bf16_t*)(p.ws + WS_Q), (bf16_t*)(p.ws + WS_K), (bf16_t*)(p.ws + WS_V), (float*)(p.ws + WS_U), p.in[12] + l * HD, p.in[13] + l * HD};
              const int t_ = FRESH_TID(); skinny_phase<SEpiIn>(lds, g.A, g.Bt, NMAIN, D, SE, TLW(t_)); }
            { const int t_ = FRESH_TID(); scan_items(p, lds, l, TLW(t_)); }
            if (l == 0 && rep == 0) {
                for (int ll = 0; ll < 2; ++ll) { SEpiBias SE{(float*)(p.ws + WS_BIAS2) + (size_t)ll * NMODROW * FF}; const int t_ = FRESH_TID();
                    skinny_phase<SEpiBias>(lds, (const bf16_t*)(p.ws + WS_SH2) + (size_t)ll * 32 * D, (const bf16_t*)(p.ws + WS_WUP) + (size_t)ll * FF * D, FF, D, SE, TLW(t_), 0, 2); }
            }
            GB();
        }
        for (int rep = 0; rep < NREP(3); ++rep) {
            { const int t_ = FRESH_TID(); phase_attn(p, lds, l, l * 2 + rep, rep == 0 ? 0 : ATT_DUP_MODE, TLW(t_)); }
            GB();
        }
        for (int rep = 0; rep < NREP(4); ++rep) {
            pg8::Gemm g{(const bf16_t*)(p.ws + WS_MIX), (const bf16_t*)(p.ws + WS_WOUT) + (size_t)l * D * D, M, D, D};
            pg8::StaticOrder S; S.init(MP, D, G, (int)blockIdx.x);
            EpiResN E{xp, xa, modl + 2 * D, modl + 4 * D, hn, (float*)(p.ws + WS_SS)};
            pg8::gemm_phase<EpiResN, false, true>(lds, g, S, E, FRESH_TID());
            { SEpiResN SE{xs, xa + (size_t)MP * D, modl + 2 * D, modl + 4 * D, hn, (float*)(p.ws + WS_SS)}; const int t_ = FRESH_TID(); skinny_phase<SEpiResN>(lds, g.A, g.Bt, D, D, SE, TLW(t_)); }
            GB();
        }
        for (int rep = 0; rep < NREP(6); ++rep) {
            pg8::Gemm g{hn, (const bf16_t*)(p.ws + WS_WUP) + (size_t)l * FF * D, M, FF, D};
            pg8::StaticOrder S; S.init(MP, FF, G, (int)blockIdx.x);
            const float* bias_l = (const float*)(p.ws + WS_BIAS2) + (size_t)l * NMODROW * FF;
            EpiUpN E{(bf16_t*)(p.ws + WS_HID), (const float*)(p.ws + WS_SS), bias_l};
            pg8::gemm_phase<EpiUpN, true, true>(lds, g, S, E, FRESH_TID());
            { SEpiUpN SE{(bf16_t*)(p.ws + WS_HID), (const float*)(p.ws + WS_SS), bias_l}; const int t_ = FRESH_TID(); skinny_phase<SEpiUpN>(lds, g.A, g.Bt, FF, D, SE, TLW(t_)); }
            GB();
        }
        for (int rep = 0; rep < NREP(7); ++rep) {
            pg8::Gemm g{(const bf16_t*)(p.ws + WS_HID), (const bf16_t*)(p.ws + WS_WDN) + (size_t)l * D * FF, M, D, FF};
            pg8::StaticOrder S; S.init(MP, D, G, (int)blockIdx.x);
            EpiRes E{xa, xa + (size_t)MP * D, yp, ys, modl + 5 * D};
            pg8::gemm_phase<EpiRes, false, true>(lds, g, S, E, FRESH_TID());
            { SEpiRes SE{xa + (size_t)MP * D, ys, modl + 5 * D}; const int t_ = FRESH_TID(); skinny_phase<SEpiRes>(lds, g.A, g.Bt, D, FF, SE, TLW(t_)); }
            if (l == 0 || rep + 1 < NREP(7)) GB();
        }
    }
}

extern "C" void kernel_launch(void* const* d_in, const int* in_sizes, int n_in, void* d_out, int out_size, void* d_ws, size_t ws_size, hipStream_t stream) {
    static int grid = 0;
    if (grid == 0) {
        if (n_in != 19 || (size_t)out_size != OUT_TOTAL || ws_size < WS_END) { fprintf(stderr, "kernel_launch: unexpected shapes (n_in %d out %d ws %zu)\n", n_in, out_size, ws_size); grid = -1; return; }
        int dev = 0, cus = 0, per_cu = 0;
        hipGetDevice(&dev);
        hipDeviceGetAttribute(&cus, hipDeviceAttributeMultiprocessorCount, dev);
        hipFuncSetAttribute((const void*)fwd_megakernel, hipFuncAttributeMaxDynamicSharedMemorySize, LDS_BYTES);
        hipOccupancyMaxActiveBlocksPerMultiprocessor(&per_cu, (const void*)fwd_megakernel, 512, LDS_BYTES);
        if (per_cu < 1) { fprintf(stderr, "kernel_launch: occupancy query says %d blocks per CU\n", per_cu); per_cu = 1; }
        grid = cus;
    }
    if (grid < 0) return;
    hipMemsetAsync((char*)d_ws + WS_CTL, 0, 20480, stream);
    Params p{};
    for (int i = 0; i < 19; ++i) p.in[i] = (const float*)d_in[i];
    p.out = (float*)d_out; p.ws = (unsigned char*)d_ws;
    void* args[] = {&p};
    hipError_t e = hipLaunchCooperativeKernel((const void*)fwd_megakernel, dim3(grid), dim3(512), args, LDS_BYTES, stream);
    if (e != hipSuccess) fprintf(stderr, "cooperative launch failed: %s (grid %d)\n", hipGetErrorString(e), grid);
}
```

```cpp
#include <hip/hip_runtime.h>
#include <hip/hip_cooperative_groups.h>
#include <cstdio>
#include <cstdint>
namespace cg = cooperative_groups;

#define LAS __attribute__((address_space(3)))
typedef unsigned short bf16_t;
typedef short bf16x8 __attribute__((ext_vector_type(8)));
typedef short s16x4 __attribute__((ext_vector_type(4)));
typedef float f32x4 __attribute__((ext_vector_type(4)));
typedef float f32x2 __attribute__((ext_vector_type(2)));
typedef unsigned u32x4 __attribute__((ext_vector_type(4)));
typedef unsigned u32x2 __attribute__((ext_vector_type(2)));

constexpr int D = 1024, T = 8192, NBP = 2, SB = 16, ST = 16, PAST = 4096;
constexpr int MP = NBP * T, MS = SB * ST, M = MP + MS;
constexpr int NH = 12, HD = 64, AW = 768, PW = 256, INC = 2572, NMAIN = 2560, FF = 4096;
constexpr int NMODROW = 18, MODW = 6 * D;
constexpr float EPS = 1e-6f;
constexpr float LOG2E = 1.4426950408889634f;
constexpr float C2 = 0.125f * LOG2E;
constexpr int SKEYS = PAST + ST;

constexpr size_t OFF_Y = 0;
constexpr size_t OFF_KP = (size_t)M * D;
constexpr size_t OFF_VP = OFF_KP + (size_t)2 * MP * AW;
constexpr size_t OFF_FP = OFF_VP + (size_t)2 * MP * AW;
constexpr size_t OFF_PP = OFF_FP + (size_t)2 * MP * NH;
constexpr size_t OFF_KS = OFF_PP + (size_t)2 * NBP * 15 * PW;
constexpr size_t OFF_VS = OFF_KS + (size_t)2 * MS * AW;
constexpr size_t OFF_FS = OFF_VS + (size_t)2 * MS * AW;
constexpr size_t OFF_PS = OFF_FS + (size_t)2 * MS * NH;
constexpr size_t OUT_TOTAL = OFF_PS + (size_t)2 * SB * 15 * PW;

constexpr size_t MiB = 1u << 20;
constexpr size_t WS_CTL = 0;
constexpr size_t WS_MOD = 1 * MiB;
constexpr size_t WS_WIN = 2 * MiB;
constexpr size_t WS_WOUT = 12 * MiB;
constexpr size_t WS_WUP = 16 * MiB;
constexpr size_t WS_WDN = 32 * MiB;
constexpr size_t WS_HN = 48 * MiB;
constexpr size_t WS_Q = 82 * MiB;
constexpr size_t WS_K = 108 * MiB;
constexpr size_t WS_V = 134 * MiB;
constexpr size_t WS_U = 160 * MiB;
constexpr size_t WS_MIX = 178 * MiB;
constexpr size_t WS_FP = 212 * MiB;
constexpr size_t WS_FS = 213 * MiB;
constexpr size_t WS_SS = 217 * MiB;
constexpr size_t WS_BIAS2 = WS_SS + 128 * 1024;
constexpr size_t WS_SH2 = WS_BIAS2 + 640 * 1024;
constexpr size_t WS_XA = 218 * MiB;
constexpr size_t WS_XB = 284 * MiB;
constexpr size_t WS_HID = 350 * MiB;
constexpr size_t WS_END = 482 * MiB;

constexpr int LDS_BYTES = 147456;
#ifndef DUP
#define DUP 0
#endif
#define NREP(k) (1 + ((DUP >> (k)) & 1))
#ifndef ATT_DUP_MODE
#define ATT_DUP_MODE 0
#endif

__device__ __forceinline__ unsigned f2bf(float f) { unsigned u = __builtin_bit_cast(unsigned, f); return (u + 0x7fffu + ((u >> 16) & 1u)) >> 16; }
typedef __bf16 bf16x2_t __attribute__((ext_vector_type(2)));
__device__ __forceinline__ unsigned pk2(float lo, float hi) { const f32x2 v = {lo, hi}; const bf16x2_t b = __builtin_convertvector(v, bf16x2_t); return __builtin_bit_cast(unsigned, b); }
template <int CTRL> __device__ __forceinline__ float dpp_f(float v) { return __builtin_bit_cast(float, __builtin_amdgcn_update_dpp(0, __builtin_bit_cast(int, v), CTRL, 0xF, 0xF, false)); }
__device__ __forceinline__ float quad_sum(float v) {
    auto a = __builtin_amdgcn_permlane16_swap(__float_as_uint(v), __float_as_uint(v), false, false);
    const float s = __uint_as_float(a[0]) + __uint_as_float(a[1]);
    auto b = __builtin_amdgcn_permlane32_swap(__float_as_uint(s), __float_as_uint(s), false, false);
    return __uint_as_float(b[0]) + __uint_as_float(b[1]);
}
__device__ __forceinline__ float wave_sum(float v) {
    v += dpp_f<0x128>(v); v += dpp_f<0x124>(v); v += dpp_f<0x122>(v); v += dpp_f<0x121>(v);
    return quad_sum(v);
}

__device__ __forceinline__ int vzero() { int z = 0; asm volatile("" : "+v"(z)); return z; }
__device__ __forceinline__ int fresh_tid() { int t = threadIdx.x; asm volatile("" : "+v"(t)); return t; }
namespace pg8 {
constexpr int BM = 256, BK = 64, HALF = 128, HTB = HALF * BK * 2, NXCD = 8, WGM = 8;
__host__ __device__ __forceinline__ int lds_byte(int r, int c) { const int st = (r >> 4) * 2 + (c >> 5), rr = r & 15, cc = c & 31, ob = rr * 64 + cc * 2; return st * 1024 + (ob ^ (((ob >> 9) & 1) << 5)); }
__host__ __device__ __forceinline__ void stage_rc(int b, int& R, int& C) { const int st = b / 1024, sb = b % 1024, swz = sb ^ (((sb >> 9) & 1) << 5); R = (st >> 1) * 16 + swz / 64; C = (st & 1) * 32 + (swz % 64) / 2; }
__host__ __device__ __forceinline__ int perm32(int rho) { const int n = rho >> 4, i = rho & 15; return 8 * (i >> 2) + 4 * n + (i & 3); }

struct Unit { int pm, pn; };
struct Gemm { const bf16_t* A; const bf16_t* Bt; int M, N, K; };

struct StaticOrder {
    int nM, nN, nwg, G, c;
    __device__ void init(int M_, int N_, int G_, int c_) { nM = M_ / BM; nN = N_ / BM; nwg = nM * nN; G = G_; c = c_; }
    __device__ bool next(int i, Unit& u) const {
        const long L = (long)i * G + c; if (L >= nwg) return false;
        int wgid = (int)L; { const int q = nwg / NXCD, r = nwg % NXCD, xcd = wgid % NXCD, off = wgid / NXCD; wgid = (xcd < r ? xcd * (q + 1) : r * (q + 1) + (xcd - r) * q) + off; }
        const int nig = WGM * nN, gid = wgid / nig, fm = gid * WGM, gsz = (nM - fm) < WGM ? (nM - fm) : WGM;
        u.pm = fm + ((wgid % nig) % gsz); u.pn = (wgid % nig) / gsz; return true;
    }
};

template <class Epi, bool ALIGN_EPI, bool SP2>
__device__ __forceinline__ void gemm_phase(LAS unsigned char* lds, const Gemm g, const StaticOrder& S, const Epi& E, const int tid) {
    const int wid = __builtin_amdgcn_readfirstlane(tid >> 6), lane = tid & 63, wr = wid >> 2, wc = wid & 3, fr = lane & 15, fq = lane >> 4;
    const int K = g.K, nt = K / BK;
    unsigned voffA[2], voffB[2];
#pragma unroll
    for (int i = 0; i < 2; ++i) { int R, C; stage_rc(tid * 16 + i * 8192, R, C); const int Rb = 64 * (R >> 5) + perm32(R & 31);
        voffA[i] = (unsigned)(R * K + C) * 2u; voffB[i] = (unsigned)(Rb * K + C) * 2u; }
    const size_t kstep = (size_t)(BK * 2);
    const size_t hstep = (size_t)HALF * K * 2;
    const size_t hstepB = (size_t)32 * K * 2;
    const size_t tstep = 2 * hstep;
    const unsigned ldsw = (unsigned)wid * 1024u;
    const int aoff = lds_byte(wr * 64 + fr, fq * 8), boff = lds_byte(wc * 32 + fr, fq * 8);
#define PG8_SA(b, h) (((b) * 2 + (h)) * HTB)
#define PG8_SB(b, h) ((4 + (b) * 2 + (h)) * HTB)
#define PG8_STAGE(bufoff, gbase, voff) do { _Pragma("unroll") for (int _i = 0; _i < 2; ++_i) \
        __builtin_amdgcn_global_load_lds((const unsigned*)((const char*)(gbase) + (voff)[_i]), (LAS unsigned*)(lds + (bufoff) + ldsw + _i * 8192), 16, 0, 0); } while (0)
#define PG8_LDA(dst, b, h) do { _Pragma("unroll") for (int m = 0; m < 4; ++m) _Pragma("unroll") for (int k = 0; k < 2; ++k) dst[m][k] = *(const LAS bf16x8*)(lds + PG8_SA(b, h) + aoff + m * 2048 + k * 1024); } while (0)
#define PG8_LDB(dst, b, h) do { _Pragma("unroll") for (int n = 0; n < 2; ++n) _Pragma("unroll") for (int k = 0; k < 2; ++k) dst[n][k] = *(const LAS bf16x8*)(lds + PG8_SB(b, h) + boff + n * 2048 + k * 1024); } while (0)
#define PG8_MMA(ai, bj, At, Bt) do { __builtin_amdgcn_s_setprio(1); _Pragma("unroll") for (int m = 0; m < 4; ++m) _Pragma("unroll") for (int n = 0; n < 2; ++n) _Pragma("unroll") for (int k = 0; k < 2; ++k) \
        acc[ai][bj][m][n] = __builtin_amdgcn_mfma_f32_16x16x32_bf16(Bt[n][k], At[m][k], acc[ai][bj][m][n], 0, 0, 0); __builtin_amdgcn_s_setprio(0); } while (0)
#define PG8_WAIT_V(n) asm volatile("s_waitcnt vmcnt(" #n ")" ::: "memory")
#define PG8_WAIT_L(n) asm volatile("s_waitcnt lgkmcnt(" #n ")" ::: "memory")
#define PG8_BAR __builtin_amdgcn_s_barrier()
#define PG8_SCHED __builtin_amdgcn_sched_barrier(0)
    Unit cur, nxt; int ui = 0;
    if (!S.next(0, cur)) return;
    f32x4 acc[2][2][4][2];
#pragma unroll
    for (int a = 0; a < 2; ++a)
#pragma unroll
        for (int b = 0; b < 2; ++b)
#pragma unroll
            for (int m = 0; m < 4; ++m)
#pragma unroll
                for (int n = 0; n < 2; ++n) acc[a][b][m][n] = (f32x4){0.f, 0.f, 0.f, 0.f};
    bf16x8 At[4][2], B0[2][2], B1[2][2];
    const char* cA = (const char*)g.A + (size_t)cur.pm * tstep; const char* cB = (const char*)g.Bt + (size_t)cur.pn * tstep;
    if constexpr (SP2) {
        PG8_STAGE(PG8_SB(0, 0), cB, voffB); PG8_STAGE(PG8_SB(0, 1), cB + hstepB, voffB); PG8_STAGE(PG8_SA(0, 0), cA, voffA); PG8_STAGE(PG8_SA(0, 1), cA + hstep, voffA);
        if (wr == 1) PG8_BAR;
        PG8_WAIT_V(2); PG8_BAR;
        PG8_STAGE(PG8_SB(1, 0), cB + kstep, voffB); PG8_STAGE(PG8_SA(1, 0), cA + kstep, voffA); PG8_STAGE(PG8_SB(1, 1), cB + hstepB + kstep, voffB);
        PG8_WAIT_V(6); PG8_BAR;
    } else {
    PG8_STAGE(PG8_SB(0, 0), cB, voffB); PG8_STAGE(PG8_SA(0, 0), cA, voffA); PG8_STAGE(PG8_SB(0, 1), cB + hstepB, voffB); PG8_STAGE(PG8_SA(0, 1), cA + hstep, voffA);
    if (wr == 1) PG8_BAR;
    PG8_WAIT_V(4); PG8_BAR;
    PG8_STAGE(PG8_SB(1, 0), cB + kstep, voffB); PG8_STAGE(PG8_SA(1, 0), cA + kstep, voffA); PG8_STAGE(PG8_SB(1, 1), cB + hstepB + kstep, voffB);
    PG8_WAIT_V(6); PG8_BAR;
    }
    for (;;) {
        const bool has_next = S.next(ui + 1, nxt);
        const char* nA = has_next ? (const char*)g.A + (size_t)nxt.pm * tstep : cA; const char* nB = has_next ? (const char*)g.Bt + (size_t)nxt.pn * tstep : cB;
        for (int t = 0; t < nt; t += 2) {
            const bool last = (t == nt - 2);
            const char* a1 = cA + (size_t)(t + 1) * kstep;
            const char* a2 = last ? nA : cA + (size_t)(t + 2) * kstep; const char* b2 = last ? nB : cB + (size_t)(t + 2) * kstep;
            const char* a3 = a2 + kstep; const char* b3 = b2 + kstep;
            if constexpr (SP2) {
            PG8_LDB(B0, 0, 0); PG8_LDB(B1, 0, 1); PG8_SCHED; PG8_LDA(At, 0, 0); PG8_STAGE(PG8_SA(1, 1), a1 + hstep, voffA);
            PG8_WAIT_V(8); PG8_WAIT_L(0); PG8_BAR; PG8_MMA(0, 0, At, B0); PG8_MMA(0, 1, At, B1); PG8_BAR; PG8_SCHED;
            PG8_LDA(At, 0, 1); PG8_STAGE(PG8_SB(0, 0), b2, voffB); PG8_STAGE(PG8_SB(0, 1), b2 + hstepB, voffB); PG8_STAGE(PG8_SA(0, 0), a2, voffA);
            PG8_WAIT_V(8); PG8_WAIT_L(0); PG8_BAR; PG8_MMA(1, 0, At, B0); PG8_MMA(1, 1, At, B1); PG8_BAR; PG8_SCHED;
            PG8_LDB(B0, 1, 0); PG8_LDB(B1, 1, 1); PG8_SCHED; PG8_LDA(At, 1, 0); PG8_STAGE(PG8_SA(0, 1), a2 + hstep, voffA);
            PG8_WAIT_V(8); PG8_WAIT_L(0); PG8_BAR; PG8_MMA(0, 0, At, B0); PG8_MMA(0, 1, At, B1); PG8_BAR; PG8_SCHED;
            PG8_LDA(At, 1, 1); PG8_STAGE(PG8_SB(1, 0), b3, voffB); PG8_STAGE(PG8_SB(1, 1), b3 + hstepB, voffB); PG8_STAGE(PG8_SA(1, 0), a3, voffA);
            PG8_WAIT_V(8); PG8_WAIT_L(0); PG8_BAR; PG8_MMA(1, 0, At, B0); PG8_MMA(1, 1, At, B1); PG8_BAR; PG8_SCHED;
            } else {
            PG8_LDB(B0, 0, 0); PG8_SCHED; PG8_LDA(At, 0, 0); PG8_STAGE(PG8_SA(1, 1), a1 + hstep, voffA);
            PG8_WAIT_L(8); PG8_BAR; PG8_WAIT_L(0); PG8_MMA(0, 0, At, B0); PG8_BAR; PG8_SCHED;
            PG8_LDB(B1, 0, 1); PG8_STAGE(PG8_SB(0, 0), b2, voffB);
            PG8_BAR; PG8_WAIT_L(0); PG8_MMA(0, 1, At, B1); PG8_BAR;
            PG8_LDA(At, 0, 1); PG8_STAGE(PG8_SA(0, 0), a2, voffA);
            PG8_BAR; PG8_WAIT_L(0); PG8_MMA(1, 0, At, B0); PG8_BAR; PG8_SCHED;
            PG8_STAGE(PG8_SB(0, 1), b2 + hstepB, voffB);
            PG8_WAIT_V(6); PG8_BAR; PG8_MMA(1, 1, At, B1); PG8_BAR;
            PG8_LDB(B0, 1, 0); PG8_SCHED; PG8_LDA(At, 1, 0); PG8_STAGE(PG8_SA(0, 1), a2 + hstep, voffA);
            PG8_WAIT_L(8); PG8_BAR; PG8_WAIT_L(0); PG8_MMA(0, 0, At, B0); PG8_BAR; PG8_SCHED;
            PG8_LDB(B1, 1, 1); PG8_STAGE(PG8_SB(1, 0), b3, voffB);
            PG8_BAR; PG8_WAIT_L(0); PG8_MMA(0, 1, At, B1); PG8_BAR;
            PG8_LDA(At, 1, 1); PG8_STAGE(PG8_SA(1, 0), a3, voffA);
            PG8_BAR; PG8_WAIT_L(0); PG8_MMA(1, 0, At, B0); PG8_BAR; PG8_SCHED;
            PG8_STAGE(PG8_SB(1, 1), b3 + hstepB, voffB);
            PG8_WAIT_V(6); PG8_BAR; PG8_MMA(1, 1, At, B1); PG8_BAR;
            }
        }
        if constexpr (ALIGN_EPI) { if (wr == 0) PG8_BAR; }
        E(acc, cur, wr, wc, fr, fq);
        if (!has_next) break;
#pragma unroll
        for (int a = 0; a < 2; ++a)
#pragma unroll
            for (int b = 0; b < 2; ++b)
#pragma unroll
                for (int m = 0; m < 4; ++m)
#pragma unroll
                    for (int n = 0; n < 2; ++n) acc[a][b][m][n] = (f32x4){0.f, 0.f, 0.f, 0.f};
        cur = nxt; cA = nA; cB = nB; ++ui;
        if constexpr (ALIGN_EPI) { if (wr == 1) PG8_BAR; }
    }
    PG8_WAIT_V(0);
    if constexpr (!ALIGN_EPI) { if (wr == 0) PG8_BAR; }
    PG8_BAR;
#undef PG8_SA
#undef PG8_SB
#undef PG8_STAGE
#undef PG8_LDA
#undef PG8_LDB
#undef PG8_MMA
#undef PG8_WAIT_V
#undef PG8_WAIT_L
#undef PG8_BAR
#undef PG8_SCHED
}
}

__device__ __forceinline__ void st_bf16x8(bf16_t* p, f32x4 a, f32x4 b) {
    u32x4 w; w.x = pk2(a[0], a[1]); w.y = pk2(a[2], a[3]); w.z = pk2(b[0], b[1]); w.w = pk2(b[2], b[3]);
    *(u32x4*)p = w;
}
__device__ __forceinline__ int brow_of(int r) { return r < MP ? (r >> 13) : 2 + ((r - MP) >> 4); }

struct EpiIn {
    int l; float* out; bf16_t* qb; bf16_t* kb; bf16_t* vb; float* ub; const float* qg; const float* kg;
    __device__ __forceinline__ void operator()(const f32x4 (&acc)[2][2][4][2], const pg8::Unit& u, int wr, int wc, int fr, int fq) const {
        const int pn = u.pn, rbase = u.pm * 256 + wr * 64 + fr;
        if (pn == 0) {
            const int cb = 64 * wc + 8 * fq;
#pragma unroll
            for (int ai = 0; ai < 2; ++ai)
#pragma unroll
                for (int m = 0; m < 4; ++m) {
                    const int r = rbase + ai * 128 + m * 16;
                    float* up = ub + (size_t)r * PW + cb;
                    float* sp = nullptr;
                    if (r < MP) { const int t = r & (T - 1); if (t >= T - 15) sp = out + OFF_PP + ((size_t)((l * NBP + (r >> 13)) * 15 + (t - (T - 15)))) * PW + cb; }
                    else { const int rr = r - MP, t = rr & 15; if (t >= 1) sp = out + OFF_PS + ((size_t)((l * SB + (rr >> 4)) * 15 + (t - 1))) * PW + cb; }
#pragma unroll
                    for (int bj = 0; bj < 2; ++bj) {
                        *(f32x4*)(up + 32 * bj) = acc[ai][bj][m][0]; *(f32x4*)(up + 32 * bj + 4) = acc[ai][bj][m][1];
                        if (sp) { *(f32x4*)(sp + 32 * bj) = acc[ai][bj][m][0]; *(f32x4*)(sp + 32 * bj + 4) = acc[ai][bj][m][1]; }
                    }
                }
        } else if (pn <= 6) {
            const bool isq = pn <= 3;
            const int head = ((pn - 1) % 3) * 4 + wc;
            const float* gp = (isq ? qg : kg) + 8 * fq;
            f32x4 gv[2][2];
#pragma unroll
            for (int bj = 0; bj < 2; ++bj)
#pragma unroll
                for (int n = 0; n < 2; ++n) gv[bj][n] = *(const f32x4*)(gp + 32 * bj + 4 * n);
            bf16_t* dst = isq ? qb : kb;
#pragma unroll
            for (int ai = 0; ai < 2; ++ai)
#pragma unroll
                for (int m = 0; m < 4; ++m) {
                    const int r = rbase + ai * 128 + m * 16;
                    float ss = 0.f;
#pragma unroll
                    for (int bj = 0; bj < 2; ++bj)
#pragma unroll
                        for (int n = 0; n < 2; ++n) { const f32x4 a = acc[ai][bj][m][n]; ss += (a[0] * a[0] + a[1] * a[1]) + (a[2] * a[2] + a[3] * a[3]); }
                    ss = quad_sum(ss);
                    float rinv = 1.0f / sqrtf(ss * (1.f / 64.f) + EPS);
                    const float rq = isq ? rinv * C2 : rinv;
                    float* ko = nullptr;
                    if (!isq) ko = out + (r < MP ? OFF_KP + ((size_t)l * MP + r) * AW : OFF_KS + ((size_t)l * MS + (r - MP)) * AW) + head * 64 + 8 * fq;
#pragma unroll
                    for (int bj = 0; bj < 2; ++bj) {
                        const f32x4 n0 = acc[ai][bj][m][0] * rinv * gv[bj][0], n1 = acc[ai][bj][m][1] * rinv * gv[bj][1];
                        if (isq) { const f32x4 s0 = acc[ai][bj][m][0] * rq * gv[bj][0], s1 = acc[ai][bj][m][1] * rq * gv[bj][1];
                            st_bf16x8(dst + (size_t)r * AW + head * 64 + 32 * bj + 8 * fq, s0, s1); }
                        else { st_bf16x8(dst + (size_t)r * AW + head * 64 + 32 * bj + 8 * fq, n0, n1);
                            *(f32x4*)(ko + 32 * bj) = n0; *(f32x4*)(ko + 32 * bj + 4) = n1; }
                    }
                }
        } else {
            const int head = (pn - 7) * 4 + wc;
#pragma unroll
            for (int ai = 0; ai < 2; ++ai)
#pragma unroll
                for (int m = 0; m < 4; ++m) {
                    const int r = rbase + ai * 128 + m * 16;
                    float* vo = out + (r < MP ? OFF_VP + ((size_t)l * MP + r) * AW : OFF_VS + ((size_t)l * MS + (r - MP)) * AW) + head * 64 + 8 * fq;
#pragma unroll
                    for (int bj = 0; bj < 2; ++bj) {
                        st_bf16x8(vb + (size_t)r * AW + head * 64 + 32 * bj + 8 * fq, acc[ai][bj][m][0], acc[ai][bj][m][1]);
                        *(f32x4*)(vo + 32 * bj) = acc[ai][bj][m][0]; *(f32x4*)(vo + 32 * bj + 4) = acc[ai][bj][m][1];
                    }
                }
        }
    }
};

struct EpiRes {
    const float* xip; const float* xis; float* xop; float* xos; const float* gate;
    __device__ __forceinline__ void operator()(const f32x4 (&acc)[2][2][4][2], const pg8::Unit& u, int wr, int wc, int fr, int fq) const {
        const int rbase = u.pm * 256 + wr * 64 + fr, cb = u.pn * 256 + 64 * wc + 8 * fq;
        const float* gp = gate + (size_t)((u.pm * 256) >> 13) * MODW + cb;
        constexpr int DEPTH = 3;
        f32x4 gg[2][2], xq[DEPTH][2][2];
#pragma unroll
        for (int bj = 0; bj < 2; ++bj)
#pragma unroll
            for (int n = 0; n < 2; ++n) gg[bj][n] = *(const f32x4*)(gp + 32 * bj + 4 * n);
#pragma unroll
        for (int d = 0; d < DEPTH; ++d) { const int r2 = rbase + (d >> 2) * 128 + (d & 3) * 16;
#pragma unroll
            for (int bj = 0; bj < 2; ++bj)
#pragma unroll
                for (int n = 0; n < 2; ++n) xq[d][bj][n] = *(const f32x4*)(xip + (size_t)r2 * D + cb + 32 * bj + 4 * n); }
#pragma unroll
        for (int it = 0; it < 8; ++it) {
            const int ai = it >> 2, m = it & 3, r = rbase + ai * 128 + m * 16;
            f32x4 xc[2][2];
#pragma unroll
            for (int bj = 0; bj < 2; ++bj)
#pragma unroll
                for (int n = 0; n < 2; ++n) xc[bj][n] = xq[it % DEPTH][bj][n];
            if (it + DEPTH < 8) { const int r2 = rbase + ((it + DEPTH) >> 2) * 128 + ((it + DEPTH) & 3) * 16;
#pragma unroll
                for (int bj = 0; bj < 2; ++bj)
#pragma unroll
                    for (int n = 0; n < 2; ++n) xq[it % DEPTH][bj][n] = *(const f32x4*)(xip + (size_t)r2 * D + cb + 32 * bj + 4 * n); }
            float* xo = xop + (size_t)r * D + cb;
#pragma unroll
            for (int bj = 0; bj < 2; ++bj)
#pragma unroll
                for (int n = 0; n < 2; ++n) *(f32x4*)(xo + 32 * bj + 4 * n) = xc[bj][n] + gg[bj][n] * acc[ai][bj][m][n];
            __builtin_amdgcn_sched_barrier(0);
        }
    }
};

struct EpiUp {
    bf16_t* hid;
    __device__ __forceinline__ void operator()(const f32x4 (&acc)[2][2][4][2], const pg8::Unit& u, int wr, int wc, int fr, int fq) const {
        const int rbase = u.pm * 256 + wr * 64 + fr, cb = u.pn * 256 + 64 * wc + 8 * fq;
#pragma unroll
        for (int ai = 0; ai < 2; ++ai)
#pragma unroll
            for (int m = 0; m < 4; ++m) {
                const int r = rbase + ai * 128 + m * 16;
#pragma unroll
                for (int bj = 0; bj < 2; ++bj) {
                    f32x4 a = acc[ai][bj][m][0], b = acc[ai][bj][m][1];
#pragma unroll
                    for (int j = 0; j < 4; ++j) { const float x = fmaxf(a[j], 0.f), y = fmaxf(b[j], 0.f); a[j] = x * x; b[j] = y * y; }
                    st_bf16x8(hid + (size_t)r * FF + cb + 32 * bj, a, b);
                }
            }
    }
};

template <class SEpi>
__device__ __forceinline__ void skinny_phase(LAS unsigned char* lds, const bf16_t* A, const bf16_t* Bt, int N, int K, const SEpi& E, int tid, int lane, int wave, int row0 = MP, int nrg = 16) {
    const int l16 = lane & 15, quad = lane >> 4;
    const int nr2 = nrg >> 1, nitems = nr2 * (N / 64);
    LAS float* red = (LAS float*)lds;
    const int kw = K / 8;
    const int G_ = (int)gridDim.x, b_ = (int)blockIdx.x;
    const int vb = (G_ % 8 == 0 && nr2 == 8 && nitems <= 2 * G_ && nitems != 320) ? (b_ % 8) * (G_ / 8) + b_ / 8 : G_ - 1 - b_;
    for (int it = vb; it < nitems; it += G_) {
        const int rg2 = it % nr2, cg = it / nr2;
        const bf16_t* ap = A + (size_t)(row0 + 32 * rg2 + l16) * K + wave * kw + quad * 8;
        const bf16_t* bp = Bt + (size_t)(cg * 64 + l16) * K + wave * kw + quad * 8;
        f32x4 acc[2][4];
#pragma unroll
        for (int h = 0; h < 2; ++h)
#pragma unroll
            for (int nt = 0; nt < 4; ++nt) acc[h][nt] = (f32x4){0.f, 0.f, 0.f, 0.f};
        for (int k0 = 0; k0 < kw; k0 += 128) {
            bf16x8 a0[4], a1[4], b[4][4];
#pragma unroll
            for (int s = 0; s < 4; ++s) {
                a0[s] = *(const bf16x8*)(ap + k0 + 32 * s); a1[s] = *(const bf16x8*)(ap + (size_t)16 * K + k0 + 32 * s);
#pragma unroll
                for (int nt = 0; nt < 4; ++nt) b[s][nt] = *(const bf16x8*)(bp + (size_t)nt * 16 * K + k0 + 32 * s);
            }
#pragma unroll
            for (int s = 0; s < 4; ++s)
#pragma unroll
                for (int nt = 0; nt < 4; ++nt) { acc[0][nt] = __builtin_amdgcn_mfma_f32_16x16x32_bf16(a0[s], b[s][nt], acc[0][nt], 0, 0, 0);
                    acc[1][nt] = __builtin_amdgcn_mfma_f32_16x16x32_bf16(a1[s], b[s][nt], acc[1][nt], 0, 0, 0); }
        }
#pragma unroll
        for (int h = 0; h < 2; ++h)
#pragma unroll
            for (int nt = 0; nt < 4; ++nt)
#pragma unroll
                for (int r = 0; r < 4; ++r) red[(wave * 32 + 16 * h + quad * 4 + r) * 64 + 16 * nt + l16] = acc[h][nt][r];
        __syncthreads();
        const int row = tid >> 5, c2 = (tid & 31) * 2;
#pragma unroll
        for (int h = 0; h < 2; ++h) {
            float v0 = 0.f, v1 = 0.f;
#pragma unroll
            for (int w = 0; w < 8; ++w) { const f32x2 t = *(const LAS f32x2*)(red + (w * 32 + 16 * h + row) * 64 + c2); v0 += t.x; v1 += t.y; }
            E(2 * rg2 + h, row, cg, c2, v0, v1);
        }
        __syncthreads();
    }
}

struct SEpiIn {
    int l; float* out; bf16_t* qb; bf16_t* kb; bf16_t* vb; float* ub; const float* qg; const float* kg;
    __device__ __forceinline__ void operator()(int b, int t, int cg, int c2, float v0, float v1) const {
        const int rr = 16 * b + t; const size_t r = (size_t)MP + rr;
        if (cg < 4) {
            const int c = cg * 64 + c2;
            *(f32x2*)(ub + r * PW + c) = (f32x2){v0, v1};
            if (t >= 1) *(f32x2*)(out + OFF_PS + ((size_t)((l * SB + b) * 15 + (t - 1))) * PW + c) = (f32x2){v0, v1};
        } else if (cg < 28) {
            const bool isq = cg < 16; const int head = isq ? cg - 4 : cg - 16;
            float ss = v0 * v0 + v1 * v1;
#pragma unroll
            for (int o = 1; o < 32; o <<= 1) ss += __shfl_xor(ss, o);
            const float rinv = 1.0f / sqrtf(ss * (1.f / 64.f) + EPS);
            const float* gp = (isq ? qg : kg) + c2;
            const float n0 = v0 * rinv * gp[0], n1 = v1 * rinv * gp[1];
            if (isq) *(unsigned*)(qb + r * AW + head * 64 + c2) = pk2(n0 * C2, n1 * C2);
            else { *(unsigned*)(kb + r * AW + head * 64 + c2) = pk2(n0, n1); *(f32x2*)(out + OFF_KS + ((size_t)l * MS + rr) * AW + head * 64 + c2) = (f32x2){n0, n1}; }
        } else {
            const int head = cg - 28;
            *(unsigned*)(vb + r * AW + head * 64 + c2) = pk2(v0, v1);
            *(f32x2*)(out + OFF_VS + ((size_t)l * MS + rr) * AW + head * 64 + c2) = (f32x2){v0, v1};
        }
    }
};
struct SEpiRes {
    const float* xis; float* xos; const float* gate;
    __device__ __forceinline__ void operator()(int b, int t, int cg, int c2, float v0, float v1) const {
        const size_t o = (size_t)(16 * b + t) * D + cg * 64 + c2;
        const f32x2 xv = *(const f32x2*)(xis + o), gg = *(const f32x2*)(gate + (size_t)(2 + b) * MODW + cg * 64 + c2);
        *(f32x2*)(xos + o) = (f32x2){xv.x + gg.x * v0, xv.y + gg.y * v1};
    }
};
struct SEpiUp {
    bf16_t* hid;
    __device__ __forceinline__ void operator()(int b, int t, int cg, int c2, float v0, float v1) const {
        const float x = fmaxf(v0, 0.f), y = fmaxf(v1, 0.f);
        *(unsigned*)(hid + ((size_t)MP + 16 * b + t) * FF + cg * 64 + c2) = pk2(x * x, y * y);
    }
};


struct EpiResN {
    const float* xip; float* xop; const float* gate; const float* sc2; bf16_t* xt; float* ss;
    __device__ __forceinline__ void operator()(const f32x4 (&acc)[2][2][4][2], const pg8::Unit& u, int wr, int wc, int fr, int fq) const {
        const int rbase = u.pm * 256 + wr * 64 + fr, cb = u.pn * 256 + 64 * wc + 8 * fq;
        const int brow = (u.pm * 256) >> 13;
        const float* gp = gate + (size_t)brow * MODW + cb; const float* sp = sc2 + (size_t)brow * MODW + cb;
        constexpr int DEPTH = 2;
        f32x4 gg[2][2], sv[2][2], xq[DEPTH][2][2];
#pragma unroll
        for (int bj = 0; bj < 2; ++bj)
#pragma unroll
            for (int n = 0; n < 2; ++n) { gg[bj][n] = *(const f32x4*)(gp + 32 * bj + 4 * n); sv[bj][n] = *(const f32x4*)(sp + 32 * bj + 4 * n) + 1.0f; }
#pragma unroll
        for (int d = 0; d < DEPTH; ++d) { const int r2 = rbase + (d >> 2) * 128 + (d & 3) * 16;
#pragma unroll
            for (int bj = 0; bj < 2; ++bj)
#pragma unroll
                for (int n = 0; n < 2; ++n) xq[d][bj][n] = *(const f32x4*)(xip + (size_t)r2 * D + cb + 32 * bj + 4 * n); }
#pragma unroll
        for (int it = 0; it < 8; ++it) {
            const int ai = it >> 2, m = it & 3, r = rbase + ai * 128 + m * 16;
            f32x4 xc[2][2];
#pragma unroll
            for (int bj = 0; bj < 2; ++bj)
#pragma unroll
                for (int n = 0; n < 2; ++n) xc[bj][n] = xq[it % DEPTH][bj][n];
            if (it + DEPTH < 8) { const int r2 = rbase + ((it + DEPTH) >> 2) * 128 + ((it + DEPTH) & 3) * 16;
#pragma unroll
                for (int bj = 0; bj < 2; ++bj)
#pragma unroll
                    for (int n = 0; n < 2; ++n) xq[it % DEPTH][bj][n] = *(const f32x4*)(xip + (size_t)r2 * D + cb + 32 * bj + 4 * n); }
            float* xo = xop + (size_t)r * D + cb;
            float s = 0.f;
#pragma unroll
            for (int bj = 0; bj < 2; ++bj) {
                f32x4 t[2];
#pragma unroll
                for (int n = 0; n < 2; ++n) {
                    const f32x4 x1 = xc[bj][n] + gg[bj][n] * acc[ai][bj][m][n];
                    *(f32x4*)(xo + 32 * bj + 4 * n) = x1;
                    s += (x1[0] * x1[0] + x1[1] * x1[1]) + (x1[2] * x1[2] + x1[3] * x1[3]);
                    t[n] = x1 * sv[bj][n];
                }
                st_bf16x8(xt + (size_t)r * D + cb + 32 * bj, t[0], t[1]);
            }
            s = quad_sum(s);
            if (fq == 0) atomicAdd(ss + r, s);
            __builtin_amdgcn_sched_barrier(0);
        }
    }
};
struct SEpiResN {
    const float* xis; float* xos; const float* gate; const float* sc2; bf16_t* xt; float* ss;
    __device__ __forceinline__ void operator()(int b, int t, int cg, int c2, float v0, float v1) const {
        const int rr = 16 * b + t; const size_t o = (size_t)rr * D + cg * 64 + c2;
        const f32x2 xv = *(const f32x2*)(xis + o), gg = *(const f32x2*)(gate + (size_t)(2 + b) * MODW + cg * 64 + c2), sv = *(const f32x2*)(sc2 + (size_t)(2 + b) * MODW + cg * 64 + c2);
        const float a0 = xv.x + gg.x * v0, a1 = xv.y + gg.y * v1;
        *(f32x2*)(xos + o) = (f32x2){a0, a1};
        *(unsigned*)(xt + ((size_t)MP + rr) * D + cg * 64 + c2) = pk2(a0 * (sv.x + 1.0f), a1 * (sv.y + 1.0f));
        float s = a0 * a0 + a1 * a1;
#pragma unroll
        for (int q = 1; q < 32; q <<= 1) s += __shfl_xor(s, q);
        if ((c2 >> 1) == 0) atomicAdd(ss + MP + rr, s);
    }
};
struct EpiUpN {
    bf16_t* hid; const float* ss; const float* bias;
    __device__ __forceinline__ void operator()(const f32x4 (&acc)[2][2][4][2], const pg8::Unit& u, int wr, int wc, int fr, int fq) const {
        const int rbase = u.pm * 256 + wr * 64 + fr, cb = u.pn * 256 + 64 * wc + 8 * fq;
        const float* bp = bias + (size_t)((u.pm * 256) >> 13) * FF + cb;
        f32x4 bv[2][2];
#pragma unroll
        for (int bj = 0; bj < 2; ++bj)
#pragma unroll
            for (int n = 0; n < 2; ++n) bv[bj][n] = *(const f32x4*)(bp + 32 * bj + 4 * n);
#pragma unroll
        for (int ai = 0; ai < 2; ++ai)
#pragma unroll
            for (int m = 0; m < 4; ++m) {
                const int r = rbase + ai * 128 + m * 16;
                const float rinv = 1.0f / sqrtf(ss[r] * (1.f / D) + EPS);
#pragma unroll
                for (int bj = 0; bj < 2; ++bj) {
                    f32x4 a = acc[ai][bj][m][0] * rinv + bv[bj][0], b = acc[ai][bj][m][1] * rinv + bv[bj][1];
#pragma unroll
                    for (int j = 0; j < 4; ++j) { const float x = fmaxf(a[j], 0.f), y = fmaxf(b[j], 0.f); a[j] = x * x; b[j] = y * y; }
                    st_bf16x8(hid + (size_t)r * FF + cb + 32 * bj, a, b);
                }
            }
    }
};
struct SEpiUpN {
    bf16_t* hid; const float* ss; const float* bias;
    __device__ __forceinline__ void operator()(int b, int t, int cg, int c2, float v0, float v1) const {
        const int r = MP + 16 * b + t;
        const float rinv = 1.0f / sqrtf(ss[r] * (1.f / D) + EPS);
        const f32x2 bb = *(const f32x2*)(bias + (size_t)(2 + b) * FF + cg * 64 + c2);
        const float x = fmaxf(v0 * rinv + bb.x, 0.f), y = fmaxf(v1 * rinv + bb.y, 0.f);
        *(unsigned*)(hid + (size_t)r * FF + cg * 64 + c2) = pk2(x * x, y * y);
    }
};
struct SEpiBias {
    float* bias;
    __device__ __forceinline__ void operator()(int rg, int t, int cg, int c2, float v0, float v1) const {
        const int row = 16 * rg + t;
        if (row < NMODROW) *(f32x2*)(bias + (size_t)row * FF + cg * 64 + c2) = (f32x2){v0, v1};
    }
};

struct Params { const float* in[19]; float* out; unsigned char* ws; };

__device__ __forceinline__ void transpose_item(const float* W, int ldw, int K, int nblk, bf16_t* WT, LAS float* scr, int item, int lane) {
    const int kb = item / nblk, nb = item % nblk, k0 = 64 * kb, n0 = 32 * nb;
    float tv[32];
#pragma unroll
    for (int i = 0; i < 32; ++i) tv[i] = W[(size_t)(k0 + 2 * i + (lane >> 5)) * ldw + n0 + (lane & 31)];
#pragma unroll
    for (int i = 0; i < 32; ++i) scr[(2 * i + (lane >> 5)) * 33 + (lane & 31)] = tv[i];
    asm volatile("s_waitcnt lgkmcnt(0)" ::: "memory");
    const int c = lane & 7;
#pragma unroll
    for (int j = 0; j < 4; ++j) { const int n = (lane >> 3) + 8 * j; const LAS float* s = scr + (8 * c) * 33 + n;
        u32x4 o; o.x = pk2(s[0 * 33], s[1 * 33]); o.y = pk2(s[2 * 33], s[3 * 33]); o.z = pk2(s[4 * 33], s[5 * 33]); o.w = pk2(s[6 * 33], s[7 * 33]);
        *(u32x4*)(WT + (size_t)(n0 + n) * K + k0 + 8 * c) = o; }
    asm volatile("s_waitcnt lgkmcnt(0)" ::: "memory");
}

__device__ __forceinline__ void phase_prologue(const Params& p, LAS unsigned char* lds, int tid, int lane, int wave) {
    LAS float* sc = (LAS float*)lds;
    LAS float* red = (LAS float*)(lds + 73728);
    for (int idx = tid; idx < NMODROW * D; idx += 512) {
        const int r = idx >> 10, k = idx & 1023;
        const float c = (r < 2) ? p.in[2][r * D + k] : p.in[3][(r - 2) * D + k];
        sc[k * 18 + r] = c / (1.f + __expf(-c));
    }
    __syncthreads();
    float* modw = (float*)(p.ws + WS_MOD);
    for (int it = blockIdx.x; it < 256; it += gridDim.x) {
        const int l = it >> 7, col0 = (it & 127) * 48;
        const int la = lane < 48 ? lane : 47, kk2 = la / 24, c2 = la % 24;
        const float* W = p.in[8] + (size_t)l * D * MODW + col0 + 2 * c2;
        float acc[18][2];
#pragma unroll
        for (int r = 0; r < 18; ++r) { acc[r][0] = 0.f; acc[r][1] = 0.f; }
        const int kb = wave * 128 + kk2;
#pragma unroll 16
        for (int i = 0; i < 64; ++i) {
            const int k = kb + 2 * i;
            const f32x2 wv = *(const f32x2*)(W + (size_t)k * MODW);
            const LAS f32x2* s2 = (const LAS f32x2*)(sc + k * 18);
#pragma unroll
            for (int r2 = 0; r2 < 9; ++r2) { const f32x2 s = s2[r2];
                acc[2 * r2][0] += s.x * wv.x; acc[2 * r2][1] += s.x * wv.y; acc[2 * r2 + 1][0] += s.y * wv.x; acc[2 * r2 + 1][1] += s.y * wv.y; }
        }
        if (lane < 48) {
#pragma unroll
            for (int r = 0; r < 18; ++r) { red[((wave * 2 + kk2) * 18 + r) * 48 + 2 * c2] = acc[r][0]; red[((wave * 2 + kk2) * 18 + r) * 48 + 2 * c2 + 1] = acc[r][1]; }
        }
        __syncthreads();
        for (int idx = tid; idx < 18 * 48; idx += 512) {
            const int r = idx / 48, c = idx % 48;
            float s = p.in[9][l * MODW + col0 + c];
#pragma unroll
            for (int w = 0; w < 16; ++w) s += red[(w * 18 + r) * 48 + c];
            modw[((size_t)l * NMODROW + r) * MODW + col0 + c] = s;
        }
        __syncthreads();
    }
    LAS float* scr = (LAS float*)(lds + 73728 + wave * 8448);
    const int gw = blockIdx.x * 8 + wave, NGW = gridDim.x * 8;
    constexpr int I_IN = 16 * 80, I_OUT = 16 * 32, I_UP = 16 * 128, I_DN = 64 * 32, I_L = I_IN + I_OUT + I_UP + I_DN;
    for (int it = gw; it < 2 * I_L; it += NGW) {
        const int l = it / I_L; int r = it % I_L;
        if (r < I_IN) { transpose_item(p.in[10] + (size_t)l * D * INC, INC, D, 80, (bf16_t*)(p.ws + WS_WIN) + (size_t)l * NMAIN * D, scr, r, lane); continue; } r -= I_IN;
        if (r < I_OUT) { transpose_item(p.in[16] + (size_t)l * D * D, D, D, 32, (bf16_t*)(p.ws + WS_WOUT) + (size_t)l * D * D, scr, r, lane); continue; } r -= I_OUT;
        if (r < I_UP) { transpose_item(p.in[17] + (size_t)l * D * FF, FF, D, 128, (bf16_t*)(p.ws + WS_WUP) + (size_t)l * FF * D, scr, r, lane); continue; } r -= I_UP;
        transpose_item(p.in[18] + (size_t)l * FF * D, D, FF, 32, (bf16_t*)(p.ws + WS_WDN) + (size_t)l * D * FF, scr, r, lane);
    }
}

__device__ __forceinline__ void phase_norm(const Params& p, LAS unsigned char* lds, int l, int stage, const float* xp, const float* xs, int tid, int lane, int wave) {
    constexpr int HP = 1032;
    LAS bf16_t* wfb = (LAS bf16_t*)lds;
    LAS bf16_t* ht = (LAS bf16_t*)(lds + 33280);
    LAS float* pc = (LAS float*)(lds + 66560);
    {
        const float* W = p.in[10] + (size_t)l * D * INC + NMAIN;
        for (int idx = tid; idx < 16 * D; idx += 512) { const int k = idx >> 4, hh = idx & 15; wfb[hh * HP + k] = (bf16_t)f2bf(hh < NH ? W[(size_t)k * INC + hh] : 0.f); }
        float* SS = (float*)(p.ws + WS_SS);
        for (int i = blockIdx.x * 512 + tid; i < M; i += gridDim.x * 512) SS[i] = 0.f;
        if (l == 0) {
            bf16_t* s2 = (bf16_t*)(p.ws + WS_SH2); const float* modall = (const float*)(p.ws + WS_MOD);
            for (int i = blockIdx.x * 512 + tid; i < 2 * 32 * D; i += gridDim.x * 512) { const int ll = i >> 15, row = (i >> 10) & 31, k = i & 1023;
                s2[i] = (bf16_t)f2bf(row < NMODROW ? modall[((size_t)ll * NMODROW + row) * MODW + 3 * D + k] : 0.f); }
        }
    }
    __syncthreads();
    const float* modl = (const float*)(p.ws + WS_MOD) + (size_t)l * NMODROW * MODW;
    bf16_t* hn = (bf16_t*)(p.ws + WS_HN);
    const int l16 = lane & 15, quad = lane >> 4;
    const int rpb = (M + (int)gridDim.x - 1) / (int)gridDim.x, R0 = (int)blockIdx.x * rpb, R1 = (R0 + rpb < M) ? R0 + rpb : M;
    for (int g0 = R0; g0 < R1; g0 += 16) {
#pragma unroll
        for (int rr = 0; rr < 2; ++rr) {
            const int lr = 2 * wave + rr, m = g0 + lr;
            LAS unsigned long long* h8 = (LAS unsigned long long*)(ht + lr * HP) + lane;
            if (m < R1) {
                const f32x4* xr = (const f32x4*)(m < MP ? xp + (size_t)m * D : xs + (size_t)(m - MP) * D) + lane;
                f32x4 v[4]; float ss = 0.f;
#pragma unroll
                for (int j = 0; j < 4; ++j) { v[j] = xr[64 * j]; ss += (v[j].x * v[j].x + v[j].y * v[j].y) + (v[j].z * v[j].z + v[j].w * v[j].w); }
                ss = wave_sum(ss);
                const float rinv = 1.0f / sqrtf(ss * (1.f / D) + EPS);
                const float* mrow = modl + (size_t)brow_of(m) * MODW;
                const f32x4* sh4 = (const f32x4*)mrow + lane; const f32x4* sc4 = (const f32x4*)(mrow + D) + lane;
                unsigned long long* o8 = (unsigned long long*)(hn + (size_t)m * D) + lane;
#pragma unroll
                for (int j = 0; j < 4; ++j) {
                    const f32x4 shv = sh4[64 * j], scv = sc4[64 * j];
                    v[j] = v[j] * rinv * (scv + 1.0f) + shv;
                    const unsigned long long w = (unsigned long long)pk2(v[j].x, v[j].y) | ((unsigned long long)pk2(v[j].z, v[j].w) << 32);
                    o8[64 * j] = w; h8[64 * j] = w;
                }
            } else {
#pragma unroll
                for (int j = 0; j < 4; ++j) h8[64 * j] = 0ull;
            }
        }
        __syncthreads();
        {
            f32x4 c = (f32x4){0.f, 0.f, 0.f, 0.f};
#pragma unroll
            for (int s = 0; s < 4; ++s) {
                const int k0 = 32 * (4 * wave + s) + 8 * quad;
                const bf16x8 a = *(const LAS bf16x8*)(ht + l16 * HP + k0), b = *(const LAS bf16x8*)(wfb + l16 * HP + k0);
                c = __builtin_amdgcn_mfma_f32_16x16x32_bf16(a, b, c, 0, 0, 0);
            }
#pragma unroll
            for (int r = 0; r < 4; ++r) pc[(wave * 16 + quad * 4 + r) * 16 + l16] = c[r];
        }
        __syncthreads();
        if (tid < 16 * NH) {
            const int row = tid / NH, hh = tid % NH, m = g0 + row;
            if (m < R1) {
                float x = p.in[11][l * NH + hh];
#pragma unroll
                for (int w = 0; w < 8; ++w) x += pc[(w * 16 + row) * 16 + hh];
                const float lf = fminf(x, 0.f) - log1pf(expf(-fabsf(x)));
                float* o = p.out + (m < MP ? OFF_FP + ((size_t)l * MP + m) * NH : OFF_FS + ((size_t)l * MS + (m - MP)) * NH);
                o[hh] = lf;
            }
        }
    }
}

__device__ __forceinline__ float block_scan_offset(float total, LAS float* sm, int lane, int wave) {
    float x = total;
#pragma unroll
    for (int o = 1; o < 64; o <<= 1) { const float n = __shfl_up(x, o); if (lane >= o) x += n; }
    __syncthreads();
    if (lane == 63) sm[wave] = x;
    __syncthreads();
    float off = x - total;
    for (int w = 0; w < wave; ++w) off += sm[w];
    return off;
}

__device__ __forceinline__ void scan_items(const Params& p, LAS unsigned char* lds, int l, int tid, int lane, int wave) {
    LAS float* sm = (LAS float*)(lds + 65536);
    float* Fp = (float*)(p.ws + WS_FP); float* Fs = (float*)(p.ws + WS_FS);
    const int nb = (int)gridDim.x / 2;
    if ((int)blockIdx.x < (int)gridDim.x - nb) return;
    for (int it = (int)(gridDim.x - 1 - blockIdx.x); it < 24 + 192; it += nb) {
        if (it < 24) {
            const int b = it / NH, h = it % NH;
            const float* src = p.out + OFF_FP + ((size_t)(l * NBP + b) * T) * NH + h;
            const int t0 = tid * 16;
            float v[16]; float run = 0.f;
#pragma unroll
            for (int e = 0; e < 16; ++e) { run += src[(size_t)(t0 + e) * NH]; v[e] = run; }
            const float off = block_scan_offset(run, sm, lane, wave);
            float* dst = Fp + (size_t)it * T + t0;
#pragma unroll
            for (int e = 0; e < 16; e += 4) *(f32x4*)(dst + e) = (f32x4){(off + v[e]) * LOG2E, (off + v[e + 1]) * LOG2E, (off + v[e + 2]) * LOG2E, (off + v[e + 3]) * LOG2E};
        } else {
            const int bh = it - 24, b = bh / NH, h = bh % NH;
            const float* src = p.in[6] + ((size_t)(l * SB + b) * PAST) * NH + h;
            const int t0 = tid * 8;
            float v[8]; float run = 0.f;
#pragma unroll
            for (int e = 0; e < 8; ++e) { run += src[(size_t)(t0 + e) * NH]; v[e] = run; }
            const float off = block_scan_offset(run, sm, lane, wave);
            float* dst = Fs + (size_t)bh * SKEYS + t0;
#pragma unroll
            for (int e = 0; e < 8; e += 4) *(f32x4*)(dst + e) = (f32x4){(off + v[e]) * LOG2E, (off + v[e + 1]) * LOG2E, (off + v[e + 2]) * LOG2E, (off + v[e + 3]) * LOG2E};
            if (tid == 511) sm[8] = off + run;
            __syncthreads();
            if (tid < ST) {
                const float* ns = p.out + OFF_FS + ((size_t)(l * SB + b) * ST) * NH + h;
                float s = sm[8];
                for (int e = 0; e <= tid; ++e) s += ns[e * NH];
                Fs[(size_t)bh * SKEYS + PAST + tid] = s * LOG2E;
            }
        }
        __syncthreads();
    }
}

__device__ __forceinline__ void pool_items(const Params& p, LAS unsigned char* lds, int l, unsigned* ctr, LAS unsigned* slot, int tid, int lane, int wave) {
    LAS float* z = (LAS float*)lds;
    LAS bf16_t* am = (LAS bf16_t*)(lds + 81920);
    const float* ub = (const float*)(p.ws + WS_U);
    bf16_t* mix = (bf16_t*)(p.ws + WS_MIX);
    const int g = wave >> 1, ntp = (wave & 1) * 2, l16 = lane & 15, quad = lane >> 4;
    bf16x8 bw[2][2];
    {
        const float* wp = p.in[14] + ((size_t)(l * 4 + g) * 64) * 64;
#pragma unroll
        for (int nt = 0; nt < 2; ++nt)
#pragma unroll
            for (int ks = 0; ks < 2; ++ks) {
                bf16x8 t;
#pragma unroll
                for (int j = 0; j < 8; ++j) t[j] = (short)f2bf(wp[(size_t)(32 * ks + 8 * quad + j) * 64 + 16 * (ntp + nt) + l16]);
                bw[nt][ks] = t;
            }
    }
    for (;;) {
      if (tid == 0) *slot = atomicAdd(ctr, 1u);
      __syncthreads();
      const int ent = (int)*slot;
      __syncthreads();
      if (ent >= MP / 64 + MS / 16) break;
      const bool prm = ent < MP / 64;
      const int row0 = prm ? ent * 64 : MP + (ent - MP / 64) * 16;
      const int nr = prm ? 4 : 1, nz = 15 + 16 * nr;
      const int t0 = prm ? (row0 & (T - 1)) : 0;
      for (int idx = tid; idx < nz * 64; idx += 512) {
          const int zr = idx >> 6, c4 = (idx & 63) * 4;
          f32x4 val = (f32x4){0.f, 0.f, 0.f, 0.f};
          if (zr >= 15) val = *(const f32x4*)(ub + (size_t)(row0 + zr - 15) * PW + c4);
          else if (prm) { if (t0 > 0) val = *(const f32x4*)(ub + (size_t)(row0 + zr - 15) * PW + c4); }
          else val = *(const f32x4*)(p.in[7] + ((size_t)(l * SB + ((row0 - MP) >> 4)) * 15 + zr) * PW + c4);
          *(LAS f32x4*)(z + zr * 256 + c4) = val;
      }
      __syncthreads();
      for (int i = 0; i < nr; ++i) {
          const int row = (tid >> 5) + 16 * i, c0 = (tid & 31) * 8, gg = c0 >> 6, w = 2 << gg;
          f32x4 s0 = (f32x4){0.f, 0.f, 0.f, 0.f}, s1 = s0;
          for (int j = 0; j < w; ++j) { s0 += *(const LAS f32x4*)(z + (15 + row - j) * 256 + c0); s1 += *(const LAS f32x4*)(z + (15 + row - j) * 256 + c0 + 4); }
          float cnt = (float)w;
          if (prm) { const float pos1 = (float)(t0 + row + 1); cnt = fminf(pos1, cnt); }
          const float ic = 1.0f / cnt;
          const f32x4 u0 = *(const LAS f32x4*)(z + (15 + row) * 256 + c0), u1 = *(const LAS f32x4*)(z + (15 + row) * 256 + c0 + 4);
          s0 = s0 * ic - u0; s1 = s1 * ic - u1;
          u32x4 o; o.x = pk2(s0[0], s0[1]); o.y = pk2(s0[2], s0[3]); o.z = pk2(s1[0], s1[1]); o.w = pk2(s1[2], s1[3]);
          *(LAS u32x4*)(am + row * 264 + c0) = o;
      }
      __syncthreads();
      for (int i = 0; i < nr; ++i) {
          f32x4 c[2] = {(f32x4){0.f, 0.f, 0.f, 0.f}, (f32x4){0.f, 0.f, 0.f, 0.f}};
#pragma unroll
          for (int ks = 0; ks < 2; ++ks) {
              const bf16x8 a = *(const LAS bf16x8*)(am + (16 * i + l16) * 264 + g * 64 + 32 * ks + 8 * quad);
#pragma unroll
              for (int nt = 0; nt < 2; ++nt) c[nt] = __builtin_amdgcn_mfma_f32_16x16x32_bf16(a, bw[nt][ks], c[nt], 0, 0, 0);
          }
#pragma unroll
          for (int nt = 0; nt < 2; ++nt) {
              const int col = g * 64 + 16 * (ntp + nt) + l16;
              const float ps = p.in[15][l * PW + col];
#pragma unroll
              for (int r = 0; r < 4; ++r) mix[(size_t)(row0 + 16 * i + quad * 4 + r) * D + col] = (bf16_t)f2bf(c[nt][r] * ps);
          }
      }
      __syncthreads();
    }
}

__device__ __forceinline__ s16x4 vtr(const LAS unsigned char* ptr) { return __builtin_bit_cast(s16x4, __builtin_amdgcn_ds_read_tr16_b64_v4i16((LAS s16x4*)ptr)); }
constexpr int KP = 144;

__device__ __forceinline__ float xmax_q(float v) {
    auto a = __builtin_amdgcn_permlane16_swap(__float_as_uint(v), __float_as_uint(v), false, false);
    const float m = __builtin_fmaxf(__uint_as_float(a[0]), __uint_as_float(a[1]));
    auto b = __builtin_amdgcn_permlane32_swap(__float_as_uint(m), __float_as_uint(m), false, false);
    return __builtin_fmaxf(__uint_as_float(b[0]), __uint_as_float(b[1]));
}
__device__ __forceinline__ void attn_tile64(const LAS unsigned char* Kt, const LAS unsigned char* Vt, const LAS float* Ft, int key0, int Qw, bool diag,
                                            const bf16x8 (&qf)[2][2], const float (&fq)[2], float (&fqm)[2], float (&mrun)[2], float (&lrun)[2], f32x4 (&o)[4][2], int l16, int quad) {
    f32x4 s[4][2];
    bf16x8 kf[2][4]; f32x4 fk[4];
#pragma unroll
    for (int ks = 0; ks < 2; ++ks)
#pragma unroll
        for (int kt = 0; kt < 4; ++kt) kf[ks][kt] = *(const LAS bf16x8*)(Kt + (16 * kt + l16) * KP + ks * 64 + quad * 16);
#pragma unroll
    for (int kt = 0; kt < 4; ++kt) fk[kt] = *(const LAS f32x4*)(Ft + 16 * kt + 4 * quad);
    __builtin_amdgcn_sched_barrier(0);
#pragma unroll
    for (int kt = 0; kt < 4; ++kt)
#pragma unroll
        for (int qt = 0; qt < 2; ++qt) s[kt][qt] = (f32x4){fqm[qt] - fk[kt][0], fqm[qt] - fk[kt][1], fqm[qt] - fk[kt][2], fqm[qt] - fk[kt][3]};
#pragma unroll
    for (int ks = 0; ks < 2; ++ks)
#pragma unroll
        for (int kt = 0; kt < 4; ++kt)
#pragma unroll
            for (int qt = 0; qt < 2; ++qt) s[kt][qt] = __builtin_amdgcn_mfma_f32_16x16x32_bf16(kf[ks][kt], qf[qt][ks], s[kt][qt], 0, 0, 0);
    s16x4 va[2][4][2];
    {
        const LAS unsigned char* vb0 = Vt + (4 * quad + (l16 >> 2)) * KP + 8 * (l16 & 3);
#pragma unroll
        for (int k2 = 0; k2 < 2; ++k2)
#pragma unroll
            for (int dt = 0; dt < 4; ++dt) { va[k2][dt][0] = vtr(vb0 + 32 * k2 * KP + 32 * dt); va[k2][dt][1] = vtr(vb0 + (32 * k2 + 16) * KP + 32 * dt); }
    }
    __builtin_amdgcn_sched_barrier(0);
    if (diag) {
#pragma unroll
        for (int kt = 0; kt < 4; ++kt)
#pragma unroll
            for (int qt = 0; qt < 2; ++qt)
#pragma unroll
                for (int r = 0; r < 4; ++r) { const int key = key0 + 16 * kt + 4 * quad + r, qq = Qw + 16 * qt + l16; if (key > qq) s[kt][qt][r] = -INFINITY; }
    }
    float mx[2];
#pragma unroll
    for (int qt = 0; qt < 2; ++qt) {
        float a = __builtin_fmaxf(__builtin_fmaxf(s[0][qt][0], s[0][qt][1]), s[0][qt][2]), c = __builtin_fmaxf(__builtin_fmaxf(s[0][qt][3], s[1][qt][0]), s[1][qt][1]);
        a = __builtin_fmaxf(__builtin_fmaxf(a, s[1][qt][2]), s[1][qt][3]); c = __builtin_fmaxf(__builtin_fmaxf(c, s[2][qt][0]), s[2][qt][1]);
        a = __builtin_fmaxf(__builtin_fmaxf(a, s[2][qt][2]), s[2][qt][3]); c = __builtin_fmaxf(__builtin_fmaxf(c, s[3][qt][0]), s[3][qt][1]);
        a = __builtin_fmaxf(__builtin_fmaxf(a, s[3][qt][2]), s[3][qt][3]);
        float m_ = __builtin_fmaxf(a, c);
        mx[qt] = xmax_q(m_);
    }
    if (__any((mx[0] > 8.f) || (mx[1] > 8.f))) {
#pragma unroll
        for (int qt = 0; qt < 2; ++qt) {
            const float dl = __builtin_fmaxf(mx[qt], 0.f);
            mrun[qt] += dl; fqm[qt] = fq[qt] - mrun[qt];
            const float al = __builtin_amdgcn_exp2f(-dl);
            lrun[qt] *= al;
#pragma unroll
            for (int kt = 0; kt < 4; ++kt) s[kt][qt] -= dl;
#pragma unroll
            for (int dt = 0; dt < 4; ++dt) o[dt][qt] *= al;
        }
    }
#pragma unroll
    for (int qt = 0; qt < 2; ++qt) {
        float ps = 0.f;
#pragma unroll
        for (int kt = 0; kt < 4; ++kt)
#pragma unroll
            for (int r = 0; r < 4; ++r) { const float e = __builtin_amdgcn_exp2f(s[kt][qt][r]); s[kt][qt][r] = e; ps += e; }
        lrun[qt] += ps;
    }
#pragma unroll
    for (int k2 = 0; k2 < 2; ++k2) {
        bf16x8 pb[2];
#pragma unroll
        for (int qt = 0; qt < 2; ++qt) {
            u32x4 w; w.x = pk2(s[2 * k2][qt][0], s[2 * k2][qt][1]); w.y = pk2(s[2 * k2][qt][2], s[2 * k2][qt][3]);
            w.z = pk2(s[2 * k2 + 1][qt][0], s[2 * k2 + 1][qt][1]); w.w = pk2(s[2 * k2 + 1][qt][2], s[2 * k2 + 1][qt][3]);
            pb[qt] = __builtin_bit_cast(bf16x8, w);
        }
#pragma unroll
        for (int dt = 0; dt < 4; ++dt) {
            const s16x4 a0 = va[k2][dt][0], a1 = va[k2][dt][1];
            const bf16x8 vf = (bf16x8){a0[0], a0[1], a0[2], a0[3], a1[0], a1[1], a1[2], a1[3]};
#pragma unroll
            for (int qt = 0; qt < 2; ++qt) o[dt][qt] = __builtin_amdgcn_mfma_f32_16x16x32_bf16(vf, pb[qt], o[dt][qt], 0, 0, 0);
        }
    }
}

constexpr int TB = 128 * KP;
__device__ __forceinline__ void attn_prompt_unit(int b, int h, int qb, const bf16_t* Q, const bf16_t* Kb, const bf16_t* Vb, const float* F2, bf16_t* mix,
                                                 LAS unsigned char* lds, int tid, int lane, int wave) {
    const int l16 = lane & 15, quad = lane >> 4;
    const size_t rowbase = (size_t)b * T;
    const int Qw = qb * 256 + wave * 32;
    const float* Fh = F2 + (size_t)(b * NH + h) * T;
    bf16x8 qf[2][2]; float fq[2];
#pragma unroll
    for (int qt = 0; qt < 2; ++qt) {
#pragma unroll
        for (int ks = 0; ks < 2; ++ks) qf[qt][ks] = *(const bf16x8*)(Q + (rowbase + Qw + 16 * qt + l16) * AW + h * HD + 32 * ks + 8 * quad);
        fq[qt] = Fh[Qw + 16 * qt + l16];
    }
    f32x4 o[4][2];
#pragma unroll
    for (int dt = 0; dt < 4; ++dt) { o[dt][0] = (f32x4){0.f, 0.f, 0.f, 0.f}; o[dt][1] = o[dt][0]; }
    float mrun[2] = {0.f, 0.f}, lrun[2] = {0.f, 0.f}, fqm[2] = {fq[0], fq[1]};
    const int NT = 2 * qb + 2;
    LAS unsigned char* Kl = lds; LAS unsigned char* Vl = lds + 2 * TB; LAS float* Fl = (LAS float*)(lds + 4 * TB);
    const int skey = tid >> 3, sch = tid & 7;
    const bf16_t* kg = Kb + (rowbase + skey) * AW + h * HD + sch * 8;
    const bf16_t* vg = Vb + (rowbase + skey) * AW + h * HD + sch * 8;
    u32x4 kreg0 = *(const u32x4*)kg, kreg1 = *(const u32x4*)(kg + (size_t)64 * AW), vreg0 = *(const u32x4*)vg, vreg1 = *(const u32x4*)(vg + (size_t)64 * AW);
    f32x4 freg = (f32x4){0.f, 0.f, 0.f, 0.f};
    if (tid < 32) freg = *(const f32x4*)(Fh + tid * 4);
    const int soff = skey * KP + sch * 16;
    *(LAS u32x4*)(Kl + soff) = kreg0; *(LAS u32x4*)(Kl + 64 * KP + soff) = kreg1; *(LAS u32x4*)(Vl + soff) = vreg0; *(LAS u32x4*)(Vl + 64 * KP + soff) = vreg1;
    if (tid < 32) *(LAS f32x4*)(Fl + tid * 4) = freg;
    __syncthreads();
    for (int t = 0; t < NT; ++t) {
        const int buf = t & 1;
        if (t + 1 < NT) {
            const size_t go = (size_t)(t + 1) * 128 * AW;
            kreg0 = *(const u32x4*)(kg + go); kreg1 = *(const u32x4*)(kg + go + (size_t)64 * AW); vreg0 = *(const u32x4*)(vg + go); vreg1 = *(const u32x4*)(vg + go + (size_t)64 * AW);
            if (tid < 32) freg = *(const f32x4*)(Fh + (t + 1) * 128 + tid * 4);
        }
#pragma unroll
        for (int sub = 0; sub < 2; ++sub) {
            const int key0 = t * 128 + sub * 64;
            if (key0 <= Qw)
                attn_tile64(Kl + buf * TB + sub * 64 * KP, Vl + buf * TB + sub * 64 * KP, Fl + buf * 128 + sub * 64, key0, Qw, key0 + 63 > Qw, qf, fq, fqm, mrun, lrun, o, l16, quad);
        }
        if (t + 1 < NT) {
            const int nb = buf ^ 1;
            *(LAS u32x4*)(Kl + nb * TB + soff) = kreg0; *(LAS u32x4*)(Kl + nb * TB + 64 * KP + soff) = kreg1;
            *(LAS u32x4*)(Vl + nb * TB + soff) = vreg0; *(LAS u32x4*)(Vl + nb * TB + 64 * KP + soff) = vreg1;
            if (tid < 32) *(LAS f32x4*)(Fl + nb * 128 + tid * 4) = freg;
        }
        __syncthreads();
    }
#pragma unroll
    for (int qt = 0; qt < 2; ++qt) {
        float lt = lrun[qt]; lt += __shfl_xor(lt, 16); lt += __shfl_xor(lt, 32);
        const float il = 1.0f / lt;
        bf16_t* op = mix + (rowbase + Qw + 16 * qt + l16) * D + PW + h * HD + 4 * quad;
#pragma unroll
        for (int dt = 0; dt < 4; ++dt) {
            u32x2 w; w.x = pk2(o[dt][qt][0] * il, o[dt][qt][1] * il); w.y = pk2(o[dt][qt][2] * il, o[dt][qt][3] * il);
            *(u32x2*)(op + 16 * dt) = w;
        }
    }
}


namespace fa {
using f32x16 = __attribute__((ext_vector_type(16))) float;
constexpr int SEQ = T, DH = 64, DM = AW;
constexpr int NW = 8, QBLK = 32, QB = QBLK * NW, KVBLK = 64;
__device__ __forceinline__ int crow(int r, int hi) { return (r & 3) + 8 * (r >> 2) + 4 * hi; }
#define SBAR() __builtin_amdgcn_sched_barrier(0)
__device__ __forceinline__ void cmask(f32x16& p0, f32x16& p1, int jb, int qrel, int hi) {
    const float NEG = -INFINITY; int kb = 64 * jb + 4 * hi;
#pragma unroll
    for (int r = 0; r < 16; ++r) { int kv = kb + (r & 3) + 8 * (r >> 2); if (kv > qrel) p0[r] = NEG; if (kv + 32 > qrel) p1[r] = NEG; }
}
constexpr int NSLOT = 3, SLOTB = 8192;
constexpr int LDS_K = 0, LDS_V = NSLOT * SLOTB, LDS_WS = 2 * NSLOT * SLOTB, LDS_OST = LDS_WS + NW * 64 * 4, LDS_FK = LDS_OST + NW * 4096, LDS_END = LDS_FK + SEQ * 4;
__device__ __forceinline__ void glds16(const void* gsrc, unsigned lds_dst) { unsigned keep;
    asm volatile("s_mov_b32 %0, m0\n\ts_mov_b32 m0, %2\n\ts_nop 0\n\tglobal_load_lds_dwordx4 %1, off\n\ts_mov_b32 m0, %0" : "=&s"(keep) : "v"(gsrc), "s"(lds_dst) : "memory"); }
__device__ __forceinline__ float max3f(float a, float b, float c) { float r; asm("v_max3_f32 %0, %1, %2, %3" : "=v"(r) : "v"(a), "v"(b), "v"(c)); return r; }
__device__ __forceinline__ float max2f(float a, float b) { float r; asm("v_max_f32_e32 %0, %1, %2" : "=v"(r) : "v"(a), "v"(b)); return r; }
__device__ __forceinline__ float fadd_s(float a, float b) { float r; asm("v_add_f32_e32 %0, %1, %2" : "=v"(r) : "v"(a), "v"(b)); return r; }
__device__ __forceinline__ float fsub_s(float a, float b) { float r; asm("v_sub_f32_e32 %0, %1, %2" : "=v"(r) : "v"(a), "v"(b)); return r; }
__device__ __forceinline__ unsigned cvtpk_s(float lo, float hi) { return pk2(lo, hi); }
#define WAIT_BAR(N) asm volatile("s_waitcnt vmcnt(" #N ") lgkmcnt(0)\n\ts_barrier" ::: "memory")
typedef __attribute__((address_space(3))) const char* lds_cptr;
__device__ __forceinline__ void bias_half(f32x16& c, lds_cptr fkt, float cq, int hi) {
#pragma unroll
    for (int g = 0; g < 4; ++g) {
        const f32x4 a = *(const LAS f32x4*)(fkt + (8 * g + 4 * hi) * 4);
#pragma unroll
        for (int j = 0; j < 4; ++j) c[4 * g + j] = cq - a[j];
    }
}
__device__ __forceinline__ void bias_init(f32x16& c0, f32x16& c1, lds_cptr fkt, float cq, int hi) {
#pragma unroll
    for (int g = 0; g < 4; ++g) {
        const f32x4 a = *(const LAS f32x4*)(fkt + (8 * g + 4 * hi) * 4), b = *(const LAS f32x4*)(fkt + (32 + 8 * g + 4 * hi) * 4);
#pragma unroll
        for (int j = 0; j < 4; ++j) { c0[4 * g + j] = cq - a[j]; c1[4 * g + j] = cq - b[j]; }
    }
}
__device__ __forceinline__ void qkt(f32x16& p0, f32x16& p1, const char* Kslot, const bf16x8* qr, int r32, int hi) {
    const char* kb = Kslot + hi * 1024 + r32 * 16;
#pragma unroll
    for (int d0 = 0; d0 < 4; ++d0) {
        const bf16x8 b0 = *reinterpret_cast<const bf16x8*>(kb + d0 * 2048);
        const bf16x8 b1 = *reinterpret_cast<const bf16x8*>(kb + d0 * 2048 + 512);
        p0 = __builtin_amdgcn_mfma_f32_32x32x16_bf16(b0, qr[d0], p0, 0, 0, 0); p1 = __builtin_amdgcn_mfma_f32_32x32x16_bf16(b1, qr[d0], p1, 0, 0, 0); }
}
__device__ __forceinline__ void kload8(bf16x8* kf, lds_cptr kp) {
    kf[0] = *(const LAS bf16x8*)(kp);        kf[1] = *(const LAS bf16x8*)(kp + 512);
    kf[2] = *(const LAS bf16x8*)(kp + 2048); kf[3] = *(const LAS bf16x8*)(kp + 2560);
    kf[4] = *(const LAS bf16x8*)(kp + 4096); kf[5] = *(const LAS bf16x8*)(kp + 4608);
    kf[6] = *(const LAS bf16x8*)(kp + 6144); kf[7] = *(const LAS bf16x8*)(kp + 6656);
}
__device__ __forceinline__ void kload2(bf16x8* kf, lds_cptr kp, int j) { kf[2 * j] = *(const LAS bf16x8*)(kp + j * 2048); kf[2 * j + 1] = *(const LAS bf16x8*)(kp + j * 2048 + 512); }
__device__ __forceinline__ s16x4 vtr2(lds_cptr p) { return __builtin_bit_cast(s16x4, __builtin_amdgcn_ds_read_tr16_b64_v4i16((LAS s16x4*)p)); }
__device__ __forceinline__ float rowmax(const f32x16& p0, const f32x16& p1) {
    float a = max3f(p0[0], p0[1], p1[0]), b = max3f(p0[2], p0[3], p1[1]); a = max3f(a, p1[2], p1[3]);
#pragma unroll
    for (int r = 4; r < 16; r += 4) { a = max3f(a, p0[r], p0[r + 1]); b = max3f(b, p0[r + 2], p0[r + 3]); a = max3f(a, p1[r], p1[r + 1]); b = max3f(b, p1[r + 2], p1[r + 3]); }
    const float m = max2f(a, b);
    auto rr = __builtin_amdgcn_permlane32_swap(__float_as_uint(m), __float_as_uint(m), false, false);
    return max2f(__uint_as_float(rr[0]), __uint_as_float(rr[1]));
}
__device__ __forceinline__ void pv(f32x16* o, int vb, bf16x8 pa0, bf16x8 pa1, bf16x8 pa2, bf16x8 pa3) {
#pragma unroll
    for (int d0 = 0; d0 < 2; ++d0) { s16x4 lo[4], hi[4];
#pragma unroll
        for (int ks = 0; ks < 4; ++ks) {
            asm volatile("ds_read_b64_tr_b16 %0,%1 offset:%c2" : "=&v"(lo[ks]) : "v"(vb), "i"(d0 * 4096 + ks * 1024) : "memory");
            asm volatile("ds_read_b64_tr_b16 %0,%1 offset:%c2" : "=&v"(hi[ks]) : "v"(vb), "i"(d0 * 4096 + ks * 1024 + 512) : "memory"); }
        asm volatile("s_waitcnt lgkmcnt(0)" ::: "memory"); SBAR();
#define PK(k) (bf16x8){lo[k][0], lo[k][1], lo[k][2], lo[k][3], hi[k][0], hi[k][1], hi[k][2], hi[k][3]}
        o[d0] = __builtin_amdgcn_mfma_f32_32x32x16_bf16(pa0, PK(0), o[d0], 0, 0, 0);
        o[d0] = __builtin_amdgcn_mfma_f32_32x32x16_bf16(pa1, PK(1), o[d0], 0, 0, 0);
        o[d0] = __builtin_amdgcn_mfma_f32_32x32x16_bf16(pa2, PK(2), o[d0], 0, 0, 0);
        o[d0] = __builtin_amdgcn_mfma_f32_32x32x16_bf16(pa3, PK(3), o[d0], 0, 0, 0);
#undef PK
    }
}

template <int THRL> __device__ __forceinline__ void attn_unit(int b, int h, int qb, const bf16_t* Q, const bf16_t* __restrict__ K, const bf16_t* __restrict__ V, const float* F2, bf16_t* mix, char* shm, const int tid, const int t0) {
    const int lane = tid & 63, r32 = lane & 31, hi = lane >> 5; const int wid = __builtin_amdgcn_readfirstlane(tid >> 6);
    const long rowbase = (long)b * SEQ; const int q0 = qb * QB;
    const bf16_t* Qw = Q + (rowbase + q0 + wid * QBLK) * DM + h * DH;
    const bf16_t* Kh = K + (rowbase + t0 * KVBLK) * DM + h * DH, *Vh = V + (rowbase + t0 * KVBLK) * DM + h * DH;
    const float* Fh = F2 + (long)(b * NH + h) * SEQ;
    const unsigned lds0 = (unsigned)(uintptr_t)shm;
    float* wsf = (float*)(shm + LDS_WS) + wid * 64;
    { float* fl = (float*)(shm + LDS_FK); for (int i = t0 * KVBLK + tid * 4; i < q0 + QB; i += 2048) *(f32x4*)(fl + i - t0 * KVBLK) = *(const f32x4*)(Fh + i); }
    const float fq = Fh[q0 + wid * QBLK + r32];
    const bf16_t* ksrc = Kh + (long)lane * DM + wid * 8;
    const bf16_t* vsrc = Vh + (long)(16 * (wid & 3) + (lane >> 2)) * DM + (wid >> 2) * 32 + (lane & 3) * 8;
    const unsigned kdst = lds0 + LDS_K + wid * 1024, vdst = lds0 + LDS_V + wid * 1024;
#define DMA_K(t, slot) glds16(ksrc + (long)(t) * KVBLK * DM, (unsigned)__builtin_amdgcn_readfirstlane(kdst + (slot)))
#define DMA_V(t, slot) glds16(vsrc + (long)(t) * KVBLK * DM, (unsigned)__builtin_amdgcn_readfirstlane(vdst + (slot)))
    const int vb0 = (int)(lds0 + LDS_V) + ((lane >> 4) & 1) * 32 + (lane & 3) * 8 + (4 * hi + ((lane & 15) >> 2)) * 64;
    const char* Kbase = shm + LDS_K; bf16x8 kf[8];
    const lds_cptr shm3 = (lds_cptr)shm; const lds_cptr kp0 = shm3 + LDS_K + hi * 1024 + r32 * 16; const lds_cptr vp0 = shm3 + LDS_V + ((lane >> 4) & 1) * 32 + (lane & 3) * 8 + (4 * hi + ((lane & 15) >> 2)) * 64;
    const lds_cptr fk0 = shm3 + LDS_FK;
    const int NT = (q0 + QB) / KVBLK - t0;
    DMA_K(0, 0); DMA_V(0, 0); DMA_K(1, SLOTB);
    bf16x8 qr[4];
#pragma unroll
    for (int d0 = 0; d0 < 4; ++d0) qr[d0] = *reinterpret_cast<const bf16x8*>(&Qw[(long)r32 * DM + d0 * 16 + hi * 8]);
    float mhat = 0.f, l_reg = 0.f, cq = fq; f32x16 o[2]; o[0] = f32x16{}; o[1] = f32x16{};
    const int qrel = wid * QBLK + r32;
#define CMASK(P0, P1, t) do { int jb_ = (t) - (NT - 4); if (jb_ >= 0) cmask(P0, P1, jb_, qrel, hi); } while (0)
    bool resc = false;
#define START(P0, P1) do { const float rm = rowmax(P0, P1); resc = false; \
    { const float dl = rm; mhat = fadd_s(mhat, dl); \
      _Pragma("unroll") for (int r = 0; r < 16; ++r) { P0[r] = fsub_s(P0[r], dl); P1[r] = fsub_s(P1[r], dl); } \
      cq = fq - mhat; } \
    _Pragma("unroll") for (int r = 0; r < 16; ++r) P0[r] = __builtin_amdgcn_exp2f(P0[r]); } while (0)
#define RESC() do { if (resc) { asm volatile("s_waitcnt lgkmcnt(0)" ::: "memory"); \
      _Pragma("unroll") for (int d_ = 0; d_ < 2; ++d_) _Pragma("unroll") for (int r = 0; r < 16; ++r) o[d_][r] *= wsf[crow(r, hi)]; } } while (0)
    f32x16 pA0, pA1, pB0, pB1;
    int sl_prev = 0, sl_cur = 0, sl_next = SLOTB;
#define ROT() do { sl_prev = sl_cur; sl_cur = sl_next; sl_next = (sl_next == (NSLOT - 1) * SLOTB) ? 0 : sl_next + SLOTB; } while (0)
    DMA_K(2, 2 * SLOTB);
    WAIT_BAR(3);
    bias_init(pA0, pA1, fk0, cq, hi);
    qkt(pA0, pA1, Kbase, qr, r32, hi); asm volatile("s_nop 15\n\ts_nop 7" : "+v"(pA0), "+v"(pA1)); CMASK(pA0, pA1, 0);
    START(pA0, pA1);
    _Pragma("unroll") for (int r = 0; r < 16; ++r) pA1[r] = __builtin_amdgcn_exp2f(pA1[r]);
    WAIT_BAR(0);
    DMA_K(3, 0); DMA_V(1, SLOTB);
    ROT();
    kload8(kf, kp0 + sl_cur);
    WAIT_BAR(2);
    s16x4 vlo[8], vhi[8]; u32x4 pw0, pw1, pw2, pw3;
#define PKW(P, B) cvtpk_s(P[B], P[B + 1])
#define PAF(k) __builtin_bit_cast(bf16x8, pw##k)
#define VFR(i) (bf16x8){vlo[i][0], vlo[i][1], vlo[i][2], vlo[i][3], vhi[i][0], vhi[i][1], vhi[i][2], vhi[i][3]}
#define PIN(x) asm volatile("" : "+v"(x))
#define MX3(a, b, c) __builtin_fmaxf(__builtin_fmaxf((a), (b)), (c))
#define GAPA(MF, A0, A1, A2, A3, W0, W1, PW) do { MF; sacc += A0; sacc += A1; sacc += A2; sacc += A3; PIN(sacc); W0; W1; PIN(PW); SBAR(); } while (0)
#define EX(v) __builtin_amdgcn_exp2f(v)
#define GAPB(MF, X, B) do { MF; X[B] = EX(X[B]); X[B + 1] = EX(X[B + 1]); X[B + 2] = EX(X[B + 2]); X[B + 3] = EX(X[B + 3]); PIN(X); SBAR(); } while (0)
#define VRD(i) do { vlo[i] = vtr2(vp_ + (((i) >> 2) * 4096 + ((i) & 3) * 1024)); vhi[i] = vtr2(vp_ + (((i) >> 2) * 4096 + ((i) & 3) * 1024 + 512)); } while (0)
#define KRD(G, j) do { if (G) { kload2(kf, kp0 + sl_next, j); SBAR(); } } while (0)
#define STEP(C0, C1, P0, P1, t, GK, GV, GL) do { SBAR(); \
    bias_half(C0, fk0 + (t) * 256, cq, hi); SBAR(); \
    const lds_cptr vp_ = vp0 + sl_prev; \
    VRD(0); SBAR(); float sacc = (P0[0] + P0[1]); \
    GAPA(C0 = __builtin_amdgcn_mfma_f32_32x32x16_bf16(kf[0], qr[0], C0, 0, 0, 0), P0[2], P0[3], P0[4], P0[5],     pw0[0] = PKW(P0, 0), pw0[1] = PKW(P0, 2), pw0); \
    bias_half(C1, fk0 + (t) * 256 + 128, cq, hi); SBAR(); \
    VRD(4); SBAR(); GAPA(C1 = __builtin_amdgcn_mfma_f32_32x32x16_bf16(kf[1], qr[0], C1, 0, 0, 0), P0[6], P0[7], P0[8], P0[9],     pw0[2] = PKW(P0, 4), pw0[3] = PKW(P0, 6), pw0); \
    VRD(1); SBAR(); GAPA(C0 = __builtin_amdgcn_mfma_f32_32x32x16_bf16(kf[2], qr[1], C0, 0, 0, 0),   P0[10], P0[11], P0[12], P0[13], pw1[0] = PKW(P0, 8), pw1[1] = PKW(P0, 10), pw1); \
    VRD(5); SBAR(); GAPA(C1 = __builtin_amdgcn_mfma_f32_32x32x16_bf16(kf[3], qr[1], C1, 0, 0, 0),   P0[14], P0[15], P1[0], P1[1],   pw1[2] = PKW(P0, 12), pw1[3] = PKW(P0, 14), pw1); \
    VRD(2); SBAR(); GAPA(C0 = __builtin_amdgcn_mfma_f32_32x32x16_bf16(kf[4], qr[2], C0, 0, 0, 0),   P1[2], P1[3], P1[4], P1[5],     pw2[0] = PKW(P1, 0), pw2[1] = PKW(P1, 2), pw2); \
    VRD(6); SBAR(); GAPA(C1 = __builtin_amdgcn_mfma_f32_32x32x16_bf16(kf[5], qr[2], C1, 0, 0, 0),   P1[6], P1[7], P1[8], P1[9],     pw2[2] = PKW(P1, 4), pw2[3] = PKW(P1, 6), pw2); \
    VRD(3); SBAR(); GAPA(C0 = __builtin_amdgcn_mfma_f32_32x32x16_bf16(kf[6], qr[3], C0, 0, 0, 0),   P1[10], P1[11], P1[12], P1[13], pw3[0] = PKW(P1, 8), pw3[1] = PKW(P1, 10), pw3); \
    VRD(7); SBAR(); GAPA(C1 = __builtin_amdgcn_mfma_f32_32x32x16_bf16(kf[7], qr[3], C1, 0, 0, 0),   P1[14], P1[15], 0.f, 0.f,       pw3[2] = PKW(P1, 12), pw3[3] = PKW(P1, 14), pw3); \
    l_reg += sacc; \
    if (GK) { DMA_K((t) + 3, sl_cur); } if (GV) { DMA_V((t) + 1, sl_next); } \
    CMASK(C0, C1, t); \
    { float a = MX3(C0[0], C0[1], C1[0]), b = MX3(C0[2], C0[3], C1[1]); a = MX3(a, C1[2], C1[3]); \
      _Pragma("unroll") for (int r = 4; r < 16; r += 4) { a = MX3(a, C0[r], C0[r + 1]); b = MX3(b, C0[r + 2], C0[r + 3]); a = MX3(a, C1[r], C1[r + 1]); b = MX3(b, C1[r + 2], C1[r + 3]); } \
      float rm = __builtin_fmaxf(a, b); { auto rr = __builtin_amdgcn_permlane32_swap(__float_as_uint(rm), __float_as_uint(rm), false, false); rm = __builtin_fmaxf(__uint_as_float(rr[0]), __uint_as_float(rr[1])); } \
      resc = false; \
      if (__builtin_expect(__any(rm > (float)THRL), 0)) { const float dl = __builtin_fmaxf(rm, 0.f); mhat += dl; \
        _Pragma("unroll") for (int r = 0; r < 16; ++r) { C0[r] -= dl; C1[r] -= dl; } \
        cq = fq - mhat; \
        const float f = __builtin_amdgcn_exp2f(-dl); l_reg *= f; if (hi == 0) wsf[r32] = f; resc = true; } } \
    SBAR(); \
    GAPB(o[0] = __builtin_amdgcn_mfma_f32_32x32x16_bf16(PAF(0), VFR(0), o[0], 0, 0, 0), C0, 0); \
    GAPB(o[1] = __builtin_amdgcn_mfma_f32_32x32x16_bf16(PAF(0), VFR(4), o[1], 0, 0, 0), C0, 4); \
    KRD(GL, 0); GAPB(o[0] = __builtin_amdgcn_mfma_f32_32x32x16_bf16(PAF(1), VFR(1), o[0], 0, 0, 0), C0, 8); \
    KRD(GL, 1); GAPB(o[1] = __builtin_amdgcn_mfma_f32_32x32x16_bf16(PAF(1), VFR(5), o[1], 0, 0, 0), C0, 12); \
    KRD(GL, 2); GAPB(o[0] = __builtin_amdgcn_mfma_f32_32x32x16_bf16(PAF(2), VFR(2), o[0], 0, 0, 0), C1, 0); \
    KRD(GL, 3); GAPB(o[1] = __builtin_amdgcn_mfma_f32_32x32x16_bf16(PAF(2), VFR(6), o[1], 0, 0, 0), C1, 4); \
    GAPB(o[0] = __builtin_amdgcn_mfma_f32_32x32x16_bf16(PAF(3), VFR(3), o[0], 0, 0, 0), C1, 8); \
    GAPB(o[1] = __builtin_amdgcn_mfma_f32_32x32x16_bf16(PAF(3), VFR(7), o[1], 0, 0, 0), C1, 12); \
    } while (0)
    int t = 1;
#undef CMASK
#define CMASK(P0, P1, t) do { } while (0)
    for (; t + 5 < NT; t += 2) {
        STEP(pB0, pB1, pA0, pA1, t, true, true, true);     WAIT_BAR(2); RESC(); ROT();
        STEP(pA0, pA1, pB0, pB1, t + 1, true, true, true); WAIT_BAR(2); RESC(); ROT();
    }
#undef CMASK
#define CMASK(P0, P1, t) do { int jb_ = (t) - (NT - 4); if (jb_ >= 0) cmask(P0, P1, jb_, qrel, hi); } while (0)
#define ENDW(tt) do { if ((tt) + 3 < NT) { WAIT_BAR(2); } else if ((tt) + 2 < NT) { WAIT_BAR(1); } else { WAIT_BAR(0); } } while (0)
    for (; t + 1 < NT; t += 2) {
        STEP(pB0, pB1, pA0, pA1, t, (t + 3 < NT), (t + 1 < NT), (t + 1 < NT));       ENDW(t);     RESC(); ROT();
        STEP(pA0, pA1, pB0, pB1, t + 1, (t + 4 < NT), (t + 2 < NT), (t + 2 < NT)); ENDW(t + 1); RESC(); ROT();
    }
    STEP(pB0, pB1, pA0, pA1, NT - 1, false, false, false); RESC();
    { float sacc = pB0[0] + pB0[1]; _Pragma("unroll") for (int r = 2; r < 16; ++r) sacc += pB0[r]; _Pragma("unroll") for (int r = 0; r < 16; ++r) sacc += pB1[r]; l_reg += sacc;
      pw0 = (u32x4){PKW(pB0, 0), PKW(pB0, 2), PKW(pB0, 4), PKW(pB0, 6)}; pw1 = (u32x4){PKW(pB0, 8), PKW(pB0, 10), PKW(pB0, 12), PKW(pB0, 14)}; pw2 = (u32x4){PKW(pB1, 0), PKW(pB1, 2), PKW(pB1, 4), PKW(pB1, 6)}; pw3 = (u32x4){PKW(pB1, 8), PKW(pB1, 10), PKW(pB1, 12), PKW(pB1, 14)};
      SBAR(); pv(o, vb0 + sl_cur, PAF(0), PAF(1), PAF(2), PAF(3)); }
#undef PKW
#undef PAF
#undef VFR
#undef PIN
#undef MX3
#undef GAPA
#undef GAPB
#undef EX
#undef VRD
#undef KRD
#undef STEP
#undef ENDW
    { auto rr = __builtin_amdgcn_permlane32_swap(__float_as_uint(l_reg), __float_as_uint(l_reg), false, false); l_reg = __uint_as_float(rr[0]) + __uint_as_float(rr[1]); }
    if (hi == 0) wsf[32 + r32] = l_reg; asm volatile("s_waitcnt lgkmcnt(0)" ::: "memory");
    float rli[16];
#pragma unroll
    for (int r = 0; r < 16; ++r) rli[r] = __builtin_amdgcn_rcpf(wsf[32 + crow(r, hi)]);
    bf16_t* Ow = mix + (rowbase + q0 + wid * QBLK) * D + PW + h * DH;
    { bf16_t* stg = (bf16_t*)(shm + LDS_OST) + wid * 2048;
#pragma unroll
      for (int r = 0; r < 16; ++r) { const int orow = crow(r, hi);
#pragma unroll
        for (int d0 = 0; d0 < 2; ++d0) stg[orow * 64 + d0 * 32 + r32] = (bf16_t)f2bf(o[d0][r] * rli[r]); }
      asm volatile("s_waitcnt lgkmcnt(0)" ::: "memory");
#pragma unroll
      for (int i = 0; i < 4; ++i) { const int row = i * 8 + (lane >> 3), ch = lane & 7; const u32x4 v = *(const u32x4*)(stg + row * 64 + ch * 8); *(u32x4*)(Ow + (long)row * D + ch * 8) = v; } }
    asm volatile("s_waitcnt lgkmcnt(0)\n\ts_barrier" ::: "memory");
#undef DMA_K
#undef DMA_V
#undef CMASK
#undef START
#undef RESC
#undef ROT
}
#undef SBAR
#undef WAIT_BAR
}

__device__ __forceinline__ void attn_sample_unit(int l, int b, int h, const Params& p, LAS unsigned char* lds, int tid, int lane, int wave, float thr) {
    const int l16 = lane & 15, quad = lane >> 4;
    const bf16_t* Q = (const bf16_t*)(p.ws + WS_Q); const bf16_t* Kb = (const bf16_t*)(p.ws + WS_K); const bf16_t* Vb = (const bf16_t*)(p.ws + WS_V);
    bf16_t* mix = (bf16_t*)(p.ws + WS_MIX);
    const size_t row0 = (size_t)MP + b * ST;
    const float* Fh = (const float*)(p.ws + WS_FS) + (size_t)(b * NH + h) * SKEYS;
    bf16x8 qf[2];
#pragma unroll
    for (int ks = 0; ks < 2; ++ks) qf[ks] = *(const bf16x8*)(Q + (row0 + l16) * AW + h * HD + 32 * ks + 8 * quad);
    const float fq = Fh[PAST + l16];
    f32x4 o[4];
#pragma unroll
    for (int dt = 0; dt < 4; ++dt) o[dt] = (f32x4){0.f, 0.f, 0.f, 0.f};
    float mrun = -INFINITY, lrun = 0.f;
    const float* Kc = p.in[4] + ((size_t)(l * SB + b) * PAST) * AW + h * HD;
    const float* Vc = p.in[5] + ((size_t)(l * SB + b) * PAST) * AW + h * HD;
    LAS unsigned char* Vw = lds + wave * (64 * KP);
    f32x4 rk[2][2][2], rv[8], rf[2];
#define SAMPLE_LOAD(key0_) do { \
        _Pragma("unroll") for (int kt = 0; kt < 2; ++kt) _Pragma("unroll") for (int ks = 0; ks < 2; ++ks) { \
            const float* kp = Kc + (size_t)((key0_) + 16 * kt + l16) * AW + 32 * ks + 8 * quad; rk[kt][ks][0] = __builtin_nontemporal_load((const f32x4*)kp); rk[kt][ks][1] = __builtin_nontemporal_load((const f32x4*)(kp + 4)); } \
        _Pragma("unroll") for (int j = 0; j < 8; ++j) rv[j] = __builtin_nontemporal_load((const f32x4*)(Vc + (size_t)((key0_) + 4 * j + quad) * AW + 4 * l16)); \
        _Pragma("unroll") for (int kt = 0; kt < 2; ++kt) rf[kt] = *(const f32x4*)(Fh + (key0_) + 16 * kt + 4 * quad); } while (0)
    int ks;
    { const int j = lane & 15; const bool c = (j >= 1) && (Fh[256 * (j >= 1 ? j : 1) - 1] - Fh[PAST + vzero()] >= thr); ks = 256 * __popcll(__ballot(c && lane < 16)); }
    const int nst = (PAST - ks) >> 8;
    const int kbeg = ks + wave * nst * 32;
    SAMPLE_LOAD(kbeg);
    const int nsteps = nst + (wave == 7 ? 1 : 0);
    for (int step = 0; step < nsteps; ++step) {
        const bool isnew = step == nst;
        f32x4 s[2];
        bf16x8 kf[2][2];
        asm volatile("s_waitcnt lgkmcnt(0)" ::: "memory");
        if (!isnew) {
#pragma unroll
            for (int kt = 0; kt < 2; ++kt)
#pragma unroll
                for (int ks = 0; ks < 2; ++ks) {
                    const f32x4 a = rk[kt][ks][0], c = rk[kt][ks][1];
                    u32x4 w; w.x = pk2(a[0], a[1]); w.y = pk2(a[2], a[3]); w.z = pk2(c[0], c[1]); w.w = pk2(c[2], c[3]);
                    kf[kt][ks] = __builtin_bit_cast(bf16x8, w);
                }
#pragma unroll
            for (int j = 0; j < 8; ++j) {
                const int kr = 4 * j + quad;
                u32x2 w; w.x = pk2(rv[j][0], rv[j][1]); w.y = pk2(rv[j][2], rv[j][3]);
                *(LAS u32x2*)(Vw + kr * KP + 8 * l16) = w;
            }
#pragma unroll
            for (int kt = 0; kt < 2; ++kt) s[kt] = (f32x4){fq - rf[kt][0], fq - rf[kt][1], fq - rf[kt][2], fq - rf[kt][3]};
            if (step + 1 < nst) SAMPLE_LOAD(kbeg + (step + 1) * 32);
        } else {
#pragma unroll
            for (int ks = 0; ks < 2; ++ks) { kf[0][ks] = *(const bf16x8*)(Kb + (row0 + l16) * AW + h * HD + 32 * ks + 8 * quad); kf[1][ks] = (bf16x8){0, 0, 0, 0, 0, 0, 0, 0}; }
            {
                const int kr = lane >> 2, ch = lane & 3;
                const u32x4 a = *(const u32x4*)(Vb + (row0 + kr) * AW + h * HD + 16 * ch), c = *(const u32x4*)(Vb + (row0 + kr) * AW + h * HD + 16 * ch + 8);
                *(LAS u32x4*)(Vw + kr * KP + 32 * ch) = a; *(LAS u32x4*)(Vw + kr * KP + 32 * ch + 16) = c;
                *(LAS u32x4*)(Vw + (16 + kr) * KP + 32 * ch) = (u32x4){0u, 0u, 0u, 0u}; *(LAS u32x4*)(Vw + (16 + kr) * KP + 32 * ch + 16) = (u32x4){0u, 0u, 0u, 0u};
            }
            const f32x4 fk = *(const f32x4*)(Fh + PAST + 4 * quad);
            s[0] = (f32x4){fq - fk[0], fq - fk[1], fq - fk[2], fq - fk[3]};
            s[1] = (f32x4){-INFINITY, -INFINITY, -INFINITY, -INFINITY};
        }
#pragma unroll
        for (int ks = 0; ks < 2; ++ks) {
            s[0] = __builtin_amdgcn_mfma_f32_16x16x32_bf16(kf[0][ks], qf[ks], s[0], 0, 0, 0);
            if (!isnew) s[1] = __builtin_amdgcn_mfma_f32_16x16x32_bf16(kf[1][ks], qf[ks], s[1], 0, 0, 0);
        }
        if (isnew) {
#pragma unroll
            for (int r = 0; r < 4; ++r) if (4 * quad + r > l16) s[0][r] = -INFINITY;
        }
        float mx = fmaxf(fmaxf(s[0][0], s[0][1]), fmaxf(s[0][2], s[0][3]));
        mx = fmaxf(mx, fmaxf(fmaxf(s[1][0], s[1][1]), fmaxf(s[1][2], s[1][3])));
        mx = fmaxf(mx, __shfl_xor(mx, 16)); mx = fmaxf(mx, __shfl_xor(mx, 32));
        const float mnew = fmaxf(mrun, mx);
        const float alpha = __builtin_amdgcn_exp2f(mrun - mnew);
        mrun = mnew;
        float ps = 0.f;
#pragma unroll
        for (int kt = 0; kt < 2; ++kt)
#pragma unroll
            for (int r = 0; r < 4; ++r) { const float e = __builtin_amdgcn_exp2f(s[kt][r] - mnew); s[kt][r] = e; ps += e; }
        lrun = lrun * alpha + ps;
        u32x4 w; w.x = pk2(s[0][0], s[0][1]); w.y = pk2(s[0][2], s[0][3]); w.z = pk2(s[1][0], s[1][1]); w.w = pk2(s[1][2], s[1][3]);
        const bf16x8 pb = __builtin_bit_cast(bf16x8, w);
        asm volatile("s_waitcnt lgkmcnt(0)" ::: "memory");
        const LAS unsigned char* vb0 = Vw + (4 * quad + (l16 >> 2)) * KP + 8 * (l16 & 3);
#pragma unroll
        for (int dt = 0; dt < 4; ++dt) {
            const s16x4 a0 = vtr(vb0 + 32 * dt), a1 = vtr(vb0 + 16 * KP + 32 * dt);
            const bf16x8 vf = (bf16x8){a0[0], a0[1], a0[2], a0[3], a1[0], a1[1], a1[2], a1[3]};
            o[dt] = o[dt] * alpha;
            o[dt] = __builtin_amdgcn_mfma_f32_16x16x32_bf16(vf, pb, o[dt], 0, 0, 0);
        }
    }
#undef SAMPLE_LOAD
    float lt = lrun; lt += __shfl_xor(lt, 16); lt += __shfl_xor(lt, 32);
    LAS float* cm = (LAS float*)(lds + 8 * 64 * KP);
    LAS float* cl = cm + 128; LAS float* co = cl + 128;
    if (quad == 0) { cm[wave * 16 + l16] = mrun; cl[wave * 16 + l16] = lt; }
#pragma unroll
    for (int dt = 0; dt < 4; ++dt)
#pragma unroll
        for (int r = 0; r < 4; ++r) co[(wave * 16 + l16) * 64 + 16 * dt + 4 * quad + r] = o[dt][r];
    __syncthreads();
    {
        const int q = tid >> 5, d0 = (tid & 31) * 2;
        float mm = cm[q];
#pragma unroll
        for (int w = 1; w < 8; ++w) mm = fmaxf(mm, cm[w * 16 + q]);
        float L = 0.f, a0 = 0.f, a1 = 0.f;
#pragma unroll
        for (int w = 0; w < 8; ++w) { const float f = __builtin_amdgcn_exp2f(cm[w * 16 + q] - mm); L += cl[w * 16 + q] * f; a0 += co[(w * 16 + q) * 64 + d0] * f; a1 += co[(w * 16 + q) * 64 + d0 + 1] * f; }
        const float il = 1.0f / L;
        *(unsigned*)(mix + (row0 + q) * D + PW + h * HD + d0) = pk2(a0 * il, a1 * il);
    }
    __syncthreads();
}

__device__ __forceinline__ void phase_attn(const Params& p, LAS unsigned char* lds, int l, int ci, int mode, int tid, int lane, int wave) {
    unsigned* ctr = (unsigned*)(p.ws + WS_CTL) + 64 * ci;
    LAS unsigned* slot = (LAS unsigned*)(lds + LDS_BYTES - 64);
    char* lds_generic = (char*)lds;
    const bf16_t* Q = (const bf16_t*)(p.ws + WS_Q); const bf16_t* Kb = (const bf16_t*)(p.ws + WS_K); const bf16_t* Vb = (const bf16_t*)(p.ws + WS_V);
    const float* Fp = (const float*)(p.ws + WS_FP); bf16_t* mix = (bf16_t*)(p.ws + WS_MIX);
    float thr;
    {
        const float gq = fabsf(p.in[12][l * HD + lane]), gk = fabsf(p.in[13][l * HD + lane]);
        float mq = gq, mk = gk;
#pragma unroll
        for (int o = 1; o < 64; o <<= 1) { mq = fmaxf(mq, __shfl_xor(mq, o)); mk = fmaxf(mk, __shfl_xor(mk, o)); }
        thr = 53.f + 2.f * (64.f * mq * mk * C2 + 0.5f);
    }
    LAS unsigned* cnt = (LAS unsigned*)lds;
    LAS unsigned* keys = (LAS unsigned*)(lds + 1024);
    LAS unsigned short* order = (LAS unsigned short*)(lds + fa::LDS_END);
    const float* Fs = (const float*)(p.ws + WS_FS);
    for (int i = tid; i < 216; i += 512) cnt[i] = 0u;
    __syncthreads();
    for (int i = tid; i < 24 * 124; i += 512) { const int bh = i / 124, j = i % 124 + 1; const float* Fh = Fp + (size_t)bh * T; if (Fh[64 * j - 1] - Fh[31 * 256] >= thr) atomicAdd((unsigned*)(cnt + bh), 1u); }
    for (int i = tid; i < 192 * 15; i += 512) { const int si = i / 15, j = i % 15 + 1; const float* Fh = Fs + (size_t)si * SKEYS; if (Fh[256 * j - 1] - Fh[PAST] >= thr) atomicAdd((unsigned*)(cnt + 24 + si), 1u); }
    __syncthreads();
    for (int id = tid; id < 1024; id += 512) {
        unsigned key = 0u;
        if (id < 768) { const int bh = id >> 5, qb = id & 31, w = 124 - (int)(cnt[bh] & ~1u); int t0a = 4 * qb - w; t0a = t0a > 0 ? (t0a & ~1) : 0;
            key = ((unsigned)(4 * (qb + 1) - t0a + 3) << 10) | (unsigned)(1023 - id); }
        else if (id < 960) { const int nst = 16 - (int)cnt[24 + id - 768]; key = ((unsigned)(5 + (10 * nst) / 3) << 10) | (unsigned)(1023 - id); }
        keys[id] = key;
    }
    __syncthreads();
    {
        const unsigned k0 = keys[tid], k1 = keys[tid + 512]; unsigned p0 = 0u, p1 = 0u;
        for (int k = 0; k < 1024; k += 4) { const u32x4 v = *(const LAS u32x4*)(keys + k);
            p0 += (v.x > k0) + (v.y > k0) + (v.z > k0) + (v.w > k0); p1 += (v.x > k1) + (v.y > k1) + (v.z > k1) + (v.w > k1); }
        order[p0] = (unsigned short)tid;
        if (tid + 512 < 960) order[p1] = (unsigned short)(tid + 512);
    }
    __syncthreads();
    for (;;) {
        if (tid == 0) *slot = atomicAdd(ctr, 1u);
        __syncthreads();
        const int idx = (int)*slot;
        __syncthreads();
        if (idx >= 960) break;
        const int id = (int)order[idx];
        const int tf = fresh_tid(), lf = tf & 63, wf = __builtin_amdgcn_readfirstlane(tf >> 6);
        if (id >= 768) { if (mode == 1) continue; const int si = id - 768; attn_sample_unit(l, si / NH, si % NH, p, lds, tf, lf, wf, thr); }
        else { if (mode == 2) continue; const int bh = id >> 5, qb = id & 31;
            int t0;
            { const float* Fh = Fp + (size_t)bh * T; const float f0 = Fh[qb * 256 + vzero()];
              const int ja = lf + 1, jb2 = lf + 65, jmax = 4 * qb;
              const bool ca = (ja <= jmax) && (Fh[64 * (ja <= jmax ? ja : 1) - 1] - f0 >= thr), cb = (jb2 <= jmax) && (Fh[64 * (jb2 <= jmax ? jb2 : 1) - 1] - f0 >= thr);
              t0 = (__popcll(__ballot(ca)) + __popcll(__ballot(cb))) & ~1; }
            fa::attn_unit<8>(bh / NH, bh % NH, qb, Q, Kb, Vb, Fp, mix, lds_generic, tf, t0);
        }
    }
    if (mode == 0) { const int tf = fresh_tid(); pool_items(p, lds, l, ctr + 8, slot, tf, tf & 63, __builtin_amdgcn_readfirstlane(tf >> 6)); }
}

#define XB_XCNT(j) (1024 + 64 * (j))
#define XB_XSUB(j) (2048 + 64 * (j))
#define XB_XGEN(j) (3072 + 64 * (j))
#define XB_TOP 4096
#define XB_TOPGEN 4160
__device__ __forceinline__ unsigned xb_ld(unsigned* p) { return __hip_atomic_load(p, __ATOMIC_RELAXED, __HIP_MEMORY_SCOPE_AGENT); }
__device__ __forceinline__ unsigned xb_add(unsigned* p, unsigned v) { return __hip_atomic_fetch_add(p, v, __ATOMIC_RELAXED, __HIP_MEMORY_SCOPE_AGENT); }
__device__ __forceinline__ unsigned xcc_id() { return (unsigned)__builtin_amdgcn_s_getreg((3 << 11) | 20) & 0xFu; }
__device__ __forceinline__ void grid_bar(unsigned* bar, volatile LAS unsigned* st) {
    asm volatile("s_waitcnt vmcnt(0)" ::: "memory");
    __syncthreads();
    if (threadIdx.x == 0) {
        __builtin_amdgcn_s_waitcnt(0);
        const unsigned x = xcc_id(), nloc = st[0], nx = st[1];
        const unsigned old = xb_add(&bar[XB_XSUB(x)], 1u);
        const unsigned gen = old / nloc;
        if (old + 1u == (gen + 1u) * nloc) {
            __builtin_amdgcn_fence(__ATOMIC_RELEASE, "agent");
            asm volatile("s_waitcnt vmcnt(0)" ::: "memory");
            const unsigned og = xb_add(&bar[XB_TOP], 1u);
            const unsigned tg = og / nx;
            if (og + 1u == (tg + 1u) * nx) xb_add(&bar[XB_TOPGEN], 1u);
            else { while (xb_ld(&bar[XB_TOPGEN]) == tg) __builtin_amdgcn_s_sleep(1); }
            __builtin_amdgcn_fence(__ATOMIC_ACQUIRE, "agent");
            xb_add(&bar[XB_XGEN(x)], 1u);
            asm volatile("s_waitcnt vmcnt(0)" ::: "memory");
        } else {
            while (xb_ld(&bar[XB_XGEN(x)]) == gen) __builtin_amdgcn_s_sleep(1);
            __builtin_amdgcn_fence(__ATOMIC_ACQUIRE, "agent");
            asm volatile("s_waitcnt vmcnt(0)" ::: "memory");
        }
    }
    __syncthreads();
}
#define FRESH_TID() fresh_tid()
#define TLW(t) (t), ((t) & 63), __builtin_amdgcn_readfirstlane((t) >> 6)
__global__ void __launch_bounds__(512, 2) fwd_megakernel(Params p) {
    extern __shared__ __attribute__((aligned(16))) unsigned char lds_raw[];
    LAS unsigned char* lds = (LAS unsigned char*)lds_raw;
    cg::grid_group grid = cg::this_grid();
    const int G = gridDim.x;

    unsigned* bar_w = (unsigned*)(p.ws + WS_CTL);
    if (threadIdx.x == 0) (void)xb_add(&bar_w[XB_XCNT(xcc_id())], 1u);
    { const int t_ = FRESH_TID(); phase_prologue(p, lds, TLW(t_)); }

#ifdef XSYNC
    for (int i = 0; i < XSYNC; ++i) grid.sync();
#endif
    volatile LAS unsigned* bar_st = (volatile LAS unsigned*)(lds + LDS_BYTES - 32);
    if (threadIdx.x == 0) {
        unsigned mine, cnt, sum; const unsigned x = xcc_id();
        for (;;) {
            mine = 0u; cnt = 0u; sum = 0u;
            for (unsigned j = 0; j < 16; ++j) { const unsigned c = xb_ld(&bar_w[XB_XCNT(j)]); sum += c; cnt += (c > 0u) ? 1u : 0u; mine = (j == x) ? c : mine; }
            if (sum == (unsigned)G) break;
            __builtin_amdgcn_s_sleep(1);
        }
        bar_st[0] = mine; bar_st[1] = cnt;
    }
    __syncthreads();
#define GB() grid_bar(bar_w, bar_st)
    if (G == 0x7fffffff) grid.sync();
    GB();
    float* xa = (float*)(p.ws + WS_XA); float* xb = (float*)(p.ws + WS_XB);
    bf16_t* hn = (bf16_t*)(p.ws + WS_HN);
    for (int l = 0; l < 2; ++l) {
        const float* xp = (l == 0) ? p.in[0] : xb; const float* xs = (l == 0) ? p.in[1] : xb + (size_t)MP * D;
        float* yp = (l == 0) ? xb : p.out; float* ys = yp + (size_t)MP * D;
        const float* modl = (const float*)(p.ws + WS_MOD) + (size_t)l * NMODROW * MODW;
        for (int rep = 0; rep < NREP(0); ++rep) {
            { const int t_ = FRESH_TID(); phase_norm(p, lds, l, 1, xp, xs, TLW(t_)); }
            GB();
        }
        for (int rep = 0; rep < NREP(1); ++rep) {
            pg8::Gemm g{hn, (const bf16_t*)(p.ws + WS_WIN) + (size_t)l * NMAIN * D, M, NMAIN, D};
            pg8::StaticOrder S; S.init(MP, NMAIN, G, (int)blockIdx.x);
            EpiIn E{l, p.out, (bf16_t*)(p.ws + WS_Q), (bf16_t*)(p.ws + WS_K), (bf16_t*)(p.ws + WS_V), (float*)(p.ws + WS_U), p.in[12] + l * HD, p.in[13] + l * HD};
            pg8::gemm_phase<EpiIn, true, true>(lds, g, S, E, FRESH_TID());
            { SEpiIn SE{l, p.out, (bf16_t*)(p.ws + WS_Q), (bf16_t*)(p.ws + WS_K), (bf16_t*)(p.ws + WS_V), (float*)(p.ws + WS_U), p.in[12] + l * HD, p.in[13] + l * HD};
              const int t_ = FRESH_TID(); skinny_phase<SEpiIn>(lds, g.A, g.Bt, NMAIN, D, SE, TLW(t_)); }
            { const int t_ = FRESH_TID(); scan_items(p, lds, l, TLW(t_)); }
            if (l == 0 && rep == 0) {
                for (int ll = 0; ll < 2; ++ll) { SEpiBias SE{(float*)(p.ws + WS_BIAS2) + (size_t)ll * NMODROW * FF}; const int t_ = FRESH_TID();
                    skinny_phase<SEpiBias>(lds, (const bf16_t*)(p.ws + WS_SH2) + (size_t)ll * 32 * D, (const bf16_t*)(p.ws + WS_WUP) + (size_t)ll * FF * D, FF, D, SE, TLW(t_), 0, 2); }
            }
            GB();
        }
        for (int rep = 0; rep < NREP(3); ++rep) {
            { const int t_ = FRESH_TID(); phase_attn(p, lds, l, l * 2 + rep, rep == 0 ? 0 : ATT_DUP_MODE, TLW(t_)); }
            GB();
        }
        for (int rep = 0; rep < NREP(4); ++rep) {
            pg8::Gemm g{(const bf16_t*)(p.ws + WS_MIX), (const bf16_t*)(p.ws + WS_WOUT) + (size_t)l * D * D, M, D, D};
            pg8::StaticOrder S; S.init(MP, D, G, (int)blockIdx.x);
            EpiResN E{xp, xa, modl + 2 * D, modl + 4 * D, hn, (float*)(p.ws + WS_SS)};
            pg8::gemm_phase<EpiResN, false, true>(lds, g, S, E, FRESH_TID());
            { SEpiResN SE{xs, xa + (size_t)MP * D, modl + 2 * D, modl + 4 * D, hn, (float*)(p.ws + WS_SS)}; const int t_ = FRESH_TID(); skinny_phase<SEpiResN>(lds, g.A, g.Bt, D, D, SE, TLW(t_)); }
            GB();
        }
        for (int rep = 0; rep < NREP(6); ++rep) {
            pg8::Gemm g{hn, (const bf16_t*)(p.ws + WS_WUP) + (size_t)l * FF * D, M, FF, D};
            pg8::StaticOrder S; S.init(MP, FF, G, (int)blockIdx.x);
            const float* bias_l = (const float*)(p.ws + WS_BIAS2) + (size_t)l * NMODROW * FF;
            EpiUpN E{(bf16_t*)(p.ws + WS_HID), (const float*)(p.ws + WS_SS), bias_l};
            pg8::gemm_phase<EpiUpN, true, true>(lds, g, S, E, FRESH_TID());
            { SEpiUpN SE{(bf16_t*)(p.ws + WS_HID), (const float*)(p.ws + WS_SS), bias_l}; const int t_ = FRESH_TID(); skinny_phase<SEpiUpN>(lds, g.A, g.Bt, FF, D, SE, TLW(t_)); }
            GB();
        }
        for (int rep = 0; rep < NREP(7); ++rep) {
            pg8::Gemm g{(const bf16_t*)(p.ws + WS_HID), (const bf16_t*)(p.ws + WS_WDN) + (size_t)l * D * FF, M, D, FF};
            pg8::StaticOrder S; S.init(MP, D, G, (int)blockIdx.x);
            EpiRes E{xa, xa + (size_t)MP * D, yp, ys, modl + 5 * D};
            pg8::gemm_phase<EpiRes, false, true>(lds, g, S, E, FRESH_TID());
            { SEpiRes SE{xa + (size_t)MP * D, ys, modl + 5 * D}; const int t_ = FRESH_TID(); skinny_phase<SEpiRes>(lds, g.A, g.Bt, D, FF, SE, TLW(t_)); }
            if (l == 0 || rep + 1 < NREP(7)) GB();
        }
    }
}

extern "C" void kernel_launch(void* const* d_in, const int* in_sizes, int n_in, void* d_out, int out_size, void* d_ws, size_t ws_size, hipStream_t stream) {
    static int grid = 0;
    if (grid == 0) {
        if (n_in != 19 || (size_t)out_size != OUT_TOTAL || ws_size < WS_END) { fprintf(stderr, "kernel_launch: unexpected shapes (n_in %d out %d ws %zu)\n", n_in, out_size, ws_size); grid = -1; return; }
        int dev = 0, cus = 0, per_cu = 0;
        hipGetDevice(&dev);
        hipDeviceGetAttribute(&cus, hipDeviceAttributeMultiprocessorCount, dev);
        hipFuncSetAttribute((const void*)fwd_megakernel, hipFuncAttributeMaxDynamicSharedMemorySize, LDS_BYTES);
        hipOccupancyMaxActiveBlocksPerMultiprocessor(&per_cu, (const void*)fwd_megakernel, 512, LDS_BYTES);
        if (per_cu < 1) { fprintf(stderr, "kernel_launch: occupancy query says %d blocks per CU\n", per_cu); per_cu = 1; }
        grid = cus;
    }
    if (grid < 0) return;
    hipMemsetAsync((char*)d_ws + WS_CTL, 0, 20480, stream);
    Params p{};
    for (int i = 0; i < 19; ++i) p.in[i] = (const float*)d_in[i];
    p.out = (float*)d_out; p.ws = (unsigned char*)d_ws;
    void* args[] = {&p};
    hipError_t e = hipLaunchCooperativeKernel((const void*)fwd_megakernel, dim3(grid), dim3(512), args, LDS_BYTES, stream);
    if (e != hipSuccess) fprintf(stderr, "cooperative launch failed: %s (grid %d)\n", hipGetErrorString(e), grid);
}
```

```cpp
#include <hip/hip_runtime.h>
#include <hip/hip_cooperative_groups.h>
#include <cstdio>
#include <cstdint>
namespace cg = cooperative_groups;

#define LAS __attribute__((address_space(3)))
typedef unsigned short bf16_t;
typedef short bf16x8 __attribute__((ext_vector_type(8)));
typedef short s16x4 __attribute__((ext_vector_type(4)));
typedef float f32x4 __attribute__((ext_vector_type(4)));
typedef float f32x2 __attribute__((ext_vector_type(2)));
typedef unsigned u32x4 __attribute__((ext_vector_type(4)));
typedef unsigned u32x2 __attribute__((ext_vector_type(2)));

constexpr int D = 1024, T = 8192, NBP = 2, SB = 16, ST = 16, PAST = 4096;
constexpr int MP = NBP * T, MS = SB * ST, M = MP + MS;
constexpr int NH = 12, HD = 64, AW = 768, PW = 256, INC = 2572, NMAIN = 2560, FF = 4096;
constexpr int NMODROW = 18, MODW = 6 * D;
constexpr float EPS = 1e-6f;
constexpr float LOG2E = 1.4426950408889634f;
constexpr float C2 = 0.125f * LOG2E;
constexpr int SKEYS = PAST + ST;

constexpr size_t OFF_Y = 0;
constexpr size_t OFF_KP = (size_t)M * D;
constexpr size_t OFF_VP = OFF_KP + (size_t)2 * MP * AW;
constexpr size_t OFF_FP = OFF_VP + (size_t)2 * MP * AW;
constexpr size_t OFF_PP = OFF_FP + (size_t)2 * MP * NH;
constexpr size_t OFF_KS = OFF_PP + (size_t)2 * NBP * 15 * PW;
constexpr size_t OFF_VS = OFF_KS + (size_t)2 * MS * AW;
constexpr size_t OFF_FS = OFF_VS + (size_t)2 * MS * AW;
constexpr size_t OFF_PS = OFF_FS + (size_t)2 * MS * NH;
constexpr size_t OUT_TOTAL = OFF_PS + (size_t)2 * SB * 15 * PW;

constexpr size_t MiB = 1u << 20;
constexpr size_t WS_CTL = 0;
constexpr size_t WS_MOD = 1 * MiB;
constexpr size_t WS_WIN = 2 * MiB;
constexpr size_t WS_WOUT = 12 * MiB;
constexpr size_t WS_WUP = 16 * MiB;
constexpr size_t WS_WDN = 32 * MiB;
constexpr size_t WS_HN = 48 * MiB;
constexpr size_t WS_Q = 82 * MiB;
constexpr size_t WS_K = 108 * MiB;
constexpr size_t WS_V = 134 * MiB;
constexpr size_t WS_U = 160 * MiB;
constexpr size_t WS_MIX = 178 * MiB;
constexpr size_t WS_FP = 212 * MiB;
constexpr size_t WS_FS = 213 * MiB;
constexpr size_t WS_SS = 217 * MiB;
constexpr size_t WS_BIAS2 = WS_SS + 128 * 1024;
constexpr size_t WS_SH2 = WS_BIAS2 + 640 * 1024;
constexpr size_t WS_XA = 218 * MiB;
constexpr size_t WS_XB = 284 * MiB;
constexpr size_t WS_HID = 350 * MiB;
constexpr size_t WS_END = 482 * MiB;

constexpr int LDS_BYTES = 147456;
#ifndef DUP
#define DUP 0
#endif
#define NREP(k) (1 + ((DUP >> (k)) & 1))
#ifndef ATT_DUP_MODE
#define ATT_DUP_MODE 0
#endif

__device__ __forceinline__ unsigned f2bf(float f) { unsigned u = __builtin_bit_cast(unsigned, f); return (u + 0x7fffu + ((u >> 16) & 1u)) >> 16; }
typedef __bf16 bf16x2_t __attribute__((ext_vector_type(2)));
__device__ __forceinline__ unsigned pk2(float lo, float hi) { const f32x2 v = {lo, hi}; const bf16x2_t b = __builtin_convertvector(v, bf16x2_t); return __builtin_bit_cast(unsigned, b); }
template <int CTRL> __device__ __forceinline__ float dpp_f(float v) { return __builtin_bit_cast(float, __builtin_amdgcn_update_dpp(0, __builtin_bit_cast(int, v), CTRL, 0xF, 0xF, false)); }
__device__ __forceinline__ float quad_sum(float v) {
    auto a = __builtin_amdgcn_permlane16_swap(__float_as_uint(v), __float_as_uint(v), false, false);
    const float s = __uint_as_float(a[0]) + __uint_as_float(a[1]);
    auto b = __builtin_amdgcn_permlane32_swap(__float_as_uint(s), __float_as_uint(s), false, false);
    return __uint_as_float(b[0]) + __uint_as_float(b[1]);
}
__device__ __forceinline__ float wave_sum(float v) {
    v += dpp_f<0x128>(v); v += dpp_f<0x124>(v); v += dpp_f<0x122>(v); v += dpp_f<0x121>(v);
    return quad_sum(v);
}

__device__ __forceinline__ int vzero() { int z = 0; asm volatile("" : "+v"(z)); return z; }
__device__ __forceinline__ int fresh_tid() { int t = threadIdx.x; asm volatile("" : "+v"(t)); return t; }
namespace pg8 {
constexpr int BM = 256, BK = 64, HALF = 128, HTB = HALF * BK * 2, NXCD = 8, WGM = 8;
__host__ __device__ __forceinline__ int lds_byte(int r, int c) { const int st = (r >> 4) * 2 + (c >> 5), rr = r & 15, cc = c & 31, ob = rr * 64 + cc * 2; return st * 1024 + (ob ^ (((ob >> 9) & 1) << 5)); }
__host__ __device__ __forceinline__ void stage_rc(int b, int& R, int& C) { const int st = b / 1024, sb = b % 1024, swz = sb ^ (((sb >> 9) & 1) << 5); R = (st >> 1) * 16 + swz / 64; C = (st & 1) * 32 + (swz % 64) / 2; }
__host__ __device__ __forceinline__ int perm32(int rho) { const int n = rho >> 4, i = rho & 15; return 8 * (i >> 2) + 4 * n + (i & 3); }

struct Unit { int pm, pn; };
struct Gemm { const bf16_t* A; const bf16_t* Bt; int M, N, K; };

struct StaticOrder {
    int nM, nN, nwg, G, c;
    __device__ void init(int M_, int N_, int G_, int c_) { nM = M_ / BM; nN = N_ / BM; nwg = nM * nN; G = G_; c = c_; }
    __device__ bool next(int i, Unit& u) const {
        const long L = (long)i * G + c; if (L >= nwg) return false;
        int wgid = (int)L; { const int q = nwg / NXCD, r = nwg % NXCD, xcd = wgid % NXCD, off = wgid / NXCD; wgid = (xcd < r ? xcd * (q + 1) : r * (q + 1) + (xcd - r) * q) + off; }
        const int nig = WGM * nN, gid = wgid / nig, fm = gid * WGM, gsz = (nM - fm) < WGM ? (nM - fm) : WGM;
        u.pm = fm + ((wgid % nig) % gsz); u.pn = (wgid % nig) / gsz; return true;
    }
};

template <class Epi, bool ALIGN_EPI, bool SP2>
__device__ __forceinline__ void gemm_phase(LAS unsigned char* lds, const Gemm g, const StaticOrder& S, const Epi& E, const int tid) {
    const int wid = __builtin_amdgcn_readfirstlane(tid >> 6), lane = tid & 63, wr = wid >> 2, wc = wid & 3, fr = lane & 15, fq = lane >> 4;
    const int K = g.K, nt = K / BK;
    unsigned voffA[2], voffB[2];
#pragma unroll
    for (int i = 0; i < 2; ++i) { int R, C; stage_rc(tid * 16 + i * 8192, R, C); const int Rb = 64 * (R >> 5) + perm32(R & 31);
        voffA[i] = (unsigned)(R * K + C) * 2u; voffB[i] = (unsigned)(Rb * K + C) * 2u; }
    const size_t kstep = (size_t)(BK * 2);
    const size_t hstep = (size_t)HALF * K * 2;
    const size_t hstepB = (size_t)32 * K * 2;
    const size_t tstep = 2 * hstep;
    const unsigned ldsw = (unsigned)wid * 1024u;
    const int aoff = lds_byte(wr * 64 + fr, fq * 8), boff = lds_byte(wc * 32 + fr, fq * 8);
#define PG8_SA(b, h) (((b) * 2 + (h)) * HTB)
#define PG8_SB(b, h) ((4 + (b) * 2 + (h)) * HTB)
#define PG8_STAGE(bufoff, gbase, voff) do { _Pragma("unroll") for (int _i = 0; _i < 2; ++_i) \
        __builtin_amdgcn_global_load_lds((const unsigned*)((const char*)(gbase) + (voff)[_i]), (LAS unsigned*)(lds + (bufoff) + ldsw + _i * 8192), 16, 0, 0); } while (0)
#define PG8_LDA(dst, b, h) do { _Pragma("unroll") for (int m = 0; m < 4; ++m) _Pragma("unroll") for (int k = 0; k < 2; ++k) dst[m][k] = *(const LAS bf16x8*)(lds + PG8_SA(b, h) + aoff + m * 2048 + k * 1024); } while (0)
#define PG8_LDB(dst, b, h) do { _Pragma("unroll") for (int n = 0; n < 2; ++n) _Pragma("unroll") for (int k = 0; k < 2; ++k) dst[n][k] = *(const LAS bf16x8*)(lds + PG8_SB(b, h) + boff + n * 2048 + k * 1024); } while (0)
#define PG8_MMA(ai, bj, At, Bt) do { __builtin_amdgcn_s_setprio(1); _Pragma("unroll") for (int m = 0; m < 4; ++m) _Pragma("unroll") for (int n = 0; n < 2; ++n) _Pragma("unroll") for (int k = 0; k < 2; ++k) \
        acc[ai][bj][m][n] = __builtin_amdgcn_mfma_f32_16x16x32_bf16(Bt[n][k], At[m][k], acc[ai][bj][m][n], 0, 0, 0); __builtin_amdgcn_s_setprio(0); } while (0)
#define PG8_WAIT_V(n) asm volatile("s_waitcnt vmcnt(" #n ")" ::: "memory")
#define PG8_WAIT_L(n) asm volatile("s_waitcnt lgkmcnt(" #n ")" ::: "memory")
#define PG8_BAR __builtin_amdgcn_s_barrier()
#define PG8_SCHED __builtin_amdgcn_sched_barrier(0)
    Unit cur, nxt; int ui = 0;
    if (!S.next(0, cur)) return;
    f32x4 acc[2][2][4][2];
#pragma unroll
    for (int a = 0; a < 2; ++a)
#pragma unroll
        for (int b = 0; b < 2; ++b)
#pragma unroll
            for (int m = 0; m < 4; ++m)
#pragma unroll
                for (int n = 0; n < 2; ++n) acc[a][b][m][n] = (f32x4){0.f, 0.f, 0.f, 0.f};
    bf16x8 At[4][2], B0[2][2], B1[2][2];
    const char* cA = (const char*)g.A + (size_t)cur.pm * tstep; const char* cB = (const char*)g.Bt + (size_t)cur.pn * tstep;
    if constexpr (SP2) {
        PG8_STAGE(PG8_SB(0, 0), cB, voffB); PG8_STAGE(PG8_SB(0, 1), cB + hstepB, voffB); PG8_STAGE(PG8_SA(0, 0), cA, voffA); PG8_STAGE(PG8_SA(0, 1), cA + hstep, voffA);
        if (wr == 1) PG8_BAR;
        PG8_WAIT_V(2); PG8_BAR;
        PG8_STAGE(PG8_SB(1, 0), cB + kstep, voffB); PG8_STAGE(PG8_SA(1, 0), cA + kstep, voffA); PG8_STAGE(PG8_SB(1, 1), cB + hstepB + kstep, voffB);
        PG8_WAIT_V(6); PG8_BAR;
    } else {
    PG8_STAGE(PG8_SB(0, 0), cB, voffB); PG8_STAGE(PG8_SA(0, 0), cA, voffA); PG8_STAGE(PG8_SB(0, 1), cB + hstepB, voffB); PG8_STAGE(PG8_SA(0, 1), cA + hstep, voffA);
    if (wr == 1) PG8_BAR;
    PG8_WAIT_V(4); PG8_BAR;
    PG8_STAGE(PG8_SB(1, 0), cB + kstep, voffB); PG8_STAGE(PG8_SA(1, 0), cA + kstep, voffA); PG8_STAGE(PG8_SB(1, 1), cB + hstepB + kstep, voffB);
    PG8_WAIT_V(6); PG8_BAR;
    }
    for (;;) {
        const bool has_next = S.next(ui + 1, nxt);
        const char* nA = has_next ? (const char*)g.A + (size_t)nxt.pm * tstep : cA; const char* nB = has_next ? (const char*)g.Bt + (size_t)nxt.pn * tstep : cB;
        for (int t = 0; t < nt; t += 2) {
            const bool last = (t == nt - 2);
            const char* a1 = cA + (size_t)(t + 1) * kstep;
            const char* a2 = last ? nA : cA + (size_t)(t + 2) * kstep; const char* b2 = last ? nB : cB + (size_t)(t + 2) * kstep;
            const char* a3 = a2 + kstep; const char* b3 = b2 + kstep;
            if constexpr (SP2) {
            PG8_LDB(B0, 0, 0); PG8_LDB(B1, 0, 1); PG8_SCHED; PG8_LDA(At, 0, 0); PG8_STAGE(PG8_SA(1, 1), a1 + hstep, voffA);
            PG8_WAIT_V(8); PG8_WAIT_L(0); PG8_BAR; PG8_MMA(0, 0, At, B0); PG8_MMA(0, 1, At, B1); PG8_BAR; PG8_SCHED;
            PG8_LDA(At, 0, 1); PG8_STAGE(PG8_SB(0, 0), b2, voffB); PG8_STAGE(PG8_SB(0, 1), b2 + hstepB, voffB); PG8_STAGE(PG8_SA(0, 0), a2, voffA);
            PG8_WAIT_V(8); PG8_WAIT_L(0); PG8_BAR; PG8_MMA(1, 0, At, B0); PG8_MMA(1, 1, At, B1); PG8_BAR; PG8_SCHED;
            PG8_LDB(B0, 1, 0); PG8_LDB(B1, 1, 1); PG8_SCHED; PG8_LDA(At, 1, 0); PG8_STAGE(PG8_SA(0, 1), a2 + hstep, voffA);
            PG8_WAIT_V(8); PG8_WAIT_L(0); PG8_BAR; PG8_MMA(0, 0, At, B0); PG8_MMA(0, 1, At, B1); PG8_BAR; PG8_SCHED;
            PG8_LDA(At, 1, 1); PG8_STAGE(PG8_SB(1, 0), b3, voffB); PG8_STAGE(PG8_SB(1, 1), b3 + hstepB, voffB); PG8_STAGE(PG8_SA(1, 0), a3, voffA);
            PG8_WAIT_V(8); PG8_WAIT_L(0); PG8_BAR; PG8_MMA(1, 0, At, B0); PG8_MMA(1, 1, At, B1); PG8_BAR; PG8_SCHED;
            } else {
            PG8_LDB(B0, 0, 0); PG8_SCHED; PG8_LDA(At, 0, 0); PG8_STAGE(PG8_SA(1, 1), a1 + hstep, voffA);
            PG8_WAIT_L(8); PG8_BAR; PG8_WAIT_L(0); PG8_MMA(0, 0, At, B0); PG8_BAR; PG8_SCHED;
            PG8_LDB(B1, 0, 1); PG8_STAGE(PG8_SB(0, 0), b2, voffB);
            PG8_BAR; PG8_WAIT_L(0); PG8_MMA(0, 1, At, B1); PG8_BAR;
            PG8_LDA(At, 0, 1); PG8_STAGE(PG8_SA(0, 0), a2, voffA);
            PG8_BAR; PG8_WAIT_L(0); PG8_MMA(1, 0, At, B0); PG8_BAR; PG8_SCHED;
            PG8_STAGE(PG8_SB(0, 1), b2 + hstepB, voffB);
            PG8_WAIT_V(6); PG8_BAR; PG8_MMA(1, 1, At, B1); PG8_BAR;
            PG8_LDB(B0, 1, 0); PG8_SCHED; PG8_LDA(At, 1, 0); PG8_STAGE(PG8_SA(0, 1), a2 + hstep, voffA);
            PG8_WAIT_L(8); PG8_BAR; PG8_WAIT_L(0); PG8_MMA(0, 0, At, B0); PG8_BAR; PG8_SCHED;
            PG8_LDB(B1, 1, 1); PG8_STAGE(PG8_SB(1, 0), b3, voffB);
            PG8_BAR; PG8_WAIT_L(0); PG8_MMA(0, 1, At, B1); PG8_BAR;
            PG8_LDA(At, 1, 1); PG8_STAGE(PG8_SA(1, 0), a3, voffA);
            PG8_BAR; PG8_WAIT_L(0); PG8_MMA(1, 0, At, B0); PG8_BAR; PG8_SCHED;
            PG8_STAGE(PG8_SB(1, 1), b3 + hstepB, voffB);
            PG8_WAIT_V(6); PG8_BAR; PG8_MMA(1, 1, At, B1); PG8_BAR;
            }
        }
        if constexpr (ALIGN_EPI) { if (wr == 0) PG8_BAR; }
        E(acc, cur, wr, wc, fr, fq);
        if (!has_next) break;
#pragma unroll
        for (int a = 0; a < 2; ++a)
#pragma unroll
            for (int b = 0; b < 2; ++b)
#pragma unroll
                for (int m = 0; m < 4; ++m)
#pragma unroll
                    for (int n = 0; n < 2; ++n) acc[a][b][m][n] = (f32x4){0.f, 0.f, 0.f, 0.f};
        cur = nxt; cA = nA; cB = nB; ++ui;
        if constexpr (ALIGN_EPI) { if (wr == 1) PG8_BAR; }
    }
    PG8_WAIT_V(0);
    if constexpr (!ALIGN_EPI) { if (wr == 0) PG8_BAR; }
    PG8_BAR;
#undef PG8_SA
#undef PG8_SB
#undef PG8_STAGE
#undef PG8_LDA
#undef PG8_LDB
#undef PG8_MMA
#undef PG8_WAIT_V
#undef PG8_WAIT_L
#undef PG8_BAR
#undef PG8_SCHED
}
}

__device__ __forceinline__ void st_bf16x8(bf16_t* p, f32x4 a, f32x4 b) {
    u32x4 w; w.x = pk2(a[0], a[1]); w.y = pk2(a[2], a[3]); w.z = pk2(b[0], b[1]); w.w = pk2(b[2], b[3]);
    *(u32x4*)p = w;
}
__device__ __forceinline__ int brow_of(int r) { return r < MP ? (r >> 13) : 2 + ((r - MP) >> 4); }

struct EpiIn {
    int l; float* out; bf16_t* qb; bf16_t* kb; bf16_t* vb; float* ub; const float* qg; const float* kg;
    __device__ __forceinline__ void operator()(const f32x4 (&acc)[2][2][4][2], const pg8::Unit& u, int wr, int wc, int fr, int fq) const {
        const int pn = u.pn, rbase = u.pm * 256 + wr * 64 + fr;
        if (pn == 0) {
            const int cb = 64 * wc + 8 * fq;
#pragma unroll
            for (int ai = 0; ai < 2; ++ai)
#pragma unroll
                for (int m = 0; m < 4; ++m) {
                    const int r = rbase + ai * 128 + m * 16;
                    float* up = ub + (size_t)r * PW + cb;
                    float* sp = nullptr;
                    if (r < MP) { const int t = r & (T - 1); if (t >= T - 15) sp = out + OFF_PP + ((size_t)((l * NBP + (r >> 13)) * 15 + (t - (T - 15)))) * PW + cb; }
                    else { const int rr = r - MP, t = rr & 15; if (t >= 1) sp = out + OFF_PS + ((size_t)((l * SB + (rr >> 4)) * 15 + (t - 1))) * PW + cb; }
#pragma unroll
                    for (int bj = 0; bj < 2; ++bj) {
                        *(f32x4*)(up + 32 * bj) = acc[ai][bj][m][0]; *(f32x4*)(up + 32 * bj + 4) = acc[ai][bj][m][1];
                        if (sp) { *(f32x4*)(sp + 32 * bj) = acc[ai][bj][m][0]; *(f32x4*)(sp + 32 * bj + 4) = acc[ai][bj][m][1]; }
                    }
                }
        } else if (pn <= 6) {
            const bool isq = pn <= 3;
            const int head = ((pn - 1) % 3) * 4 + wc;
            const float* gp = (isq ? qg : kg) + 8 * fq;
            f32x4 gv[2][2];
#pragma unroll
            for (int bj = 0; bj < 2; ++bj)
#pragma unroll
                for (int n = 0; n < 2; ++n) gv[bj][n] = *(const f32x4*)(gp + 32 * bj + 4 * n);
            bf16_t* dst = isq ? qb : kb;
#pragma unroll
            for (int ai = 0; ai < 2; ++ai)
#pragma unroll
                for (int m = 0; m < 4; ++m) {
                    const int r = rbase + ai * 128 + m * 16;
                    float ss = 0.f;
#pragma unroll
                    for (int bj = 0; bj < 2; ++bj)
#pragma unroll
                        for (int n = 0; n < 2; ++n) { const f32x4 a = acc[ai][bj][m][n]; ss += (a[0] * a[0] + a[1] * a[1]) + (a[2] * a[2] + a[3] * a[3]); }
                    ss = quad_sum(ss);
                    float rinv = 1.0f / sqrtf(ss * (1.f / 64.f) + EPS);
                    const float rq = isq ? rinv * C2 : rinv;
                    float* ko = nullptr;
                    if (!isq) ko = out + (r < MP ? OFF_KP + ((size_t)l * MP + r) * AW : OFF_KS + ((size_t)l * MS + (r - MP)) * AW) + head * 64 + 8 * fq;
#pragma unroll
                    for (int bj = 0; bj < 2; ++bj) {
                        const f32x4 n0 = acc[ai][bj][m][0] * rinv * gv[bj][0], n1 = acc[ai][bj][m][1] * rinv * gv[bj][1];
                        if (isq) { const f32x4 s0 = acc[ai][bj][m][0] * rq * gv[bj][0], s1 = acc[ai][bj][m][1] * rq * gv[bj][1];
                            st_bf16x8(dst + (size_t)r * AW + head * 64 + 32 * bj + 8 * fq, s0, s1); }
                        else { st_bf16x8(dst + (size_t)r * AW + head * 64 + 32 * bj + 8 * fq, n0, n1);
                            *(f32x4*)(ko + 32 * bj) = n0; *(f32x4*)(ko + 32 * bj + 4) = n1; }
                    }
                }
        } else {
            const int head = (pn - 7) * 4 + wc;
#pragma unroll
            for (int ai = 0; ai < 2; ++ai)
#pragma unroll
                for (int m = 0; m < 4; ++m) {
                    const int r = rbase + ai * 128 + m * 16;
                    float* vo = out + (r < MP ? OFF_VP + ((size_t)l * MP + r) * AW : OFF_VS + ((size_t)l * MS + (r - MP)) * AW) + head * 64 + 8 * fq;
#pragma unroll
                    for (int bj = 0; bj < 2; ++bj) {
                        st_bf16x8(vb + (size_t)r * AW + head * 64 + 32 * bj + 8 * fq, acc[ai][bj][m][0], acc[ai][bj][m][1]);
                        *(f32x4*)(vo + 32 * bj) = acc[ai][bj][m][0]; *(f32x4*)(vo + 32 * bj + 4) = acc[ai][bj][m][1];
                    }
                }
        }
    }
};

struct EpiRes {
    const float* xip; const float* xis; float* xop; float* xos; const float* gate;
    __device__ __forceinline__ void operator()(const f32x4 (&acc)[2][2][4][2], const pg8::Unit& u, int wr, int wc, int fr, int fq) const {
        const int rbase = u.pm * 256 + wr * 64 + fr, cb = u.pn * 256 + 64 * wc + 8 * fq;
        const float* gp = gate + (size_t)((u.pm * 256) >> 13) * MODW + cb;
        constexpr int DEPTH = 3;
        f32x4 gg[2][2], xq[DEPTH][2][2];
#pragma unroll
        for (int bj = 0; bj < 2; ++bj)
#pragma unroll
            for (int n = 0; n < 2; ++n) gg[bj][n] = *(const f32x4*)(gp + 32 * bj + 4 * n);
#pragma unroll
        for (int d = 0; d < DEPTH; ++d) { const int r2 = rbase + (d >> 2) * 128 + (d & 3) * 16;
#pragma unroll
            for (int bj = 0; bj < 2; ++bj)
#pragma unroll
                for (int n = 0; n < 2; ++n) xq[d][bj][n] = *(const f32x4*)(xip + (size_t)r2 * D + cb + 32 * bj + 4 * n); }
#pragma unroll
        for (int it = 0; it < 8; ++it) {
            const int ai = it >> 2, m = it & 3, r = rbase + ai * 128 + m * 16;
            f32x4 xc[2][2];
#pragma unroll
            for (int bj = 0; bj < 2; ++bj)
#pragma unroll
                for (int n = 0; n < 2; ++n) xc[bj][n] = xq[it % DEPTH][bj][n];
            if (it + DEPTH < 8) { const int r2 = rbase + ((it + DEPTH) >> 2) * 128 + ((it + DEPTH) & 3) * 16;
#pragma unroll
                for (int bj = 0; bj < 2; ++bj)
#pragma unroll
                    for (int n = 0; n < 2; ++n) xq[it % DEPTH][bj][n] = *(const f32x4*)(xip + (size_t)r2 * D + cb + 32 * bj + 4 * n); }
            float* xo = xop + (size_t)r * D + cb;
#pragma unroll
            for (int bj = 0; bj < 2; ++bj)
#pragma unroll
                for (int n = 0; n < 2; ++n) *(f32x4*)(xo + 32 * bj + 4 * n) = xc[bj][n] + gg[bj][n] * acc[ai][bj][m][n];
            __builtin_amdgcn_sched_barrier(0);
        }
    }
};

struct EpiUp {
    bf16_t* hid;
    __device__ __forceinline__ void operator()(const f32x4 (&acc)[2][2][4][2], const pg8::Unit& u, int wr, int wc, int fr, int fq) const {
        const int rbase = u.pm * 256 + wr * 64 + fr, cb = u.pn * 256 + 64 * wc + 8 * fq;
#pragma unroll
        for (int ai = 0; ai < 2; ++ai)
#pragma unroll
            for (int m = 0; m < 4; ++m) {
                const int r = rbase + ai * 128 + m * 16;
#pragma unroll
                for (int bj = 0; bj < 2; ++bj) {
                    f32x4 a = acc[ai][bj][m][0], b = acc[ai][bj][m][1];
#pragma unroll
                    for (int j = 0; j < 4; ++j) { const float x = fmaxf(a[j], 0.f), y = fmaxf(b[j], 0.f); a[j] = x * x; b[j] = y * y; }
                    st_bf16x8(hid + (size_t)r * FF + cb + 32 * bj, a, b);
                }
            }
    }
};

template <class SEpi>
__device__ __forceinline__ void skinny_phase(LAS unsigned char* lds, const bf16_t* A, const bf16_t* Bt, int N, int K, const SEpi& E, int tid, int lane, int wave, int row0 = MP, int nrg = 16) {
    const int l16 = lane & 15, quad = lane >> 4;
    const int nr2 = nrg >> 1, nitems = nr2 * (N / 64);
    LAS float* red = (LAS float*)lds;
    const int kw = K / 8;
    const int G_ = (int)gridDim.x, b_ = (int)blockIdx.x;
    const int vb = (G_ % 8 == 0 && nr2 == 8 && nitems <= 2 * G_ && nitems != 320) ? (b_ % 8) * (G_ / 8) + b_ / 8 : G_ - 1 - b_;
    for (int it = vb; it < nitems; it += G_) {
        const int rg2 = it % nr2, cg = it / nr2;
        const bf16_t* ap = A + (size_t)(row0 + 32 * rg2 + l16) * K + wave * kw + quad * 8;
        const bf16_t* bp = Bt + (size_t)(cg * 64 + l16) * K + wave * kw + quad * 8;
        f32x4 acc[2][4];
#pragma unroll
        for (int h = 0; h < 2; ++h)
#pragma unroll
            for (int nt = 0; nt < 4; ++nt) acc[h][nt] = (f32x4){0.f, 0.f, 0.f, 0.f};
        for (int k0 = 0; k0 < kw; k0 += 128) {
            bf16x8 a0[4], a1[4], b[4][4];
#pragma unroll
            for (int s = 0; s < 4; ++s) {
                a0[s] = *(const bf16x8*)(ap + k0 + 32 * s); a1[s] = *(const bf16x8*)(ap + (size_t)16 * K + k0 + 32 * s);
#pragma unroll
                for (int nt = 0; nt < 4; ++nt) b[s][nt] = *(const bf16x8*)(bp + (size_t)nt * 16 * K + k0 + 32 * s);
            }
#pragma unroll
            for (int s = 0; s < 4; ++s)
#pragma unroll
                for (int nt = 0; nt < 4; ++nt) { acc[0][nt] = __builtin_amdgcn_mfma_f32_16x16x32_bf16(a0[s], b[s][nt], acc[0][nt], 0, 0, 0);
                    acc[1][nt] = __builtin_amdgcn_mfma_f32_16x16x32_bf16(a1[s], b[s][nt], acc[1][nt], 0, 0, 0); }
        }
#pragma unroll
        for (int h = 0; h < 2; ++h)
#pragma unroll
            for (int nt = 0; nt < 4; ++nt)
#pragma unroll
                for (int r = 0; r < 4; ++r) red[(wave * 32 + 16 * h + quad * 4 + r) * 64 + 16 * nt + l16] = acc[h][nt][r];
        __syncthreads();
        const int row = tid >> 5, c2 = (tid & 31) * 2;
#pragma unroll
        for (int h = 0; h < 2; ++h) {
            float v0 = 0.f, v1 = 0.f;
#pragma unroll
            for (int w = 0; w < 8; ++w) { const f32x2 t = *(const LAS f32x2*)(red + (w * 32 + 16 * h + row) * 64 + c2); v0 += t.x; v1 += t.y; }
            E(2 * rg2 + h, row, cg, c2, v0, v1);
        }
        __syncthreads();
    }
}

struct SEpiIn {
    int l; float* out; bf16_t* qb; bf16_t* kb; bf16_t* vb; float* ub; const float* qg; const float* kg;
    __device__ __forceinline__ void operator()(int b, int t, int cg, int c2, float v0, float v1) const {
        const int rr = 16 * b + t; const size_t r = (size_t)MP + rr;
        if (cg < 4) {
            const int c = cg * 64 + c2;
            *(f32x2*)(ub + r * PW + c) = (f32x2){v0, v1};
            if (t >= 1) *(f32x2*)(out + OFF_PS + ((size_t)((l * SB + b) * 15 + (t - 1))) * PW + c) = (f32x2){v0, v1};
        } else if (cg < 28) {
            const bool isq = cg < 16; const int head = isq ? cg - 4 : cg - 16;
            float ss = v0 * v0 + v1 * v1;
#pragma unroll
            for (int o = 1; o < 32; o <<= 1) ss += __shfl_xor(ss, o);
            const float rinv = 1.0f / sqrtf(ss * (1.f / 64.f) + EPS);
            const float* gp = (isq ? qg : kg) + c2;
            const float n0 = v0 * rinv * gp[0], n1 = v1 * rinv * gp[1];
            if (isq) *(unsigned*)(qb + r * AW + head * 64 + c2) = pk2(n0 * C2, n1 * C2);
            else { *(unsigned*)(kb + r * AW + head * 64 + c2) = pk2(n0, n1); *(f32x2*)(out + OFF_KS + ((size_t)l * MS + rr) * AW + head * 64 + c2) = (f32x2){n0, n1}; }
        } else {
            const int head = cg - 28;
            *(unsigned*)(vb + r * AW + head * 64 + c2) = pk2(v0, v1);
            *(f32x2*)(out + OFF_VS + ((size_t)l * MS + rr) * AW + head * 64 + c2) = (f32x2){v0, v1};
        }
    }
};
struct SEpiRes {
    const float* xis; float* xos; const float* gate;
    __device__ __forceinline__ void operator()(int b, int t, int cg, int c2, float v0, float v1) const {
        const size_t o = (size_t)(16 * b + t) * D + cg * 64 + c2;
        const f32x2 xv = *(const f32x2*)(xis + o), gg = *(const f32x2*)(gate + (size_t)(2 + b) * MODW + cg * 64 + c2);
        *(f32x2*)(xos + o) = (f32x2){xv.x + gg.x * v0, xv.y + gg.y * v1};
    }
};
struct SEpiUp {
    bf16_t* hid;
    __device__ __forceinline__ void operator()(int b, int t, int cg, int c2, float v0, float v1) const {
        const float x = fmaxf(v0, 0.f), y = fmaxf(v1, 0.f);
        *(unsigned*)(hid + ((size_t)MP + 16 * b + t) * FF + cg * 64 + c2) = pk2(x * x, y * y);
    }
};


struct EpiResN {
    const float* xip; float* xop; const float* gate; const float* sc2; bf16_t* xt; float* ss;
    __device__ __forceinline__ void operator()(const f32x4 (&acc)[2][2][4][2], const pg8::Unit& u, int wr, int wc, int fr, int fq) const {
        const int rbase = u.pm * 256 + wr * 64 + fr, cb = u.pn * 256 + 64 * wc + 8 * fq;
        const int brow = (u.pm * 256) >> 13;
        const float* gp = gate + (size_t)brow * MODW + cb; const float* sp = sc2 + (size_t)brow * MODW + cb;
        constexpr int DEPTH = 2;
        f32x4 gg[2][2], sv[2][2], xq[DEPTH][2][2];
#pragma unroll
        for (int bj = 0; bj < 2; ++bj)
#pragma unroll
            for (int n = 0; n < 2; ++n) { gg[bj][n] = *(const f32x4*)(gp + 32 * bj + 4 * n); sv[bj][n] = *(const f32x4*)(sp + 32 * bj + 4 * n) + 1.0f; }
#pragma unroll
        for (int d = 0; d < DEPTH; ++d) { const int r2 = rbase + (d >> 2) * 128 + (d & 3) * 16;
#pragma unroll
            for (int bj = 0; bj < 2; ++bj)
#pragma unroll
                for (int n = 0; n < 2; ++n) xq[d][bj][n] = *(const f32x4*)(xip + (size_t)r2 * D + cb + 32 * bj + 4 * n); }
#pragma unroll
        for (int it = 0; it < 8; ++it) {
            const int ai = it >> 2, m = it & 3, r = rbase + ai * 128 + m * 16;
            f32x4 xc[2][2];
#pragma unroll
            for (int bj = 0; bj < 2; ++bj)
#pragma unroll
                for (int n = 0; n < 2; ++n) xc[bj][n] = xq[it % DEPTH][bj][n];
            if (it + DEPTH < 8) { const int r2 = rbase + ((it + DEPTH) >> 2) * 128 + ((it + DEPTH) & 3) * 16;
#pragma unroll
                for (int bj = 0; bj < 2; ++bj)
#pragma unroll
                    for (int n = 0; n < 2; ++n) xq[it % DEPTH][bj][n] = *(const f32x4*)(xip + (size_t)r2 * D + cb + 32 * bj + 4 * n); }
            float* xo = xop + (size_t)r * D + cb;
            float s = 0.f;
#pragma unroll
            for (int bj = 0; bj < 2; ++bj) {
                f32x4 t[2];
#pragma unroll
                for (int n = 0; n < 2; ++n) {
                    const f32x4 x1 = xc[bj][n] + gg[bj][n] * acc[ai][bj][m][n];
                    *(f32x4*)(xo + 32 * bj + 4 * n) = x1;
                    s += (x1[0] * x1[0] + x1[1] * x1[1]) + (x1[2] * x1[2] + x1[3] * x1[3]);
                    t[n] = x1 * sv[bj][n];
                }
                st_bf16x8(xt + (size_t)r * D + cb + 32 * bj, t[0], t[1]);
            }
            s = quad_sum(s);
            if (fq == 0) atomicAdd(ss + r, s);
            __builtin_amdgcn_sched_barrier(0);
        }
    }
};
struct SEpiResN {
    const float* xis; float* xos; const float* gate; const float* sc2; bf16_t* xt; float* ss;
    __device__ __forceinline__ void operator()(int b, int t, int cg, int c2, float v0, float v1) const {
        const int rr = 16 * b + t; const size_t o = (size_t)rr * D + cg * 64 + c2;
        const f32x2 xv = *(const f32x2*)(xis + o), gg = *(const f32x2*)(gate + (size_t)(2 + b) * MODW + cg * 64 + c2), sv = *(const f32x2*)(sc2 + (size_t)(2 + b) * MODW + cg * 64 + c2);
        const float a0 = xv.x + gg.x * v0, a1 = xv.y + gg.y * v1;
        *(f32x2*)(xos + o) = (f32x2){a0, a1};
        *(unsigned*)(xt + ((size_t)MP + rr) * D + cg * 64 + c2) = pk2(a0 * (sv.x + 1.0f), a1 * (sv.y + 1.0f));
        float s = a0 * a0 + a1 * a1;
#pragma unroll
        for (int q = 1; q < 32; q <<= 1) s += __shfl_xor(s, q);
        if ((c2 >> 1) == 0) atomicAdd(ss + MP + rr, s);
    }
};
struct EpiUpN {
    bf16_t* hid; const float* ss; const float* bias;
    __device__ __forceinline__ void operator()(const f32x4 (&acc)[2][2][4][2], const pg8::Unit& u, int wr, int wc, int fr, int fq) const {
        const int rbase = u.pm * 256 + wr * 64 + fr, cb = u.pn * 256 + 64 * wc + 8 * fq;
        const float* bp = bias + (size_t)((u.pm * 256) >> 13) * FF + cb;
        f32x4 bv[2][2];
#pragma unroll
        for (int bj = 0; bj < 2; ++bj)
#pragma unroll
            for (int n = 0; n < 2; ++n) bv[bj][n] = *(const f32x4*)(bp + 32 * bj + 4 * n);
#pragma unroll
        for (int ai = 0; ai < 2; ++ai)
#pragma unroll
            for (int m = 0; m < 4; ++m) {
                const int r = rbase + ai * 128 + m * 16;
                const float rinv = 1.0f / sqrtf(ss[r] * (1.f / D) + EPS);
#pragma unroll
                for (int bj = 0; bj < 2; ++bj) {
                    f32x4 a = acc[ai][bj][m][0] * rinv + bv[bj][0], b = acc[ai][bj][m][1] * rinv + bv[bj][1];
#pragma unroll
                    for (int j = 0; j < 4; ++j) { const float x = fmaxf(a[j], 0.f), y = fmaxf(b[j], 0.f); a[j] = x * x; b[j] = y * y; }
                    st_bf16x8(hid + (size_t)r * FF + cb + 32 * bj, a, b);
                }
            }
    }
};
struct SEpiUpN {
    bf16_t* hid; const float* ss; const float* bias;
    __device__ __forceinline__ void operator()(int b, int t, int cg, int c2, float v0, float v1) const {
        const int r = MP + 16 * b + t;
        const float rinv = 1.0f / sqrtf(ss[r] * (1.f / D) + EPS);
        const f32x2 bb = *(const f32x2*)(bias + (size_t)(2 + b) * FF + cg * 64 + c2);
        const float x = fmaxf(v0 * rinv + bb.x, 0.f), y = fmaxf(v1 * rinv + bb.y, 0.f);
        *(unsigned*)(hid + (size_t)r * FF + cg * 64 + c2) = pk2(x * x, y * y);
    }
};
struct SEpiBias {
    float* bias;
    __device__ __forceinline__ void operator()(int rg, int t, int cg, int c2, float v0, float v1) const {
        const int row = 16 * rg + t;
        if (row < NMODROW) *(f32x2*)(bias + (size_t)row * FF + cg * 64 + c2) = (f32x2){v0, v1};
    }
};

struct Params { const float* in[19]; float* out; unsigned char* ws; };

__device__ __forceinline__ void transpose_item(const float* W, int ldw, int K, int nblk, bf16_t* WT, LAS float* scr, int item, int lane) {
    const int kb = item / nblk, nb = item % nblk, k0 = 64 * kb, n0 = 32 * nb;
    float tv[32];
#pragma unroll
    for (int i = 0; i < 32; ++i) tv[i] = W[(size_t)(k0 + 2 * i + (lane >> 5)) * ldw + n0 + (lane & 31)];
#pragma unroll
    for (int i = 0; i < 32; ++i) scr[(2 * i + (lane >> 5)) * 33 + (lane & 31)] = tv[i];
    asm volatile("s_waitcnt lgkmcnt(0)" ::: "memory");
    const int c = lane & 7;
#pragma unroll
    for (int j = 0; j < 4; ++j) { const int n = (lane >> 3) + 8 * j; const LAS float* s = scr + (8 * c) * 33 + n;
        u32x4 o; o.x = pk2(s[0 * 33], s[1 * 33]); o.y = pk2(s[2 * 33], s[3 * 33]); o.z = pk2(s[4 * 33], s[5 * 33]); o.w = pk2(s[6 * 33], s[7 * 33]);
        *(u32x4*)(WT + (size_t)(n0 + n) * K + k0 + 8 * c) = o; }
    asm volatile("s_waitcnt lgkmcnt(0)" ::: "memory");
}

__device__ __forceinline__ void phase_prologue(const Params& p, LAS unsigned char* lds, int tid, int lane, int wave) {
    LAS float* sc = (LAS float*)lds;
    LAS float* red = (LAS float*)(lds + 73728);
    for (int idx = tid; idx < NMODROW * D; idx += 512) {
        const int r = idx >> 10, k = idx & 1023;
        const float c = (r < 2) ? p.in[2][r * D + k] : p.in[3][(r - 2) * D + k];
        sc[k * 18 + r] = c / (1.f + __expf(-c));
    }
    __syncthreads();
    float* modw = (float*)(p.ws + WS_MOD);
    for (int it = blockIdx.x; it < 256; it += gridDim.x) {
        const int l = it >> 7, col0 = (it & 127) * 48;
        const int la = lane < 48 ? lane : 47, kk2 = la / 24, c2 = la % 24;
        const float* W = p.in[8] + (size_t)l * D * MODW + col0 + 2 * c2;
        float acc[18][2];
#pragma unroll
        for (int r = 0; r < 18; ++r) { acc[r][0] = 0.f; acc[r][1] = 0.f; }
        const int kb = wave * 128 + kk2;
#pragma unroll 16
        for (int i = 0; i < 64; ++i) {
            const int k = kb + 2 * i;
            const f32x2 wv = *(const f32x2*)(W + (size_t)k * MODW);
            const LAS f32x2* s2 = (const LAS f32x2*)(sc + k * 18);
#pragma unroll
            for (int r2 = 0; r2 < 9; ++r2) { const f32x2 s = s2[r2];
                acc[2 * r2][0] += s.x * wv.x; acc[2 * r2][1] += s.x * wv.y; acc[2 * r2 + 1][0] += s.y * wv.x; acc[2 * r2 + 1][1] += s.y * wv.y; }
        }
        if (lane < 48) {
#pragma unroll
            for (int r = 0; r < 18; ++r) { red[((wave * 2 + kk2) * 18 + r) * 48 + 2 * c2] = acc[r][0]; red[((wave * 2 + kk2) * 18 + r) * 48 + 2 * c2 + 1] = acc[r][1]; }
        }
        __syncthreads();
        for (int idx = tid; idx < 18 * 48; idx += 512) {
            const int r = idx / 48, c = idx % 48;
            float s = p.in[9][l * MODW + col0 + c];
#pragma unroll
            for (int w = 0; w < 16; ++w) s += red[(w * 18 + r) * 48 + c];
            modw[((size_t)l * NMODROW + r) * MODW + col0 + c] = s;
        }
        __syncthreads();
    }
    LAS float* scr = (LAS float*)(lds + 73728 + wave * 8448);
    const int gw = blockIdx.x * 8 + wave, NGW = gridDim.x * 8;
    constexpr int I_IN = 16 * 80, I_OUT = 16 * 32, I_UP = 16 * 128, I_DN = 64 * 32, I_L = I_IN + I_OUT + I_UP + I_DN;
    for (int it = gw; it < 2 * I_L; it += NGW) {
        const int l = it / I_L; int r = it % I_L;
        if (r < I_IN) { transpose_item(p.in[10] + (size_t)l * D * INC, INC, D, 80, (bf16_t*)(p.ws + WS_WIN) + (size_t)l * NMAIN * D, scr, r, lane); continue; } r -= I_IN;
        if (r < I_OUT) { transpose_item(p.in[16] + (size_t)l * D * D, D, D, 32, (bf16_t*)(p.ws + WS_WOUT) + (size_t)l * D * D, scr, r, lane); continue; } r -= I_OUT;
        if (r < I_UP) { transpose_item(p.in[17] + (size_t)l * D * FF, FF, D, 128, (bf16_t*)(p.ws + WS_WUP) + (size_t)l * FF * D, scr, r, lane); continue; } r -= I_UP;
        transpose_item(p.in[18] + (size_t)l * FF * D, D, FF, 32, (bf16_t*)(p.ws + WS_WDN) + (size_t)l * D * FF, scr, r, lane);
    }
}

__device__ __forceinline__ void phase_norm(const Params& p, LAS unsigned char* lds, int l, int stage, const float* xp, const float* xs, int tid, int lane, int wave) {
    constexpr int HP = 1032;
    LAS bf16_t* wfb = (LAS bf16_t*)lds;
    LAS bf16_t* ht = (LAS bf16_t*)(lds + 33280);
    LAS float* pc = (LAS float*)(lds + 66560);
    {
        const float* W = p.in[10] + (size_t)l * D * INC + NMAIN;
        for (int idx = tid; idx < 16 * D; idx += 512) { const int k = idx >> 4, hh = idx & 15; wfb[hh * HP + k] = (bf16_t)f2bf(hh < NH ? W[(size_t)k * INC + hh] : 0.f); }
        float* SS = (float*)(p.ws + WS_SS);
        for (int i = blockIdx.x * 512 + tid; i < M; i += gridDim.x * 512) SS[i] = 0.f;
        if (l == 0) {
            bf16_t* s2 = (bf16_t*)(p.ws + WS_SH2); const float* modall = (const float*)(p.ws + WS_MOD);
            for (int i = blockIdx.x * 512 + tid; i < 2 * 32 * D; i += gridDim.x * 512) { const int ll = i >> 15, row = (i >> 10) & 31, k = i & 1023;
                s2[i] = (bf16_t)f2bf(row < NMODROW ? modall[((size_t)ll * NMODROW + row) * MODW + 3 * D + k] : 0.f); }
        }
    }
    __syncthreads();
    const float* modl = (const float*)(p.ws + WS_MOD) + (size_t)l * NMODROW * MODW;
    bf16_t* hn = (bf16_t*)(p.ws + WS_HN);
    const int l16 = lane & 15, quad = lane >> 4;
    const int rpb = (M + (int)gridDim.x - 1) / (int)gridDim.x, R0 = (int)blockIdx.x * rpb, R1 = (R0 + rpb < M) ? R0 + rpb : M;
    for (int g0 = R0; g0 < R1; g0 += 16) {
#pragma unroll
        for (int rr = 0; rr < 2; ++rr) {
            const int lr = 2 * wave + rr, m = g0 + lr;
            LAS unsigned long long* h8 = (LAS unsigned long long*)(ht + lr * HP) + lane;
            if (m < R1) {
                const f32x4* xr = (const f32x4*)(m < MP ? xp + (size_t)m * D : xs + (size_t)(m - MP) * D) + lane;
                f32x4 v[4]; float ss = 0.f;
#pragma unroll
                for (int j = 0; j < 4; ++j) { v[j] = xr[64 * j]; ss += (v[j].x * v[j].x + v[j].y * v[j].y) + (v[j].z * v[j].z + v[j].w * v[j].w); }
                ss = wave_sum(ss);
                const float rinv = 1.0f / sqrtf(ss * (1.f / D) + EPS);
                const float* mrow = modl + (size_t)brow_of(m) * MODW;
                const f32x4* sh4 = (const f32x4*)mrow + lane; const f32x4* sc4 = (const f32x4*)(mrow + D) + lane;
                unsigned long long* o8 = (unsigned long long*)(hn + (size_t)m * D) + lane;
#pragma unroll
                for (int j = 0; j < 4; ++j) {
                    const f32x4 shv = sh4[64 * j], scv = sc4[64 * j];
                    v[j] = v[j] * rinv * (scv + 1.0f) + shv;
                    const unsigned long long w = (unsigned long long)pk2(v[j].x, v[j].y) | ((unsigned long long)pk2(v[j].z, v[j].w) << 32);
                    o8[64 * j] = w; h8[64 * j] = w;
                }
            } else {
#pragma unroll
                for (int j = 0; j < 4; ++j) h8[64 * j] = 0ull;
            }
        }
        __syncthreads();
        {
            f32x4 c = (f32x4){0.f, 0.f, 0.f, 0.f};
#pragma unroll
            for (int s = 0; s < 4; ++s) {
                const int k0 = 32 * (4 * wave + s) + 8 * quad;
                const bf16x8 a = *(const LAS bf16x8*)(ht + l16 * HP + k0), b = *(const LAS bf16x8*)(wfb + l16 * HP + k0);
                c = __builtin_amdgcn_mfma_f32_16x16x32_bf16(a, b, c, 0, 0, 0);
            }
#pragma unroll
            for (int r = 0; r < 4; ++r) pc[(wave * 16 + quad * 4 + r) * 16 + l16] = c[r];
        }
        __syncthreads();
        if (tid < 16 * NH) {
            const int row = tid / NH, hh = tid % NH, m = g0 + row;
            if (m < R1) {
                float x = p.in[11][l * NH + hh];
#pragma unroll
                for (int w = 0; w < 8; ++w) x += pc[(w * 16 + row) * 16 + hh];
                const float lf = fminf(x, 0.f) - log1pf(expf(-fabsf(x)));
                float* o = p.out + (m < MP ? OFF_FP + ((size_t)l * MP + m) * NH : OFF_FS + ((size_t)l * MS + (m - MP)) * NH);
                o[hh] = lf;
            }
        }
    }
}

__device__ __forceinline__ float block_scan_offset(float total, LAS float* sm, int lane, int wave) {
    float x = total;
#pragma unroll
    for (int o = 1; o < 64; o <<= 1) { const float n = __shfl_up(x, o); if (lane >= o) x += n; }
    __syncthreads();
    if (lane == 63) sm[wave] = x;
    __syncthreads();
    float off = x - total;
    for (int w = 0; w < wave; ++w) off += sm[w];
    return off;
}

__device__ __forceinline__ void scan_items(const Params& p, LAS unsigned char* lds, int l, int tid, int lane, int wave) {
    LAS float* sm = (LAS float*)(lds + 65536);
    float* Fp = (float*)(p.ws + WS_FP); float* Fs = (float*)(p.ws + WS_FS);
    const int nb = (int)gridDim.x / 2;
    if ((int)blockIdx.x < (int)gridDim.x - nb) return;
    for (int it = (int)(gridDim.x - 1 - blockIdx.x); it < 24 + 192; it += nb) {
        if (it < 24) {
            const int b = it / NH, h = it % NH;
            const float* src = p.out + OFF_FP + ((size_t)(l * NBP + b) * T) * NH + h;
            const int t0 = tid * 16;
            float v[16]; float run = 0.f;
#pragma unroll
            for (int e = 0; e < 16; ++e) { run += src[(size_t)(t0 + e) * NH]; v[e] = run; }
            const float off = block_scan_offset(run, sm, lane, wave);
            float* dst = Fp + (size_t)it * T + t0;
#pragma unroll
            for (int e = 0; e < 16; e += 4) *(f32x4*)(dst + e) = (f32x4){(off + v[e]) * LOG2E, (off + v[e + 1]) * LOG2E, (off + v[e + 2]) * LOG2E, (off + v[e + 3]) * LOG2E};
        } else {
            const int bh = it - 24, b = bh / NH, h = bh % NH;
            const float* src = p.in[6] + ((size_t)(l * SB + b) * PAST) * NH + h;
            const int t0 = tid * 8;
            float v[8]; float run = 0.f;
#pragma unroll
            for (int e = 0; e < 8; ++e) { run += src[(size_t)(t0 + e) * NH]; v[e] = run; }
            const float off = block_scan_offset(run, sm, lane, wave);
            float* dst = Fs + (size_t)bh * SKEYS + t0;
#pragma unroll
            for (int e = 0; e < 8; e += 4) *(f32x4*)(dst + e) = (f32x4){(off + v[e]) * LOG2E, (off + v[e + 1]) * LOG2E, (off + v[e + 2]) * LOG2E, (off + v[e + 3]) * LOG2E};
            if (tid == 511) sm[8] = off + run;
            __syncthreads();
            if (tid < ST) {
                const float* ns = p.out + OFF_FS + ((size_t)(l * SB + b) * ST) * NH + h;
                float s = sm[8];
                for (int e = 0; e <= tid; ++e) s += ns[e * NH];
                Fs[(size_t)bh * SKEYS + PAST + tid] = s * LOG2E;
            }
        }
        __syncthreads();
    }
}

__device__ __forceinline__ void pool_items(const Params& p, LAS unsigned char* lds, int l, unsigned* ctr, LAS unsigned* slot, int tid, int lane, int wave) {
    LAS float* z = (LAS float*)lds;
    LAS bf16_t* am = (LAS bf16_t*)(lds + 81920);
    const float* ub = (const float*)(p.ws + WS_U);
    bf16_t* mix = (bf16_t*)(p.ws + WS_MIX);
    const int g = wave >> 1, ntp = (wave & 1) * 2, l16 = lane & 15, quad = lane >> 4;
    bf16x8 bw[2][2];
    {
        const float* wp = p.in[14] + ((size_t)(l * 4 + g) * 64) * 64;
#pragma unroll
        for (int nt = 0; nt < 2; ++nt)
#pragma unroll
            for (int ks = 0; ks < 2; ++ks) {
                bf16x8 t;
#pragma unroll
                for (int j = 0; j < 8; ++j) t[j] = (short)f2bf(wp[(size_t)(32 * ks + 8 * quad + j) * 64 + 16 * (ntp + nt) + l16]);
                bw[nt][ks] = t;
            }
    }
    for (;;) {
      if (tid == 0) *slot = atomicAdd(ctr, 1u);
      __syncthreads();
      const int ent = (int)*slot;
      __syncthreads();
      if (ent >= MP / 64 + MS / 16) break;
      const bool prm = ent < MP / 64;
      const int row0 = prm ? ent * 64 : MP + (ent - MP / 64) * 16;
      const int nr = prm ? 4 : 1, nz = 15 + 16 * nr;
      const int t0 = prm ? (row0 & (T - 1)) : 0;
      for (int idx = tid; idx < nz * 64; idx += 512) {
          const int zr = idx >> 6, c4 = (idx & 63) * 4;
          f32x4 val = (f32x4){0.f, 0.f, 0.f, 0.f};
          if (zr >= 15) val = *(const f32x4*)(ub + (size_t)(row0 + zr - 15) * PW + c4);
          else if (prm) { if (t0 > 0) val = *(const f32x4*)(ub + (size_t)(row0 + zr - 15) * PW + c4); }
          else val = *(const f32x4*)(p.in[7] + ((size_t)(l * SB + ((row0 - MP) >> 4)) * 15 + zr) * PW + c4);
          *(LAS f32x4*)(z + zr * 256 + c4) = val;
      }
      __syncthreads();
      for (int i = 0; i < nr; ++i) {
          const int row = (tid >> 5) + 16 * i, c0 = (tid & 31) * 8, gg = c0 >> 6, w = 2 << gg;
          f32x4 s0 = (f32x4){0.f, 0.f, 0.f, 0.f}, s1 = s0;
          for (int j = 0; j < w; ++j) { s0 += *(const LAS f32x4*)(z + (15 + row - j) * 256 + c0); s1 += *(const LAS f32x4*)(z + (15 + row - j) * 256 + c0 + 4); }
          float cnt = (float)w;
          if (prm) { const float pos1 = (float)(t0 + row + 1); cnt = fminf(pos1, cnt); }
          const float ic = 1.0f / cnt;
          const f32x4 u0 = *(const LAS f32x4*)(z + (15 + row) * 256 + c0), u1 = *(const LAS f32x4*)(z + (15 + row) * 256 + c0 + 4);
          s0 = s0 * ic - u0; s1 = s1 * ic - u1;
          u32x4 o; o.x = pk2(s0[0], s0[1]); o.y = pk2(s0[2], s0[3]); o.z = pk2(s1[0], s1[1]); o.w = pk2(s1[2], s1[3]);
          *(LAS u32x4*)(am + row * 264 + c0) = o;
      }
      __syncthreads();
      for (int i = 0; i < nr; ++i) {
          f32x4 c[2] = {(f32x4){0.f, 0.f, 0.f, 0.f}, (f32x4){0.f, 0.f, 0.f, 0.f}};
#pragma unroll
          for (int ks = 0; ks < 2; ++ks) {
              const bf16x8 a = *(const LAS bf16x8*)(am + (16 * i + l16) * 264 + g * 64 + 32 * ks + 8 * quad);
#pragma unroll
              for (int nt = 0; nt < 2; ++nt) c[nt] = __builtin_amdgcn_mfma_f32_16x16x32_bf16(a, bw[nt][ks], c[nt], 0, 0, 0);
          }
#pragma unroll
          for (int nt = 0; nt < 2; ++nt) {
              const int col = g * 64 + 16 * (ntp + nt) + l16;
              const float ps = p.in[15][l * PW + col];
#pragma unroll
              for (int r = 0; r < 4; ++r) mix[(size_t)(row0 + 16 * i + quad * 4 + r) * D + col] = (bf16_t)f2bf(c[nt][r] * ps);
          }
      }
      __syncthreads();
    }
}

__device__ __forceinline__ s16x4 vtr(const LAS unsigned char* ptr) { return __builtin_bit_cast(s16x4, __builtin_amdgcn_ds_read_tr16_b64_v4i16((LAS s16x4*)ptr)); }
constexpr int KP = 144;

__device__ __forceinline__ float xmax_q(float v) {
    auto a = __builtin_amdgcn_permlane16_swap(__float_as_uint(v), __float_as_uint(v), false, false);
    const float m = __builtin_fmaxf(__uint_as_float(a[0]), __uint_as_float(a[1]));
    auto b = __builtin_amdgcn_permlane32_swap(__float_as_uint(m), __float_as_uint(m), false, false);
    return __builtin_fmaxf(__uint_as_float(b[0]), __uint_as_float(b[1]));
}
__device__ __forceinline__ void attn_tile64(const LAS unsigned char* Kt, const LAS unsigned char* Vt, const LAS float* Ft, int key0, int Qw, bool diag,
                                            const bf16x8 (&qf)[2][2], const float (&fq)[2], float (&fqm)[2], float (&mrun)[2], float (&lrun)[2], f32x4 (&o)[4][2], int l16, int quad) {
    f32x4 s[4][2];
    bf16x8 kf[2][4]; f32x4 fk[4];
#pragma unroll
    for (int ks = 0; ks < 2; ++ks)
#pragma unroll
        for (int kt = 0; kt < 4; ++kt) kf[ks][kt] = *(const LAS bf16x8*)(Kt + (16 * kt + l16) * KP + ks * 64 + quad * 16);
#pragma unroll
    for (int kt = 0; kt < 4; ++kt) fk[kt] = *(const LAS f32x4*)(Ft + 16 * kt + 4 * quad);
    __builtin_amdgcn_sched_barrier(0);
#pragma unroll
    for (int kt = 0; kt < 4; ++kt)
#pragma unroll
        for (int qt = 0; qt < 2; ++qt) s[kt][qt] = (f32x4){fqm[qt] - fk[kt][0], fqm[qt] - fk[kt][1], fqm[qt] - fk[kt][2], fqm[qt] - fk[kt][3]};
#pragma unroll
    for (int ks = 0; ks < 2; ++ks)
#pragma unroll
        for (int kt = 0; kt < 4; ++kt)
#pragma unroll
            for (int qt = 0; qt < 2; ++qt) s[kt][qt] = __builtin_amdgcn_mfma_f32_16x16x32_bf16(kf[ks][kt], qf[qt][ks], s[kt][qt], 0, 0, 0);
    s16x4 va[2][4][2];
    {
        const LAS unsigned char* vb0 = Vt + (4 * quad + (l16 >> 2)) * KP + 8 * (l16 & 3);
#pragma unroll
        for (int k2 = 0; k2 < 2; ++k2)
#pragma unroll
            for (int dt = 0; dt < 4; ++dt) { va[k2][dt][0] = vtr(vb0 + 32 * k2 * KP + 32 * dt); va[k2][dt][1] = vtr(vb0 + (32 * k2 + 16) * KP + 32 * dt); }
    }
    __builtin_amdgcn_sched_barrier(0);
    if (diag) {
#pragma unroll
        for (int kt = 0; kt < 4; ++kt)
#pragma unroll
            for (int qt = 0; qt < 2; ++qt)
#pragma unroll
                for (int r = 0; r < 4; ++r) { const int key = key0 + 16 * kt + 4 * quad + r, qq = Qw + 16 * qt + l16; if (key > qq) s[kt][qt][r] = -INFINITY; }
    }
    float mx[2];
#pragma unroll
    for (int qt = 0; qt < 2; ++qt) {
        float a = __builtin_fmaxf(__builtin_fmaxf(s[0][qt][0], s[0][qt][1]), s[0][qt][2]), c = __builtin_fmaxf(__builtin_fmaxf(s[0][qt][3], s[1][qt][0]), s[1][qt][1]);
        a = __builtin_fmaxf(__builtin_fmaxf(a, s[1][qt][2]), s[1][qt][3]); c = __builtin_fmaxf(__builtin_fmaxf(c, s[2][qt][0]), s[2][qt][1]);
        a = __builtin_fmaxf(__builtin_fmaxf(a, s[2][qt][2]), s[2][qt][3]); c = __builtin_fmaxf(__builtin_fmaxf(c, s[3][qt][0]), s[3][qt][1]);
        a = __builtin_fmaxf(__builtin_fmaxf(a, s[3][qt][2]), s[3][qt][3]);
        float m_ = __builtin_fmaxf(a, c);
        mx[qt] = xmax_q(m_);
    }
    if (__any((mx[0] > 8.f) || (mx[1] > 8.f))) {
#pragma unroll
        for (int qt = 0; qt < 2; ++qt) {
            const float dl = __builtin_fmaxf(mx[qt], 0.f);
            mrun[qt] += dl; fqm[qt] = fq[qt] - mrun[qt];
            const float al = __builtin_amdgcn_exp2f(-dl);
            lrun[qt] *= al;
#pragma unroll
            for (int kt = 0; kt < 4; ++kt) s[kt][qt] -= dl;
#pragma unroll
            for (int dt = 0; dt < 4; ++dt) o[dt][qt] *= al;
        }
    }
#pragma unroll
    for (int qt = 0; qt < 2; ++qt) {
        float ps = 0.f;
#pragma unroll
        for (int kt = 0; kt < 4; ++kt)
#pragma unroll
            for (int r = 0; r < 4; ++r) { const float e = __builtin_amdgcn_exp2f(s[kt][qt][r]); s[kt][qt][r] = e; ps += e; }
        lrun[qt] += ps;
    }
#pragma unroll
    for (int k2 = 0; k2 < 2; ++k2) {
        bf16x8 pb[2];
#pragma unroll
        for (int qt = 0; qt < 2; ++qt) {
            u32x4 w; w.x = pk2(s[2 * k2][qt][0], s[2 * k2][qt][1]); w.y = pk2(s[2 * k2][qt][2], s[2 * k2][qt][3]);
            w.z = pk2(s[2 * k2 + 1][qt][0], s[2 * k2 + 1][qt][1]); w.w = pk2(s[2 * k2 + 1][qt][2], s[2 * k2 + 1][qt][3]);
            pb[qt] = __builtin_bit_cast(bf16x8, w);
        }
#pragma unroll
        for (int dt = 0; dt < 4; ++dt) {
            const s16x4 a0 = va[k2][dt][0], a1 = va[k2][dt][1];
            const bf16x8 vf = (bf16x8){a0[0], a0[1], a0[2], a0[3], a1[0], a1[1], a1[2], a1[3]};
#pragma unroll
            for (int qt = 0; qt < 2; ++qt) o[dt][qt] = __builtin_amdgcn_mfma_f32_16x16x32_bf16(vf, pb[qt], o[dt][qt], 0, 0, 0);
        }
    }
}

constexpr int TB = 128 * KP;
__device__ __forceinline__ void attn_prompt_unit(int b, int h, int qb, const bf16_t* Q, const bf16_t* Kb, const bf16_t* Vb, const float* F2, bf16_t* mix,
                                                 LAS unsigned char* lds, int tid, int lane, int wave) {
    const int l16 = lane & 15, quad = lane >> 4;
    const size_t rowbase = (size_t)b * T;
    const int Qw = qb * 256 + wave * 32;
    const float* Fh = F2 + (size_t)(b * NH + h) * T;
    bf16x8 qf[2][2]; float fq[2];
#pragma unroll
    for (int qt = 0; qt < 2; ++qt) {
#pragma unroll
        for (int ks = 0; ks < 2; ++ks) qf[qt][ks] = *(const bf16x8*)(Q + (rowbase + Qw + 16 * qt + l16) * AW + h * HD + 32 * ks + 8 * quad);
        fq[qt] = Fh[Qw + 16 * qt + l16];
    }
    f32x4 o[4][2];
#pragma unroll
    for (int dt = 0; dt < 4; ++dt) { o[dt][0] = (f32x4){0.f, 0.f, 0.f, 0.f}; o[dt][1] = o[dt][0]; }
    float mrun[2] = {0.f, 0.f}, lrun[2] = {0.f, 0.f}, fqm[2] = {fq[0], fq[1]};
    const int NT = 2 * qb + 2;
    LAS unsigned char* Kl = lds; LAS unsigned char* Vl = lds + 2 * TB; LAS float* Fl = (LAS float*)(lds + 4 * TB);
    const int skey = tid >> 3, sch = tid & 7;
    const bf16_t* kg = Kb + (rowbase + skey) * AW + h * HD + sch * 8;
    const bf16_t* vg = Vb + (rowbase + skey) * AW + h * HD + sch * 8;
    u32x4 kreg0 = *(const u32x4*)kg, kreg1 = *(const u32x4*)(kg + (size_t)64 * AW), vreg0 = *(const u32x4*)vg, vreg1 = *(const u32x4*)(vg + (size_t)64 * AW);
    f32x4 freg = (f32x4){0.f, 0.f, 0.f, 0.f};
    if (tid < 32) freg = *(const f32x4*)(Fh + tid * 4);
    const int soff = skey * KP + sch * 16;
    *(LAS u32x4*)(Kl + soff) = kreg0; *(LAS u32x4*)(Kl + 64 * KP + soff) = kreg1; *(LAS u32x4*)(Vl + soff) = vreg0; *(LAS u32x4*)(Vl + 64 * KP + soff) = vreg1;
    if (tid < 32) *(LAS f32x4*)(Fl + tid * 4) = freg;
    __syncthreads();
    for (int t = 0; t < NT; ++t) {
        const int buf = t & 1;
        if (t + 1 < NT) {
            const size_t go = (size_t)(t + 1) * 128 * AW;
            kreg0 = *(const u32x4*)(kg + go); kreg1 = *(const u32x4*)(kg + go + (size_t)64 * AW); vreg0 = *(const u32x4*)(vg + go); vreg1 = *(const u32x4*)(vg + go + (size_t)64 * AW);
            if (tid < 32) freg = *(const f32x4*)(Fh + (t + 1) * 128 + tid * 4);
        }
#pragma unroll
        for (int sub = 0; sub < 2; ++sub) {
            const int key0 = t * 128 + sub * 64;
            if (key0 <= Qw)
                attn_tile64(Kl + buf * TB + sub * 64 * KP, Vl + buf * TB + sub * 64 * KP, Fl + buf * 128 + sub * 64, key0, Qw, key0 + 63 > Qw, qf, fq, fqm, mrun, lrun, o, l16, quad);
        }
        if (t + 1 < NT) {
            const int nb = buf ^ 1;
            *(LAS u32x4*)(Kl + nb * TB + soff) = kreg0; *(LAS u32x4*)(Kl + nb * TB + 64 * KP + soff) = kreg1;
            *(LAS u32x4*)(Vl + nb * TB + soff) = vreg0; *(LAS u32x4*)(Vl + nb * TB + 64 * KP + soff) = vreg1;
            if (tid < 32) *(LAS f32x4*)(Fl + nb * 128 + tid * 4) = freg;
        }
        __syncthreads();
    }
#pragma unroll
    for (int qt = 0; qt < 2; ++qt) {
        float lt = lrun[qt]; lt += __shfl_xor(lt, 16); lt += __shfl_xor(lt, 32);
        const float il = 1.0f / lt;
        bf16_t* op = mix + (rowbase + Qw + 16 * qt + l16) * D + PW + h * HD + 4 * quad;
#pragma unroll
        for (int dt = 0; dt < 4; ++dt) {
            u32x2 w; w.x = pk2(o[dt][qt][0] * il, o[dt][qt][1] * il); w.y = pk2(o[dt][qt][2] * il, o[dt][qt][3] * il);
            *(u32x2*)(op + 16 * dt) = w;
        }
    }
}


namespace fa {
using f32x16 = __attribute__((ext_vector_type(16))) float;
constexpr int SEQ = T, DH = 64, DM = AW;
constexpr int NW = 8, QBLK = 32, QB = QBLK * NW, KVBLK = 64;
__device__ __forceinline__ int crow(int r, int hi) { return (r & 3) + 8 * (r >> 2) + 4 * hi; }
#define SBAR() __builtin_amdgcn_sched_barrier(0)
__device__ __forceinline__ void cmask(f32x16& p0, f32x16& p1, int jb, int qrel, int hi) {
    const float NEG = -INFINITY; int kb = 64 * jb + 4 * hi;
#pragma unroll
    for (int r = 0; r < 16; ++r) { int kv = kb + (r & 3) + 8 * (r >> 2); if (kv > qrel) p0[r] = NEG; if (kv + 32 > qrel) p1[r] = NEG; }
}
constexpr int NSLOT = 3, SLOTB = 8192;
constexpr int LDS_K = 0, LDS_V = NSLOT * SLOTB, LDS_WS = 2 * NSLOT * SLOTB, LDS_OST = LDS_WS + NW * 64 * 4, LDS_FK = LDS_OST + NW * 4096, LDS_END = LDS_FK + SEQ * 4;
__device__ __forceinline__ void glds16(const void* gsrc, unsigned lds_dst) { unsigned keep;
    asm volatile("s_mov_b32 %0, m0\n\ts_mov_b32 m0, %2\n\ts_nop 0\n\tglobal_load_lds_dwordx4 %1, off\n\ts_mov_b32 m0, %0" : "=&s"(keep) : "v"(gsrc), "s"(lds_dst) : "memory"); }
__device__ __forceinline__ float max3f(float a, float b, float c) { float r; asm("v_max3_f32 %0, %1, %2, %3" : "=v"(r) : "v"(a), "v"(b), "v"(c)); return r; }
__device__ __forceinline__ float max2f(float a, float b) { float r; asm("v_max_f32_e32 %0, %1, %2" : "=v"(r) : "v"(a), "v"(b)); return r; }
__device__ __forceinline__ float fadd_s(float a, float b) { float r; asm("v_add_f32_e32 %0, %1, %2" : "=v"(r) : "v"(a), "v"(b)); return r; }
__device__ __forceinline__ float fsub_s(float a, float b) { float r; asm("v_sub_f32_e32 %0, %1, %2" : "=v"(r) : "v"(a), "v"(b)); return r; }
__device__ __forceinline__ unsigned cvtpk_s(float lo, float hi) { return pk2(lo, hi); }
#define WAIT_BAR(N) asm volatile("s_waitcnt vmcnt(" #N ") lgkmcnt(0)\n\ts_barrier" ::: "memory")
typedef __attribute__((address_space(3))) const char* lds_cptr;
__device__ __forceinline__ void bias_half(f32x16& c, lds_cptr fkt, float cq, int hi) {
#pragma unroll
    for (int g = 0; g < 4; ++g) {
        const f32x4 a = *(const LAS f32x4*)(fkt + (8 * g + 4 * hi) * 4);
#pragma unroll
        for (int j = 0; j < 4; ++j) c[4 * g + j] = cq - a[j];
    }
}
__device__ __forceinline__ void bias_init(f32x16& c0, f32x16& c1, lds_cptr fkt, float cq, int hi) {
#pragma unroll
    for (int g = 0; g < 4; ++g) {
        const f32x4 a = *(const LAS f32x4*)(fkt + (8 * g + 4 * hi) * 4), b = *(const LAS f32x4*)(fkt + (32 + 8 * g + 4 * hi) * 4);
#pragma unroll
        for (int j = 0; j < 4; ++j) { c0[4 * g + j] = cq - a[j]; c1[4 * g + j] = cq - b[j]; }
    }
}
__device__ __forceinline__ void qkt(f32x16& p0, f32x16& p1, const char* Kslot, const bf16x8* qr, int r32, int hi) {
    const char* kb = Kslot + hi * 1024 + r32 * 16;
#pragma unroll
    for (int d0 = 0; d0 < 4; ++d0) {
        const bf16x8 b0 = *reinterpret_cast<const bf16x8*>(kb + d0 * 2048);
        const bf16x8 b1 = *reinterpret_cast<const bf16x8*>(kb + d0 * 2048 + 512);
        p0 = __builtin_amdgcn_mfma_f32_32x32x16_bf16(b0, qr[d0], p0, 0, 0, 0); p1 = __builtin_amdgcn_mfma_f32_32x32x16_bf16(b1, qr[d0], p1, 0, 0, 0); }
}
__device__ __forceinline__ void kload8(bf16x8* kf, lds_cptr kp) {
    kf[0] = *(const LAS bf16x8*)(kp);        kf[1] = *(const LAS bf16x8*)(kp + 512);
    kf[2] = *(const LAS bf16x8*)(kp + 2048); kf[3] = *(const LAS bf16x8*)(kp + 2560);
    kf[4] = *(const LAS bf16x8*)(kp + 4096); kf[5] = *(const LAS bf16x8*)(kp + 4608);
    kf[6] = *(const LAS bf16x8*)(kp + 6144); kf[7] = *(const LAS bf16x8*)(kp + 6656);
}
__device__ __forceinline__ void kload2(bf16x8* kf, lds_cptr kp, int j) { kf[2 * j] = *(const LAS bf16x8*)(kp + j * 2048); kf[2 * j + 1] = *(const LAS bf16x8*)(kp + j * 2048 + 512); }
__device__ __forceinline__ s16x4 vtr2(lds_cptr p) { return __builtin_bit_cast(s16x4, __builtin_amdgcn_ds_read_tr16_b64_v4i16((LAS s16x4*)p)); }
__device__ __forceinline__ float rowmax(const f32x16& p0, const f32x16& p1) {
    float a = max3f(p0[0], p0[1], p1[0]), b = max3f(p0[2], p0[3], p1[1]); a = max3f(a, p1[2], p1[3]);
#pragma unroll
    for (int r = 4; r < 16; r += 4) { a = max3f(a, p0[r], p0[r + 1]); b = max3f(b, p0[r + 2], p0[r + 3]); a = max3f(a, p1[r], p1[r + 1]); b = max3f(b, p1[r + 2], p1[r + 3]); }
    const float m = max2f(a, b);
    auto rr = __builtin_amdgcn_permlane32_swap(__float_as_uint(m), __float_as_uint(m), false, false);
    return max2f(__uint_as_float(rr[0]), __uint_as_float(rr[1]));
}
__device__ __forceinline__ void pv(f32x16* o, int vb, bf16x8 pa0, bf16x8 pa1, bf16x8 pa2, bf16x8 pa3) {
#pragma unroll
    for (int d0 = 0; d0 < 2; ++d0) { s16x4 lo[4], hi[4];
#pragma unroll
        for (int ks = 0; ks < 4; ++ks) {
            asm volatile("ds_read_b64_tr_b16 %0,%1 offset:%c2" : "=&v"(lo[ks]) : "v"(vb), "i"(d0 * 4096 + ks * 1024) : "memory");
            asm volatile("ds_read_b64_tr_b16 %0,%1 offset:%c2" : "=&v"(hi[ks]) : "v"(vb), "i"(d0 * 4096 + ks * 1024 + 512) : "memory"); }
        asm volatile("s_waitcnt lgkmcnt(0)" ::: "memory"); SBAR();
#define PK(k) (bf16x8){lo[k][0], lo[k][1], lo[k][2], lo[k][3], hi[k][0], hi[k][1], hi[k][2], hi[k][3]}
        o[d0] = __builtin_amdgcn_mfma_f32_32x32x16_bf16(pa0, PK(0), o[d0], 0, 0, 0);
        o[d0] = __builtin_amdgcn_mfma_f32_32x32x16_bf16(pa1, PK(1), o[d0], 0, 0, 0);
        o[d0] = __builtin_amdgcn_mfma_f32_32x32x16_bf16(pa2, PK(2), o[d0], 0, 0, 0);
        o[d0] = __builtin_amdgcn_mfma_f32_32x32x16_bf16(pa3, PK(3), o[d0], 0, 0, 0);
#undef PK
    }
}

template <int THRL> __device__ __forceinline__ void attn_unit(int b, int h, int qb, const bf16_t* Q, const bf16_t* __restrict__ K, const bf16_t* __restrict__ V, const float* F2, bf16_t* mix, char* shm, const int tid, const int t0) {
    const int lane = tid & 63, r32 = lane & 31, hi = lane >> 5; const int wid = __builtin_amdgcn_readfirstlane(tid >> 6);
    const long rowbase = (long)b * SEQ; const int q0 = qb * QB;
    const bf16_t* Qw = Q + (rowbase + q0 + wid * QBLK) * DM + h * DH;
    const bf16_t* Kh = K + (rowbase + t0 * KVBLK) * DM + h * DH, *Vh = V + (rowbase + t0 * KVBLK) * DM + h * DH;
    const float* Fh = F2 + (long)(b * NH + h) * SEQ;
    const unsigned lds0 = (unsigned)(uintptr_t)shm;
    float* wsf = (float*)(shm + LDS_WS) + wid * 64;
    const bf16_t* ksrc = Kh + (long)lane * DM + wid * 8;
    const bf16_t* vsrc = Vh + (long)(16 * (wid & 3) + (lane >> 2)) * DM + (wid >> 2) * 32 + (lane & 3) * 8;
    const unsigned kdst = lds0 + LDS_K + wid * 1024, vdst = lds0 + LDS_V + wid * 1024;
#define DMA_K(t, slot) glds16(ksrc + (long)(t) * KVBLK * DM, (unsigned)__builtin_amdgcn_readfirstlane(kdst + (slot)))
#define DMA_V(t, slot) glds16(vsrc + (long)(t) * KVBLK * DM, (unsigned)__builtin_amdgcn_readfirstlane(vdst + (slot)))
    const int vb0 = (int)(lds0 + LDS_V) + ((lane >> 4) & 1) * 32 + (lane & 3) * 8 + (4 * hi + ((lane & 15) >> 2)) * 64;
    const char* Kbase = shm + LDS_K; bf16x8 kf[8];
    const lds_cptr shm3 = (lds_cptr)shm; const lds_cptr kp0 = shm3 + LDS_K + hi * 1024 + r32 * 16; const lds_cptr vp0 = shm3 + LDS_V + ((lane >> 4) & 1) * 32 + (lane & 3) * 8 + (4 * hi + ((lane & 15) >> 2)) * 64;
    const lds_cptr fk0 = shm3 + LDS_FK;
    const int NT = (q0 + QB) / KVBLK - t0;
    DMA_K(0, 0); DMA_V(0, 0); DMA_K(1, SLOTB);
    { float* fl = (float*)(shm + LDS_FK); for (int i = t0 * KVBLK + tid * 4; i < q0 + QB; i += 2048) *(f32x4*)(fl + i - t0 * KVBLK) = *(const f32x4*)(Fh + i); }
    const float fq = Fh[q0 + wid * QBLK + r32];
    bf16x8 qr[4];
#pragma unroll
    for (int d0 = 0; d0 < 4; ++d0) qr[d0] = *reinterpret_cast<const bf16x8*>(&Qw[(long)r32 * DM + d0 * 16 + hi * 8]);
    float mhat = 0.f, l_reg = 0.f, cq = fq; f32x16 o[2]; o[0] = f32x16{}; o[1] = f32x16{};
    const int qrel = wid * QBLK + r32;
#define CMASK(P0, P1, t) do { int jb_ = (t) - (NT - 4); if (jb_ >= 0) cmask(P0, P1, jb_, qrel, hi); } while (0)
    bool resc = false;
#define START(P0, P1) do { const float rm = rowmax(P0, P1); resc = false; \
    { const float dl = rm; mhat = fadd_s(mhat, dl); \
      _Pragma("unroll") for (int r = 0; r < 16; ++r) { P0[r] = fsub_s(P0[r], dl); P1[r] = fsub_s(P1[r], dl); } \
      cq = fq - mhat; } \
    _Pragma("unroll") for (int r = 0; r < 16; ++r) P0[r] = __builtin_amdgcn_exp2f(P0[r]); } while (0)
#define RESC() do { if (resc) { asm volatile("s_waitcnt lgkmcnt(0)" ::: "memory"); \
      _Pragma("unroll") for (int d_ = 0; d_ < 2; ++d_) _Pragma("unroll") for (int r = 0; r < 16; ++r) o[d_][r] *= wsf[crow(r, hi)]; } } while (0)
    f32x16 pA0, pA1, pB0, pB1;
    int sl_prev = 0, sl_cur = 0, sl_next = SLOTB;
#define ROT() do { sl_prev = sl_cur; sl_cur = sl_next; sl_next = (sl_next == (NSLOT - 1) * SLOTB) ? 0 : sl_next + SLOTB; } while (0)
    DMA_K(2, 2 * SLOTB);
    WAIT_BAR(3);
    bias_init(pA0, pA1, fk0, cq, hi);
    qkt(pA0, pA1, Kbase, qr, r32, hi); asm volatile("s_nop 15\n\ts_nop 7" : "+v"(pA0), "+v"(pA1)); CMASK(pA0, pA1, 0);
    START(pA0, pA1);
    _Pragma("unroll") for (int r = 0; r < 16; ++r) pA1[r] = __builtin_amdgcn_exp2f(pA1[r]);
    WAIT_BAR(0);
    DMA_K(3, 0); DMA_V(1, SLOTB);
    ROT();
    kload8(kf, kp0 + sl_cur);
    WAIT_BAR(2);
    s16x4 vlo[8], vhi[8]; u32x4 pw0, pw1, pw2, pw3;
#define PKW(P, B) cvtpk_s(P[B], P[B + 1])
#define PAF(k) __builtin_bit_cast(bf16x8, pw##k)
#define VFR(i) (bf16x8){vlo[i][0], vlo[i][1], vlo[i][2], vlo[i][3], vhi[i][0], vhi[i][1], vhi[i][2], vhi[i][3]}
#define PIN(x) asm volatile("" : "+v"(x))
#define MX3(a, b, c) __builtin_fmaxf(__builtin_fmaxf((a), (b)), (c))
#define GAPA(MF, A0, A1, A2, A3, W0, W1, PW) do { MF; sacc += A0; sacc += A1; sacc += A2; sacc += A3; PIN(sacc); W0; W1; PIN(PW); SBAR(); } while (0)
#define EX(v) __builtin_amdgcn_exp2f(v)
#define GAPB(MF, X, B) do { MF; X[B] = EX(X[B]); X[B + 1] = EX(X[B + 1]); X[B + 2] = EX(X[B + 2]); X[B + 3] = EX(X[B + 3]); PIN(X); SBAR(); } while (0)
#define VRD(i) do { vlo[i] = vtr2(vp_ + (((i) >> 2) * 4096 + ((i) & 3) * 1024)); vhi[i] = vtr2(vp_ + (((i) >> 2) * 4096 + ((i) & 3) * 1024 + 512)); } while (0)
#define KRD(G, j) do { if (G) { kload2(kf, kp0 + sl_next, j); SBAR(); } } while (0)
#define STEP(C0, C1, P0, P1, t, GK, GV, GL) do { SBAR(); \
    bias_half(C0, fk0 + (t) * 256, cq, hi); SBAR(); \
    const lds_cptr vp_ = vp0 + sl_prev; \
    VRD(0); SBAR(); float sacc = (P0[0] + P0[1]); \
    GAPA(C0 = __builtin_amdgcn_mfma_f32_32x32x16_bf16(kf[0], qr[0], C0, 0, 0, 0), P0[2], P0[3], P0[4], P0[5],     pw0[0] = PKW(P0, 0), pw0[1] = PKW(P0, 2), pw0); \
    bias_half(C1, fk0 + (t) * 256 + 128, cq, hi); SBAR(); \
    VRD(4); SBAR(); GAPA(C1 = __builtin_amdgcn_mfma_f32_32x32x16_bf16(kf[1], qr[0], C1, 0, 0, 0), P0[6], P0[7], P0[8], P0[9],     pw0[2] = PKW(P0, 4), pw0[3] = PKW(P0, 6), pw0); \
    VRD(1); SBAR(); GAPA(C0 = __builtin_amdgcn_mfma_f32_32x32x16_bf16(kf[2], qr[1], C0, 0, 0, 0),   P0[10], P0[11], P0[12], P0[13], pw1[0] = PKW(P0, 8), pw1[1] = PKW(P0, 10), pw1); \
    VRD(5); SBAR(); GAPA(C1 = __builtin_amdgcn_mfma_f32_32x32x16_bf16(kf[3], qr[1], C1, 0, 0, 0),   P0[14], P0[15], P1[0], P1[1],   pw1[2] = PKW(P0, 12), pw1[3] = PKW(P0, 14), pw1); \
    VRD(2); SBAR(); GAPA(C0 = __builtin_amdgcn_mfma_f32_32x32x16_bf16(kf[4], qr[2], C0, 0, 0, 0),   P1[2], P1[3], P1[4], P1[5],     pw2[0] = PKW(P1, 0), pw2[1] = PKW(P1, 2), pw2); \
    VRD(6); SBAR(); GAPA(C1 = __builtin_amdgcn_mfma_f32_32x32x16_bf16(kf[5], qr[2], C1, 0, 0, 0),   P1[6], P1[7], P1[8], P1[9],     pw2[2] = PKW(P1, 4), pw2[3] = PKW(P1, 6), pw2); \
    VRD(3); SBAR(); GAPA(C0 = __builtin_amdgcn_mfma_f32_32x32x16_bf16(kf[6], qr[3], C0, 0, 0, 0),   P1[10], P1[11], P1[12], P1[13], pw3[0] = PKW(P1, 8), pw3[1] = PKW(P1, 10), pw3); \
    VRD(7); SBAR(); GAPA(C1 = __builtin_amdgcn_mfma_f32_32x32x16_bf16(kf[7], qr[3], C1, 0, 0, 0),   P1[14], P1[15], 0.f, 0.f,       pw3[2] = PKW(P1, 12), pw3[3] = PKW(P1, 14), pw3); \
    l_reg += sacc; \
    if (GK) { DMA_K((t) + 3, sl_cur); } if (GV) { DMA_V((t) + 1, sl_next); } \
    CMASK(C0, C1, t); \
    { float a = MX3(C0[0], C0[1], C1[0]), b = MX3(C0[2], C0[3], C1[1]); a = MX3(a, C1[2], C1[3]); \
      _Pragma("unroll") for (int r = 4; r < 16; r += 4) { a = MX3(a, C0[r], C0[r + 1]); b = MX3(b, C0[r + 2], C0[r + 3]); a = MX3(a, C1[r], C1[r + 1]); b = MX3(b, C1[r + 2], C1[r + 3]); } \
      float rm = __builtin_fmaxf(a, b); { auto rr = __builtin_amdgcn_permlane32_swap(__float_as_uint(rm), __float_as_uint(rm), false, false); rm = __builtin_fmaxf(__uint_as_float(rr[0]), __uint_as_float(rr[1])); } \
      resc = false; \
      if (__builtin_expect(__any(rm > (float)THRL), 0)) { const float dl = __builtin_fmaxf(rm, 0.f); mhat += dl; \
        _Pragma("unroll") for (int r = 0; r < 16; ++r) { C0[r] -= dl; C1[r] -= dl; } \
        cq = fq - mhat; \
        const float f = __builtin_amdgcn_exp2f(-dl); l_reg *= f; if (hi == 0) wsf[r32] = f; resc = true; } } \
    SBAR(); \
    GAPB(o[0] = __builtin_amdgcn_mfma_f32_32x32x16_bf16(PAF(0), VFR(0), o[0], 0, 0, 0), C0, 0); \
    GAPB(o[1] = __builtin_amdgcn_mfma_f32_32x32x16_bf16(PAF(0), VFR(4), o[1], 0, 0, 0), C0, 4); \
    KRD(GL, 0); GAPB(o[0] = __builtin_amdgcn_mfma_f32_32x32x16_bf16(PAF(1), VFR(1), o[0], 0, 0, 0), C0, 8); \
    KRD(GL, 1); GAPB(o[1] = __builtin_amdgcn_mfma_f32_32x32x16_bf16(PAF(1), VFR(5), o[1], 0, 0, 0), C0, 12); \
    KRD(GL, 2); GAPB(o[0] = __builtin_amdgcn_mfma_f32_32x32x16_bf16(PAF(2), VFR(2), o[0], 0, 0, 0), C1, 0); \
    KRD(GL, 3); GAPB(o[1] = __builtin_amdgcn_mfma_f32_32x32x16_bf16(PAF(2), VFR(6), o[1], 0, 0, 0), C1, 4); \
    GAPB(o[0] = __builtin_amdgcn_mfma_f32_32x32x16_bf16(PAF(3), VFR(3), o[0], 0, 0, 0), C1, 8); \
    GAPB(o[1] = __builtin_amdgcn_mfma_f32_32x32x16_bf16(PAF(3), VFR(7), o[1], 0, 0, 0), C1, 12); \
    } while (0)
    int t = 1;
#undef CMASK
#define CMASK(P0, P1, t) do { } while (0)
    for (; t + 5 < NT; t += 2) {
        STEP(pB0, pB1, pA0, pA1, t, true, true, true);     WAIT_BAR(2); RESC(); ROT();
        STEP(pA0, pA1, pB0, pB1, t + 1, true, true, true); WAIT_BAR(2); RESC(); ROT();
    }
#undef CMASK
#define CMASK(P0, P1, t) do { int jb_ = (t) - (NT - 4); if (jb_ >= 0) cmask(P0, P1, jb_, qrel, hi); } while (0)
#define ENDW(tt) do { if ((tt) + 3 < NT) { WAIT_BAR(2); } else if ((tt) + 2 < NT) { WAIT_BAR(1); } else { WAIT_BAR(0); } } while (0)
    for (; t + 1 < NT; t += 2) {
        STEP(pB0, pB1, pA0, pA1, t, (t + 3 < NT), (t + 1 < NT), (t + 1 < NT));       ENDW(t);     RESC(); ROT();
        STEP(pA0, pA1, pB0, pB1, t + 1, (t + 4 < NT), (t + 2 < NT), (t + 2 < NT)); ENDW(t + 1); RESC(); ROT();
    }
    STEP(pB0, pB1, pA0, pA1, NT - 1, false, false, false); RESC();
    { float sacc = pB0[0] + pB0[1]; _Pragma("unroll") for (int r = 2; r < 16; ++r) sacc += pB0[r]; _Pragma("unroll") for (int r = 0; r < 16; ++r) sacc += pB1[r]; l_reg += sacc;
      pw0 = (u32x4){PKW(pB0, 0), PKW(pB0, 2), PKW(pB0, 4), PKW(pB0, 6)}; pw1 = (u32x4){PKW(pB0, 8), PKW(pB0, 10), PKW(pB0, 12), PKW(pB0, 14)}; pw2 = (u32x4){PKW(pB1, 0), PKW(pB1, 2), PKW(pB1, 4), PKW(pB1, 6)}; pw3 = (u32x4){PKW(pB1, 8), PKW(pB1, 10), PKW(pB1, 12), PKW(pB1, 14)};
      SBAR(); pv(o, vb0 + sl_cur, PAF(0), PAF(1), PAF(2), PAF(3)); }
#undef PKW
#undef PAF
#undef VFR
#undef PIN
#undef MX3
#undef GAPA
#undef GAPB
#undef EX
#undef VRD
#undef KRD
#undef STEP
#undef ENDW
    { auto rr = __builtin_amdgcn_permlane32_swap(__float_as_uint(l_reg), __float_as_uint(l_reg), false, false); l_reg = __uint_as_float(rr[0]) + __uint_as_float(rr[1]); }
    if (hi == 0) wsf[32 + r32] = l_reg; asm volatile("s_waitcnt lgkmcnt(0)" ::: "memory");
    float rli[16];
#pragma unroll
    for (int r = 0; r < 16; ++r) rli[r] = __builtin_amdgcn_rcpf(wsf[32 + crow(r, hi)]);
    bf16_t* Ow = mix + (rowbase + q0 + wid * QBLK) * D + PW + h * DH;
    { bf16_t* stg = (bf16_t*)(shm + LDS_OST) + wid * 2048;
#pragma unroll
      for (int r = 0; r < 16; ++r) { const int orow = crow(r, hi);
#pragma unroll
        for (int d0 = 0; d0 < 2; ++d0) stg[orow * 64 + d0 * 32 + r32] = (bf16_t)f2bf(o[d0][r] * rli[r]); }
      asm volatile("s_waitcnt lgkmcnt(0)" ::: "memory");
#pragma unroll
      for (int i = 0; i < 4; ++i) { const int row = i * 8 + (lane >> 3), ch = lane & 7; const u32x4 v = *(const u32x4*)(stg + row * 64 + ch * 8); *(u32x4*)(Ow + (long)row * D + ch * 8) = v; } }
    asm volatile("s_waitcnt lgkmcnt(0)\n\ts_barrier" ::: "memory");
#undef DMA_K
#undef DMA_V
#undef CMASK
#undef START
#undef RESC
#undef ROT
}
#undef SBAR
#undef WAIT_BAR
}

__device__ __forceinline__ void attn_sample_unit(int l, int b, int h, const Params& p, LAS unsigned char* lds, int tid, int lane, int wave, float thr) {
    const int l16 = lane & 15, quad = lane >> 4;
    const bf16_t* Q = (const bf16_t*)(p.ws + WS_Q); const bf16_t* Kb = (const bf16_t*)(p.ws + WS_K); const bf16_t* Vb = (const bf16_t*)(p.ws + WS_V);
    bf16_t* mix = (bf16_t*)(p.ws + WS_MIX);
    const size_t row0 = (size_t)MP + b * ST;
    const float* Fh = (const float*)(p.ws + WS_FS) + (size_t)(b * NH + h) * SKEYS;
    bf16x8 qf[2];
#pragma unroll
    for (int ks = 0; ks < 2; ++ks) qf[ks] = *(const bf16x8*)(Q + (row0 + l16) * AW + h * HD + 32 * ks + 8 * quad);
    const float fq = Fh[PAST + l16];
    f32x4 o[4];
#pragma unroll
    for (int dt = 0; dt < 4; ++dt) o[dt] = (f32x4){0.f, 0.f, 0.f, 0.f};
    float mrun = -INFINITY, lrun = 0.f;
    const float* Kc = p.in[4] + ((size_t)(l * SB + b) * PAST) * AW + h * HD;
    const float* Vc = p.in[5] + ((size_t)(l * SB + b) * PAST) * AW + h * HD;
    LAS unsigned char* Vw = lds + wave * (64 * KP);
    f32x4 rk[2][2][2], rv[8], rf[2];
#define SAMPLE_LOAD(key0_) do { \
        _Pragma("unroll") for (int kt = 0; kt < 2; ++kt) _Pragma("unroll") for (int ks = 0; ks < 2; ++ks) { \
            const float* kp = Kc + (size_t)((key0_) + 16 * kt + l16) * AW + 32 * ks + 8 * quad; rk[kt][ks][0] = __builtin_nontemporal_load((const f32x4*)kp); rk[kt][ks][1] = __builtin_nontemporal_load((const f32x4*)(kp + 4)); } \
        _Pragma("unroll") for (int j = 0; j < 8; ++j) rv[j] = __builtin_nontemporal_load((const f32x4*)(Vc + (size_t)((key0_) + 4 * j + quad) * AW + 4 * l16)); \
        _Pragma("unroll") for (int kt = 0; kt < 2; ++kt) rf[kt] = *(const f32x4*)(Fh + (key0_) + 16 * kt + 4 * quad); } while (0)
    int ks;
    { const int j = lane & 15; const bool c = (j >= 1) && (Fh[256 * (j >= 1 ? j : 1) - 1] - Fh[PAST + vzero()] >= thr); ks = 256 * __popcll(__ballot(c && lane < 16)); }
    const int nst = (PAST - ks) >> 8;
    const int kbeg = ks + wave * nst * 32;
    SAMPLE_LOAD(kbeg);
    const int nsteps = nst + (wave == 7 ? 1 : 0);
    for (int step = 0; step < nsteps; ++step) {
        const bool isnew = step == nst;
        f32x4 s[2];
        bf16x8 kf[2][2];
        asm volatile("s_waitcnt lgkmcnt(0)" ::: "memory");
        if (!isnew) {
#pragma unroll
            for (int kt = 0; kt < 2; ++kt)
#pragma unroll
                for (int ks = 0; ks < 2; ++ks) {
                    const f32x4 a = rk[kt][ks][0], c = rk[kt][ks][1];
                    u32x4 w; w.x = pk2(a[0], a[1]); w.y = pk2(a[2], a[3]); w.z = pk2(c[0], c[1]); w.w = pk2(c[2], c[3]);
                    kf[kt][ks] = __builtin_bit_cast(bf16x8, w);
                }
#pragma unroll
            for (int j = 0; j < 8; ++j) {
                const int kr = 4 * j + quad;
                u32x2 w; w.x = pk2(rv[j][0], rv[j][1]); w.y = pk2(rv[j][2], rv[j][3]);
                *(LAS u32x2*)(Vw + kr * KP + 8 * l16) = w;
            }
#pragma unroll
            for (int kt = 0; kt < 2; ++kt) s[kt] = (f32x4){fq - rf[kt][0], fq - rf[kt][1], fq - rf[kt][2], fq - rf[kt][3]};
            if (step + 1 < nst) SAMPLE_LOAD(kbeg + (step + 1) * 32);
        } else {
#pragma unroll
            for (int ks = 0; ks < 2; ++ks) { kf[0][ks] = *(const bf16x8*)(Kb + (row0 + l16) * AW + h * HD + 32 * ks + 8 * quad); kf[1][ks] = (bf16x8){0, 0, 0, 0, 0, 0, 0, 0}; }
            {
                const int kr = lane >> 2, ch = lane & 3;
                const u32x4 a = *(const u32x4*)(Vb + (row0 + kr) * AW + h * HD + 16 * ch), c = *(const u32x4*)(Vb + (row0 + kr) * AW + h * HD + 16 * ch + 8);
                *(LAS u32x4*)(Vw + kr * KP + 32 * ch) = a; *(LAS u32x4*)(Vw + kr * KP + 32 * ch + 16) = c;
                *(LAS u32x4*)(Vw + (16 + kr) * KP + 32 * ch) = (u32x4){0u, 0u, 0u, 0u}; *(LAS u32x4*)(Vw + (16 + kr) * KP + 32 * ch + 16) = (u32x4){0u, 0u, 0u, 0u};
            }
            const f32x4 fk = *(const f32x4*)(Fh + PAST + 4 * quad);
            s[0] = (f32x4){fq - fk[0], fq - fk[1], fq - fk[2], fq - fk[3]};
            s[1] = (f32x4){-INFINITY, -INFINITY, -INFINITY, -INFINITY};
        }
#pragma unroll
        for (int ks = 0; ks < 2; ++ks) {
            s[0] = __builtin_amdgcn_mfma_f32_16x16x32_bf16(kf[0][ks], qf[ks], s[0], 0, 0, 0);
            if (!isnew) s[1] = __builtin_amdgcn_mfma_f32_16x16x32_bf16(kf[1][ks], qf[ks], s[1], 0, 0, 0);
        }
        if (isnew) {
#pragma unroll
            for (int r = 0; r < 4; ++r) if (4 * quad + r > l16) s[0][r] = -INFINITY;
        }
        float mx = fmaxf(fmaxf(s[0][0], s[0][1]), fmaxf(s[0][2], s[0][3]));
        mx = fmaxf(mx, fmaxf(fmaxf(s[1][0], s[1][1]), fmaxf(s[1][2], s[1][3])));
        mx = fmaxf(mx, __shfl_xor(mx, 16)); mx = fmaxf(mx, __shfl_xor(mx, 32));
        const float mnew = fmaxf(mrun, mx);
        const float alpha = __builtin_amdgcn_exp2f(mrun - mnew);
        mrun = mnew;
        float ps = 0.f;
#pragma unroll
        for (int kt = 0; kt < 2; ++kt)
#pragma unroll
            for (int r = 0; r < 4; ++r) { const float e = __builtin_amdgcn_exp2f(s[kt][r] - mnew); s[kt][r] = e; ps += e; }
        lrun = lrun * alpha + ps;
        u32x4 w; w.x = pk2(s[0][0], s[0][1]); w.y = pk2(s[0][2], s[0][3]); w.z = pk2(s[1][0], s[1][1]); w.w = pk2(s[1][2], s[1][3]);
        const bf16x8 pb = __builtin_bit_cast(bf16x8, w);
        asm volatile("s_waitcnt lgkmcnt(0)" ::: "memory");
        const LAS unsigned char* vb0 = Vw + (4 * quad + (l16 >> 2)) * KP + 8 * (l16 & 3);
#pragma unroll
        for (int dt = 0; dt < 4; ++dt) {
            const s16x4 a0 = vtr(vb0 + 32 * dt), a1 = vtr(vb0 + 16 * KP + 32 * dt);
            const bf16x8 vf = (bf16x8){a0[0], a0[1], a0[2], a0[3], a1[0], a1[1], a1[2], a1[3]};
            o[dt] = o[dt] * alpha;
            o[dt] = __builtin_amdgcn_mfma_f32_16x16x32_bf16(vf, pb, o[dt], 0, 0, 0);
        }
    }
#undef SAMPLE_LOAD
    float lt = lrun; lt += __shfl_xor(lt, 16); lt += __shfl_xor(lt, 32);
    LAS float* cm = (LAS float*)(lds + 8 * 64 * KP);
    LAS float* cl = cm + 128; LAS float* co = cl + 128;
    if (quad == 0) { cm[wave * 16 + l16] = mrun; cl[wave * 16 + l16] = lt; }
#pragma unroll
    for (int dt = 0; dt < 4; ++dt)
#pragma unroll
        for (int r = 0; r < 4; ++r) co[(wave * 16 + l16) * 64 + 16 * dt + 4 * quad + r] = o[dt][r];
    __syncthreads();
    {
        const int q = tid >> 5, d0 = (tid & 31) * 2;
        float mm = cm[q];
#pragma unroll
        for (int w = 1; w < 8; ++w) mm = fmaxf(mm, cm[w * 16 + q]);
        float L = 0.f, a0 = 0.f, a1 = 0.f;
#pragma unroll
        for (int w = 0; w < 8; ++w) { const float f = __builtin_amdgcn_exp2f(cm[w * 16 + q] - mm); L += cl[w * 16 + q] * f; a0 += co[(w * 16 + q) * 64 + d0] * f; a1 += co[(w * 16 + q) * 64 + d0 + 1] * f; }
        const float il = 1.0f / L;
        *(unsigned*)(mix + (row0 + q) * D + PW + h * HD + d0) = pk2(a0 * il, a1 * il);
    }
    __syncthreads();
}

__device__ __forceinline__ void phase_attn(const Params& p, LAS unsigned char* lds, int l, int ci, int mode, int tid, int lane, int wave) {
    unsigned* ctr = (unsigned*)(p.ws + WS_CTL) + 64 * ci;
    LAS unsigned* slot = (LAS unsigned*)(lds + LDS_BYTES - 64);
    char* lds_generic = (char*)lds;
    const bf16_t* Q = (const bf16_t*)(p.ws + WS_Q); const bf16_t* Kb = (const bf16_t*)(p.ws + WS_K); const bf16_t* Vb = (const bf16_t*)(p.ws + WS_V);
    const float* Fp = (const float*)(p.ws + WS_FP); bf16_t* mix = (bf16_t*)(p.ws + WS_MIX);
    float thr;
    {
        const float gq = fabsf(p.in[12][l * HD + lane]), gk = fabsf(p.in[13][l * HD + lane]);
        float mq = gq, mk = gk;
#pragma unroll
        for (int o = 1; o < 64; o <<= 1) { mq = fmaxf(mq, __shfl_xor(mq, o)); mk = fmaxf(mk, __shfl_xor(mk, o)); }
        thr = 53.f + 2.f * (64.f * mq * mk * C2 + 0.5f);
    }
    LAS unsigned* cnt = (LAS unsigned*)lds;
    LAS unsigned* keys = (LAS unsigned*)(lds + 1024);
    LAS unsigned short* order = (LAS unsigned short*)(lds + fa::LDS_END);
    const float* Fs = (const float*)(p.ws + WS_FS);
    for (int i = tid; i < 216; i += 512) cnt[i] = 0u;
    __syncthreads();
    for (int i = tid; i < 24 * 124; i += 512) { const int bh = i / 124, j = i % 124 + 1; const float* Fh = Fp + (size_t)bh * T; if (Fh[64 * j - 1] - Fh[31 * 256] >= thr) atomicAdd((unsigned*)(cnt + bh), 1u); }
    for (int i = tid; i < 192 * 15; i += 512) { const int si = i / 15, j = i % 15 + 1; const float* Fh = Fs + (size_t)si * SKEYS; if (Fh[256 * j - 1] - Fh[PAST] >= thr) atomicAdd((unsigned*)(cnt + 24 + si), 1u); }
    __syncthreads();
    for (int id = tid; id < 1024; id += 512) {
        unsigned key = 0u;
        if (id < 768) { const int bh = id >> 5, qb = id & 31, w = 124 - (int)(cnt[bh] & ~1u); int t0a = 4 * qb - w; t0a = t0a > 0 ? (t0a & ~1) : 0;
            key = ((unsigned)(4 * (qb + 1) - t0a + 3) << 10) | (unsigned)(1023 - id); }
        else if (id < 960) { const int nst = 16 - (int)cnt[24 + id - 768]; key = ((unsigned)(5 + (10 * nst) / 3) << 10) | (unsigned)(1023 - id); }
        keys[id] = key;
    }
    __syncthreads();
    {
        const unsigned k0 = keys[tid], k1 = keys[tid + 512]; unsigned p0 = 0u, p1 = 0u;
        for (int k = 0; k < 1024; k += 4) { const u32x4 v = *(const LAS u32x4*)(keys + k);
            p0 += (v.x > k0) + (v.y > k0) + (v.z > k0) + (v.w > k0); p1 += (v.x > k1) + (v.y > k1) + (v.z > k1) + (v.w > k1); }
        order[p0] = (unsigned short)tid;
        if (tid + 512 < 960) order[p1] = (unsigned short)(tid + 512);
    }
    __syncthreads();
    for (;;) {
        if (tid == 0) *slot = atomicAdd(ctr, 1u);
        __syncthreads();
        const int idx = (int)*slot;
        __syncthreads();
        if (idx >= 960) break;
        const int id = (int)order[idx];
        const int tf = fresh_tid(), lf = tf & 63, wf = __builtin_amdgcn_readfirstlane(tf >> 6);
        if (id >= 768) { if (mode == 1) continue; const int si = id - 768; attn_sample_unit(l, si / NH, si % NH, p, lds, tf, lf, wf, thr); }
        else { if (mode == 2) continue; const int bh = id >> 5, qb = id & 31;
            int t0;
            { const float* Fh = Fp + (size_t)bh * T; const float f0 = Fh[qb * 256 + vzero()];
              const int ja = lf + 1, jb2 = lf + 65, jmax = 4 * qb;
              const bool ca = (ja <= jmax) && (Fh[64 * (ja <= jmax ? ja : 1) - 1] - f0 >= thr), cb = (jb2 <= jmax) && (Fh[64 * (jb2 <= jmax ? jb2 : 1) - 1] - f0 >= thr);
              t0 = (__popcll(__ballot(ca)) + __popcll(__ballot(cb))) & ~1; }
            fa::attn_unit<8>(bh / NH, bh % NH, qb, Q, Kb, Vb, Fp, mix, lds_generic, tf, t0);
        }
    }
    if (mode == 0) { const int tf = fresh_tid(); pool_items(p, lds, l, ctr + 8, slot, tf, tf & 63, __builtin_amdgcn_readfirstlane(tf >> 6)); }
}

#define XB_XCNT(j) (1024 + 64 * (j))
#define XB_XSUB(j) (2048 + 64 * (j))
#define XB_XGEN(j) (3072 + 64 * (j))
#define XB_TOP 4096
#define XB_TOPGEN 4160
__device__ __forceinline__ unsigned xb_ld(unsigned* p) { return __hip_atomic_load(p, __ATOMIC_RELAXED, __HIP_MEMORY_SCOPE_AGENT); }
__device__ __forceinline__ unsigned xb_add(unsigned* p, unsigned v) { return __hip_atomic_fetch_add(p, v, __ATOMIC_RELAXED, __HIP_MEMORY_SCOPE_AGENT); }
__device__ __forceinline__ unsigned xcc_id() { return (unsigned)__builtin_amdgcn_s_getreg((3 << 11) | 20) & 0xFu; }
__device__ __forceinline__ void grid_bar(unsigned* bar, volatile LAS unsigned* st) {
    asm volatile("s_waitcnt vmcnt(0)" ::: "memory");
    __syncthreads();
    if (threadIdx.x == 0) {
        __builtin_amdgcn_s_waitcnt(0);
        const unsigned x = xcc_id(), nloc = st[0], nx = st[1];
        const unsigned old = xb_add(&bar[XB_XSUB(x)], 1u);
        const unsigned gen = old / nloc;
        if (old + 1u == (gen + 1u) * nloc) {
            __builtin_amdgcn_fence(__ATOMIC_RELEASE, "agent");
            asm volatile("s_waitcnt vmcnt(0)" ::: "memory");
            const unsigned og = xb_add(&bar[XB_TOP], 1u);
            const unsigned tg = og / nx;
            if (og + 1u == (tg + 1u) * nx) xb_add(&bar[XB_TOPGEN], 1u);
            else { while (xb_ld(&bar[XB_TOPGEN]) == tg) __builtin_amdgcn_s_sleep(1); }
            __builtin_amdgcn_fence(__ATOMIC_ACQUIRE, "agent");
            xb_add(&bar[XB_XGEN(x)], 1u);
            asm volatile("s_waitcnt vmcnt(0)" ::: "memory");
        } else {
            while (xb_ld(&bar[XB_XGEN(x)]) == gen) __builtin_amdgcn_s_sleep(1);
            __builtin_amdgcn_fence(__ATOMIC_ACQUIRE, "agent");
            asm volatile("s_waitcnt vmcnt(0)" ::: "memory");
        }
    }
    __syncthreads();
}
#define FRESH_TID() fresh_tid()
#define TLW(t) (t), ((t) & 63), __builtin_amdgcn_readfirstlane((t) >> 6)
__global__ void __launch_bounds__(512, 2) fwd_megakernel(Params p) {
    extern __shared__ __attribute__((aligned(16))) unsigned char lds_raw[];
    LAS unsigned char* lds = (LAS unsigned char*)lds_raw;
    cg::grid_group grid = cg::this_grid();
    const int G = gridDim.x;

    unsigned* bar_w = (unsigned*)(p.ws + WS_CTL);
    if (threadIdx.x == 0) (void)xb_add(&bar_w[XB_XCNT(xcc_id())], 1u);
    { const int t_ = FRESH_TID(); phase_prologue(p, lds, TLW(t_)); }

#ifdef XSYNC
    for (int i = 0; i < XSYNC; ++i) grid.sync();
#endif
    volatile LAS unsigned* bar_st = (volatile LAS unsigned*)(lds + LDS_BYTES - 32);
    if (threadIdx.x == 0) {
        unsigned mine, cnt, sum; const unsigned x = xcc_id();
        for (;;) {
            mine = 0u; cnt = 0u; sum = 0u;
            for (unsigned j = 0; j < 16; ++j) { const unsigned c = xb_ld(&bar_w[XB_XCNT(j)]); sum += c; cnt += (c > 0u) ? 1u : 0u; mine = (j == x) ? c : mine; }
            if (sum == (unsigned)G) break;
            __builtin_amdgcn_s_sleep(1);
        }
        bar_st[0] = mine; bar_st[1] = cnt;
    }
    __syncthreads();
#define GB() grid_bar(bar_w, bar_st)
    if (G == 0x7fffffff) grid.sync();
    GB();
    float* xa = (float*)(p.ws + WS_XA); float* xb = (float*)(p.ws + WS_XB);
    bf16_t* hn = (bf16_t*)(p.ws + WS_HN);
    for (int l = 0; l < 2; ++l) {
        const float* xp = (l == 0) ? p.in[0] : xb; const float* xs = (l == 0) ? p.in[1] : xb + (size_t)MP * D;
        float* yp = (l == 0) ? xb : p.out; float* ys = yp + (size_t)MP * D;
        const float* modl = (const float*)(p.ws + WS_MOD) + (size_t)l * NMODROW * MODW;
        for (int rep = 0; rep < NREP(0); ++rep) {
            { const int t_ = FRESH_TID(); phase_norm(p, lds, l, 1, xp, xs, TLW(t_)); }
            GB();
        }
        for (int rep = 0; rep < NREP(1); ++rep) {
            pg8::Gemm g{hn, (const bf16_t*)(p.ws + WS_WIN) + (size_t)l * NMAIN * D, M, NMAIN, D};
            pg8::StaticOrder S; S.init(MP, NMAIN, G, (int)blockIdx.x);
            EpiIn E{l, p.out, (bf16_t*)(p.ws + WS_Q), (bf16_t*)(p.ws + WS_K), (bf16_t*)(p.ws + WS_V), (float*)(p.ws + WS_U), p.in[12] + l * HD, p.in[13] + l * HD};
            pg8::gemm_phase<EpiIn, true, true>(lds, g, S, E, FRESH_TID());
            { SEpiIn SE{l, p.out, (bf16_t*)(p.ws + WS_Q), (bf16_t*)(p.ws + WS_K), (bf16_t*)(p.ws + WS_V), (float*)(p.ws + WS_U), p.in[12] + l * HD, p.in[13] + l * HD};
              const int t_ = FRESH_TID(); skinny_phase<SEpiIn>(lds, g.A, g.Bt, NMAIN, D, SE, TLW(t_)); }
            { const int t_ = FRESH_TID(); scan_items(p, lds, l, TLW(t_)); }
            if (l == 0 && rep == 0) {
                for (int ll = 0; ll < 2; ++ll) { SEpiBias SE{(float*)(p.ws + WS_BIAS2) + (size_t)ll * NMODROW * FF}; const int t_ = FRESH_TID();
                    skinny_phase<SEpiBias>(lds, (const bf16_t*)(p.ws + WS_SH2) + (size_t)ll * 32 * D, (const bf16_t*)(p.ws + WS_WUP) + (size_t)ll * FF * D, FF, D, SE, TLW(t_), 0, 2); }
            }
            GB();
        }
        for (int rep = 0; rep < NREP(3); ++rep) {
            { const int t_ = FRESH_TID(); phase_attn(p, lds, l, l * 2 + rep, rep == 0 ? 0 : ATT_DUP_MODE, TLW(t_)); }
            GB();
        }
        for (int rep = 0; rep < NREP(4); ++rep) {
            pg8::Gemm g{(const bf16_t*)(p.ws + WS_MIX), (const bf16_t*)(p.ws + WS_WOUT) + (size_t)l * D * D, M, D, D};
            pg8::StaticOrder S; S.init(MP, D, G, (int)blockIdx.x);
            EpiResN E{xp, xa, modl + 2 * D, modl + 4 * D, hn, (float*)(p.ws + WS_SS)};
            pg8::gemm_phase<EpiResN, false, true>(lds, g, S, E, FRESH_TID());
            { SEpiResN SE{xs, xa + (size_t)MP * D, modl + 2 * D, modl + 4 * D, hn, (float*)(p.ws + WS_SS)}; const int t_ = FRESH_TID(); skinny_phase<SEpiResN>(lds, g.A, g.Bt, D, D, SE, TLW(t_)); }
            GB();
        }
        for (int rep = 0; rep < NREP(6); ++rep) {
            pg8::Gemm g{hn, (const bf16_t*)(p.ws + WS_WUP) + (size_t)l * FF * D, M, FF, D};
            pg8::StaticOrder S; S.init(MP, FF, G, (int)blockIdx.x);
            const float* bias_l = (const float*)(p.ws + WS_BIAS2) + (size_t)l * NMODROW * FF;
            EpiUpN E{(bf16_t*)(p.ws + WS_HID), (const float*)(p.ws + WS_SS), bias_l};
            pg8::gemm_phase<EpiUpN, true, true>(lds, g, S, E, FRESH_TID());
            { SEpiUpN SE{(bf16_t*)(p.ws + WS_HID), (const float*)(p.ws + WS_SS), bias_l}; const int t_ = FRESH_TID(); skinny_phase<SEpiUpN>(lds, g.A, g.Bt, FF, D, SE, TLW(t_)); }
            GB();
        }
        for (int rep = 0; rep < NREP(7); ++rep) {
            pg8::Gemm g{(const bf16_t*)(p.ws + WS_HID), (const bf16_t*)(p.ws + WS_WDN) + (size_t)l * D * FF, M, D, FF};
            pg8::StaticOrder S; S.init(MP, D, G, (int)blockIdx.x);
            EpiRes E{xa, xa + (size_t)MP * D, yp, ys, modl + 5 * D};
            pg8::gemm_phase<EpiRes, false, true>(lds, g, S, E, FRESH_TID());
            { SEpiRes SE{xa + (size_t)MP * D, ys, modl + 5 * D}; const int t_ = FRESH_TID(); skinny_phase<SEpiRes>(lds, g.A, g.Bt, D, FF, SE, TLW(t_)); }
            if (l == 0 || rep + 1 < NREP(7)) GB();
        }
    }
}

extern "C" void kernel_launch(void* const* d_in, const int* in_sizes, int n_in, void* d_out, int out_size, void* d_ws, size_t ws_size, hipStream_t stream) {
    static int grid = 0;
    if (grid == 0) {
        if (n_in != 19 || (size_t)out_size != OUT_TOTAL || ws_size < WS_END) { fprintf(stderr, "kernel_launch: unexpected shapes (n_in %d out %d ws %zu)\n", n_in, out_size, ws_size); grid = -1; return; }
        int dev = 0, cus = 0, per_cu = 0;
        hipGetDevice(&dev);
        hipDeviceGetAttribute(&cus, hipDeviceAttributeMultiprocessorCount, dev);
        hipFuncSetAttribute((const void*)fwd_megakernel, hipFuncAttributeMaxDynamicSharedMemorySize, LDS_BYTES);
        hipOccupancyMaxActiveBlocksPerMultiprocessor(&per_cu, (const void*)fwd_megakernel, 512, LDS_BYTES);
        if (per_cu < 1) { fprintf(stderr, "kernel_launch: occupancy query says %d blocks per CU\n", per_cu); per_cu = 1; }
        grid = cus;
    }
    if (grid < 0) return;
    hipMemsetAsync((char*)d_ws + WS_CTL, 0, 20480, stream);
    Params p{};
    for (int i = 0; i < 19; ++i) p.in[i] = (const float*)d_in[i];
    p.out = (float*)d_out; p.ws = (unsigned char*)d_ws;
    void* args[] = {&p};
    hipError_t e = hipLaunchCooperativeKernel((const void*)fwd_megakernel, dim3(grid), dim3(512), args, LDS_BYTES, stream);
    if (e != hipSuccess) fprintf(stderr, "cooperative launch failed: %s (grid %d)\n", hipGetErrorString(e), grid);
}
```

```cpp
#include <hip/hip_runtime.h>
#include <hip/hip_cooperative_groups.h>
#include <cstdio>
#include <cstdint>
namespace cg = cooperative_groups;

#define LAS __attribute__((address_space(3)))
typedef unsigned short bf16_t;
typedef short bf16x8 __attribute__((ext_vector_type(8)));
typedef short s16x4 __attribute__((ext_vector_type(4)));
typedef float f32x4 __attribute__((ext_vector_type(4)));
typedef float f32x2 __attribute__((ext_vector_type(2)));
typedef unsigned u32x4 __attribute__((ext_vector_type(4)));
typedef unsigned u32x2 __attribute__((ext_vector_type(2)));

constexpr int D = 1024, T = 8192, NBP = 2, SB = 16, ST = 16, PAST = 4096;
constexpr int MP = NBP * T, MS = SB * ST, M = MP + MS;
constexpr int NH = 12, HD = 64, AW = 768, PW = 256, INC = 2572, NMAIN = 2560, FF = 4096;
constexpr int NMODROW = 18, MODW = 6 * D;
constexpr float EPS = 1e-6f;
constexpr float LOG2E = 1.4426950408889634f;
constexpr float C2 = 0.125f * LOG2E;
constexpr int SKEYS = PAST + ST;

constexpr size_t OFF_Y = 0;
constexpr size_t OFF_KP = (size_t)M * D;
constexpr size_t OFF_VP = OFF_KP + (size_t)2 * MP * AW;
constexpr size_t OFF_FP = OFF_VP + (size_t)2 * MP * AW;
constexpr size_t OFF_PP = OFF_FP + (size_t)2 * MP * NH;
constexpr size_t OFF_KS = OFF_PP + (size_t)2 * NBP * 15 * PW;
constexpr size_t OFF_VS = OFF_KS + (size_t)2 * MS * AW;
constexpr size_t OFF_FS = OFF_VS + (size_t)2 * MS * AW;
constexpr size_t OFF_PS = OFF_FS + (size_t)2 * MS * NH;
constexpr size_t OUT_TOTAL = OFF_PS + (size_t)2 * SB * 15 * PW;

constexpr size_t MiB = 1u << 20;
constexpr size_t WS_CTL = 0;
constexpr size_t WS_MOD = 1 * MiB;
constexpr size_t WS_WIN = 2 * MiB;
constexpr size_t WS_WOUT = 12 * MiB;
constexpr size_t WS_WUP = 16 * MiB;
constexpr size_t WS_WDN = 32 * MiB;
constexpr size_t WS_HN = 48 * MiB;
constexpr size_t WS_Q = 82 * MiB;
constexpr size_t WS_K = 108 * MiB;
constexpr size_t WS_V = 134 * MiB;
constexpr size_t WS_U = 160 * MiB;
constexpr size_t WS_MIX = 178 * MiB;
constexpr size_t WS_FP = 212 * MiB;
constexpr size_t WS_FS = 213 * MiB;
constexpr size_t WS_SS = 217 * MiB;
constexpr size_t WS_BIAS2 = WS_SS + 128 * 1024;
constexpr size_t WS_SH2 = WS_BIAS2 + 640 * 1024;
constexpr size_t WS_WF = WS_SH2 + 128 * 1024;
constexpr size_t WS_XA = 218 * MiB;
constexpr size_t WS_XB = 284 * MiB;
constexpr size_t WS_HID = 350 * MiB;
constexpr size_t WS_END = 482 * MiB;

constexpr int LDS_BYTES = 147456;
#ifndef DUP
#define DUP 0
#endif
#define NREP(k) (1 + ((DUP >> (k)) & 1))
#ifndef ATT_DUP_MODE
#define ATT_DUP_MODE 0
#endif

__device__ __forceinline__ unsigned f2bf(float f) { unsigned u = __builtin_bit_cast(unsigned, f); return (u + 0x7fffu + ((u >> 16) & 1u)) >> 16; }
typedef __bf16 bf16x2_t __attribute__((ext_vector_type(2)));
__device__ __forceinline__ unsigned pk2(float lo, float hi) { const f32x2 v = {lo, hi}; const bf16x2_t b = __builtin_convertvector(v, bf16x2_t); return __builtin_bit_cast(unsigned, b); }
template <int CTRL> __device__ __forceinline__ float dpp_f(float v) { return __builtin_bit_cast(float, __builtin_amdgcn_update_dpp(0, __builtin_bit_cast(int, v), CTRL, 0xF, 0xF, false)); }
__device__ __forceinline__ float quad_sum(float v) {
    auto a = __builtin_amdgcn_permlane16_swap(__float_as_uint(v), __float_as_uint(v), false, false);
    const float s = __uint_as_float(a[0]) + __uint_as_float(a[1]);
    auto b = __builtin_amdgcn_permlane32_swap(__float_as_uint(s), __float_as_uint(s), false, false);
    return __uint_as_float(b[0]) + __uint_as_float(b[1]);
}
__device__ __forceinline__ float wave_sum(float v) {
    v += dpp_f<0x128>(v); v += dpp_f<0x124>(v); v += dpp_f<0x122>(v); v += dpp_f<0x121>(v);
    return quad_sum(v);
}

__device__ __forceinline__ int vzero() { int z = 0; asm volatile("" : "+v"(z)); return z; }
__device__ __forceinline__ int fresh_tid() { int t = threadIdx.x; asm volatile("" : "+v"(t)); return t; }
namespace pg8 {
constexpr int BM = 256, BK = 64, HALF = 128, HTB = HALF * BK * 2, NXCD = 8, WGM = 8;
__host__ __device__ __forceinline__ int lds_byte(int r, int c) { const int st = (r >> 4) * 2 + (c >> 5), rr = r & 15, cc = c & 31, ob = rr * 64 + cc * 2; return st * 1024 + (ob ^ (((ob >> 9) & 1) << 5)); }
__host__ __device__ __forceinline__ void stage_rc(int b, int& R, int& C) { const int st = b / 1024, sb = b % 1024, swz = sb ^ (((sb >> 9) & 1) << 5); R = (st >> 1) * 16 + swz / 64; C = (st & 1) * 32 + (swz % 64) / 2; }
__host__ __device__ __forceinline__ int perm32(int rho) { const int n = rho >> 4, i = rho & 15; return 8 * (i >> 2) + 4 * n + (i & 3); }

struct Unit { int pm, pn; };
struct Gemm { const bf16_t* A; const bf16_t* Bt; int M, N, K; };

struct StaticOrder {
    int nM, nN, nwg, G, c;
    __device__ void init(int M_, int N_, int G_, int c_) { nM = M_ / BM; nN = N_ / BM; nwg = nM * nN; G = G_; c = c_; }
    __device__ bool next(int i, Unit& u) const {
        const long L = (long)i * G + c; if (L >= nwg) return false;
        int wgid = (int)L; { const int q = nwg / NXCD, r = nwg % NXCD, xcd = wgid % NXCD, off = wgid / NXCD; wgid = (xcd < r ? xcd * (q + 1) : r * (q + 1) + (xcd - r) * q) + off; }
        const int nig = WGM * nN, gid = wgid / nig, fm = gid * WGM, gsz = (nM - fm) < WGM ? (nM - fm) : WGM;
        u.pm = fm + ((wgid % nig) % gsz); u.pn = (wgid % nig) / gsz; return true;
    }
};

template <class Epi, bool ALIGN_EPI, bool SP2>
__device__ __forceinline__ void gemm_phase(LAS unsigned char* lds, const Gemm g, const StaticOrder& S, const Epi& E, const int tid) {
    const int wid = __builtin_amdgcn_readfirstlane(tid >> 6), lane = tid & 63, wr = wid >> 2, wc = wid & 3, fr = lane & 15, fq = lane >> 4;
    const int K = g.K, nt = K / BK;
    unsigned voffA[2], voffB[2];
#pragma unroll
    for (int i = 0; i < 2; ++i) { int R, C; stage_rc(tid * 16 + i * 8192, R, C); const int Rb = 64 * (R >> 5) + perm32(R & 31);
        voffA[i] = (unsigned)(R * K + C) * 2u; voffB[i] = (unsigned)(Rb * K + C) * 2u; }
    const size_t kstep = (size_t)(BK * 2);
    const size_t hstep = (size_t)HALF * K * 2;
    const size_t hstepB = (size_t)32 * K * 2;
    const size_t tstep = 2 * hstep;
    const unsigned ldsw = (unsigned)wid * 1024u;
    const int aoff = lds_byte(wr * 64 + fr, fq * 8), boff = lds_byte(wc * 32 + fr, fq * 8);
#define PG8_SA(b, h) (((b) * 2 + (h)) * HTB)
#define PG8_SB(b, h) ((4 + (b) * 2 + (h)) * HTB)
#define PG8_STAGE(bufoff, gbase, voff) do { _Pragma("unroll") for (int _i = 0; _i < 2; ++_i) \
        __builtin_amdgcn_global_load_lds((const unsigned*)((const char*)(gbase) + (voff)[_i]), (LAS unsigned*)(lds + (bufoff) + ldsw + _i * 8192), 16, 0, 0); } while (0)
#define PG8_LDA(dst, b, h) do { _Pragma("unroll") for (int m = 0; m < 4; ++m) _Pragma("unroll") for (int k = 0; k < 2; ++k) dst[m][k] = *(const LAS bf16x8*)(lds + PG8_SA(b, h) + aoff + m * 2048 + k * 1024); } while (0)
#define PG8_LDB(dst, b, h) do { _Pragma("unroll") for (int n = 0; n < 2; ++n) _Pragma("unroll") for (int k = 0; k < 2; ++k) dst[n][k] = *(const LAS bf16x8*)(lds + PG8_SB(b, h) + boff + n * 2048 + k * 1024); } while (0)
#define PG8_MMA(ai, bj, At, Bt) do { __builtin_amdgcn_s_setprio(1); _Pragma("unroll") for (int m = 0; m < 4; ++m) _Pragma("unroll") for (int n = 0; n < 2; ++n) _Pragma("unroll") for (int k = 0; k < 2; ++k) \
        acc[ai][bj][m][n] = __builtin_amdgcn_mfma_f32_16x16x32_bf16(Bt[n][k], At[m][k], acc[ai][bj][m][n], 0, 0, 0); __builtin_amdgcn_s_setprio(0); } while (0)
#define PG8_WAIT_V(n) asm volatile("s_waitcnt vmcnt(" #n ")" ::: "memory")
#define PG8_WAIT_L(n) asm volatile("s_waitcnt lgkmcnt(" #n ")" ::: "memory")
#define PG8_BAR __builtin_amdgcn_s_barrier()
#define PG8_SCHED __builtin_amdgcn_sched_barrier(0)
    Unit cur, nxt; int ui = 0;
    if (!S.next(0, cur)) return;
    f32x4 acc[2][2][4][2];
#pragma unroll
    for (int a = 0; a < 2; ++a)
#pragma unroll
        for (int b = 0; b < 2; ++b)
#pragma unroll
            for (int m = 0; m < 4; ++m)
#pragma unroll
                for (int n = 0; n < 2; ++n) acc[a][b][m][n] = (f32x4){0.f, 0.f, 0.f, 0.f};
    bf16x8 At[4][2], B0[2][2], B1[2][2];
    const char* cA = (const char*)g.A + (size_t)cur.pm * tstep; const char* cB = (const char*)g.Bt + (size_t)cur.pn * tstep;
    if constexpr (SP2) {
        PG8_STAGE(PG8_SB(0, 0), cB, voffB); PG8_STAGE(PG8_SB(0, 1), cB + hstepB, voffB); PG8_STAGE(PG8_SA(0, 0), cA, voffA); PG8_STAGE(PG8_SA(0, 1), cA + hstep, voffA);
        if (wr == 1) PG8_BAR;
        PG8_WAIT_V(2); PG8_BAR;
        PG8_STAGE(PG8_SB(1, 0), cB + kstep, voffB); PG8_STAGE(PG8_SA(1, 0), cA + kstep, voffA); PG8_STAGE(PG8_SB(1, 1), cB + hstepB + kstep, voffB);
        PG8_WAIT_V(6); PG8_BAR;
    } else {
    PG8_STAGE(PG8_SB(0, 0), cB, voffB); PG8_STAGE(PG8_SA(0, 0), cA, voffA); PG8_STAGE(PG8_SB(0, 1), cB + hstepB, voffB); PG8_STAGE(PG8_SA(0, 1), cA + hstep, voffA);
    if (wr == 1) PG8_BAR;
    PG8_WAIT_V(4); PG8_BAR;
    PG8_STAGE(PG8_SB(1, 0), cB + kstep, voffB); PG8_STAGE(PG8_SA(1, 0), cA + kstep, voffA); PG8_STAGE(PG8_SB(1, 1), cB + hstepB + kstep, voffB);
    PG8_WAIT_V(6); PG8_BAR;
    }
    for (;;) {
        const bool has_next = S.next(ui + 1, nxt);
        const char* nA = has_next ? (const char*)g.A + (size_t)nxt.pm * tstep : cA; const char* nB = has_next ? (const char*)g.Bt + (size_t)nxt.pn * tstep : cB;
        for (int t = 0; t < nt; t += 2) {
            const bool last = (t == nt - 2);
            const char* a1 = cA + (size_t)(t + 1) * kstep;
            const char* a2 = last ? nA : cA + (size_t)(t + 2) * kstep; const char* b2 = last ? nB : cB + (size_t)(t + 2) * kstep;
            const char* a3 = a2 + kstep; const char* b3 = b2 + kstep;
            if constexpr (SP2) {
            PG8_LDB(B0, 0, 0); PG8_LDB(B1, 0, 1); PG8_SCHED; PG8_LDA(At, 0, 0); PG8_STAGE(PG8_SA(1, 1), a1 + hstep, voffA);
            PG8_WAIT_V(8); PG8_WAIT_L(0); PG8_BAR; PG8_MMA(0, 0, At, B0); PG8_MMA(0, 1, At, B1); PG8_BAR; PG8_SCHED;
            PG8_LDA(At, 0, 1); PG8_STAGE(PG8_SB(0, 0), b2, voffB); PG8_STAGE(PG8_SB(0, 1), b2 + hstepB, voffB); PG8_STAGE(PG8_SA(0, 0), a2, voffA);
            PG8_WAIT_V(8); PG8_WAIT_L(0); PG8_BAR; PG8_MMA(1, 0, At, B0); PG8_MMA(1, 1, At, B1); PG8_BAR; PG8_SCHED;
            PG8_LDB(B0, 1, 0); PG8_LDB(B1, 1, 1); PG8_SCHED; PG8_LDA(At, 1, 0); PG8_STAGE(PG8_SA(0, 1), a2 + hstep, voffA);
            PG8_WAIT_V(8); PG8_WAIT_L(0); PG8_BAR; PG8_MMA(0, 0, At, B0); PG8_MMA(0, 1, At, B1); PG8_BAR; PG8_SCHED;
            PG8_LDA(At, 1, 1); PG8_STAGE(PG8_SB(1, 0), b3, voffB); PG8_STAGE(PG8_SB(1, 1), b3 + hstepB, voffB); PG8_STAGE(PG8_SA(1, 0), a3, voffA);
            PG8_WAIT_V(8); PG8_WAIT_L(0); PG8_BAR; PG8_MMA(1, 0, At, B0); PG8_MMA(1, 1, At, B1); PG8_BAR; PG8_SCHED;
            } else {
            PG8_LDB(B0, 0, 0); PG8_SCHED; PG8_LDA(At, 0, 0); PG8_STAGE(PG8_SA(1, 1), a1 + hstep, voffA);
            PG8_WAIT_L(8); PG8_BAR; PG8_WAIT_L(0); PG8_MMA(0, 0, At, B0); PG8_BAR; PG8_SCHED;
            PG8_LDB(B1, 0, 1); PG8_STAGE(PG8_SB(0, 0), b2, voffB);
            PG8_BAR; PG8_WAIT_L(0); PG8_MMA(0, 1, At, B1); PG8_BAR;
            PG8_LDA(At, 0, 1); PG8_STAGE(PG8_SA(0, 0), a2, voffA);
            PG8_BAR; PG8_WAIT_L(0); PG8_MMA(1, 0, At, B0); PG8_BAR; PG8_SCHED;
            PG8_STAGE(PG8_SB(0, 1), b2 + hstepB, voffB);
            PG8_WAIT_V(6); PG8_BAR; PG8_MMA(1, 1, At, B1); PG8_BAR;
            PG8_LDB(B0, 1, 0); PG8_SCHED; PG8_LDA(At, 1, 0); PG8_STAGE(PG8_SA(0, 1), a2 + hstep, voffA);
            PG8_WAIT_L(8); PG8_BAR; PG8_WAIT_L(0); PG8_MMA(0, 0, At, B0); PG8_BAR; PG8_SCHED;
            PG8_LDB(B1, 1, 1); PG8_STAGE(PG8_SB(1, 0), b3, voffB);
            PG8_BAR; PG8_WAIT_L(0); PG8_MMA(0, 1, At, B1); PG8_BAR;
            PG8_LDA(At, 1, 1); PG8_STAGE(PG8_SA(1, 0), a3, voffA);
            PG8_BAR; PG8_WAIT_L(0); PG8_MMA(1, 0, At, B0); PG8_BAR; PG8_SCHED;
            PG8_STAGE(PG8_SB(1, 1), b3 + hstepB, voffB);
            PG8_WAIT_V(6); PG8_BAR; PG8_MMA(1, 1, At, B1); PG8_BAR;
            }
        }
        if constexpr (ALIGN_EPI) { if (wr == 0) PG8_BAR; }
        E(acc, cur, wr, wc, fr, fq);
        if (!has_next) break;
#pragma unroll
        for (int a = 0; a < 2; ++a)
#pragma unroll
            for (int b = 0; b < 2; ++b)
#pragma unroll
                for (int m = 0; m < 4; ++m)
#pragma unroll
                    for (int n = 0; n < 2; ++n) acc[a][b][m][n] = (f32x4){0.f, 0.f, 0.f, 0.f};
        cur = nxt; cA = nA; cB = nB; ++ui;
        if constexpr (ALIGN_EPI) { if (wr == 1) PG8_BAR; }
    }
    PG8_WAIT_V(0);
    if constexpr (!ALIGN_EPI) { if (wr == 0) PG8_BAR; }
    PG8_BAR;
#undef PG8_SA
#undef PG8_SB
#undef PG8_STAGE
#undef PG8_LDA
#undef PG8_LDB
#undef PG8_MMA
#undef PG8_WAIT_V
#undef PG8_WAIT_L
#undef PG8_BAR
#undef PG8_SCHED
}
}

__device__ __forceinline__ void st_bf16x8(bf16_t* p, f32x4 a, f32x4 b) {
    u32x4 w; w.x = pk2(a[0], a[1]); w.y = pk2(a[2], a[3]); w.z = pk2(b[0], b[1]); w.w = pk2(b[2], b[3]);
    *(u32x4*)p = w;
}
__device__ __forceinline__ int brow_of(int r) { return r < MP ? (r >> 13) : 2 + ((r - MP) >> 4); }

struct EpiIn {
    int l; float* out; bf16_t* qb; bf16_t* kb; bf16_t* vb; float* ub; const float* qg; const float* kg;
    __device__ __forceinline__ void operator()(const f32x4 (&acc)[2][2][4][2], const pg8::Unit& u, int wr, int wc, int fr, int fq) const {
        const int pn = u.pn, rbase = u.pm * 256 + wr * 64 + fr;
        if (pn == 0) {
            const int cb = 64 * wc + 8 * fq;
#pragma unroll
            for (int ai = 0; ai < 2; ++ai)
#pragma unroll
                for (int m = 0; m < 4; ++m) {
                    const int r = rbase + ai * 128 + m * 16;
                    float* up = ub + (size_t)r * PW + cb;
                    float* sp = nullptr;
                    if (r < MP) { const int t = r & (T - 1); if (t >= T - 15) sp = out + OFF_PP + ((size_t)((l * NBP + (r >> 13)) * 15 + (t - (T - 15)))) * PW + cb; }
                    else { const int rr = r - MP, t = rr & 15; if (t >= 1) sp = out + OFF_PS + ((size_t)((l * SB + (rr >> 4)) * 15 + (t - 1))) * PW + cb; }
#pragma unroll
                    for (int bj = 0; bj < 2; ++bj) {
                        *(f32x4*)(up + 32 * bj) = acc[ai][bj][m][0]; *(f32x4*)(up + 32 * bj + 4) = acc[ai][bj][m][1];
                        if (sp) { *(f32x4*)(sp + 32 * bj) = acc[ai][bj][m][0]; *(f32x4*)(sp + 32 * bj + 4) = acc[ai][bj][m][1]; }
                    }
                }
        } else if (pn <= 6) {
            const bool isq = pn <= 3;
            const int head = ((pn - 1) % 3) * 4 + wc;
            const float* gp = (isq ? qg : kg) + 8 * fq;
            f32x4 gv[2][2];
#pragma unroll
            for (int bj = 0; bj < 2; ++bj)
#pragma unroll
                for (int n = 0; n < 2; ++n) gv[bj][n] = *(const f32x4*)(gp + 32 * bj + 4 * n);
            bf16_t* dst = isq ? qb : kb;
#pragma unroll
            for (int ai = 0; ai < 2; ++ai)
#pragma unroll
                for (int m = 0; m < 4; ++m) {
                    const int r = rbase + ai * 128 + m * 16;
                    float ss = 0.f;
#pragma unroll
                    for (int bj = 0; bj < 2; ++bj)
#pragma unroll
                        for (int n = 0; n < 2; ++n) { const f32x4 a = acc[ai][bj][m][n]; ss += (a[0] * a[0] + a[1] * a[1]) + (a[2] * a[2] + a[3] * a[3]); }
                    ss = quad_sum(ss);
                    float rinv = 1.0f / sqrtf(ss * (1.f / 64.f) + EPS);
                    const float rq = isq ? rinv * C2 : rinv;
                    float* ko = nullptr;
                    if (!isq) ko = out + (r < MP ? OFF_KP + ((size_t)l * MP + r) * AW : OFF_KS + ((size_t)l * MS + (r - MP)) * AW) + head * 64 + 8 * fq;
#pragma unroll
                    for (int bj = 0; bj < 2; ++bj) {
                        const f32x4 n0 = acc[ai][bj][m][0] * rinv * gv[bj][0], n1 = acc[ai][bj][m][1] * rinv * gv[bj][1];
                        if (isq) { const f32x4 s0 = acc[ai][bj][m][0] * rq * gv[bj][0], s1 = acc[ai][bj][m][1] * rq * gv[bj][1];
                            st_bf16x8(dst + (size_t)r * AW + head * 64 + 32 * bj + 8 * fq, s0, s1); }
                        else { st_bf16x8(dst + (size_t)r * AW + head * 64 + 32 * bj + 8 * fq, n0, n1);
                            *(f32x4*)(ko + 32 * bj) = n0; *(f32x4*)(ko + 32 * bj + 4) = n1; }
                    }
                }
        } else {
            const int head = (pn - 7) * 4 + wc;
#pragma unroll
            for (int ai = 0; ai < 2; ++ai)
#pragma unroll
                for (int m = 0; m < 4; ++m) {
                    const int r = rbase + ai * 128 + m * 16;
                    float* vo = out + (r < MP ? OFF_VP + ((size_t)l * MP + r) * AW : OFF_VS + ((size_t)l * MS + (r - MP)) * AW) + head * 64 + 8 * fq;
#pragma unroll
                    for (int bj = 0; bj < 2; ++bj) {
                        st_bf16x8(vb + (size_t)r * AW + head * 64 + 32 * bj + 8 * fq, acc[ai][bj][m][0], acc[ai][bj][m][1]);
                        *(f32x4*)(vo + 32 * bj) = acc[ai][bj][m][0]; *(f32x4*)(vo + 32 * bj + 4) = acc[ai][bj][m][1];
                    }
                }
        }
    }
};

struct EpiRes {
    const float* xip; const float* xis; float* xop; float* xos; const float* gate;
    __device__ __forceinline__ void operator()(const f32x4 (&acc)[2][2][4][2], const pg8::Unit& u, int wr, int wc, int fr, int fq) const {
        const int rbase = u.pm * 256 + wr * 64 + fr, cb = u.pn * 256 + 64 * wc + 8 * fq;
        const float* gp = gate + (size_t)((u.pm * 256) >> 13) * MODW + cb;
        constexpr int DEPTH = 3;
        f32x4 gg[2][2], xq[DEPTH][2][2];
#pragma unroll
        for (int bj = 0; bj < 2; ++bj)
#pragma unroll
            for (int n = 0; n < 2; ++n) gg[bj][n] = *(const f32x4*)(gp + 32 * bj + 4 * n);
#pragma unroll
        for (int d = 0; d < DEPTH; ++d) { const int r2 = rbase + (d >> 2) * 128 + (d & 3) * 16;
#pragma unroll
            for (int bj = 0; bj < 2; ++bj)
#pragma unroll
                for (int n = 0; n < 2; ++n) xq[d][bj][n] = *(const f32x4*)(xip + (size_t)r2 * D + cb + 32 * bj + 4 * n); }
#pragma unroll
        for (int it = 0; it < 8; ++it) {
            const int ai = it >> 2, m = it & 3, r = rbase + ai * 128 + m * 16;
            f32x4 xc[2][2];
#pragma unroll
            for (int bj = 0; bj < 2; ++bj)
#pragma unroll
                for (int n = 0; n < 2; ++n) xc[bj][n] = xq[it % DEPTH][bj][n];
            if (it + DEPTH < 8) { const int r2 = rbase + ((it + DEPTH) >> 2) * 128 + ((it + DEPTH) & 3) * 16;
#pragma unroll
                for (int bj = 0; bj < 2; ++bj)
#pragma unroll
                    for (int n = 0; n < 2; ++n) xq[it % DEPTH][bj][n] = *(const f32x4*)(xip + (size_t)r2 * D + cb + 32 * bj + 4 * n); }
            float* xo = xop + (size_t)r * D + cb;
#pragma unroll
            for (int bj = 0; bj < 2; ++bj)
#pragma unroll
                for (int n = 0; n < 2; ++n) *(f32x4*)(xo + 32 * bj + 4 * n) = xc[bj][n] + gg[bj][n] * acc[ai][bj][m][n];
            __builtin_amdgcn_sched_barrier(0);
        }
    }
};

struct EpiUp {
    bf16_t* hid;
    __device__ __forceinline__ void operator()(const f32x4 (&acc)[2][2][4][2], const pg8::Unit& u, int wr, int wc, int fr, int fq) const {
        const int rbase = u.pm * 256 + wr * 64 + fr, cb = u.pn * 256 + 64 * wc + 8 * fq;
#pragma unroll
        for (int ai = 0; ai < 2; ++ai)
#pragma unroll
            for (int m = 0; m < 4; ++m) {
                const int r = rbase + ai * 128 + m * 16;
#pragma unroll
                for (int bj = 0; bj < 2; ++bj) {
                    f32x4 a = acc[ai][bj][m][0], b = acc[ai][bj][m][1];
#pragma unroll
                    for (int j = 0; j < 4; ++j) { const float x = fmaxf(a[j], 0.f), y = fmaxf(b[j], 0.f); a[j] = x * x; b[j] = y * y; }
                    st_bf16x8(hid + (size_t)r * FF + cb + 32 * bj, a, b);
                }
            }
    }
};

template <class SEpi>
__device__ __forceinline__ void skinny_phase(LAS unsigned char* lds, const bf16_t* A, const bf16_t* Bt, int N, int K, const SEpi& E, int tid, int lane, int wave, int row0 = MP, int nrg = 16) {
    const int l16 = lane & 15, quad = lane >> 4;
    const int nr2 = nrg >> 1, nitems = nr2 * (N / 64);
    LAS float* red = (LAS float*)lds;
    const int kw = K / 8;
    const int G_ = (int)gridDim.x, b_ = (int)blockIdx.x;
    const int vb = (G_ % 8 == 0 && nr2 == 8 && nitems <= 2 * G_ && nitems != 320) ? (b_ % 8) * (G_ / 8) + b_ / 8 : G_ - 1 - b_;
    for (int it = vb; it < nitems; it += G_) {
        const int rg2 = it % nr2, cg = it / nr2;
        const bf16_t* ap = A + (size_t)(row0 + 32 * rg2 + l16) * K + wave * kw + quad * 8;
        const bf16_t* bp = Bt + (size_t)(cg * 64 + l16) * K + wave * kw + quad * 8;
        f32x4 acc[2][4];
#pragma unroll
        for (int h = 0; h < 2; ++h)
#pragma unroll
            for (int nt = 0; nt < 4; ++nt) acc[h][nt] = (f32x4){0.f, 0.f, 0.f, 0.f};
        for (int k0 = 0; k0 < kw; k0 += 128) {
            bf16x8 a0[4], a1[4], b[4][4];
#pragma unroll
            for (int s = 0; s < 4; ++s) {
                a0[s] = *(const bf16x8*)(ap + k0 + 32 * s); a1[s] = *(const bf16x8*)(ap + (size_t)16 * K + k0 + 32 * s);
#pragma unroll
                for (int nt = 0; nt < 4; ++nt) b[s][nt] = *(const bf16x8*)(bp + (size_t)nt * 16 * K + k0 + 32 * s);
            }
#pragma unroll
            for (int s = 0; s < 4; ++s)
#pragma unroll
                for (int nt = 0; nt < 4; ++nt) { acc[0][nt] = __builtin_amdgcn_mfma_f32_16x16x32_bf16(a0[s], b[s][nt], acc[0][nt], 0, 0, 0);
                    acc[1][nt] = __builtin_amdgcn_mfma_f32_16x16x32_bf16(a1[s], b[s][nt], acc[1][nt], 0, 0, 0); }
        }
#pragma unroll
        for (int h = 0; h < 2; ++h)
#pragma unroll
            for (int nt = 0; nt < 4; ++nt)
#pragma unroll
                for (int r = 0; r < 4; ++r) red[(wave * 32 + 16 * h + quad * 4 + r) * 64 + 16 * nt + l16] = acc[h][nt][r];
        __syncthreads();
        const int row = tid >> 5, c2 = (tid & 31) * 2;
#pragma unroll
        for (int h = 0; h < 2; ++h) {
            float v0 = 0.f, v1 = 0.f;
#pragma unroll
            for (int w = 0; w < 8; ++w) { const f32x2 t = *(const LAS f32x2*)(red + (w * 32 + 16 * h + row) * 64 + c2); v0 += t.x; v1 += t.y; }
            E(2 * rg2 + h, row, cg, c2, v0, v1);
        }
        __syncthreads();
    }
}

struct SEpiIn {
    int l; float* out; bf16_t* qb; bf16_t* kb; bf16_t* vb; float* ub; const float* qg; const float* kg;
    __device__ __forceinline__ void operator()(int b, int t, int cg, int c2, float v0, float v1) const {
        const int rr = 16 * b + t; const size_t r = (size_t)MP + rr;
        if (cg < 4) {
            const int c = cg * 64 + c2;
            *(f32x2*)(ub + r * PW + c) = (f32x2){v0, v1};
            if (t >= 1) *(f32x2*)(out + OFF_PS + ((size_t)((l * SB + b) * 15 + (t - 1))) * PW + c) = (f32x2){v0, v1};
        } else if (cg < 28) {
            const bool isq = cg < 16; const int head = isq ? cg - 4 : cg - 16;
            float ss = v0 * v0 + v1 * v1;
#pragma unroll
            for (int o = 1; o < 32; o <<= 1) ss += __shfl_xor(ss, o);
            const float rinv = 1.0f / sqrtf(ss * (1.f / 64.f) + EPS);
            const float* gp = (isq ? qg : kg) + c2;
            const float n0 = v0 * rinv * gp[0], n1 = v1 * rinv * gp[1];
            if (isq) *(unsigned*)(qb + r * AW + head * 64 + c2) = pk2(n0 * C2, n1 * C2);
            else { *(unsigned*)(kb + r * AW + head * 64 + c2) = pk2(n0, n1); *(f32x2*)(out + OFF_KS + ((size_t)l * MS + rr) * AW + head * 64 + c2) = (f32x2){n0, n1}; }
        } else {
            const int head = cg - 28;
            *(unsigned*)(vb + r * AW + head * 64 + c2) = pk2(v0, v1);
            *(f32x2*)(out + OFF_VS + ((size_t)l * MS + rr) * AW + head * 64 + c2) = (f32x2){v0, v1};
        }
    }
};
struct SEpiRes {
    const float* xis; float* xos; const float* gate;
    __device__ __forceinline__ void operator()(int b, int t, int cg, int c2, float v0, float v1) const {
        const size_t o = (size_t)(16 * b + t) * D + cg * 64 + c2;
        const f32x2 xv = *(const f32x2*)(xis + o), gg = *(const f32x2*)(gate + (size_t)(2 + b) * MODW + cg * 64 + c2);
        *(f32x2*)(xos + o) = (f32x2){xv.x + gg.x * v0, xv.y + gg.y * v1};
    }
};
struct SEpiUp {
    bf16_t* hid;
    __device__ __forceinline__ void operator()(int b, int t, int cg, int c2, float v0, float v1) const {
        const float x = fmaxf(v0, 0.f), y = fmaxf(v1, 0.f);
        *(unsigned*)(hid + ((size_t)MP + 16 * b + t) * FF + cg * 64 + c2) = pk2(x * x, y * y);
    }
};


struct EpiResN {
    const float* xip; float* xop; const float* gate; const float* sc2; bf16_t* xt; float* ss;
    __device__ __forceinline__ void operator()(const f32x4 (&acc)[2][2][4][2], const pg8::Unit& u, int wr, int wc, int fr, int fq) const {
        const int rbase = u.pm * 256 + wr * 64 + fr, cb = u.pn * 256 + 64 * wc + 8 * fq;
        const int brow = (u.pm * 256) >> 13;
        const float* gp = gate + (size_t)brow * MODW + cb; const float* sp = sc2 + (size_t)brow * MODW + cb;
        constexpr int DEPTH = 2;
        f32x4 gg[2][2], sv[2][2], xq[DEPTH][2][2];
#pragma unroll
        for (int bj = 0; bj < 2; ++bj)
#pragma unroll
            for (int n = 0; n < 2; ++n) { gg[bj][n] = *(const f32x4*)(gp + 32 * bj + 4 * n); sv[bj][n] = *(const f32x4*)(sp + 32 * bj + 4 * n) + 1.0f; }
#pragma unroll
        for (int d = 0; d < DEPTH; ++d) { const int r2 = rbase + (d >> 2) * 128 + (d & 3) * 16;
#pragma unroll
            for (int bj = 0; bj < 2; ++bj)
#pragma unroll
                for (int n = 0; n < 2; ++n) xq[d][bj][n] = *(const f32x4*)(xip + (size_t)r2 * D + cb + 32 * bj + 4 * n); }
#pragma unroll
        for (int it = 0; it < 8; ++it) {
            const int ai = it >> 2, m = it & 3, r = rbase + ai * 128 + m * 16;
            f32x4 xc[2][2];
#pragma unroll
            for (int bj = 0; bj < 2; ++bj)
#pragma unroll
                for (int n = 0; n < 2; ++n) xc[bj][n] = xq[it % DEPTH][bj][n];
            if (it + DEPTH < 8) { const int r2 = rbase + ((it + DEPTH) >> 2) * 128 + ((it + DEPTH) & 3) * 16;
#pragma unroll
                for (int bj = 0; bj < 2; ++bj)
#pragma unroll
                    for (int n = 0; n < 2; ++n) xq[it % DEPTH][bj][n] = *(const f32x4*)(xip + (size_t)r2 * D + cb + 32 * bj + 4 * n); }
            float* xo = xop + (size_t)r * D + cb;
            float s = 0.f;
#pragma unroll
            for (int bj = 0; bj < 2; ++bj) {
                f32x4 t[2];
#pragma unroll
                for (int n = 0; n < 2; ++n) {
                    const f32x4 x1 = xc[bj][n] + gg[bj][n] * acc[ai][bj][m][n];
                    *(f32x4*)(xo + 32 * bj + 4 * n) = x1;
                    s += (x1[0] * x1[0] + x1[1] * x1[1]) + (x1[2] * x1[2] + x1[3] * x1[3]);
                    t[n] = x1 * sv[bj][n];
                }
                st_bf16x8(xt + (size_t)r * D + cb + 32 * bj, t[0], t[1]);
            }
            s = quad_sum(s);
            if (fq == 0) atomicAdd(ss + r, s);
            __builtin_amdgcn_sched_barrier(0);
        }
    }
};
struct SEpiResN {
    const float* xis; float* xos; const float* gate; const float* sc2; bf16_t* xt; float* ss;
    __device__ __forceinline__ void operator()(int b, int t, int cg, int c2, float v0, float v1) const {
        const int rr = 16 * b + t; const size_t o = (size_t)rr * D + cg * 64 + c2;
        const f32x2 xv = *(const f32x2*)(xis + o), gg = *(const f32x2*)(gate + (size_t)(2 + b) * MODW + cg * 64 + c2), sv = *(const f32x2*)(sc2 + (size_t)(2 + b) * MODW + cg * 64 + c2);
        const float a0 = xv.x + gg.x * v0, a1 = xv.y + gg.y * v1;
        *(f32x2*)(xos + o) = (f32x2){a0, a1};
        *(unsigned*)(xt + ((size_t)MP + rr) * D + cg * 64 + c2) = pk2(a0 * (sv.x + 1.0f), a1 * (sv.y + 1.0f));
        float s = a0 * a0 + a1 * a1;
#pragma unroll
        for (int q = 1; q < 32; q <<= 1) s += __shfl_xor(s, q);
        if ((c2 >> 1) == 0) atomicAdd(ss + MP + rr, s);
    }
};
struct EpiUpN {
    bf16_t* hid; const float* ss; const float* bias;
    __device__ __forceinline__ void operator()(const f32x4 (&acc)[2][2][4][2], const pg8::Unit& u, int wr, int wc, int fr, int fq) const {
        const int rbase = u.pm * 256 + wr * 64 + fr, cb = u.pn * 256 + 64 * wc + 8 * fq;
        const float* bp = bias + (size_t)((u.pm * 256) >> 13) * FF + cb;
        f32x4 bv[2][2];
#pragma unroll
        for (int bj = 0; bj < 2; ++bj)
#pragma unroll
            for (int n = 0; n < 2; ++n) bv[bj][n] = *(const f32x4*)(bp + 32 * bj + 4 * n);
#pragma unroll
        for (int ai = 0; ai < 2; ++ai)
#pragma unroll
            for (int m = 0; m < 4; ++m) {
                const int r = rbase + ai * 128 + m * 16;
                const float rinv = 1.0f / sqrtf(ss[r] * (1.f / D) + EPS);
#pragma unroll
                for (int bj = 0; bj < 2; ++bj) {
                    f32x4 a = acc[ai][bj][m][0] * rinv + bv[bj][0], b = acc[ai][bj][m][1] * rinv + bv[bj][1];
#pragma unroll
                    for (int j = 0; j < 4; ++j) { const float x = fmaxf(a[j], 0.f), y = fmaxf(b[j], 0.f); a[j] = x * x; b[j] = y * y; }
                    st_bf16x8(hid + (size_t)r * FF + cb + 32 * bj, a, b);
                }
            }
    }
};
struct SEpiUpN {
    bf16_t* hid; const float* ss; const float* bias;
    __device__ __forceinline__ void operator()(int b, int t, int cg, int c2, float v0, float v1) const {
        const int r = MP + 16 * b + t;
        const float rinv = 1.0f / sqrtf(ss[r] * (1.f / D) + EPS);
        const f32x2 bb = *(const f32x2*)(bias + (size_t)(2 + b) * FF + cg * 64 + c2);
        const float x = fmaxf(v0 * rinv + bb.x, 0.f), y = fmaxf(v1 * rinv + bb.y, 0.f);
        *(unsigned*)(hid + (size_t)r * FF + cg * 64 + c2) = pk2(x * x, y * y);
    }
};
struct SEpiBias {
    float* bias;
    __device__ __forceinline__ void operator()(int rg, int t, int cg, int c2, float v0, float v1) const {
        const int row = 16 * rg + t;
        if (row < NMODROW) *(f32x2*)(bias + (size_t)row * FF + cg * 64 + c2) = (f32x2){v0, v1};
    }
};

struct Params { const float* in[19]; float* out; unsigned char* ws; };

__device__ __forceinline__ void transpose_item(const float* W, int ldw, int K, int nblk, bf16_t* WT, LAS float* scr, int item, int lane) {
    const int kb = item / nblk, nb = item % nblk, k0 = 64 * kb, n0 = 32 * nb;
    float tv[32];
#pragma unroll
    for (int i = 0; i < 32; ++i) tv[i] = W[(size_t)(k0 + 2 * i + (lane >> 5)) * ldw + n0 + (lane & 31)];
#pragma unroll
    for (int i = 0; i < 32; ++i) scr[(2 * i + (lane >> 5)) * 33 + (lane & 31)] = tv[i];
    asm volatile("s_waitcnt lgkmcnt(0)" ::: "memory");
    const int c = lane & 7;
#pragma unroll
    for (int j = 0; j < 4; ++j) { const int n = (lane >> 3) + 8 * j; const LAS float* s = scr + (8 * c) * 33 + n;
        u32x4 o; o.x = pk2(s[0 * 33], s[1 * 33]); o.y = pk2(s[2 * 33], s[3 * 33]); o.z = pk2(s[4 * 33], s[5 * 33]); o.w = pk2(s[6 * 33], s[7 * 33]);
        *(u32x4*)(WT + (size_t)(n0 + n) * K + k0 + 8 * c) = o; }
    asm volatile("s_waitcnt lgkmcnt(0)" ::: "memory");
}

__device__ __forceinline__ void phase_prologue(const Params& p, LAS unsigned char* lds, int tid, int lane, int wave) {
    LAS float* sc = (LAS float*)lds;
    LAS float* red = (LAS float*)(lds + 73728);
    for (int idx = tid; idx < NMODROW * D; idx += 512) {
        const int r = idx >> 10, k = idx & 1023;
        const float c = (r < 2) ? p.in[2][r * D + k] : p.in[3][(r - 2) * D + k];
        sc[k * 18 + r] = c / (1.f + __expf(-c));
    }
    __syncthreads();
    float* modw = (float*)(p.ws + WS_MOD);
    for (int it = blockIdx.x; it < 256; it += gridDim.x) {
        const int l = it >> 7, col0 = (it & 127) * 48;
        const int la = lane < 48 ? lane : 47, kk2 = la / 24, c2 = la % 24;
        const float* W = p.in[8] + (size_t)l * D * MODW + col0 + 2 * c2;
        float acc[18][2];
#pragma unroll
        for (int r = 0; r < 18; ++r) { acc[r][0] = 0.f; acc[r][1] = 0.f; }
        const int kb = wave * 128 + kk2;
#pragma unroll 16
        for (int i = 0; i < 64; ++i) {
            const int k = kb + 2 * i;
            const f32x2 wv = *(const f32x2*)(W + (size_t)k * MODW);
            const LAS f32x2* s2 = (const LAS f32x2*)(sc + k * 18);
#pragma unroll
            for (int r2 = 0; r2 < 9; ++r2) { const f32x2 s = s2[r2];
                acc[2 * r2][0] += s.x * wv.x; acc[2 * r2][1] += s.x * wv.y; acc[2 * r2 + 1][0] += s.y * wv.x; acc[2 * r2 + 1][1] += s.y * wv.y; }
        }
        if (lane < 48) {
#pragma unroll
            for (int r = 0; r < 18; ++r) { red[((wave * 2 + kk2) * 18 + r) * 48 + 2 * c2] = acc[r][0]; red[((wave * 2 + kk2) * 18 + r) * 48 + 2 * c2 + 1] = acc[r][1]; }
        }
        __syncthreads();
        for (int idx = tid; idx < 18 * 48; idx += 512) {
            const int r = idx / 48, c = idx % 48;
            float s = p.in[9][l * MODW + col0 + c];
#pragma unroll
            for (int w = 0; w < 16; ++w) s += red[(w * 18 + r) * 48 + c];
            modw[((size_t)l * NMODROW + r) * MODW + col0 + c] = s;
        }
        __syncthreads();
    }
    if (blockIdx.x < 32) {
        const int l = blockIdx.x >> 4, hh = blockIdx.x & 15;
        const float* Wf = p.in[10] + (size_t)l * D * INC + NMAIN + hh;
        bf16_t* wft = (bf16_t*)(p.ws + WS_WF) + ((size_t)l * 16 + hh) * 1032;
        for (int k = tid; k < 1032; k += 512) wft[k] = (bf16_t)f2bf((hh < NH && k < D) ? Wf[(size_t)k * INC] : 0.f);
    }
    LAS float* scr = (LAS float*)(lds + 73728 + wave * 8448);
    const int gw = blockIdx.x * 8 + wave, NGW = gridDim.x * 8;
    constexpr int I_IN = 16 * 80, I_OUT = 16 * 32, I_UP = 16 * 128, I_DN = 64 * 32, I_L = I_IN + I_OUT + I_UP + I_DN;
    for (int it = gw; it < 2 * I_L; it += NGW) {
        const int l = it / I_L; int r = it % I_L;
        if (r < I_IN) { transpose_item(p.in[10] + (size_t)l * D * INC, INC, D, 80, (bf16_t*)(p.ws + WS_WIN) + (size_t)l * NMAIN * D, scr, r, lane); continue; } r -= I_IN;
        if (r < I_OUT) { transpose_item(p.in[16] + (size_t)l * D * D, D, D, 32, (bf16_t*)(p.ws + WS_WOUT) + (size_t)l * D * D, scr, r, lane); continue; } r -= I_OUT;
        if (r < I_UP) { transpose_item(p.in[17] + (size_t)l * D * FF, FF, D, 128, (bf16_t*)(p.ws + WS_WUP) + (size_t)l * FF * D, scr, r, lane); continue; } r -= I_UP;
        transpose_item(p.in[18] + (size_t)l * FF * D, D, FF, 32, (bf16_t*)(p.ws + WS_WDN) + (size_t)l * D * FF, scr, r, lane);
    }
}

__device__ __forceinline__ void phase_norm(const Params& p, LAS unsigned char* lds, int l, int stage, const float* xp, const float* xs, int tid, int lane, int wave) {
    constexpr int HP = 1032;
    LAS bf16_t* wfb = (LAS bf16_t*)lds;
    LAS bf16_t* ht = (LAS bf16_t*)(lds + 33280);
    LAS float* pc = (LAS float*)(lds + 66560);
    {
        const u32x4* wsrc = (const u32x4*)(p.ws + WS_WF + (size_t)l * 16 * HP * 2);
        for (int i = tid; i < 16 * HP * 2 / 16; i += 512) *(LAS u32x4*)(lds + 16 * i) = wsrc[i];
        float* SS = (float*)(p.ws + WS_SS);
        for (int i = blockIdx.x * 512 + tid; i < M; i += gridDim.x * 512) SS[i] = 0.f;
        if (l == 0) {
            bf16_t* s2 = (bf16_t*)(p.ws + WS_SH2); const float* modall = (const float*)(p.ws + WS_MOD);
            for (int i = blockIdx.x * 512 + tid; i < 2 * 32 * D; i += gridDim.x * 512) { const int ll = i >> 15, row = (i >> 10) & 31, k = i & 1023;
                s2[i] = (bf16_t)f2bf(row < NMODROW ? modall[((size_t)ll * NMODROW + row) * MODW + 3 * D + k] : 0.f); }
        }
    }
    __syncthreads();
    const float* modl = (const float*)(p.ws + WS_MOD) + (size_t)l * NMODROW * MODW;
    bf16_t* hn = (bf16_t*)(p.ws + WS_HN);
    const int l16 = lane & 15, quad = lane >> 4;
    const int rpb = (M + (int)gridDim.x - 1) / (int)gridDim.x, R0 = (int)blockIdx.x * rpb, R1 = (R0 + rpb < M) ? R0 + rpb : M;
    for (int g0 = R0; g0 < R1; g0 += 16) {
#pragma unroll
        for (int rr = 0; rr < 2; ++rr) {
            const int lr = 2 * wave + rr, m = g0 + lr;
            LAS unsigned long long* h8 = (LAS unsigned long long*)(ht + lr * HP) + lane;
            if (m < R1) {
                const f32x4* xr = (const f32x4*)(m < MP ? xp + (size_t)m * D : xs + (size_t)(m - MP) * D) + lane;
                f32x4 v[4]; float ss = 0.f;
#pragma unroll
                for (int j = 0; j < 4; ++j) { v[j] = xr[64 * j]; ss += (v[j].x * v[j].x + v[j].y * v[j].y) + (v[j].z * v[j].z + v[j].w * v[j].w); }
                ss = wave_sum(ss);
                const float rinv = 1.0f / sqrtf(ss * (1.f / D) + EPS);
                const float* mrow = modl + (size_t)brow_of(m) * MODW;
                const f32x4* sh4 = (const f32x4*)mrow + lane; const f32x4* sc4 = (const f32x4*)(mrow + D) + lane;
                unsigned long long* o8 = (unsigned long long*)(hn + (size_t)m * D) + lane;
#pragma unroll
                for (int j = 0; j < 4; ++j) {
                    const f32x4 shv = sh4[64 * j], scv = sc4[64 * j];
                    v[j] = v[j] * rinv * (scv + 1.0f) + shv;
                    const unsigned long long w = (unsigned long long)pk2(v[j].x, v[j].y) | ((unsigned long long)pk2(v[j].z, v[j].w) << 32);
                    o8[64 * j] = w; h8[64 * j] = w;
                }
            } else {
#pragma unroll
                for (int j = 0; j < 4; ++j) h8[64 * j] = 0ull;
            }
        }
        __syncthreads();
        {
            f32x4 c = (f32x4){0.f, 0.f, 0.f, 0.f};
#pragma unroll
            for (int s = 0; s < 4; ++s) {
                const int k0 = 32 * (4 * wave + s) + 8 * quad;
                const bf16x8 a = *(const LAS bf16x8*)(ht + l16 * HP + k0), b = *(const LAS bf16x8*)(wfb + l16 * HP + k0);
                c = __builtin_amdgcn_mfma_f32_16x16x32_bf16(a, b, c, 0, 0, 0);
            }
#pragma unroll
            for (int r = 0; r < 4; ++r) pc[(wave * 16 + quad * 4 + r) * 16 + l16] = c[r];
        }
        __syncthreads();
        if (tid < 16 * NH) {
            const int row = tid / NH, hh = tid % NH, m = g0 + row;
            if (m < R1) {
                float x = p.in[11][l * NH + hh];
#pragma unroll
                for (int w = 0; w < 8; ++w) x += pc[(w * 16 + row) * 16 + hh];
                const float lf = fminf(x, 0.f) - log1pf(expf(-fabsf(x)));
                float* o = p.out + (m < MP ? OFF_FP + ((size_t)l * MP + m) * NH : OFF_FS + ((size_t)l * MS + (m - MP)) * NH);
                o[hh] = lf;
            }
        }
    }
}

__device__ __forceinline__ float block_scan_offset(float total, LAS float* sm, int lane, int wave) {
    float x = total;
#pragma unroll
    for (int o = 1; o < 64; o <<= 1) { const float n = __shfl_up(x, o); if (lane >= o) x += n; }
    __syncthreads();
    if (lane == 63) sm[wave] = x;
    __syncthreads();
    float off = x - total;
    for (int w = 0; w < wave; ++w) off += sm[w];
    return off;
}

__device__ __forceinline__ void scan_items(const Params& p, LAS unsigned char* lds, int l, int tid, int lane, int wave) {
    LAS float* sm = (LAS float*)(lds + 65536);
    float* Fp = (float*)(p.ws + WS_FP); float* Fs = (float*)(p.ws + WS_FS);
    const int nb = (int)gridDim.x / 2;
    if ((int)blockIdx.x < (int)gridDim.x - nb) return;
    for (int it = (int)(gridDim.x - 1 - blockIdx.x); it < 24 + 192; it += nb) {
        if (it < 24) {
            const int b = it / NH, h = it % NH;
            const float* src = p.out + OFF_FP + ((size_t)(l * NBP + b) * T) * NH + h;
            const int t0 = tid * 16;
            float v[16]; float run = 0.f;
#pragma unroll
            for (int e = 0; e < 16; ++e) { run += src[(size_t)(t0 + e) * NH]; v[e] = run; }
            const float off = block_scan_offset(run, sm, lane, wave);
            float* dst = Fp + (size_t)it * T + t0;
#pragma unroll
            for (int e = 0; e < 16; e += 4) *(f32x4*)(dst + e) = (f32x4){(off + v[e]) * LOG2E, (off + v[e + 1]) * LOG2E, (off + v[e + 2]) * LOG2E, (off + v[e + 3]) * LOG2E};
        } else {
            const int bh = it - 24, b = bh / NH, h = bh % NH;
            const float* src = p.in[6] + ((size_t)(l * SB + b) * PAST) * NH + h;
            const int t0 = tid * 8;
            float v[8]; float run = 0.f;
#pragma unroll
            for (int e = 0; e < 8; ++e) { run += src[(size_t)(t0 + e) * NH]; v[e] = run; }
            const float off = block_scan_offset(run, sm, lane, wave);
            float* dst = Fs + (size_t)bh * SKEYS + t0;
#pragma unroll
            for (int e = 0; e < 8; e += 4) *(f32x4*)(dst + e) = (f32x4){(off + v[e]) * LOG2E, (off + v[e + 1]) * LOG2E, (off + v[e + 2]) * LOG2E, (off + v[e + 3]) * LOG2E};
            if (tid == 511) sm[8] = off + run;
            __syncthreads();
            if (tid < ST) {
                const float* ns = p.out + OFF_FS + ((size_t)(l * SB + b) * ST) * NH + h;
                float s = sm[8];
                for (int e = 0; e <= tid; ++e) s += ns[e * NH];
                Fs[(size_t)bh * SKEYS + PAST + tid] = s * LOG2E;
            }
        }
        __syncthreads();
    }
}

__device__ __forceinline__ void pool_items(const Params& p, LAS unsigned char* lds, int l, unsigned* ctr, LAS unsigned* slot, int tid, int lane, int wave) {
    LAS float* z = (LAS float*)lds;
    LAS bf16_t* am = (LAS bf16_t*)(lds + 81920);
    const float* ub = (const float*)(p.ws + WS_U);
    bf16_t* mix = (bf16_t*)(p.ws + WS_MIX);
    const int g = wave >> 1, ntp = (wave & 1) * 2, l16 = lane & 15, quad = lane >> 4;
    bf16x8 bw[2][2];
    {
        const float* wp = p.in[14] + ((size_t)(l * 4 + g) * 64) * 64;
#pragma unroll
        for (int nt = 0; nt < 2; ++nt)
#pragma unroll
            for (int ks = 0; ks < 2; ++ks) {
                bf16x8 t;
#pragma unroll
                for (int j = 0; j < 8; ++j) t[j] = (short)f2bf(wp[(size_t)(32 * ks + 8 * quad + j) * 64 + 16 * (ntp + nt) + l16]);
                bw[nt][ks] = t;
            }
    }
    for (;;) {
      if (tid == 0) *slot = atomicAdd(ctr, 1u);
      __syncthreads();
      const int ent = (int)*slot;
      __syncthreads();
      if (ent >= MP / 64 + MS / 16) break;
      const bool prm = ent < MP / 64;
      const int row0 = prm ? ent * 64 : MP + (ent - MP / 64) * 16;
      const int nr = prm ? 4 : 1, nz = 15 + 16 * nr;
      const int t0 = prm ? (row0 & (T - 1)) : 0;
      for (int idx = tid; idx < nz * 64; idx += 512) {
          const int zr = idx >> 6, c4 = (idx & 63) * 4;
          f32x4 val = (f32x4){0.f, 0.f, 0.f, 0.f};
          if (zr >= 15) val = *(const f32x4*)(ub + (size_t)(row0 + zr - 15) * PW + c4);
          else if (prm) { if (t0 > 0) val = *(const f32x4*)(ub + (size_t)(row0 + zr - 15) * PW + c4); }
          else val = *(const f32x4*)(p.in[7] + ((size_t)(l * SB + ((row0 - MP) >> 4)) * 15 + zr) * PW + c4);
          *(LAS f32x4*)(z + zr * 256 + c4) = val;
      }
      __syncthreads();
      for (int i = 0; i < nr; ++i) {
          const int row = (tid >> 5) + 16 * i, c0 = (tid & 31) * 8, gg = c0 >> 6, w = 2 << gg;
          f32x4 s0 = (f32x4){0.f, 0.f, 0.f, 0.f}, s1 = s0;
          for (int j = 0; j < w; ++j) { s0 += *(const LAS f32x4*)(z + (15 + row - j) * 256 + c0); s1 += *(const LAS f32x4*)(z + (15 + row - j) * 256 + c0 + 4); }
          float cnt = (float)w;
          if (prm) { const float pos1 = (float)(t0 + row + 1); cnt = fminf(pos1, cnt); }
          const float ic = 1.0f / cnt;
          const f32x4 u0 = *(const LAS f32x4*)(z + (15 + row) * 256 + c0), u1 = *(const LAS f32x4*)(z + (15 + row) * 256 + c0 + 4);
          s0 = s0 * ic - u0; s1 = s1 * ic - u1;
          u32x4 o; o.x = pk2(s0[0], s0[1]); o.y = pk2(s0[2], s0[3]); o.z = pk2(s1[0], s1[1]); o.w = pk2(s1[2], s1[3]);
          *(LAS u32x4*)(am + row * 264 + c0) = o;
      }
      __syncthreads();
      for (int i = 0; i < nr; ++i) {
          f32x4 c[2] = {(f32x4){0.f, 0.f, 0.f, 0.f}, (f32x4){0.f, 0.f, 0.f, 0.f}};
#pragma unroll
          for (int ks = 0; ks < 2; ++ks) {
              const bf16x8 a = *(const LAS bf16x8*)(am + (16 * i + l16) * 264 + g * 64 + 32 * ks + 8 * quad);
#pragma unroll
              for (int nt = 0; nt < 2; ++nt) c[nt] = __builtin_amdgcn_mfma_f32_16x16x32_bf16(a, bw[nt][ks], c[nt], 0, 0, 0);
          }
#pragma unroll
          for (int nt = 0; nt < 2; ++nt) {
              const int col = g * 64 + 16 * (ntp + nt) + l16;
              const float ps = p.in[15][l * PW + col];
#pragma unroll
              for (int r = 0; r < 4; ++r) mix[(size_t)(row0 + 16 * i + quad * 4 + r) * D + col] = (bf16_t)f2bf(c[nt][r] * ps);
          }
      }
      __syncthreads();
    }
}

__device__ __forceinline__ s16x4 vtr(const LAS unsigned char* ptr) { return __builtin_bit_cast(s16x4, __builtin_amdgcn_ds_read_tr16_b64_v4i16((LAS s16x4*)ptr)); }
constexpr int KP = 144;

__device__ __forceinline__ float xmax_q(float v) {
    auto a = __builtin_amdgcn_permlane16_swap(__float_as_uint(v), __float_as_uint(v), false, false);
    const float m = __builtin_fmaxf(__uint_as_float(a[0]), __uint_as_float(a[1]));
    auto b = __builtin_amdgcn_permlane32_swap(__float_as_uint(m), __float_as_uint(m), false, false);
    return __builtin_fmaxf(__uint_as_float(b[0]), __uint_as_float(b[1]));
}
__device__ __forceinline__ void attn_tile64(const LAS unsigned char* Kt, const LAS unsigned char* Vt, const LAS float* Ft, int key0, int Qw, bool diag,
                                            const bf16x8 (&qf)[2][2], const float (&fq)[2], float (&fqm)[2], float (&mrun)[2], float (&lrun)[2], f32x4 (&o)[4][2], int l16, int quad) {
    f32x4 s[4][2];
    bf16x8 kf[2][4]; f32x4 fk[4];
#pragma unroll
    for (int ks = 0; ks < 2; ++ks)
#pragma unroll
        for (int kt = 0; kt < 4; ++kt) kf[ks][kt] = *(const LAS bf16x8*)(Kt + (16 * kt + l16) * KP + ks * 64 + quad * 16);
#pragma unroll
    for (int kt = 0; kt < 4; ++kt) fk[kt] = *(const LAS f32x4*)(Ft + 16 * kt + 4 * quad);
    __builtin_amdgcn_sched_barrier(0);
#pragma unroll
    for (int kt = 0; kt < 4; ++kt)
#pragma unroll
        for (int qt = 0; qt < 2; ++qt) s[kt][qt] = (f32x4){fqm[qt] - fk[kt][0], fqm[qt] - fk[kt][1], fqm[qt] - fk[kt][2], fqm[qt] - fk[kt][3]};
#pragma unroll
    for (int ks = 0; ks < 2; ++ks)
#pragma unroll
        for (int kt = 0; kt < 4; ++kt)
#pragma unroll
            for (int qt = 0; qt < 2; ++qt) s[kt][qt] = __builtin_amdgcn_mfma_f32_16x16x32_bf16(kf[ks][kt], qf[qt][ks], s[kt][qt], 0, 0, 0);
    s16x4 va[2][4][2];
    {
        const LAS unsigned char* vb0 = Vt + (4 * quad + (l16 >> 2)) * KP + 8 * (l16 & 3);
#pragma unroll
        for (int k2 = 0; k2 < 2; ++k2)
#pragma unroll
            for (int dt = 0; dt < 4; ++dt) { va[k2][dt][0] = vtr(vb0 + 32 * k2 * KP + 32 * dt); va[k2][dt][1] = vtr(vb0 + (32 * k2 + 16) * KP + 32 * dt); }
    }
    __builtin_amdgcn_sched_barrier(0);
    if (diag) {
#pragma unroll
        for (int kt = 0; kt < 4; ++kt)
#pragma unroll
            for (int qt = 0; qt < 2; ++qt)
#pragma unroll
                for (int r = 0; r < 4; ++r) { const int key = key0 + 16 * kt + 4 * quad + r, qq = Qw + 16 * qt + l16; if (key > qq) s[kt][qt][r] = -INFINITY; }
    }
    float mx[2];
#pragma unroll
    for (int qt = 0; qt < 2; ++qt) {
        float a = __builtin_fmaxf(__builtin_fmaxf(s[0][qt][0], s[0][qt][1]), s[0][qt][2]), c = __builtin_fmaxf(__builtin_fmaxf(s[0][qt][3], s[1][qt][0]), s[1][qt][1]);
        a = __builtin_fmaxf(__builtin_fmaxf(a, s[1][qt][2]), s[1][qt][3]); c = __builtin_fmaxf(__builtin_fmaxf(c, s[2][qt][0]), s[2][qt][1]);
        a = __builtin_fmaxf(__builtin_fmaxf(a, s[2][qt][2]), s[2][qt][3]); c = __builtin_fmaxf(__builtin_fmaxf(c, s[3][qt][0]), s[3][qt][1]);
        a = __builtin_fmaxf(__builtin_fmaxf(a, s[3][qt][2]), s[3][qt][3]);
        float m_ = __builtin_fmaxf(a, c);
        mx[qt] = xmax_q(m_);
    }
    if (__any((mx[0] > 8.f) || (mx[1] > 8.f))) {
#pragma unroll
        for (int qt = 0; qt < 2; ++qt) {
            const float dl = __builtin_fmaxf(mx[qt], 0.f);
            mrun[qt] += dl; fqm[qt] = fq[qt] - mrun[qt];
            const float al = __builtin_amdgcn_exp2f(-dl);
            lrun[qt] *= al;
#pragma unroll
            for (int kt = 0; kt < 4; ++kt) s[kt][qt] -= dl;
#pragma unroll
            for (int dt = 0; dt < 4; ++dt) o[dt][qt] *= al;
        }
    }
#pragma unroll
    for (int qt = 0; qt < 2; ++qt) {
        float ps = 0.f;
#pragma unroll
        for (int kt = 0; kt < 4; ++kt)
#pragma unroll
            for (int r = 0; r < 4; ++r) { const float e = __builtin_amdgcn_exp2f(s[kt][qt][r]); s[kt][qt][r] = e; ps += e; }
        lrun[qt] += ps;
    }
#pragma unroll
    for (int k2 = 0; k2 < 2; ++k2) {
        bf16x8 pb[2];
#pragma unroll
        for (int qt = 0; qt < 2; ++qt) {
            u32x4 w; w.x = pk2(s[2 * k2][qt][0], s[2 * k2][qt][1]); w.y = pk2(s[2 * k2][qt][2], s[2 * k2][qt][3]);
            w.z = pk2(s[2 * k2 + 1][qt][0], s[2 * k2 + 1][qt][1]); w.w = pk2(s[2 * k2 + 1][qt][2], s[2 * k2 + 1][qt][3]);
            pb[qt] = __builtin_bit_cast(bf16x8, w);
        }
#pragma unroll
        for (int dt = 0; dt < 4; ++dt) {
            const s16x4 a0 = va[k2][dt][0], a1 = va[k2][dt][1];
            const bf16x8 vf = (bf16x8){a0[0], a0[1], a0[2], a0[3], a1[0], a1[1], a1[2], a1[3]};
#pragma unroll
            for (int qt = 0; qt < 2; ++qt) o[dt][qt] = __builtin_amdgcn_mfma_f32_16x16x32_bf16(vf, pb[qt], o[dt][qt], 0, 0, 0);
        }
    }
}

constexpr int TB = 128 * KP;
__device__ __forceinline__ void attn_prompt_unit(int b, int h, int qb, const bf16_t* Q, const bf16_t* Kb, const bf16_t* Vb, const float* F2, bf16_t* mix,
                                                 LAS unsigned char* lds, int tid, int lane, int wave) {
    const int l16 = lane & 15, quad = lane >> 4;
    const size_t rowbase = (size_t)b * T;
    const int Qw = qb * 256 + wave * 32;
    const float* Fh = F2 + (size_t)(b * NH + h) * T;
    bf16x8 qf[2][2]; float fq[2];
#pragma unroll
    for (int qt = 0; qt < 2; ++qt) {
#pragma unroll
        for (int ks = 0; ks < 2; ++ks) qf[qt][ks] = *(const bf16x8*)(Q + (rowbase + Qw + 16 * qt + l16) * AW + h * HD + 32 * ks + 8 * quad);
        fq[qt] = Fh[Qw + 16 * qt + l16];
    }
    f32x4 o[4][2];
#pragma unroll
    for (int dt = 0; dt < 4; ++dt) { o[dt][0] = (f32x4){0.f, 0.f, 0.f, 0.f}; o[dt][1] = o[dt][0]; }
    float mrun[2] = {0.f, 0.f}, lrun[2] = {0.f, 0.f}, fqm[2] = {fq[0], fq[1]};
    const int NT = 2 * qb + 2;
    LAS unsigned char* Kl = lds; LAS unsigned char* Vl = lds + 2 * TB; LAS float* Fl = (LAS float*)(lds + 4 * TB);
    const int skey = tid >> 3, sch = tid & 7;
    const bf16_t* kg = Kb + (rowbase + skey) * AW + h * HD + sch * 8;
    const bf16_t* vg = Vb + (rowbase + skey) * AW + h * HD + sch * 8;
    u32x4 kreg0 = *(const u32x4*)kg, kreg1 = *(const u32x4*)(kg + (size_t)64 * AW), vreg0 = *(const u32x4*)vg, vreg1 = *(const u32x4*)(vg + (size_t)64 * AW);
    f32x4 freg = (f32x4){0.f, 0.f, 0.f, 0.f};
    if (tid < 32) freg = *(const f32x4*)(Fh + tid * 4);
    const int soff = skey * KP + sch * 16;
    *(LAS u32x4*)(Kl + soff) = kreg0; *(LAS u32x4*)(Kl + 64 * KP + soff) = kreg1; *(LAS u32x4*)(Vl + soff) = vreg0; *(LAS u32x4*)(Vl + 64 * KP + soff) = vreg1;
    if (tid < 32) *(LAS f32x4*)(Fl + tid * 4) = freg;
    __syncthreads();
    for (int t = 0; t < NT; ++t) {
        const int buf = t & 1;
        if (t + 1 < NT) {
            const size_t go = (size_t)(t + 1) * 128 * AW;
            kreg0 = *(const u32x4*)(kg + go); kreg1 = *(const u32x4*)(kg + go + (size_t)64 * AW); vreg0 = *(const u32x4*)(vg + go); vreg1 = *(const u32x4*)(vg + go + (size_t)64 * AW);
            if (tid < 32) freg = *(const f32x4*)(Fh + (t + 1) * 128 + tid * 4);
        }
#pragma unroll
        for (int sub = 0; sub < 2; ++sub) {
            const int key0 = t * 128 + sub * 64;
            if (key0 <= Qw)
                attn_tile64(Kl + buf * TB + sub * 64 * KP, Vl + buf * TB + sub * 64 * KP, Fl + buf * 128 + sub * 64, key0, Qw, key0 + 63 > Qw, qf, fq, fqm, mrun, lrun, o, l16, quad);
        }
        if (t + 1 < NT) {
            const int nb = buf ^ 1;
            *(LAS u32x4*)(Kl + nb * TB + soff) = kreg0; *(LAS u32x4*)(Kl + nb * TB + 64 * KP + soff) = kreg1;
            *(LAS u32x4*)(Vl + nb * TB + soff) = vreg0; *(LAS u32x4*)(Vl + nb * TB + 64 * KP + soff) = vreg1;
            if (tid < 32) *(LAS f32x4*)(Fl + nb * 128 + tid * 4) = freg;
        }
        __syncthreads();
    }
#pragma unroll
    for (int qt = 0; qt < 2; ++qt) {
        float lt = lrun[qt]; lt += __shfl_xor(lt, 16); lt += __shfl_xor(lt, 32);
        const float il = 1.0f / lt;
        bf16_t* op = mix + (rowbase + Qw + 16 * qt + l16) * D + PW + h * HD + 4 * quad;
#pragma unroll
        for (int dt = 0; dt < 4; ++dt) {
            u32x2 w; w.x = pk2(o[dt][qt][0] * il, o[dt][qt][1] * il); w.y = pk2(o[dt][qt][2] * il, o[dt][qt][3] * il);
            *(u32x2*)(op + 16 * dt) = w;
        }
    }
}


namespace fa {
using f32x16 = __attribute__((ext_vector_type(16))) float;
constexpr int SEQ = T, DH = 64, DM = AW;
constexpr int NW = 8, QBLK = 32, QB = QBLK * NW, KVBLK = 64;
__device__ __forceinline__ int crow(int r, int hi) { return (r & 3) + 8 * (r >> 2) + 4 * hi; }
#define SBAR() __builtin_amdgcn_sched_barrier(0)
__device__ __forceinline__ void cmask(f32x16& p0, f32x16& p1, int jb, int qrel, int hi) {
    const float NEG = -INFINITY; int kb = 64 * jb + 4 * hi;
#pragma unroll
    for (int r = 0; r < 16; ++r) { int kv = kb + (r & 3) + 8 * (r >> 2); if (kv > qrel) p0[r] = NEG; if (kv + 32 > qrel) p1[r] = NEG; }
}
constexpr int NSLOT = 3, SLOTB = 8192;
constexpr int LDS_K = 0, LDS_V = NSLOT * SLOTB, LDS_WS = 2 * NSLOT * SLOTB, LDS_OST = LDS_WS + NW * 64 * 4, LDS_FK = LDS_OST + NW * 4096, LDS_END = LDS_FK + SEQ * 4;
__device__ __forceinline__ void glds16(const void* gsrc, unsigned lds_dst) { unsigned keep;
    asm volatile("s_mov_b32 %0, m0\n\ts_mov_b32 m0, %2\n\ts_nop 0\n\tglobal_load_lds_dwordx4 %1, off\n\ts_mov_b32 m0, %0" : "=&s"(keep) : "v"(gsrc), "s"(lds_dst) : "memory"); }
__device__ __forceinline__ float max3f(float a, float b, float c) { float r; asm("v_max3_f32 %0, %1, %2, %3" : "=v"(r) : "v"(a), "v"(b), "v"(c)); return r; }
__device__ __forceinline__ float max2f(float a, float b) { float r; asm("v_max_f32_e32 %0, %1, %2" : "=v"(r) : "v"(a), "v"(b)); return r; }
__device__ __forceinline__ float fadd_s(float a, float b) { float r; asm("v_add_f32_e32 %0, %1, %2" : "=v"(r) : "v"(a), "v"(b)); return r; }
__device__ __forceinline__ float fsub_s(float a, float b) { float r; asm("v_sub_f32_e32 %0, %1, %2" : "=v"(r) : "v"(a), "v"(b)); return r; }
__device__ __forceinline__ unsigned cvtpk_s(float lo, float hi) { return pk2(lo, hi); }
#define WAIT_BAR(N) asm volatile("s_waitcnt vmcnt(" #N ") lgkmcnt(0)\n\ts_barrier" ::: "memory")
typedef __attribute__((address_space(3))) const char* lds_cptr;
__device__ __forceinline__ void bias_half(f32x16& c, lds_cptr fkt, float cq, int hi) {
#pragma unroll
    for (int g = 0; g < 4; ++g) {
        const f32x4 a = *(const LAS f32x4*)(fkt + (8 * g + 4 * hi) * 4);
#pragma unroll
        for (int j = 0; j < 4; ++j) c[4 * g + j] = cq - a[j];
    }
}
__device__ __forceinline__ void bias_init(f32x16& c0, f32x16& c1, lds_cptr fkt, float cq, int hi) {
#pragma unroll
    for (int g = 0; g < 4; ++g) {
        const f32x4 a = *(const LAS f32x4*)(fkt + (8 * g + 4 * hi) * 4), b = *(const LAS f32x4*)(fkt + (32 + 8 * g + 4 * hi) * 4);
#pragma unroll
        for (int j = 0; j < 4; ++j) { c0[4 * g + j] = cq - a[j]; c1[4 * g + j] = cq - b[j]; }
    }
}
__device__ __forceinline__ void qkt(f32x16& p0, f32x16& p1, const char* Kslot, const bf16x8* qr, int r32, int hi) {
    const char* kb = Kslot + hi * 1024 + r32 * 16;
#pragma unroll
    for (int d0 = 0; d0 < 4; ++d0) {
        const bf16x8 b0 = *reinterpret_cast<const bf16x8*>(kb + d0 * 2048);
        const bf16x8 b1 = *reinterpret_cast<const bf16x8*>(kb + d0 * 2048 + 512);
        p0 = __builtin_amdgcn_mfma_f32_32x32x16_bf16(b0, qr[d0], p0, 0, 0, 0); p1 = __builtin_amdgcn_mfma_f32_32x32x16_bf16(b1, qr[d0], p1, 0, 0, 0); }
}
__device__ __forceinline__ void kload8(bf16x8* kf, lds_cptr kp) {
    kf[0] = *(const LAS bf16x8*)(kp);        kf[1] = *(const LAS bf16x8*)(kp + 512);
    kf[2] = *(const LAS bf16x8*)(kp + 2048); kf[3] = *(const LAS bf16x8*)(kp + 2560);
    kf[4] = *(const LAS bf16x8*)(kp + 4096); kf[5] = *(const LAS bf16x8*)(kp + 4608);
    kf[6] = *(const LAS bf16x8*)(kp + 6144); kf[7] = *(const LAS bf16x8*)(kp + 6656);
}
__device__ __forceinline__ void kload2(bf16x8* kf, lds_cptr kp, int j) { kf[2 * j] = *(const LAS bf16x8*)(kp + j * 2048); kf[2 * j + 1] = *(const LAS bf16x8*)(kp + j * 2048 + 512); }
__device__ __forceinline__ s16x4 vtr2(lds_cptr p) { return __builtin_bit_cast(s16x4, __builtin_amdgcn_ds_read_tr16_b64_v4i16((LAS s16x4*)p)); }
__device__ __forceinline__ float rowmax(const f32x16& p0, const f32x16& p1) {
    float a = max3f(p0[0], p0[1], p1[0]), b = max3f(p0[2], p0[3], p1[1]); a = max3f(a, p1[2], p1[3]);
#pragma unroll
    for (int r = 4; r < 16; r += 4) { a = max3f(a, p0[r], p0[r + 1]); b = max3f(b, p0[r + 2], p0[r + 3]); a = max3f(a, p1[r], p1[r + 1]); b = max3f(b, p1[r + 2], p1[r + 3]); }
    const float m = max2f(a, b);
    auto rr = __builtin_amdgcn_permlane32_swap(__float_as_uint(m), __float_as_uint(m), false, false);
    return max2f(__uint_as_float(rr[0]), __uint_as_float(rr[1]));
}
__device__ __forceinline__ void pv(f32x16* o, int vb, bf16x8 pa0, bf16x8 pa1, bf16x8 pa2, bf16x8 pa3) {
#pragma unroll
    for (int d0 = 0; d0 < 2; ++d0) { s16x4 lo[4], hi[4];
#pragma unroll
        for (int ks = 0; ks < 4; ++ks) {
            asm volatile("ds_read_b64_tr_b16 %0,%1 offset:%c2" : "=&v"(lo[ks]) : "v"(vb), "i"(d0 * 4096 + ks * 1024) : "memory");
            asm volatile("ds_read_b64_tr_b16 %0,%1 offset:%c2" : "=&v"(hi[ks]) : "v"(vb), "i"(d0 * 4096 + ks * 1024 + 512) : "memory"); }
        asm volatile("s_waitcnt lgkmcnt(0)" ::: "memory"); SBAR();
#define PK(k) (bf16x8){lo[k][0], lo[k][1], lo[k][2], lo[k][3], hi[k][0], hi[k][1], hi[k][2], hi[k][3]}
        o[d0] = __builtin_amdgcn_mfma_f32_32x32x16_bf16(pa0, PK(0), o[d0], 0, 0, 0);
        o[d0] = __builtin_amdgcn_mfma_f32_32x32x16_bf16(pa1, PK(1), o[d0], 0, 0, 0);
        o[d0] = __builtin_amdgcn_mfma_f32_32x32x16_bf16(pa2, PK(2), o[d0], 0, 0, 0);
        o[d0] = __builtin_amdgcn_mfma_f32_32x32x16_bf16(pa3, PK(3), o[d0], 0, 0, 0);
#undef PK
    }
}

template <int THRL> __device__ __forceinline__ void attn_unit(int b, int h, int qb, const bf16_t* Q, const bf16_t* __restrict__ K, const bf16_t* __restrict__ V, const float* F2, bf16_t* mix, char* shm, const int tid, const int t0) {
    const int lane = tid & 63, r32 = lane & 31, hi = lane >> 5; const int wid = __builtin_amdgcn_readfirstlane(tid >> 6);
    const long rowbase = (long)b * SEQ; const int q0 = qb * QB;
    const bf16_t* Qw = Q + (rowbase + q0 + wid * QBLK) * DM + h * DH;
    const bf16_t* Kh = K + (rowbase + t0 * KVBLK) * DM + h * DH, *Vh = V + (rowbase + t0 * KVBLK) * DM + h * DH;
    const float* Fh = F2 + (long)(b * NH + h) * SEQ;
    const unsigned lds0 = (unsigned)(uintptr_t)shm;
    float* wsf = (float*)(shm + LDS_WS) + wid * 64;
    const bf16_t* ksrc = Kh + (long)lane * DM + wid * 8;
    const bf16_t* vsrc = Vh + (long)(16 * (wid & 3) + (lane >> 2)) * DM + (wid >> 2) * 32 + (lane & 3) * 8;
    const unsigned kdst = lds0 + LDS_K + wid * 1024, vdst = lds0 + LDS_V + wid * 1024;
#define DMA_K(t, slot) glds16(ksrc + (long)(t) * KVBLK * DM, (unsigned)__builtin_amdgcn_readfirstlane(kdst + (slot)))
#define DMA_V(t, slot) glds16(vsrc + (long)(t) * KVBLK * DM, (unsigned)__builtin_amdgcn_readfirstlane(vdst + (slot)))
    const int vb0 = (int)(lds0 + LDS_V) + ((lane >> 4) & 1) * 32 + (lane & 3) * 8 + (4 * hi + ((lane & 15) >> 2)) * 64;
    const char* Kbase = shm + LDS_K; bf16x8 kf[8];
    const lds_cptr shm3 = (lds_cptr)shm; const lds_cptr kp0 = shm3 + LDS_K + hi * 1024 + r32 * 16; const lds_cptr vp0 = shm3 + LDS_V + ((lane >> 4) & 1) * 32 + (lane & 3) * 8 + (4 * hi + ((lane & 15) >> 2)) * 64;
    const lds_cptr fk0 = shm3 + LDS_FK;
    const int NT = (q0 + QB) / KVBLK - t0;
    DMA_K(0, 0); DMA_V(0, 0); DMA_K(1, SLOTB);
    { float* fl = (float*)(shm + LDS_FK); for (int i = t0 * KVBLK + tid * 4; i < q0 + QB; i += 2048) *(f32x4*)(fl + i - t0 * KVBLK) = *(const f32x4*)(Fh + i); }
    const float fq = Fh[q0 + wid * QBLK + r32];
    bf16x8 qr[4];
#pragma unroll
    for (int d0 = 0; d0 < 4; ++d0) qr[d0] = *reinterpret_cast<const bf16x8*>(&Qw[(long)r32 * DM + d0 * 16 + hi * 8]);
    float mhat = 0.f, l_reg = 0.f, cq = fq; f32x16 o[2]; o[0] = f32x16{}; o[1] = f32x16{};
    const int qrel = wid * QBLK + r32;
#define CMASK(P0, P1, t) do { int jb_ = (t) - (NT - 4); if (jb_ >= 0) cmask(P0, P1, jb_, qrel, hi); } while (0)
    bool resc = false;
#define START(P0, P1) do { const float rm = rowmax(P0, P1); resc = false; \
    { const float dl = rm; mhat = fadd_s(mhat, dl); \
      _Pragma("unroll") for (int r = 0; r < 16; ++r) { P0[r] = fsub_s(P0[r], dl); P1[r] = fsub_s(P1[r], dl); } \
      cq = fq - mhat; } \
    _Pragma("unroll") for (int r = 0; r < 16; ++r) P0[r] = __builtin_amdgcn_exp2f(P0[r]); } while (0)
#define RESC() do { if (resc) { asm volatile("s_waitcnt lgkmcnt(0)" ::: "memory"); \
      _Pragma("unroll") for (int d_ = 0; d_ < 2; ++d_) _Pragma("unroll") for (int r = 0; r < 16; ++r) o[d_][r] *= wsf[crow(r, hi)]; } } while (0)
    f32x16 pA0, pA1, pB0, pB1;
    int sl_prev = 0, sl_cur = 0, sl_next = SLOTB;
#define ROT() do { sl_prev = sl_cur; sl_cur = sl_next; sl_next = (sl_next == (NSLOT - 1) * SLOTB) ? 0 : sl_next + SLOTB; } while (0)
    DMA_K(2, 2 * SLOTB);
    WAIT_BAR(3);
    bias_init(pA0, pA1, fk0, cq, hi);
    qkt(pA0, pA1, Kbase, qr, r32, hi); asm volatile("s_nop 15\n\ts_nop 7" : "+v"(pA0), "+v"(pA1)); CMASK(pA0, pA1, 0);
    START(pA0, pA1);
    _Pragma("unroll") for (int r = 0; r < 16; ++r) pA1[r] = __builtin_amdgcn_exp2f(pA1[r]);
    WAIT_BAR(0);
    DMA_K(3, 0); DMA_V(1, SLOTB);
    ROT();
    kload8(kf, kp0 + sl_cur);
    WAIT_BAR(2);
    s16x4 vlo[8], vhi[8]; u32x4 pw0, pw1, pw2, pw3;
#define PKW(P, B) cvtpk_s(P[B], P[B + 1])
#define PAF(k) __builtin_bit_cast(bf16x8, pw##k)
#define VFR(i) (bf16x8){vlo[i][0], vlo[i][1], vlo[i][2], vlo[i][3], vhi[i][0], vhi[i][1], vhi[i][2], vhi[i][3]}
#define PIN(x) asm volatile("" : "+v"(x))
#define MX3(a, b, c) __builtin_fmaxf(__builtin_fmaxf((a), (b)), (c))
#define GAPA(MF, A0, A1, A2, A3, W0, W1, PW) do { MF; sacc += A0; sacc += A1; sacc += A2; sacc += A3; PIN(sacc); W0; W1; PIN(PW); SBAR(); } while (0)
#define EX(v) __builtin_amdgcn_exp2f(v)
#define GAPB(MF, X, B) do { MF; X[B] = EX(X[B]); X[B + 1] = EX(X[B + 1]); X[B + 2] = EX(X[B + 2]); X[B + 3] = EX(X[B + 3]); PIN(X); SBAR(); } while (0)
#define VRD(i) do { vlo[i] = vtr2(vp_ + (((i) >> 2) * 4096 + ((i) & 3) * 1024)); vhi[i] = vtr2(vp_ + (((i) >> 2) * 4096 + ((i) & 3) * 1024 + 512)); } while (0)
#define KRD(G, j) do { if (G) { kload2(kf, kp0 + sl_next, j); SBAR(); } } while (0)
#define STEP(C0, C1, P0, P1, t, GK, GV, GL) do { SBAR(); \
    bias_half(C0, fk0 + (t) * 256, cq, hi); SBAR(); \
    const lds_cptr vp_ = vp0 + sl_prev; \
    VRD(0); SBAR(); float sacc = (P0[0] + P0[1]); \
    GAPA(C0 = __builtin_amdgcn_mfma_f32_32x32x16_bf16(kf[0], qr[0], C0, 0, 0, 0), P0[2], P0[3], P0[4], P0[5],     pw0[0] = PKW(P0, 0), pw0[1] = PKW(P0, 2), pw0); \
    bias_half(C1, fk0 + (t) * 256 + 128, cq, hi); SBAR(); \
    VRD(4); SBAR(); GAPA(C1 = __builtin_amdgcn_mfma_f32_32x32x16_bf16(kf[1], qr[0], C1, 0, 0, 0), P0[6], P0[7], P0[8], P0[9],     pw0[2] = PKW(P0, 4), pw0[3] = PKW(P0, 6), pw0); \
    VRD(1); SBAR(); GAPA(C0 = __builtin_amdgcn_mfma_f32_32x32x16_bf16(kf[2], qr[1], C0, 0, 0, 0),   P0[10], P0[11], P0[12], P0[13], pw1[0] = PKW(P0, 8), pw1[1] = PKW(P0, 10), pw1); \
    VRD(5); SBAR(); GAPA(C1 = __builtin_amdgcn_mfma_f32_32x32x16_bf16(kf[3], qr[1], C1, 0, 0, 0),   P0[14], P0[15], P1[0], P1[1],   pw1[2] = PKW(P0, 12), pw1[3] = PKW(P0, 14), pw1); \
    VRD(2); SBAR(); GAPA(C0 = __builtin_amdgcn_mfma_f32_32x32x16_bf16(kf[4], qr[2], C0, 0, 0, 0),   P1[2], P1[3], P1[4], P1[5],     pw2[0] = PKW(P1, 0), pw2[1] = PKW(P1, 2), pw2); \
    VRD(6); SBAR(); GAPA(C1 = __builtin_amdgcn_mfma_f32_32x32x16_bf16(kf[5], qr[2], C1, 0, 0, 0),   P1[6], P1[7], P1[8], P1[9],     pw2[2] = PKW(P1, 4), pw2[3] = PKW(P1, 6), pw2); \
    VRD(3); SBAR(); GAPA(C0 = __builtin_amdgcn_mfma_f32_32x32x16_bf16(kf[6], qr[3], C0, 0, 0, 0),   P1[10], P1[11], P1[12], P1[13], pw3[0] = PKW(P1, 8), pw3[1] = PKW(P1, 10), pw3); \
    VRD(7); SBAR(); GAPA(C1 = __builtin_amdgcn_mfma_f32_32x32x16_bf16(kf[7], qr[3], C1, 0, 0, 0),   P1[14], P1[15], 0.f, 0.f,       pw3[2] = PKW(P1, 12), pw3[3] = PKW(P1, 14), pw3); \
    l_reg += sacc; \
    if (GK) { DMA_K((t) + 3, sl_cur); } if (GV) { DMA_V((t) + 1, sl_next); } \
    CMASK(C0, C1, t); \
    { float a = MX3(C0[0], C0[1], C1[0]), b = MX3(C0[2], C0[3], C1[1]); a = MX3(a, C1[2], C1[3]); \
      _Pragma("unroll") for (int r = 4; r < 16; r += 4) { a = MX3(a, C0[r], C0[r + 1]); b = MX3(b, C0[r + 2], C0[r + 3]); a = MX3(a, C1[r], C1[r + 1]); b = MX3(b, C1[r + 2], C1[r + 3]); } \
      float rm = __builtin_fmaxf(a, b); { auto rr = __builtin_amdgcn_permlane32_swap(__float_as_uint(rm), __float_as_uint(rm), false, false); rm = __builtin_fmaxf(__uint_as_float(rr[0]), __uint_as_float(rr[1])); } \
      resc = false; \
      if (__builtin_expect(__any(rm > (float)THRL), 0)) { const float dl = __builtin_fmaxf(rm, 0.f); mhat += dl; \
        _Pragma("unroll") for (int r = 0; r < 16; ++r) { C0[r] -= dl; C1[r] -= dl; } \
        cq = fq - mhat; \
        const float f = __builtin_amdgcn_exp2f(-dl); l_reg *= f; if (hi == 0) wsf[r32] = f; resc = true; } } \
    SBAR(); \
    GAPB(o[0] = __builtin_amdgcn_mfma_f32_32x32x16_bf16(PAF(0), VFR(0), o[0], 0, 0, 0), C0, 0); \
    GAPB(o[1] = __builtin_amdgcn_mfma_f32_32x32x16_bf16(PAF(0), VFR(4), o[1], 0, 0, 0), C0, 4); \
    KRD(GL, 0); GAPB(o[0] = __builtin_amdgcn_mfma_f32_32x32x16_bf16(PAF(1), VFR(1), o[0], 0, 0, 0), C0, 8); \
    KRD(GL, 1); GAPB(o[1] = __builtin_amdgcn_mfma_f32_32x32x16_bf16(PAF(1), VFR(5), o[1], 0, 0, 0), C0, 12); \
    KRD(GL, 2); GAPB(o[0] = __builtin_amdgcn_mfma_f32_32x32x16_bf16(PAF(2), VFR(2), o[0], 0, 0, 0), C1, 0); \
    KRD(GL, 3); GAPB(o[1] = __builtin_amdgcn_mfma_f32_32x32x16_bf16(PAF(2), VFR(6), o[1], 0, 0, 0), C1, 4); \
    GAPB(o[0] = __builtin_amdgcn_mfma_f32_32x32x16_bf16(PAF(3), VFR(3), o[0], 0, 0, 0), C1, 8); \
    GAPB(o[1] = __builtin_amdgcn_mfma_f32_32x32x16_bf16(PAF(3), VFR(7), o[1], 0, 0, 0), C1, 12); \
    } while (0)
    int t = 1;
#undef CMASK
#define CMASK(P0, P1, t) do { } while (0)
    for (; t + 5 < NT; t += 2) {
        STEP(pB0, pB1, pA0, pA1, t, true, true, true);     WAIT_BAR(2); RESC(); ROT();
        STEP(pA0, pA1, pB0, pB1, t + 1, true, true, true); WAIT_BAR(2); RESC(); ROT();
    }
#undef CMASK
#define CMASK(P0, P1, t) do { int jb_ = (t) - (NT - 4); if (jb_ >= 0) cmask(P0, P1, jb_, qrel, hi); } while (0)
#define ENDW(tt) do { if ((tt) + 3 < NT) { WAIT_BAR(2); } else if ((tt) + 2 < NT) { WAIT_BAR(1); } else { WAIT_BAR(0); } } while (0)
    for (; t + 1 < NT; t += 2) {
        STEP(pB0, pB1, pA0, pA1, t, (t + 3 < NT), (t + 1 < NT), (t + 1 < NT));       ENDW(t);     RESC(); ROT();
        STEP(pA0, pA1, pB0, pB1, t + 1, (t + 4 < NT), (t + 2 < NT), (t + 2 < NT)); ENDW(t + 1); RESC(); ROT();
    }
    STEP(pB0, pB1, pA0, pA1, NT - 1, false, false, false); RESC();
    { float sacc = pB0[0] + pB0[1]; _Pragma("unroll") for (int r = 2; r < 16; ++r) sacc += pB0[r]; _Pragma("unroll") for (int r = 0; r < 16; ++r) sacc += pB1[r]; l_reg += sacc;
      pw0 = (u32x4){PKW(pB0, 0), PKW(pB0, 2), PKW(pB0, 4), PKW(pB0, 6)}; pw1 = (u32x4){PKW(pB0, 8), PKW(pB0, 10), PKW(pB0, 12), PKW(pB0, 14)}; pw2 = (u32x4){PKW(pB1, 0), PKW(pB1, 2), PKW(pB1, 4), PKW(pB1, 6)}; pw3 = (u32x4){PKW(pB1, 8), PKW(pB1, 10), PKW(pB1, 12), PKW(pB1, 14)};
      SBAR(); pv(o, vb0 + sl_cur, PAF(0), PAF(1), PAF(2), PAF(3)); }
#undef PKW
#undef PAF
#undef VFR
#undef PIN
#undef MX3
#undef GAPA
#undef GAPB
#undef EX
#undef VRD
#undef KRD
#undef STEP
#undef ENDW
    { auto rr = __builtin_amdgcn_permlane32_swap(__float_as_uint(l_reg), __float_as_uint(l_reg), false, false); l_reg = __uint_as_float(rr[0]) + __uint_as_float(rr[1]); }
    if (hi == 0) wsf[32 + r32] = l_reg; asm volatile("s_waitcnt lgkmcnt(0)" ::: "memory");
    float rli[16];
#pragma unroll
    for (int r = 0; r < 16; ++r) rli[r] = __builtin_amdgcn_rcpf(wsf[32 + crow(r, hi)]);
    bf16_t* Ow = mix + (rowbase + q0 + wid * QBLK) * D + PW + h * DH;
    { bf16_t* stg = (bf16_t*)(shm + LDS_OST) + wid * 2048;
#pragma unroll
      for (int r = 0; r < 16; ++r) { const int orow = crow(r, hi);
#pragma unroll
        for (int d0 = 0; d0 < 2; ++d0) stg[orow * 64 + d0 * 32 + r32] = (bf16_t)f2bf(o[d0][r] * rli[r]); }
      asm volatile("s_waitcnt lgkmcnt(0)" ::: "memory");
#pragma unroll
      for (int i = 0; i < 4; ++i) { const int row = i * 8 + (lane >> 3), ch = lane & 7; const u32x4 v = *(const u32x4*)(stg + row * 64 + ch * 8); *(u32x4*)(Ow + (long)row * D + ch * 8) = v; } }
    asm volatile("s_waitcnt lgkmcnt(0)\n\ts_barrier" ::: "memory");
#undef DMA_K
#undef DMA_V
#undef CMASK
#undef START
#undef RESC
#undef ROT
}
#undef SBAR
#undef WAIT_BAR
}

__device__ __forceinline__ void attn_sample_unit(int l, int b, int h, const Params& p, LAS unsigned char* lds, int tid, int lane, int wave, float thr) {
    const int l16 = lane & 15, quad = lane >> 4;
    const bf16_t* Q = (const bf16_t*)(p.ws + WS_Q); const bf16_t* Kb = (const bf16_t*)(p.ws + WS_K); const bf16_t* Vb = (const bf16_t*)(p.ws + WS_V);
    bf16_t* mix = (bf16_t*)(p.ws + WS_MIX);
    const size_t row0 = (size_t)MP + b * ST;
    const float* Fh = (const float*)(p.ws + WS_FS) + (size_t)(b * NH + h) * SKEYS;
    bf16x8 qf[2];
#pragma unroll
    for (int ks = 0; ks < 2; ++ks) qf[ks] = *(const bf16x8*)(Q + (row0 + l16) * AW + h * HD + 32 * ks + 8 * quad);
    const float fq = Fh[PAST + l16];
    f32x4 o[4];
#pragma unroll
    for (int dt = 0; dt < 4; ++dt) o[dt] = (f32x4){0.f, 0.f, 0.f, 0.f};
    float mrun = -INFINITY, lrun = 0.f;
    const float* Kc = p.in[4] + ((size_t)(l * SB + b) * PAST) * AW + h * HD;
    const float* Vc = p.in[5] + ((size_t)(l * SB + b) * PAST) * AW + h * HD;
    LAS unsigned char* Vw = lds + wave * (64 * KP);
    f32x4 rk[2][2][2], rv[8], rf[2];
#define SAMPLE_LOAD(key0_) do { \
        _Pragma("unroll") for (int kt = 0; kt < 2; ++kt) _Pragma("unroll") for (int ks = 0; ks < 2; ++ks) { \
            const float* kp = Kc + (size_t)((key0_) + 16 * kt + l16) * AW + 32 * ks + 8 * quad; rk[kt][ks][0] = __builtin_nontemporal_load((const f32x4*)kp); rk[kt][ks][1] = __builtin_nontemporal_load((const f32x4*)(kp + 4)); } \
        _Pragma("unroll") for (int j = 0; j < 8; ++j) rv[j] = __builtin_nontemporal_load((const f32x4*)(Vc + (size_t)((key0_) + 4 * j + quad) * AW + 4 * l16)); \
        _Pragma("unroll") for (int kt = 0; kt < 2; ++kt) rf[kt] = *(const f32x4*)(Fh + (key0_) + 16 * kt + 4 * quad); } while (0)
    int ks;
    { const int j = lane & 15; const bool c = (j >= 1) && (Fh[256 * (j >= 1 ? j : 1) - 1] - Fh[PAST + vzero()] >= thr); ks = 256 * __popcll(__ballot(c && lane < 16)); }
    const int nst = (PAST - ks) >> 8;
    const int kbeg = ks + wave * nst * 32;
    SAMPLE_LOAD(kbeg);
    const int nsteps = nst + (wave == 7 ? 1 : 0);
    for (int step = 0; step < nsteps; ++step) {
        const bool isnew = step == nst;
        f32x4 s[2];
        bf16x8 kf[2][2];
        asm volatile("s_waitcnt lgkmcnt(0)" ::: "memory");
        if (!isnew) {
#pragma unroll
            for (int kt = 0; kt < 2; ++kt)
#pragma unroll
                for (int ks = 0; ks < 2; ++ks) {
                    const f32x4 a = rk[kt][ks][0], c = rk[kt][ks][1];
                    u32x4 w; w.x = pk2(a[0], a[1]); w.y = pk2(a[2], a[3]); w.z = pk2(c[0], c[1]); w.w = pk2(c[2], c[3]);
                    kf[kt][ks] = __builtin_bit_cast(bf16x8, w);
                }
#pragma unroll
            for (int j = 0; j < 8; ++j) {
                const int kr = 4 * j + quad;
                u32x2 w; w.x = pk2(rv[j][0], rv[j][1]); w.y = pk2(rv[j][2], rv[j][3]);
                *(LAS u32x2*)(Vw + kr * KP + 8 * l16) = w;
            }
#pragma unroll
            for (int kt = 0; kt < 2; ++kt) s[kt] = (f32x4){fq - rf[kt][0], fq - rf[kt][1], fq - rf[kt][2], fq - rf[kt][3]};
            if (step + 1 < nst) SAMPLE_LOAD(kbeg + (step + 1) * 32);
        } else {
#pragma unroll
            for (int ks = 0; ks < 2; ++ks) { kf[0][ks] = *(const bf16x8*)(Kb + (row0 + l16) * AW + h * HD + 32 * ks + 8 * quad); kf[1][ks] = (bf16x8){0, 0, 0, 0, 0, 0, 0, 0}; }
            {
                const int kr = lane >> 2, ch = lane & 3;
                const u32x4 a = *(const u32x4*)(Vb + (row0 + kr) * AW + h * HD + 16 * ch), c = *(const u32x4*)(Vb + (row0 + kr) * AW + h * HD + 16 * ch + 8);
                *(LAS u32x4*)(Vw + kr * KP + 32 * ch) = a; *(LAS u32x4*)(Vw + kr * KP + 32 * ch + 16) = c;
                *(LAS u32x4*)(Vw + (16 + kr) * KP + 32 * ch) = (u32x4){0u, 0u, 0u, 0u}; *(LAS u32x4*)(Vw + (16 + kr) * KP + 32 * ch + 16) = (u32x4){0u, 0u, 0u, 0u};
            }
            const f32x4 fk = *(const f32x4*)(Fh + PAST + 4 * quad);
            s[0] = (f32x4){fq - fk[0], fq - fk[1], fq - fk[2], fq - fk[3]};
            s[1] = (f32x4){-INFINITY, -INFINITY, -INFINITY, -INFINITY};
        }
#pragma unroll
        for (int ks = 0; ks < 2; ++ks) {
            s[0] = __builtin_amdgcn_mfma_f32_16x16x32_bf16(kf[0][ks], qf[ks], s[0], 0, 0, 0);
            if (!isnew) s[1] = __builtin_amdgcn_mfma_f32_16x16x32_bf16(kf[1][ks], qf[ks], s[1], 0, 0, 0);
        }
        if (isnew) {
#pragma unroll
            for (int r = 0; r < 4; ++r) if (4 * quad + r > l16) s[0][r] = -INFINITY;
        }
        float mx = fmaxf(fmaxf(s[0][0], s[0][1]), fmaxf(s[0][2], s[0][3]));
        mx = fmaxf(mx, fmaxf(fmaxf(s[1][0], s[1][1]), fmaxf(s[1][2], s[1][3])));
        mx = fmaxf(mx, __shfl_xor(mx, 16)); mx = fmaxf(mx, __shfl_xor(mx, 32));
        const float mnew = fmaxf(mrun, mx);
        const float alpha = __builtin_amdgcn_exp2f(mrun - mnew);
        mrun = mnew;
        float ps = 0.f;
#pragma unroll
        for (int kt = 0; kt < 2; ++kt)
#pragma unroll
            for (int r = 0; r < 4; ++r) { const float e = __builtin_amdgcn_exp2f(s[kt][r] - mnew); s[kt][r] = e; ps += e; }
        lrun = lrun * alpha + ps;
        u32x4 w; w.x = pk2(s[0][0], s[0][1]); w.y = pk2(s[0][2], s[0][3]); w.z = pk2(s[1][0], s[1][1]); w.w = pk2(s[1][2], s[1][3]);
        const bf16x8 pb = __builtin_bit_cast(bf16x8, w);
        asm volatile("s_waitcnt lgkmcnt(0)" ::: "memory");
        const LAS unsigned char* vb0 = Vw + (4 * quad + (l16 >> 2)) * KP + 8 * (l16 & 3);
#pragma unroll
        for (int dt = 0; dt < 4; ++dt) {
            const s16x4 a0 = vtr(vb0 + 32 * dt), a1 = vtr(vb0 + 16 * KP + 32 * dt);
            const bf16x8 vf = (bf16x8){a0[0], a0[1], a0[2], a0[3], a1[0], a1[1], a1[2], a1[3]};
            o[dt] = o[dt] * alpha;
            o[dt] = __builtin_amdgcn_mfma_f32_16x16x32_bf16(vf, pb, o[dt], 0, 0, 0);
        }
    }
#undef SAMPLE_LOAD
    float lt = lrun; lt += __shfl_xor(lt, 16); lt += __shfl_xor(lt, 32);
    LAS float* cm = (LAS float*)(lds + 8 * 64 * KP);
    LAS float* cl = cm + 128; LAS float* co = cl + 128;
    if (quad == 0) { cm[wave * 16 + l16] = mrun; cl[wave * 16 + l16] = lt; }
#pragma unroll
    for (int dt = 0; dt < 4; ++dt)
#pragma unroll
        for (int r = 0; r < 4; ++r) co[(wave * 16 + l16) * 64 + 16 * dt + 4 * quad + r] = o[dt][r];
    __syncthreads();
    {
        const int q = tid >> 5, d0 = (tid & 31) * 2;
        float mm = cm[q];
#pragma unroll
        for (int w = 1; w < 8; ++w) mm = fmaxf(mm, cm[w * 16 + q]);
        float L = 0.f, a0 = 0.f, a1 = 0.f;
#pragma unroll
        for (int w = 0; w < 8; ++w) { const float f = __builtin_amdgcn_exp2f(cm[w * 16 + q] - mm); L += cl[w * 16 + q] * f; a0 += co[(w * 16 + q) * 64 + d0] * f; a1 += co[(w * 16 + q) * 64 + d0 + 1] * f; }
        const float il = 1.0f / L;
        *(unsigned*)(mix + (row0 + q) * D + PW + h * HD + d0) = pk2(a0 * il, a1 * il);
    }
    __syncthreads();
}

__device__ __forceinline__ void phase_attn(const Params& p, LAS unsigned char* lds, int l, int ci, int mode, int tid, int lane, int wave) {
    unsigned* ctr = (unsigned*)(p.ws + WS_CTL) + 64 * ci;
    LAS unsigned* slot = (LAS unsigned*)(lds + LDS_BYTES - 64);
    char* lds_generic = (char*)lds;
    const bf16_t* Q = (const bf16_t*)(p.ws + WS_Q); const bf16_t* Kb = (const bf16_t*)(p.ws + WS_K); const bf16_t* Vb = (const bf16_t*)(p.ws + WS_V);
    const float* Fp = (const float*)(p.ws + WS_FP); bf16_t* mix = (bf16_t*)(p.ws + WS_MIX);
    float thr;
    {
        const float gq = fabsf(p.in[12][l * HD + lane]), gk = fabsf(p.in[13][l * HD + lane]);
        float mq = gq, mk = gk;
#pragma unroll
        for (int o = 1; o < 64; o <<= 1) { mq = fmaxf(mq, __shfl_xor(mq, o)); mk = fmaxf(mk, __shfl_xor(mk, o)); }
        thr = 53.f + 2.f * (64.f * mq * mk * C2 + 0.5f);
    }
    LAS unsigned* cnt = (LAS unsigned*)lds;
    LAS unsigned* keys = (LAS unsigned*)(lds + 1024);
    LAS unsigned short* order = (LAS unsigned short*)(lds + fa::LDS_END);
    const float* Fs = (const float*)(p.ws + WS_FS);
    for (int i = tid; i < 216; i += 512) cnt[i] = 0u;
    __syncthreads();
    for (int i = tid; i < 24 * 124; i += 512) { const int bh = i / 124, j = i % 124 + 1; const float* Fh = Fp + (size_t)bh * T; if (Fh[64 * j - 1] - Fh[31 * 256] >= thr) atomicAdd((unsigned*)(cnt + bh), 1u); }
    for (int i = tid; i < 192 * 15; i += 512) { const int si = i / 15, j = i % 15 + 1; const float* Fh = Fs + (size_t)si * SKEYS; if (Fh[256 * j - 1] - Fh[PAST] >= thr) atomicAdd((unsigned*)(cnt + 24 + si), 1u); }
    __syncthreads();
    for (int id = tid; id < 1024; id += 512) {
        unsigned key = 0u;
        if (id < 768) { const int bh = id >> 5, qb = id & 31, w = 124 - (int)(cnt[bh] & ~1u); int t0a = 4 * qb - w; t0a = t0a > 0 ? (t0a & ~1) : 0;
            key = ((unsigned)(4 * (qb + 1) - t0a + 3) << 10) | (unsigned)(1023 - id); }
        else if (id < 960) { const int nst = 16 - (int)cnt[24 + id - 768]; key = ((unsigned)(5 + (10 * nst) / 3) << 10) | (unsigned)(1023 - id); }
        keys[id] = key;
    }
    __syncthreads();
    {
        const unsigned k0 = keys[tid], k1 = keys[tid + 512]; unsigned p0 = 0u, p1 = 0u;
        for (int k = 0; k < 1024; k += 4) { const u32x4 v = *(const LAS u32x4*)(keys + k);
            p0 += (v.x > k0) + (v.y > k0) + (v.z > k0) + (v.w > k0); p1 += (v.x > k1) + (v.y > k1) + (v.z > k1) + (v.w > k1); }
        order[p0] = (unsigned short)tid;
        if (tid + 512 < 960) order[p1] = (unsigned short)(tid + 512);
    }
    __syncthreads();
    for (;;) {
        if (tid == 0) *slot = atomicAdd(ctr, 1u);
        __syncthreads();
        const int idx = (int)*slot;
        __syncthreads();
        if (idx >= 960) break;
        const int id = (int)order[idx];
        const int tf = fresh_tid(), lf = tf & 63, wf = __builtin_amdgcn_readfirstlane(tf >> 6);
        if (id >= 768) { if (mode == 1) continue; const int si = id - 768; attn_sample_unit(l, si / NH, si % NH, p, lds, tf, lf, wf, thr); }
        else { if (mode == 2) continue; const int bh = id >> 5, qb = id & 31;
            int t0;
            { const float* Fh = Fp + (size_t)bh * T; const float f0 = Fh[qb * 256 + vzero()];
              const int ja = lf + 1, jb2 = lf + 65, jmax = 4 * qb;
              const bool ca = (ja <= jmax) && (Fh[64 * (ja <= jmax ? ja : 1) - 1] - f0 >= thr), cb = (jb2 <= jmax) && (Fh[64 * (jb2 <= jmax ? jb2 : 1) - 1] - f0 >= thr);
              t0 = (__popcll(__ballot(ca)) + __popcll(__ballot(cb))) & ~1; }
            fa::attn_unit<8>(bh / NH, bh % NH, qb, Q, Kb, Vb, Fp, mix, lds_generic, tf, t0);
        }
    }
    if (mode == 0) { const int tf = fresh_tid(); pool_items(p, lds, l, ctr + 8, slot, tf, tf & 63, __builtin_amdgcn_readfirstlane(tf >> 6)); }
}

#define XB_XCNT(j) (1024 + 64 * (j))
#define XB_XSUB(j) (2048 + 64 * (j))
#define XB_XGEN(j) (3072 + 64 * (j))
#define XB_TOP 4096
#define XB_TOPGEN 4160
__device__ __forceinline__ unsigned xb_ld(unsigned* p) { return __hip_atomic_load(p, __ATOMIC_RELAXED, __HIP_MEMORY_SCOPE_AGENT); }
__device__ __forceinline__ unsigned xb_add(unsigned* p, unsigned v) { return __hip_atomic_fetch_add(p, v, __ATOMIC_RELAXED, __HIP_MEMORY_SCOPE_AGENT); }
__device__ __forceinline__ unsigned xcc_id() { return (unsigned)__builtin_amdgcn_s_getreg((3 << 11) | 20) & 0xFu; }
__device__ __forceinline__ void grid_bar(unsigned* bar, volatile LAS unsigned* st) {
    asm volatile("s_waitcnt vmcnt(0)" ::: "memory");
    __syncthreads();
    if (threadIdx.x == 0) {
        __builtin_amdgcn_s_waitcnt(0);
        const unsigned x = xcc_id(), nloc = st[0], nx = st[1];
        const unsigned old = xb_add(&bar[XB_XSUB(x)], 1u);
        const unsigned gen = old / nloc;
        if (old + 1u == (gen + 1u) * nloc) {
            __builtin_amdgcn_fence(__ATOMIC_RELEASE, "agent");
            asm volatile("s_waitcnt vmcnt(0)" ::: "memory");
            const unsigned og = xb_add(&bar[XB_TOP], 1u);
            const unsigned tg = og / nx;
            if (og + 1u == (tg + 1u) * nx) xb_add(&bar[XB_TOPGEN], 1u);
            else { while (xb_ld(&bar[XB_TOPGEN]) == tg) __builtin_amdgcn_s_sleep(1); }
            __builtin_amdgcn_fence(__ATOMIC_ACQUIRE, "agent");
            xb_add(&bar[XB_XGEN(x)], 1u);
            asm volatile("s_waitcnt vmcnt(0)" ::: "memory");
        } else {
            while (xb_ld(&bar[XB_XGEN(x)]) == gen) __builtin_amdgcn_s_sleep(1);
            __builtin_amdgcn_fence(__ATOMIC_ACQUIRE, "agent");
            asm volatile("s_waitcnt vmcnt(0)" ::: "memory");
        }
    }
    __syncthreads();
}
#define FRESH_TID() fresh_tid()
#define TLW(t) (t), ((t) & 63), __builtin_amdgcn_readfirstlane((t) >> 6)
__global__ void __launch_bounds__(512, 2) fwd_megakernel(Params p) {
    extern __shared__ __attribute__((aligned(16))) unsigned char lds_raw[];
    LAS unsigned char* lds = (LAS unsigned char*)lds_raw;
    cg::grid_group grid = cg::this_grid();
    const int G = gridDim.x;

    unsigned* bar_w = (unsigned*)(p.ws + WS_CTL);
    if (threadIdx.x == 0) (void)xb_add(&bar_w[XB_XCNT(xcc_id())], 1u);
    { const int t_ = FRESH_TID(); phase_prologue(p, lds, TLW(t_)); }

#ifdef XSYNC
    for (int i = 0; i < XSYNC; ++i) grid.sync();
#endif
    volatile LAS unsigned* bar_st = (volatile LAS unsigned*)(lds + LDS_BYTES - 32);
    if (threadIdx.x == 0) {
        unsigned mine, cnt, sum; const unsigned x = xcc_id();
        for (;;) {
            mine = 0u; cnt = 0u; sum = 0u;
            for (unsigned j = 0; j < 16; ++j) { const unsigned c = xb_ld(&bar_w[XB_XCNT(j)]); sum += c; cnt += (c > 0u) ? 1u : 0u; mine = (j == x) ? c : mine; }
            if (sum == (unsigned)G) break;
            __builtin_amdgcn_s_sleep(1);
        }
        bar_st[0] = mine; bar_st[1] = cnt;
    }
    __syncthreads();
#define GB() grid_bar(bar_w, bar_st)
    if (G == 0x7fffffff) grid.sync();
    GB();
    float* xa = (float*)(p.ws + WS_XA); float* xb = (float*)(p.ws + WS_XB);
    bf16_t* hn = (bf16_t*)(p.ws + WS_HN);
    for (int l = 0; l < 2; ++l) {
        const float* xp = (l == 0) ? p.in[0] : xb; const float* xs = (l == 0) ? p.in[1] : xb + (size_t)MP * D;
        float* yp = (l == 0) ? xb : p.out; float* ys = yp + (size_t)MP * D;
        const float* modl = (const float*)(p.ws + WS_MOD) + (size_t)l * NMODROW * MODW;
        for (int rep = 0; rep < NREP(0); ++rep) {
            { const int t_ = FRESH_TID(); phase_norm(p, lds, l, 1, xp, xs, TLW(t_)); }
            GB();
        }
        for (int rep = 0; rep < NREP(1); ++rep) {
            pg8::Gemm g{hn, (const bf16_t*)(p.ws + WS_WIN) + (size_t)l * NMAIN * D, M, NMAIN, D};
            pg8::StaticOrder S; S.init(MP, NMAIN, G, (int)blockIdx.x);
            EpiIn E{l, p.out, (bf16_t*)(p.ws + WS_Q), (bf16_t*)(p.ws + WS_K), (bf16_t*)(p.ws + WS_V), (float*)(p.ws + WS_U), p.in[12] + l * HD, p.in[13] + l * HD};
            pg8::gemm_phase<EpiIn, true, true>(lds, g, S, E, FRESH_TID());
            { SEpiIn SE{l, p.out, (bf16_t*)(p.ws + WS_Q), (bf16_t*)(p.ws + WS_K), (bf16_t*)(p.ws + WS_V), (float*)(p.ws + WS_U), p.in[12] + l * HD, p.in[13] + l * HD};
              const int t_ = FRESH_TID(); skinny_phase<SEpiIn>(lds, g.A, g.Bt, NMAIN, D, SE, TLW(t_)); }
            { const int t_ = FRESH_TID(); scan_items(p, lds, l, TLW(t_)); }
            if (l == 0 && rep == 0) {
                for (int ll = 0; ll < 2; ++ll) { SEpiBias SE{(float*)(p.ws + WS_BIAS2) + (size_t)ll * NMODROW * FF}; const int t_ = FRESH_TID();
                    skinny_phase<SEpiBias>(lds, (const bf16_t*)(p.ws + WS_SH2) + (size_t)ll * 32 * D, (const bf16_t*)(p.ws + WS_WUP) + (size_t)ll * FF * D, FF, D, SE, TLW(t_), 0, 2); }
            }
            GB();
        }
        for (int rep = 0; rep < NREP(3); ++rep) {
            { const int t_ = FRESH_TID(); phase_attn(p, lds, l, l * 2 + rep, rep == 0 ? 0 : ATT_DUP_MODE, TLW(t_)); }
            GB();
        }
        for (int rep = 0; rep < NREP(4); ++rep) {
            pg8::Gemm g{(const bf16_t*)(p.ws + WS_MIX), (const bf16_t*)(p.ws + WS_WOUT) + (size_t)l * D * D, M, D, D};
            pg8::StaticOrder S; S.init(MP, D, G, (int)blockIdx.x);
            EpiResN E{xp, xa, modl + 2 * D, modl + 4 * D, hn, (float*)(p.ws + WS_SS)};
            pg8::gemm_phase<EpiResN, false, true>(lds, g, S, E, FRESH_TID());
            { SEpiResN SE{xs, xa + (size_t)MP * D, modl + 2 * D, modl + 4 * D, hn, (float*)(p.ws + WS_SS)}; const int t_ = FRESH_TID(); skinny_phase<SEpiResN>(lds, g.A, g.Bt, D, D, SE, TLW(t_)); }
            GB();
        }
        for (int rep = 0; rep < NREP(6); ++rep) {
            pg8::Gemm g{hn, (const bf16_t*)(p.ws + WS_WUP) + (size_t)l * FF * D, M, FF, D};
            pg8::StaticOrder S; S.init(MP, FF, G, (int)blockIdx.x);
            const float* bias_l = (const float*)(p.ws + WS_BIAS2) + (size_t)l * NMODROW * FF;
            EpiUpN E{(bf16_t*)(p.ws + WS_HID), (const float*)(p.ws + WS_SS), bias_l};
            pg8::gemm_phase<EpiUpN, true, true>(lds, g, S, E, FRESH_TID());
            { SEpiUpN SE{(bf16_t*)(p.ws + WS_HID), (const float*)(p.ws + WS_SS), bias_l}; const int t_ = FRESH_TID(); skinny_phase<SEpiUpN>(lds, g.A, g.Bt, FF, D, SE, TLW(t_)); }
            GB();
        }
        for (int rep = 0; rep < NREP(7); ++rep) {
            pg8::Gemm g{(const bf16_t*)(p.ws + WS_HID), (const bf16_t*)(p.ws + WS_WDN) + (size_t)l * D * FF, M, D, FF};
            pg8::StaticOrder S; S.init(MP, D, G, (int)blockIdx.x);
            EpiRes E{xa, xa + (size_t)MP * D, yp, ys, modl + 5 * D};
            pg8::gemm_phase<EpiRes, false, true>(lds, g, S, E, FRESH_TID());
            { SEpiRes SE{xa + (size_t)MP * D, ys, modl + 5 * D}; const int t_ = FRESH_TID(); skinny_phase<SEpiRes>(lds, g.A, g.Bt, D, FF, SE, TLW(t_)); }
            if (l == 0 || rep + 1 < NREP(7)) GB();
        }
    }
}

extern "C" void kernel_launch(void* const* d_in, const int* in_sizes, int n_in, void* d_out, int out_size, void* d_ws, size_t ws_size, hipStream_t stream) {
    static int grid = 0;
    if (grid == 0) {
        if (n_in != 19 || (size_t)out_size != OUT_TOTAL || ws_size < WS_END) { fprintf(stderr, "kernel_launch: unexpected shapes (n_in %d out %d ws %zu)\n", n_in, out_size, ws_size); grid = -1; return; }
        int dev = 0, cus = 0, per_cu = 0;
        hipGetDevice(&dev);
        hipDeviceGetAttribute(&cus, hipDeviceAttributeMultiprocessorCount, dev);
        hipFuncSetAttribute((const void*)fwd_megakernel, hipFuncAttributeMaxDynamicSharedMemorySize, LDS_BYTES);
        hipOccupancyMaxActiveBlocksPerMultiprocessor(&per_cu, (const void*)fwd_megakernel, 512, LDS_BYTES);
        if (per_cu < 1) { fprintf(stderr, "kernel_launch: occupancy query says %d blocks per CU\n", per_cu); per_cu = 1; }
        grid = cus;
    }
    if (grid < 0) return;
    hipMemsetAsync((char*)d_ws + WS_CTL, 0, 20480, stream);
    Params p{};
    for (int i = 0; i < 19; ++i) p.in[i] = (const float*)d_in[i];
    p.out = (float*)d_out; p.ws = (unsigned char*)d_ws;
    void* args[] = {&p};
    hipError_t e = hipLaunchCooperativeKernel((const void*)fwd_megakernel, dim3(grid), dim3(512), args, LDS_BYTES, stream);
    if (e != hipSuccess) fprintf(stderr, "cooperative launch failed: %s (grid %d)\n", hipGetErrorString(e), grid);
}
```

```cpp
#include <hip/hip_runtime.h>
#include <hip/hip_cooperative_groups.h>
#include <cstdio>
#include <cstdint>
namespace cg = cooperative_groups;

#define LAS __attribute__((address_space(3)))
typedef unsigned short bf16_t;
typedef short bf16x8 __attribute__((ext_vector_type(8)));
typedef short s16x4 __attribute__((ext_vector_type(4)));
typedef float f32x4 __attribute__((ext_vector_type(4)));
typedef float f32x2 __attribute__((ext_vector_type(2)));
typedef unsigned u32x4 __attribute__((ext_vector_type(4)));
typedef unsigned u32x2 __attribute__((ext_vector_type(2)));

constexpr int D = 1024, T = 8192, NBP = 2, SB = 16, ST = 16, PAST = 4096;
constexpr int MP = NBP * T, MS = SB * ST, M = MP + MS;
constexpr int NH = 12, HD = 64, AW = 768, PW = 256, INC = 2572, NMAIN = 2560, FF = 4096;
constexpr int NMODROW = 18, MODW = 6 * D;
constexpr float EPS = 1e-6f;
constexpr float LOG2E = 1.4426950408889634f;
constexpr float C2 = 0.125f * LOG2E;
constexpr int SKEYS = PAST + ST;

constexpr size_t OFF_Y = 0;
constexpr size_t OFF_KP = (size_t)M * D;
constexpr size_t OFF_VP = OFF_KP + (size_t)2 * MP * AW;
constexpr size_t OFF_FP = OFF_VP + (size_t)2 * MP * AW;
constexpr size_t OFF_PP = OFF_FP + (size_t)2 * MP * NH;
constexpr size_t OFF_KS = OFF_PP + (size_t)2 * NBP * 15 * PW;
constexpr size_t OFF_VS = OFF_KS + (size_t)2 * MS * AW;
constexpr size_t OFF_FS = OFF_VS + (size_t)2 * MS * AW;
constexpr size_t OFF_PS = OFF_FS + (size_t)2 * MS * NH;
constexpr size_t OUT_TOTAL = OFF_PS + (size_t)2 * SB * 15 * PW;

constexpr size_t MiB = 1u << 20;
constexpr size_t WS_CTL = 0;
constexpr size_t WS_MOD = 1 * MiB;
constexpr size_t WS_WIN = 2 * MiB;
constexpr size_t WS_WOUT = 12 * MiB;
constexpr size_t WS_WUP = 16 * MiB;
constexpr size_t WS_WDN = 32 * MiB;
constexpr size_t WS_HN = 48 * MiB;
constexpr size_t WS_Q = 82 * MiB;
constexpr size_t WS_K = 108 * MiB;
constexpr size_t WS_V = 134 * MiB;
constexpr size_t WS_U = 160 * MiB;
constexpr size_t WS_MIX = 178 * MiB;
constexpr size_t WS_FP = 212 * MiB;
constexpr size_t WS_FS = 213 * MiB;
constexpr size_t WS_SS = 217 * MiB;
constexpr size_t WS_BIAS2 = WS_SS + 128 * 1024;
constexpr size_t WS_SH2 = WS_BIAS2 + 640 * 1024;
constexpr size_t WS_WF = WS_SH2 + 128 * 1024;
constexpr size_t WS_XA = 218 * MiB;
constexpr size_t WS_XB = 284 * MiB;
constexpr size_t WS_HID = 350 * MiB;
constexpr size_t WS_END = 482 * MiB;

constexpr int LDS_BYTES = 147456;
#ifndef DUP
#define DUP 0
#endif
#define NREP(k) (1 + ((DUP >> (k)) & 1))
#ifndef ATT_DUP_MODE
#define ATT_DUP_MODE 0
#endif

__device__ __forceinline__ unsigned f2bf(float f) { unsigned u = __builtin_bit_cast(unsigned, f); return (u + 0x7fffu + ((u >> 16) & 1u)) >> 16; }
typedef __bf16 bf16x2_t __attribute__((ext_vector_type(2)));
__device__ __forceinline__ unsigned pk2(float lo, float hi) { const f32x2 v = {lo, hi}; const bf16x2_t b = __builtin_convertvector(v, bf16x2_t); return __builtin_bit_cast(unsigned, b); }
template <int CTRL> __device__ __forceinline__ float dpp_f(float v) { return __builtin_bit_cast(float, __builtin_amdgcn_update_dpp(0, __builtin_bit_cast(int, v), CTRL, 0xF, 0xF, false)); }
__device__ __forceinline__ float quad_sum(float v) {
    auto a = __builtin_amdgcn_permlane16_swap(__float_as_uint(v), __float_as_uint(v), false, false);
    const float s = __uint_as_float(a[0]) + __uint_as_float(a[1]);
    auto b = __builtin_amdgcn_permlane32_swap(__float_as_uint(s), __float_as_uint(s), false, false);
    return __uint_as_float(b[0]) + __uint_as_float(b[1]);
}
__device__ __forceinline__ float wave_sum(float v) {
    v += dpp_f<0x128>(v); v += dpp_f<0x124>(v); v += dpp_f<0x122>(v); v += dpp_f<0x121>(v);
    return quad_sum(v);
}

__device__ __forceinline__ int vzero() { int z = 0; asm volatile("" : "+v"(z)); return z; }
__device__ __forceinline__ int fresh_tid() { int t = threadIdx.x; asm volatile("" : "+v"(t)); return t; }
namespace pg8 {
constexpr int BM = 256, BK = 64, HALF = 128, HTB = HALF * BK * 2, NXCD = 8, WGM = 8;
__host__ __device__ __forceinline__ int lds_byte(int r, int c) { const int st = (r >> 4) * 2 + (c >> 5), rr = r & 15, cc = c & 31, ob = rr * 64 + cc * 2; return st * 1024 + (ob ^ (((ob >> 9) & 1) << 5)); }
__host__ __device__ __forceinline__ void stage_rc(int b, int& R, int& C) { const int st = b / 1024, sb = b % 1024, swz = sb ^ (((sb >> 9) & 1) << 5); R = (st >> 1) * 16 + swz / 64; C = (st & 1) * 32 + (swz % 64) / 2; }
__host__ __device__ __forceinline__ int perm32(int rho) { const int n = rho >> 4, i = rho & 15; return 8 * (i >> 2) + 4 * n + (i & 3); }

struct Unit { int pm, pn; };
struct Gemm { const bf16_t* A; const bf16_t* Bt; int M, N, K; };

struct StaticOrder {
    int nM, nN, nwg, G, c;
    __device__ void init(int M_, int N_, int G_, int c_) { nM = M_ / BM; nN = N_ / BM; nwg = nM * nN; G = G_; c = c_; }
    __device__ bool next(int i, Unit& u) const {
        const long L = (long)i * G + c; if (L >= nwg) return false;
        int wgid = (int)L; { const int q = nwg / NXCD, r = nwg % NXCD, xcd = wgid % NXCD, off = wgid / NXCD; wgid = (xcd < r ? xcd * (q + 1) : r * (q + 1) + (xcd - r) * q) + off; }
        const int nig = WGM * nN, gid = wgid / nig, fm = gid * WGM, gsz = (nM - fm) < WGM ? (nM - fm) : WGM;
        u.pm = fm + ((wgid % nig) % gsz); u.pn = (wgid % nig) / gsz; return true;
    }
};

template <class Epi, bool ALIGN_EPI, bool SP2>
__device__ __forceinline__ void gemm_phase(LAS unsigned char* lds, const Gemm g, const StaticOrder& S, const Epi& E, const int tid) {
    const int wid = __builtin_amdgcn_readfirstlane(tid >> 6), lane = tid & 63, wr = wid >> 2, wc = wid & 3, fr = lane & 15, fq = lane >> 4;
    const int K = g.K, nt = K / BK;
    unsigned voffA[2], voffB[2];
#pragma unroll
    for (int i = 0; i < 2; ++i) { int R, C; stage_rc(tid * 16 + i * 8192, R, C); const int Rb = 64 * (R >> 5) + perm32(R & 31);
        voffA[i] = (unsigned)(R * K + C) * 2u; voffB[i] = (unsigned)(Rb * K + C) * 2u; }
    const size_t kstep = (size_t)(BK * 2);
    const size_t hstep = (size_t)HALF * K * 2;
    const size_t hstepB = (size_t)32 * K * 2;
    const size_t tstep = 2 * hstep;
    const unsigned ldsw = (unsigned)wid * 1024u;
    const int aoff = lds_byte(wr * 64 + fr, fq * 8), boff = lds_byte(wc * 32 + fr, fq * 8);
#define PG8_SA(b, h) (((b) * 2 + (h)) * HTB)
#define PG8_SB(b, h) ((4 + (b) * 2 + (h)) * HTB)
#define PG8_STAGE(bufoff, gbase, voff) do { _Pragma("unroll") for (int _i = 0; _i < 2; ++_i) \
        __builtin_amdgcn_global_load_lds((const unsigned*)((const char*)(gbase) + (voff)[_i]), (LAS unsigned*)(lds + (bufoff) + ldsw + _i * 8192), 16, 0, 0); } while (0)
#define PG8_LDA(dst, b, h) do { _Pragma("unroll") for (int m = 0; m < 4; ++m) _Pragma("unroll") for (int k = 0; k < 2; ++k) dst[m][k] = *(const LAS bf16x8*)(lds + PG8_SA(b, h) + aoff + m * 2048 + k * 1024); } while (0)
#define PG8_LDB(dst, b, h) do { _Pragma("unroll") for (int n = 0; n < 2; ++n) _Pragma("unroll") for (int k = 0; k < 2; ++k) dst[n][k] = *(const LAS bf16x8*)(lds + PG8_SB(b, h) + boff + n * 2048 + k * 1024); } while (0)
#define PG8_MMA(ai, bj, At, Bt) do { __builtin_amdgcn_s_setprio(1); _Pragma("unroll") for (int m = 0; m < 4; ++m) _Pragma("unroll") for (int n = 0; n < 2; ++n) _Pragma("unroll") for (int k = 0; k < 2; ++k) \
        acc[ai][bj][m][n] = __builtin_amdgcn_mfma_f32_16x16x32_bf16(Bt[n][k], At[m][k], acc[ai][bj][m][n], 0, 0, 0); __builtin_amdgcn_s_setprio(0); } while (0)
#define PG8_WAIT_V(n) asm volatile("s_waitcnt vmcnt(" #n ")" ::: "memory")
#define PG8_WAIT_L(n) asm volatile("s_waitcnt lgkmcnt(" #n ")" ::: "memory")
#define PG8_BAR __builtin_amdgcn_s_barrier()
#define PG8_SCHED __builtin_amdgcn_sched_barrier(0)
    Unit cur, nxt; int ui = 0;
    if (!S.next(0, cur)) return;
    f32x4 acc[2][2][4][2];
#pragma unroll
    for (int a = 0; a < 2; ++a)
#pragma unroll
        for (int b = 0; b < 2; ++b)
#pragma unroll
            for (int m = 0; m < 4; ++m)
#pragma unroll
                for (int n = 0; n < 2; ++n) acc[a][b][m][n] = (f32x4){0.f, 0.f, 0.f, 0.f};
    bf16x8 At[4][2], B0[2][2], B1[2][2];
    const char* cA = (const char*)g.A + (size_t)cur.pm * tstep; const char* cB = (const char*)g.Bt + (size_t)cur.pn * tstep;
    if constexpr (SP2) {
        PG8_STAGE(PG8_SB(0, 0), cB, voffB); PG8_STAGE(PG8_SB(0, 1), cB + hstepB, voffB); PG8_STAGE(PG8_SA(0, 0), cA, voffA); PG8_STAGE(PG8_SA(0, 1), cA + hstep, voffA);
        if (wr == 1) PG8_BAR;
        PG8_WAIT_V(2); PG8_BAR;
        PG8_STAGE(PG8_SB(1, 0), cB + kstep, voffB); PG8_STAGE(PG8_SA(1, 0), cA + kstep, voffA); PG8_STAGE(PG8_SB(1, 1), cB + hstepB + kstep, voffB);
        PG8_WAIT_V(6); PG8_BAR;
    } else {
    PG8_STAGE(PG8_SB(0, 0), cB, voffB); PG8_STAGE(PG8_SA(0, 0), cA, voffA); PG8_STAGE(PG8_SB(0, 1), cB + hstepB, voffB); PG8_STAGE(PG8_SA(0, 1), cA + hstep, voffA);
    if (wr == 1) PG8_BAR;
    PG8_WAIT_V(4); PG8_BAR;
    PG8_STAGE(PG8_SB(1, 0), cB + kstep, voffB); PG8_STAGE(PG8_SA(1, 0), cA + kstep, voffA); PG8_STAGE(PG8_SB(1, 1), cB + hstepB + kstep, voffB);
    PG8_WAIT_V(6); PG8_BAR;
    }
    for (;;) {
        const bool has_next = S.next(ui + 1, nxt);
        const char* nA = has_next ? (const char*)g.A + (size_t)nxt.pm * tstep : cA; const char* nB = has_next ? (const char*)g.Bt + (size_t)nxt.pn * tstep : cB;
        for (int t = 0; t < nt; t += 2) {
            const bool last = (t == nt - 2);
            const char* a1 = cA + (size_t)(t + 1) * kstep;
            const char* a2 = last ? nA : cA + (size_t)(t + 2) * kstep; const char* b2 = last ? nB : cB + (size_t)(t + 2) * kstep;
            const char* a3 = a2 + kstep; const char* b3 = b2 + kstep;
            if constexpr (SP2) {
            PG8_LDB(B0, 0, 0); PG8_LDB(B1, 0, 1); PG8_SCHED; PG8_LDA(At, 0, 0); PG8_STAGE(PG8_SA(1, 1), a1 + hstep, voffA);
            PG8_WAIT_V(8); PG8_WAIT_L(0); PG8_BAR; PG8_MMA(0, 0, At, B0); PG8_MMA(0, 1, At, B1); PG8_BAR; PG8_SCHED;
            PG8_LDA(At, 0, 1); PG8_STAGE(PG8_SB(0, 0), b2, voffB); PG8_STAGE(PG8_SB(0, 1), b2 + hstepB, voffB); PG8_STAGE(PG8_SA(0, 0), a2, voffA);
            PG8_WAIT_V(8); PG8_WAIT_L(0); PG8_BAR; PG8_MMA(1, 0, At, B0); PG8_MMA(1, 1, At, B1); PG8_BAR; PG8_SCHED;
            PG8_LDB(B0, 1, 0); PG8_LDB(B1, 1, 1); PG8_SCHED; PG8_LDA(At, 1, 0); PG8_STAGE(PG8_SA(0, 1), a2 + hstep, voffA);
            PG8_WAIT_V(8); PG8_WAIT_L(0); PG8_BAR; PG8_MMA(0, 0, At, B0); PG8_MMA(0, 1, At, B1); PG8_BAR; PG8_SCHED;
            PG8_LDA(At, 1, 1); PG8_STAGE(PG8_SB(1, 0), b3, voffB); PG8_STAGE(PG8_SB(1, 1), b3 + hstepB, voffB); PG8_STAGE(PG8_SA(1, 0), a3, voffA);
            PG8_WAIT_V(8); PG8_WAIT_L(0); PG8_BAR; PG8_MMA(1, 0, At, B0); PG8_MMA(1, 1, At, B1); PG8_BAR; PG8_SCHED;
            } else {
            PG8_LDB(B0, 0, 0); PG8_SCHED; PG8_LDA(At, 0, 0); PG8_STAGE(PG8_SA(1, 1), a1 + hstep, voffA);
            PG8_WAIT_L(8); PG8_BAR; PG8_WAIT_L(0); PG8_MMA(0, 0, At, B0); PG8_BAR; PG8_SCHED;
            PG8_LDB(B1, 0, 1); PG8_STAGE(PG8_SB(0, 0), b2, voffB);
            PG8_BAR; PG8_WAIT_L(0); PG8_MMA(0, 1, At, B1); PG8_BAR;
            PG8_LDA(At, 0, 1); PG8_STAGE(PG8_SA(0, 0), a2, voffA);
            PG8_BAR; PG8_WAIT_L(0); PG8_MMA(1, 0, At, B0); PG8_BAR; PG8_SCHED;
            PG8_STAGE(PG8_SB(0, 1), b2 + hstepB, voffB);
            PG8_WAIT_V(6); PG8_BAR; PG8_MMA(1, 1, At, B1); PG8_BAR;
            PG8_LDB(B0, 1, 0); PG8_SCHED; PG8_LDA(At, 1, 0); PG8_STAGE(PG8_SA(0, 1), a2 + hstep, voffA);
            PG8_WAIT_L(8); PG8_BAR; PG8_WAIT_L(0); PG8_MMA(0, 0, At, B0); PG8_BAR; PG8_SCHED;
            PG8_LDB(B1, 1, 1); PG8_STAGE(PG8_SB(1, 0), b3, voffB);
            PG8_BAR; PG8_WAIT_L(0); PG8_MMA(0, 1, At, B1); PG8_BAR;
            PG8_LDA(At, 1, 1); PG8_STAGE(PG8_SA(1, 0), a3, voffA);
            PG8_BAR; PG8_WAIT_L(0); PG8_MMA(1, 0, At, B0); PG8_BAR; PG8_SCHED;
            PG8_STAGE(PG8_SB(1, 1), b3 + hstepB, voffB);
            PG8_WAIT_V(6); PG8_BAR; PG8_MMA(1, 1, At, B1); PG8_BAR;
            }
        }
        if constexpr (ALIGN_EPI) { if (wr == 0) PG8_BAR; }
        E(acc, cur, wr, wc, fr, fq);
        if (!has_next) break;
#pragma unroll
        for (int a = 0; a < 2; ++a)
#pragma unroll
            for (int b = 0; b < 2; ++b)
#pragma unroll
                for (int m = 0; m < 4; ++m)
#pragma unroll
                    for (int n = 0; n < 2; ++n) acc[a][b][m][n] = (f32x4){0.f, 0.f, 0.f, 0.f};
        cur = nxt; cA = nA; cB = nB; ++ui;
        if constexpr (ALIGN_EPI) { if (wr == 1) PG8_BAR; }
    }
    PG8_WAIT_V(0);
    if constexpr (!ALIGN_EPI) { if (wr == 0) PG8_BAR; }
    PG8_BAR;
#undef PG8_SA
#undef PG8_SB
#undef PG8_STAGE
#undef PG8_LDA
#undef PG8_LDB
#undef PG8_MMA
#undef PG8_WAIT_V
#undef PG8_WAIT_L
#undef PG8_BAR
#undef PG8_SCHED
}
}

__device__ __forceinline__ void st_bf16x8(bf16_t* p, f32x4 a, f32x4 b) {
    u32x4 w; w.x = pk2(a[0], a[1]); w.y = pk2(a[2], a[3]); w.z = pk2(b[0], b[1]); w.w = pk2(b[2], b[3]);
    *(u32x4*)p = w;
}
__device__ __forceinline__ int brow_of(int r) { return r < MP ? (r >> 13) : 2 + ((r - MP) >> 4); }

struct EpiIn {
    int l; float* out; bf16_t* qb; bf16_t* kb; bf16_t* vb; float* ub; const float* qg; const float* kg;
    __device__ __forceinline__ void operator()(const f32x4 (&acc)[2][2][4][2], const pg8::Unit& u, int wr, int wc, int fr, int fq) const {
        const int pn = u.pn, rbase = u.pm * 256 + wr * 64 + fr;
        if (pn == 0) {
            const int cb = 64 * wc + 8 * fq;
#pragma unroll
            for (int ai = 0; ai < 2; ++ai)
#pragma unroll
                for (int m = 0; m < 4; ++m) {
                    const int r = rbase + ai * 128 + m * 16;
                    float* up = ub + (size_t)r * PW + cb;
                    float* sp = nullptr;
                    if (r < MP) { const int t = r & (T - 1); if (t >= T - 15) sp = out + OFF_PP + ((size_t)((l * NBP + (r >> 13)) * 15 + (t - (T - 15)))) * PW + cb; }
                    else { const int rr = r - MP, t = rr & 15; if (t >= 1) sp = out + OFF_PS + ((size_t)((l * SB + (rr >> 4)) * 15 + (t - 1))) * PW + cb; }
#pragma unroll
                    for (int bj = 0; bj < 2; ++bj) {
                        *(f32x4*)(up + 32 * bj) = acc[ai][bj][m][0]; *(f32x4*)(up + 32 * bj + 4) = acc[ai][bj][m][1];
                        if (sp) { *(f32x4*)(sp + 32 * bj) = acc[ai][bj][m][0]; *(f32x4*)(sp + 32 * bj + 4) = acc[ai][bj][m][1]; }
                    }
                }
        } else if (pn <= 6) {
            const bool isq = pn <= 3;
            const int head = ((pn - 1) % 3) * 4 + wc;
            const float* gp = (isq ? qg : kg) + 8 * fq;
            f32x4 gv[2][2];
#pragma unroll
            for (int bj = 0; bj < 2; ++bj)
#pragma unroll
                for (int n = 0; n < 2; ++n) gv[bj][n] = *(const f32x4*)(gp + 32 * bj + 4 * n);
            bf16_t* dst = isq ? qb : kb;
#pragma unroll
            for (int ai = 0; ai < 2; ++ai)
#pragma unroll
                for (int m = 0; m < 4; ++m) {
                    const int r = rbase + ai * 128 + m * 16;
                    float ss = 0.f;
#pragma unroll
                    for (int bj = 0; bj < 2; ++bj)
#pragma unroll
                        for (int n = 0; n < 2; ++n) { const f32x4 a = acc[ai][bj][m][n]; ss += (a[0] * a[0] + a[1] * a[1]) + (a[2] * a[2] + a[3] * a[3]); }
                    ss = quad_sum(ss);
                    float rinv = 1.0f / sqrtf(ss * (1.f / 64.f) + EPS);
                    const float rq = isq ? rinv * C2 : rinv;
                    float* ko = nullptr;
                    if (!isq) ko = out + (r < MP ? OFF_KP + ((size_t)l * MP + r) * AW : OFF_KS + ((size_t)l * MS + (r - MP)) * AW) + head * 64 + 8 * fq;
#pragma unroll
                    for (int bj = 0; bj < 2; ++bj) {
                        const f32x4 n0 = acc[ai][bj][m][0] * rinv * gv[bj][0], n1 = acc[ai][bj][m][1] * rinv * gv[bj][1];
                        if (isq) { const f32x4 s0 = acc[ai][bj][m][0] * rq * gv[bj][0], s1 = acc[ai][bj][m][1] * rq * gv[bj][1];
                            st_bf16x8(dst + (size_t)r * AW + head * 64 + 32 * bj + 8 * fq, s0, s1); }
                        else { st_bf16x8(dst + (size_t)r * AW + head * 64 + 32 * bj + 8 * fq, n0, n1);
                            *(f32x4*)(ko + 32 * bj) = n0; *(f32x4*)(ko + 32 * bj + 4) = n1; }
                    }
                }
        } else {
            const int head = (pn - 7) * 4 + wc;
#pragma unroll
            for (int ai = 0; ai < 2; ++ai)
#pragma unroll
                for (int m = 0; m < 4; ++m) {
                    const int r = rbase + ai * 128 + m * 16;
                    float* vo = out + (r < MP ? OFF_VP + ((size_t)l * MP + r) * AW : OFF_VS + ((size_t)l * MS + (r - MP)) * AW) + head * 64 + 8 * fq;
#pragma unroll
                    for (int bj = 0; bj < 2; ++bj) {
                        st_bf16x8(vb + (size_t)r * AW + head * 64 + 32 * bj + 8 * fq, acc[ai][bj][m][0], acc[ai][bj][m][1]);
                        *(f32x4*)(vo + 32 * bj) = acc[ai][bj][m][0]; *(f32x4*)(vo + 32 * bj + 4) = acc[ai][bj][m][1];
                    }
                }
        }
    }
};

struct EpiRes {
    const float* xip; const float* xis; float* xop; float* xos; const float* gate;
    __device__ __forceinline__ void operator()(const f32x4 (&acc)[2][2][4][2], const pg8::Unit& u, int wr, int wc, int fr, int fq) const {
        const int rbase = u.pm * 256 + wr * 64 + fr, cb = u.pn * 256 + 64 * wc + 8 * fq;
        const float* gp = gate + (size_t)((u.pm * 256) >> 13) * MODW + cb;
        constexpr int DEPTH = 3;
        f32x4 gg[2][2], xq[DEPTH][2][2];
#pragma unroll
        for (int bj = 0; bj < 2; ++bj)
#pragma unroll
            for (int n = 0; n < 2; ++n) gg[bj][n] = *(const f32x4*)(gp + 32 * bj + 4 * n);
#pragma unroll
        for (int d = 0; d < DEPTH; ++d) { const int r2 = rbase + (d >> 2) * 128 + (d & 3) * 16;
#pragma unroll
            for (int bj = 0; bj < 2; ++bj)
#pragma unroll
                for (int n = 0; n < 2; ++n) xq[d][bj][n] = *(const f32x4*)(xip + (size_t)r2 * D + cb + 32 * bj + 4 * n); }
#pragma unroll
        for (int it = 0; it < 8; ++it) {
            const int ai = it >> 2, m = it & 3, r = rbase + ai * 128 + m * 16;
            f32x4 xc[2][2];
#pragma unroll
            for (int bj = 0; bj < 2; ++bj)
#pragma unroll
                for (int n = 0; n < 2; ++n) xc[bj][n] = xq[it % DEPTH][bj][n];
            if (it + DEPTH < 8) { const int r2 = rbase + ((it + DEPTH) >> 2) * 128 + ((it + DEPTH) & 3) * 16;
#pragma unroll
                for (int bj = 0; bj < 2; ++bj)
#pragma unroll
                    for (int n = 0; n < 2; ++n) xq[it % DEPTH][bj][n] = *(const f32x4*)(xip + (size_t)r2 * D + cb + 32 * bj + 4 * n); }
            float* xo = xop + (size_t)r * D + cb;
#pragma unroll
            for (int bj = 0; bj < 2; ++bj)
#pragma unroll
                for (int n = 0; n < 2; ++n) *(f32x4*)(xo + 32 * bj + 4 * n) = xc[bj][n] + gg[bj][n] * acc[ai][bj][m][n];
            __builtin_amdgcn_sched_barrier(0);
        }
    }
};

struct EpiUp {
    bf16_t* hid;
    __device__ __forceinline__ void operator()(const f32x4 (&acc)[2][2][4][2], const pg8::Unit& u, int wr, int wc, int fr, int fq) const {
        const int rbase = u.pm * 256 + wr * 64 + fr, cb = u.pn * 256 + 64 * wc + 8 * fq;
#pragma unroll
        for (int ai = 0; ai < 2; ++ai)
#pragma unroll
            for (int m = 0; m < 4; ++m) {
                const int r = rbase + ai * 128 + m * 16;
#pragma unroll
                for (int bj = 0; bj < 2; ++bj) {
                    f32x4 a = acc[ai][bj][m][0], b = acc[ai][bj][m][1];
#pragma unroll
                    for (int j = 0; j < 4; ++j) { const float x = fmaxf(a[j], 0.f), y = fmaxf(b[j], 0.f); a[j] = x * x; b[j] = y * y; }
                    st_bf16x8(hid + (size_t)r * FF + cb + 32 * bj, a, b);
                }
            }
    }
};

template <class SEpi>
__device__ __forceinline__ void skinny_phase(LAS unsigned char* lds, const bf16_t* A, const bf16_t* Bt, int N, int K, const SEpi& E, int tid, int lane, int wave, int row0 = MP, int nrg = 16) {
    const int l16 = lane & 15, quad = lane >> 4;
    const int nr2 = nrg >> 1, nitems = nr2 * (N / 64);
    LAS float* red = (LAS float*)lds;
    const int kw = K / 8;
    const int G_ = (int)gridDim.x, b_ = (int)blockIdx.x;
    const int vb = (G_ % 8 == 0 && nr2 == 8 && nitems <= 2 * G_ && nitems != 320) ? (b_ % 8) * (G_ / 8) + b_ / 8 : G_ - 1 - b_;
    for (int it = vb; it < nitems; it += G_) {
        const int rg2 = it % nr2, cg = it / nr2;
        const bf16_t* ap = A + (size_t)(row0 + 32 * rg2 + l16) * K + wave * kw + quad * 8;
        const bf16_t* bp = Bt + (size_t)(cg * 64 + l16) * K + wave * kw + quad * 8;
        f32x4 acc[2][4];
#pragma unroll
        for (int h = 0; h < 2; ++h)
#pragma unroll
            for (int nt = 0; nt < 4; ++nt) acc[h][nt] = (f32x4){0.f, 0.f, 0.f, 0.f};
        for (int k0 = 0; k0 < kw; k0 += 128) {
            bf16x8 a0[4], a1[4], b[4][4];
#pragma unroll
            for (int s = 0; s < 4; ++s) {
                a0[s] = *(const bf16x8*)(ap + k0 + 32 * s); a1[s] = *(const bf16x8*)(ap + (size_t)16 * K + k0 + 32 * s);
#pragma unroll
                for (int nt = 0; nt < 4; ++nt) b[s][nt] = *(const bf16x8*)(bp + (size_t)nt * 16 * K + k0 + 32 * s);
            }
#pragma unroll
            for (int s = 0; s < 4; ++s)
#pragma unroll
                for (int nt = 0; nt < 4; ++nt) { acc[0][nt] = __builtin_amdgcn_mfma_f32_16x16x32_bf16(a0[s], b[s][nt], acc[0][nt], 0, 0, 0);
                    acc[1][nt] = __builtin_amdgcn_mfma_f32_16x16x32_bf16(a1[s], b[s][nt], acc[1][nt], 0, 0, 0); }
        }
#pragma unroll
        for (int h = 0; h < 2; ++h)
#pragma unroll
            for (int nt = 0; nt < 4; ++nt)
#pragma unroll
                for (int r = 0; r < 4; ++r) red[(wave * 32 + 16 * h + quad * 4 + r) * 64 + 16 * nt + l16] = acc[h][nt][r];
        __syncthreads();
        const int row = tid >> 5, c2 = (tid & 31) * 2;
#pragma unroll
        for (int h = 0; h < 2; ++h) {
            float v0 = 0.f, v1 = 0.f;
#pragma unroll
            for (int w = 0; w < 8; ++w) { const f32x2 t = *(const LAS f32x2*)(red + (w * 32 + 16 * h + row) * 64 + c2); v0 += t.x; v1 += t.y; }
            E(2 * rg2 + h, row, cg, c2, v0, v1);
        }
        __syncthreads();
    }
}

struct SEpiIn {
    int l; float* out; bf16_t* qb; bf16_t* kb; bf16_t* vb; float* ub; const float* qg; const float* kg;
    __device__ __forceinline__ void operator()(int b, int t, int cg, int c2, float v0, float v1) const {
        const int rr = 16 * b + t; const size_t r = (size_t)MP + rr;
        if (cg < 4) {
            const int c = cg * 64 + c2;
            *(f32x2*)(ub + r * PW + c) = (f32x2){v0, v1};
            if (t >= 1) *(f32x2*)(out + OFF_PS + ((size_t)((l * SB + b) * 15 + (t - 1))) * PW + c) = (f32x2){v0, v1};
        } else if (cg < 28) {
            const bool isq = cg < 16; const int head = isq ? cg - 4 : cg - 16;
            float ss = v0 * v0 + v1 * v1;
#pragma unroll
            for (int o = 1; o < 32; o <<= 1) ss += __shfl_xor(ss, o);
            const float rinv = 1.0f / sqrtf(ss * (1.f / 64.f) + EPS);
            const float* gp = (isq ? qg : kg) + c2;
            const float n0 = v0 * rinv * gp[0], n1 = v1 * rinv * gp[1];
            if (isq) *(unsigned*)(qb + r * AW + head * 64 + c2) = pk2(n0 * C2, n1 * C2);
            else { *(unsigned*)(kb + r * AW + head * 64 + c2) = pk2(n0, n1); *(f32x2*)(out + OFF_KS + ((size_t)l * MS + rr) * AW + head * 64 + c2) = (f32x2){n0, n1}; }
        } else {
            const int head = cg - 28;
            *(unsigned*)(vb + r * AW + head * 64 + c2) = pk2(v0, v1);
            *(f32x2*)(out + OFF_VS + ((size_t)l * MS + rr) * AW + head * 64 + c2) = (f32x2){v0, v1};
        }
    }
};
struct SEpiRes {
    const float* xis; float* xos; const float* gate;
    __device__ __forceinline__ void operator()(int b, int t, int cg, int c2, float v0, float v1) const {
        const size_t o = (size_t)(16 * b + t) * D + cg * 64 + c2;
        const f32x2 xv = *(const f32x2*)(xis + o), gg = *(const f32x2*)(gate + (size_t)(2 + b) * MODW + cg * 64 + c2);
        *(f32x2*)(xos + o) = (f32x2){xv.x + gg.x * v0, xv.y + gg.y * v1};
    }
};
struct SEpiUp {
    bf16_t* hid;
    __device__ __forceinline__ void operator()(int b, int t, int cg, int c2, float v0, float v1) const {
        const float x = fmaxf(v0, 0.f), y = fmaxf(v1, 0.f);
        *(unsigned*)(hid + ((size_t)MP + 16 * b + t) * FF + cg * 64 + c2) = pk2(x * x, y * y);
    }
};


struct EpiResN {
    const float* xip; float* xop; const float* gate; const float* sc2; bf16_t* xt; float* ss;
    __device__ __forceinline__ void operator()(const f32x4 (&acc)[2][2][4][2], const pg8::Unit& u, int wr, int wc, int fr, int fq) const {
        const int rbase = u.pm * 256 + wr * 64 + fr, cb = u.pn * 256 + 64 * wc + 8 * fq;
        const int brow = (u.pm * 256) >> 13;
        const float* gp = gate + (size_t)brow * MODW + cb; const float* sp = sc2 + (size_t)brow * MODW + cb;
        constexpr int DEPTH = 2;
        f32x4 gg[2][2], sv[2][2], xq[DEPTH][2][2];
#pragma unroll
        for (int bj = 0; bj < 2; ++bj)
#pragma unroll
            for (int n = 0; n < 2; ++n) { gg[bj][n] = *(const f32x4*)(gp + 32 * bj + 4 * n); sv[bj][n] = *(const f32x4*)(sp + 32 * bj + 4 * n) + 1.0f; }
#pragma unroll
        for (int d = 0; d < DEPTH; ++d) { const int r2 = rbase + (d >> 2) * 128 + (d & 3) * 16;
#pragma unroll
            for (int bj = 0; bj < 2; ++bj)
#pragma unroll
                for (int n = 0; n < 2; ++n) xq[d][bj][n] = *(const f32x4*)(xip + (size_t)r2 * D + cb + 32 * bj + 4 * n); }
#pragma unroll
        for (int it = 0; it < 8; ++it) {
            const int ai = it >> 2, m = it & 3, r = rbase + ai * 128 + m * 16;
            f32x4 xc[2][2];
#pragma unroll
            for (int bj = 0; bj < 2; ++bj)
#pragma unroll
                for (int n = 0; n < 2; ++n) xc[bj][n] = xq[it % DEPTH][bj][n];
            if (it + DEPTH < 8) { const int r2 = rbase + ((it + DEPTH) >> 2) * 128 + ((it + DEPTH) & 3) * 16;
#pragma unroll
                for (int bj = 0; bj < 2; ++bj)
#pragma unroll
                    for (int n = 0; n < 2; ++n) xq[it % DEPTH][bj][n] = *(const f32x4*)(xip + (size_t)r2 * D + cb + 32 * bj + 4 * n); }
            float* xo = xop + (size_t)r * D + cb;
            float s = 0.f;
#pragma unroll
            for (int bj = 0; bj < 2; ++bj) {
                f32x4 t[2];
#pragma unroll
                for (int n = 0; n < 2; ++n) {
                    const f32x4 x1 = xc[bj][n] + gg[bj][n] * acc[ai][bj][m][n];
                    *(f32x4*)(xo + 32 * bj + 4 * n) = x1;
                    s += (x1[0] * x1[0] + x1[1] * x1[1]) + (x1[2] * x1[2] + x1[3] * x1[3]);
                    t[n] = x1 * sv[bj][n];
                }
                st_bf16x8(xt + (size_t)r * D + cb + 32 * bj, t[0], t[1]);
            }
            s = quad_sum(s);
            if (fq == 0) atomicAdd(ss + r, s);
            __builtin_amdgcn_sched_barrier(0);
        }
    }
};
struct SEpiResN {
    const float* xis; float* xos; const float* gate; const float* sc2; bf16_t* xt; float* ss;
    __device__ __forceinline__ void operator()(int b, int t, int cg, int c2, float v0, float v1) const {
        const int rr = 16 * b + t; const size_t o = (size_t)rr * D + cg * 64 + c2;
        const f32x2 xv = *(const f32x2*)(xis + o), gg = *(const f32x2*)(gate + (size_t)(2 + b) * MODW + cg * 64 + c2), sv = *(const f32x2*)(sc2 + (size_t)(2 + b) * MODW + cg * 64 + c2);
        const float a0 = xv.x + gg.x * v0, a1 = xv.y + gg.y * v1;
        *(f32x2*)(xos + o) = (f32x2){a0, a1};
        *(unsigned*)(xt + ((size_t)MP + rr) * D + cg * 64 + c2) = pk2(a0 * (sv.x + 1.0f), a1 * (sv.y + 1.0f));
        float s = a0 * a0 + a1 * a1;
#pragma unroll
        for (int q = 1; q < 32; q <<= 1) s += __shfl_xor(s, q);
        if ((c2 >> 1) == 0) atomicAdd(ss + MP + rr, s);
    }
};
struct EpiUpN {
    bf16_t* hid; const float* ss; const float* bias;
    __device__ __forceinline__ void operator()(const f32x4 (&acc)[2][2][4][2], const pg8::Unit& u, int wr, int wc, int fr, int fq) const {
        const int rbase = u.pm * 256 + wr * 64 + fr, cb = u.pn * 256 + 64 * wc + 8 * fq;
        const float* bp = bias + (size_t)((u.pm * 256) >> 13) * FF + cb;
        f32x4 bv[2][2];
#pragma unroll
        for (int bj = 0; bj < 2; ++bj)
#pragma unroll
            for (int n = 0; n < 2; ++n) bv[bj][n] = *(const f32x4*)(bp + 32 * bj + 4 * n);
#pragma unroll
        for (int ai = 0; ai < 2; ++ai)
#pragma unroll
            for (int m = 0; m < 4; ++m) {
                const int r = rbase + ai * 128 + m * 16;
                const float rinv = 1.0f / sqrtf(ss[r] * (1.f / D) + EPS);
#pragma unroll
                for (int bj = 0; bj < 2; ++bj) {
                    f32x4 a = acc[ai][bj][m][0] * rinv + bv[bj][0], b = acc[ai][bj][m][1] * rinv + bv[bj][1];
#pragma unroll
                    for (int j = 0; j < 4; ++j) { const float x = fmaxf(a[j], 0.f), y = fmaxf(b[j], 0.f); a[j] = x * x; b[j] = y * y; }
                    st_bf16x8(hid + (size_t)r * FF + cb + 32 * bj, a, b);
                }
            }
    }
};
struct SEpiUpN {
    bf16_t* hid; const float* ss; const float* bias;
    __device__ __forceinline__ void operator()(int b, int t, int cg, int c2, float v0, float v1) const {
        const int r = MP + 16 * b + t;
        const float rinv = 1.0f / sqrtf(ss[r] * (1.f / D) + EPS);
        const f32x2 bb = *(const f32x2*)(bias + (size_t)(2 + b) * FF + cg * 64 + c2);
        const float x = fmaxf(v0 * rinv + bb.x, 0.f), y = fmaxf(v1 * rinv + bb.y, 0.f);
        *(unsigned*)(hid + (size_t)r * FF + cg * 64 + c2) = pk2(x * x, y * y);
    }
};
struct SEpiBias {
    float* bias;
    __device__ __forceinline__ void operator()(int rg, int t, int cg, int c2, float v0, float v1) const {
        const int row = 16 * rg + t;
        if (row < NMODROW) *(f32x2*)(bias + (size_t)row * FF + cg * 64 + c2) = (f32x2){v0, v1};
    }
};

struct Params { const float* in[19]; float* out; unsigned char* ws; };

__device__ __forceinline__ void transpose_item(const float* W, int ldw, int K, int nblk, bf16_t* WT, LAS float* scr, int item, int lane) {
    const int kb = item / nblk, nb = item % nblk, k0 = 64 * kb, n0 = 32 * nb;
    float tv[32];
#pragma unroll
    for (int i = 0; i < 32; ++i) tv[i] = W[(size_t)(k0 + 2 * i + (lane >> 5)) * ldw + n0 + (lane & 31)];
#pragma unroll
    for (int i = 0; i < 32; ++i) scr[(2 * i + (lane >> 5)) * 33 + (lane & 31)] = tv[i];
    asm volatile("s_waitcnt lgkmcnt(0)" ::: "memory");
    const int c = lane & 7;
#pragma unroll
    for (int j = 0; j < 4; ++j) { const int n = (lane >> 3) + 8 * j; const LAS float* s = scr + (8 * c) * 33 + n;
        u32x4 o; o.x = pk2(s[0 * 33], s[1 * 33]); o.y = pk2(s[2 * 33], s[3 * 33]); o.z = pk2(s[4 * 33], s[5 * 33]); o.w = pk2(s[6 * 33], s[7 * 33]);
        *(u32x4*)(WT + (size_t)(n0 + n) * K + k0 + 8 * c) = o; }
    asm volatile("s_waitcnt lgkmcnt(0)" ::: "memory");
}

__device__ __forceinline__ void phase_prologue(const Params& p, LAS unsigned char* lds, int tid, int lane, int wave) {
    LAS float* sc = (LAS float*)lds;
    LAS float* red = (LAS float*)(lds + 73728);
    for (int idx = tid; idx < NMODROW * D; idx += 512) {
        const int r = idx >> 10, k = idx & 1023;
        const float c = (r < 2) ? p.in[2][r * D + k] : p.in[3][(r - 2) * D + k];
        sc[k * 18 + r] = c / (1.f + __expf(-c));
    }
    __syncthreads();
    float* modw = (float*)(p.ws + WS_MOD);
    for (int it = blockIdx.x; it < 256; it += gridDim.x) {
        const int l = it >> 7, col0 = (it & 127) * 48;
        const int la = lane < 48 ? lane : 47, kk2 = la / 24, c2 = la % 24;
        const float* W = p.in[8] + (size_t)l * D * MODW + col0 + 2 * c2;
        float acc[18][2];
#pragma unroll
        for (int r = 0; r < 18; ++r) { acc[r][0] = 0.f; acc[r][1] = 0.f; }
        const int kb = wave * 128 + kk2;
#pragma unroll 16
        for (int i = 0; i < 64; ++i) {
            const int k = kb + 2 * i;
            const f32x2 wv = *(const f32x2*)(W + (size_t)k * MODW);
            const LAS f32x2* s2 = (const LAS f32x2*)(sc + k * 18);
#pragma unroll
            for (int r2 = 0; r2 < 9; ++r2) { const f32x2 s = s2[r2];
                acc[2 * r2][0] += s.x * wv.x; acc[2 * r2][1] += s.x * wv.y; acc[2 * r2 + 1][0] += s.y * wv.x; acc[2 * r2 + 1][1] += s.y * wv.y; }
        }
        if (lane < 48) {
#pragma unroll
            for (int r = 0; r < 18; ++r) { red[((wave * 2 + kk2) * 18 + r) * 48 + 2 * c2] = acc[r][0]; red[((wave * 2 + kk2) * 18 + r) * 48 + 2 * c2 + 1] = acc[r][1]; }
        }
        __syncthreads();
        for (int idx = tid; idx < 18 * 48; idx += 512) {
            const int r = idx / 48, c = idx % 48;
            float s = p.in[9][l * MODW + col0 + c];
#pragma unroll
            for (int w = 0; w < 16; ++w) s += red[(w * 18 + r) * 48 + c];
            modw[((size_t)l * NMODROW + r) * MODW + col0 + c] = s;
        }
        __syncthreads();
    }
    if (blockIdx.x < 32) {
        const int l = blockIdx.x >> 4, hh = blockIdx.x & 15;
        const float* Wf = p.in[10] + (size_t)l * D * INC + NMAIN + hh;
        bf16_t* wft = (bf16_t*)(p.ws + WS_WF) + ((size_t)l * 16 + hh) * 1032;
        for (int k = tid; k < 1032; k += 512) wft[k] = (bf16_t)f2bf((hh < NH && k < D) ? Wf[(size_t)k * INC] : 0.f);
    }
    LAS float* scr = (LAS float*)(lds + 73728 + wave * 8448);
    const int gw = blockIdx.x * 8 + wave, NGW = gridDim.x * 8;
    constexpr int I_IN = 16 * 80, I_OUT = 16 * 32, I_UP = 16 * 128, I_DN = 64 * 32, I_L = I_IN + I_OUT + I_UP + I_DN;
    for (int it = gw; it < 2 * I_L; it += NGW) {
        const int l = it / I_L; int r = it % I_L;
        if (r < I_IN) { transpose_item(p.in[10] + (size_t)l * D * INC, INC, D, 80, (bf16_t*)(p.ws + WS_WIN) + (size_t)l * NMAIN * D, scr, r, lane); continue; } r -= I_IN;
        if (r < I_OUT) { transpose_item(p.in[16] + (size_t)l * D * D, D, D, 32, (bf16_t*)(p.ws + WS_WOUT) + (size_t)l * D * D, scr, r, lane); continue; } r -= I_OUT;
        if (r < I_UP) { transpose_item(p.in[17] + (size_t)l * D * FF, FF, D, 128, (bf16_t*)(p.ws + WS_WUP) + (size_t)l * FF * D, scr, r, lane); continue; } r -= I_UP;
        transpose_item(p.in[18] + (size_t)l * FF * D, D, FF, 32, (bf16_t*)(p.ws + WS_WDN) + (size_t)l * D * FF, scr, r, lane);
    }
}

__device__ __forceinline__ void phase_norm(const Params& p, LAS unsigned char* lds, int l, int stage, const float* xp, const float* xs, int tid, int lane, int wave) {
    constexpr int HP = 1032;
    LAS bf16_t* wfb = (LAS bf16_t*)lds;
    LAS bf16_t* ht = (LAS bf16_t*)(lds + 33280);
    LAS float* pc = (LAS float*)(lds + 66560);
    {
        const u32x4* wsrc = (const u32x4*)(p.ws + WS_WF + (size_t)l * 16 * HP * 2);
        for (int i = tid; i < 16 * HP * 2 / 16; i += 512) *(LAS u32x4*)(lds + 16 * i) = wsrc[i];
        float* SS = (float*)(p.ws + WS_SS);
        for (int i = blockIdx.x * 512 + tid; i < M; i += gridDim.x * 512) SS[i] = 0.f;
        if (l == 0) {
            bf16_t* s2 = (bf16_t*)(p.ws + WS_SH2); const float* modall = (const float*)(p.ws + WS_MOD);
            for (int i = blockIdx.x * 512 + tid; i < 2 * 32 * D; i += gridDim.x * 512) { const int ll = i >> 15, row = (i >> 10) & 31, k = i & 1023;
                s2[i] = (bf16_t)f2bf(row < NMODROW ? modall[((size_t)ll * NMODROW + row) * MODW + 3 * D + k] : 0.f); }
        }
    }
    __syncthreads();
    const float* modl = (const float*)(p.ws + WS_MOD) + (size_t)l * NMODROW * MODW;
    bf16_t* hn = (bf16_t*)(p.ws + WS_HN);
    const int l16 = lane & 15, quad = lane >> 4;
    const int rpb = (M + (int)gridDim.x - 1) / (int)gridDim.x, R0 = (int)blockIdx.x * rpb, R1 = (R0 + rpb < M) ? R0 + rpb : M;
    for (int g0 = R0; g0 < R1; g0 += 16) {
#pragma unroll
        for (int rr = 0; rr < 2; ++rr) {
            const int lr = 2 * wave + rr, m = g0 + lr;
            LAS unsigned long long* h8 = (LAS unsigned long long*)(ht + lr * HP) + lane;
            if (m < R1) {
                const f32x4* xr = (const f32x4*)(m < MP ? xp + (size_t)m * D : xs + (size_t)(m - MP) * D) + lane;
                f32x4 v[4]; float ss = 0.f;
#pragma unroll
                for (int j = 0; j < 4; ++j) { v[j] = xr[64 * j]; ss += (v[j].x * v[j].x + v[j].y * v[j].y) + (v[j].z * v[j].z + v[j].w * v[j].w); }
                ss = wave_sum(ss);
                const float rinv = 1.0f / sqrtf(ss * (1.f / D) + EPS);
                const float* mrow = modl + (size_t)brow_of(m) * MODW;
                const f32x4* sh4 = (const f32x4*)mrow + lane; const f32x4* sc4 = (const f32x4*)(mrow + D) + lane;
                unsigned long long* o8 = (unsigned long long*)(hn + (size_t)m * D) + lane;
#pragma unroll
                for (int j = 0; j < 4; ++j) {
                    const f32x4 shv = sh4[64 * j], scv = sc4[64 * j];
                    v[j] = v[j] * rinv * (scv + 1.0f) + shv;
                    const unsigned long long w = (unsigned long long)pk2(v[j].x, v[j].y) | ((unsigned long long)pk2(v[j].z, v[j].w) << 32);
                    o8[64 * j] = w; h8[64 * j] = w;
                }
            } else {
#pragma unroll
                for (int j = 0; j < 4; ++j) h8[64 * j] = 0ull;
            }
        }
        __syncthreads();
        {
            f32x4 c = (f32x4){0.f, 0.f, 0.f, 0.f};
#pragma unroll
            for (int s = 0; s < 4; ++s) {
                const int k0 = 32 * (4 * wave + s) + 8 * quad;
                const bf16x8 a = *(const LAS bf16x8*)(ht + l16 * HP + k0), b = *(const LAS bf16x8*)(wfb + l16 * HP + k0);
                c = __builtin_amdgcn_mfma_f32_16x16x32_bf16(a, b, c, 0, 0, 0);
            }
#pragma unroll
            for (int r = 0; r < 4; ++r) pc[(wave * 16 + quad * 4 + r) * 16 + l16] = c[r];
        }
        __syncthreads();
        if (tid < 16 * NH) {
            const int row = tid / NH, hh = tid % NH, m = g0 + row;
            if (m < R1) {
                float x = p.in[11][l * NH + hh];
#pragma unroll
                for (int w = 0; w < 8; ++w) x += pc[(w * 16 + row) * 16 + hh];
                const float lf = fminf(x, 0.f) - log1pf(expf(-fabsf(x)));
                float* o = p.out + (m < MP ? OFF_FP + ((size_t)l * MP + m) * NH : OFF_FS + ((size_t)l * MS + (m - MP)) * NH);
                o[hh] = lf;
            }
        }
    }
}

__device__ __forceinline__ float block_scan_offset(float total, LAS float* sm, int lane, int wave) {
    float x = total;
#pragma unroll
    for (int o = 1; o < 64; o <<= 1) { const float n = __shfl_up(x, o); if (lane >= o) x += n; }
    __syncthreads();
    if (lane == 63) sm[wave] = x;
    __syncthreads();
    float off = x - total;
    for (int w = 0; w < wave; ++w) off += sm[w];
    return off;
}

__device__ __forceinline__ void scan_items(const Params& p, LAS unsigned char* lds, int l, int tid, int lane, int wave) {
    LAS float* sm = (LAS float*)(lds + 65536);
    float* Fp = (float*)(p.ws + WS_FP); float* Fs = (float*)(p.ws + WS_FS);
    const int nb = (int)gridDim.x / 2;
    if ((int)blockIdx.x < (int)gridDim.x - nb) return;
    for (int it = (int)(gridDim.x - 1 - blockIdx.x); it < 24 + 192; it += nb) {
        if (it < 24) {
            const int b = it / NH, h = it % NH;
            const float* src = p.out + OFF_FP + ((size_t)(l * NBP + b) * T) * NH + h;
            const int t0 = tid * 16;
            float v[16]; float run = 0.f;
#pragma unroll
            for (int e = 0; e < 16; ++e) { run += src[(size_t)(t0 + e) * NH]; v[e] = run; }
            const float off = block_scan_offset(run, sm, lane, wave);
            float* dst = Fp + (size_t)it * T + t0;
#pragma unroll
            for (int e = 0; e < 16; e += 4) *(f32x4*)(dst + e) = (f32x4){(off + v[e]) * LOG2E, (off + v[e + 1]) * LOG2E, (off + v[e + 2]) * LOG2E, (off + v[e + 3]) * LOG2E};
        } else {
            const int bh = it - 24, b = bh / NH, h = bh % NH;
            const float* src = p.in[6] + ((size_t)(l * SB + b) * PAST) * NH + h;
            const int t0 = tid * 8;
            float v[8]; float run = 0.f;
#pragma unroll
            for (int e = 0; e < 8; ++e) { run += src[(size_t)(t0 + e) * NH]; v[e] = run; }
            const float off = block_scan_offset(run, sm, lane, wave);
            float* dst = Fs + (size_t)bh * SKEYS + t0;
#pragma unroll
            for (int e = 0; e < 8; e += 4) *(f32x4*)(dst + e) = (f32x4){(off + v[e]) * LOG2E, (off + v[e + 1]) * LOG2E, (off + v[e + 2]) * LOG2E, (off + v[e + 3]) * LOG2E};
            if (tid == 511) sm[8] = off + run;
            __syncthreads();
            if (tid < ST) {
                const float* ns = p.out + OFF_FS + ((size_t)(l * SB + b) * ST) * NH + h;
                float s = sm[8];
                for (int e = 0; e <= tid; ++e) s += ns[e * NH];
                Fs[(size_t)bh * SKEYS + PAST + tid] = s * LOG2E;
            }
        }
        __syncthreads();
    }
}

__device__ __forceinline__ void pool_items(const Params& p, LAS unsigned char* lds, int l, unsigned* ctr, LAS unsigned* slot, int tid, int lane, int wave) {
    LAS float* z = (LAS float*)lds;
    LAS bf16_t* am = (LAS bf16_t*)(lds + 81920);
    const float* ub = (const float*)(p.ws + WS_U);
    bf16_t* mix = (bf16_t*)(p.ws + WS_MIX);
    const int g = wave >> 1, ntp = (wave & 1) * 2, l16 = lane & 15, quad = lane >> 4;
    bf16x8 bw[2][2];
    {
        const float* wp = p.in[14] + ((size_t)(l * 4 + g) * 64) * 64;
#pragma unroll
        for (int nt = 0; nt < 2; ++nt)
#pragma unroll
            for (int ks = 0; ks < 2; ++ks) {
                bf16x8 t;
#pragma unroll
                for (int j = 0; j < 8; ++j) t[j] = (short)f2bf(wp[(size_t)(32 * ks + 8 * quad + j) * 64 + 16 * (ntp + nt) + l16]);
                bw[nt][ks] = t;
            }
    }
    for (;;) {
      if (tid == 0) *slot = atomicAdd(ctr, 1u);
      __syncthreads();
      const int ent = (int)*slot;
      __syncthreads();
      if (ent >= MP / 64 + MS / 16) break;
      const bool prm = ent < MP / 64;
      const int row0 = prm ? ent * 64 : MP + (ent - MP / 64) * 16;
      const int nr = prm ? 4 : 1, nz = 15 + 16 * nr;
      const int t0 = prm ? (row0 & (T - 1)) : 0;
      for (int idx = tid; idx < nz * 64; idx += 512) {
          const int zr = idx >> 6, c4 = (idx & 63) * 4;
          f32x4 val = (f32x4){0.f, 0.f, 0.f, 0.f};
          if (zr >= 15) val = *(const f32x4*)(ub + (size_t)(row0 + zr - 15) * PW + c4);
          else if (prm) { if (t0 > 0) val = *(const f32x4*)(ub + (size_t)(row0 + zr - 15) * PW + c4); }
          else val = *(const f32x4*)(p.in[7] + ((size_t)(l * SB + ((row0 - MP) >> 4)) * 15 + zr) * PW + c4);
          *(LAS f32x4*)(z + zr * 256 + c4) = val;
      }
      __syncthreads();
      for (int i = 0; i < nr; ++i) {
          const int row = (tid >> 5) + 16 * i, c0 = (tid & 31) * 8, gg = c0 >> 6, w = 2 << gg;
          f32x4 s0 = (f32x4){0.f, 0.f, 0.f, 0.f}, s1 = s0;
          for (int j = 0; j < w; ++j) { s0 += *(const LAS f32x4*)(z + (15 + row - j) * 256 + c0); s1 += *(const LAS f32x4*)(z + (15 + row - j) * 256 + c0 + 4); }
          float cnt = (float)w;
          if (prm) { const float pos1 = (float)(t0 + row + 1); cnt = fminf(pos1, cnt); }
          const float ic = 1.0f / cnt;
          const f32x4 u0 = *(const LAS f32x4*)(z + (15 + row) * 256 + c0), u1 = *(const LAS f32x4*)(z + (15 + row) * 256 + c0 + 4);
          s0 = s0 * ic - u0; s1 = s1 * ic - u1;
          u32x4 o; o.x = pk2(s0[0], s0[1]); o.y = pk2(s0[2], s0[3]); o.z = pk2(s1[0], s1[1]); o.w = pk2(s1[2], s1[3]);
          *(LAS u32x4*)(am + row * 264 + c0) = o;
      }
      __syncthreads();
      for (int i = 0; i < nr; ++i) {
          f32x4 c[2] = {(f32x4){0.f, 0.f, 0.f, 0.f}, (f32x4){0.f, 0.f, 0.f, 0.f}};
#pragma unroll
          for (int ks = 0; ks < 2; ++ks) {
              const bf16x8 a = *(const LAS bf16x8*)(am + (16 * i + l16) * 264 + g * 64 + 32 * ks + 8 * quad);
#pragma unroll
              for (int nt = 0; nt < 2; ++nt) c[nt] = __builtin_amdgcn_mfma_f32_16x16x32_bf16(a, bw[nt][ks], c[nt], 0, 0, 0);
          }
#pragma unroll
          for (int nt = 0; nt < 2; ++nt) {
              const int col = g * 64 + 16 * (ntp + nt) + l16;
              const float ps = p.in[15][l * PW + col];
#pragma unroll
              for (int r = 0; r < 4; ++r) mix[(size_t)(row0 + 16 * i + quad * 4 + r) * D + col] = (bf16_t)f2bf(c[nt][r] * ps);
          }
      }
      __syncthreads();
    }
}

__device__ __forceinline__ s16x4 vtr(const LAS unsigned char* ptr) { return __builtin_bit_cast(s16x4, __builtin_amdgcn_ds_read_tr16_b64_v4i16((LAS s16x4*)ptr)); }
constexpr int KP = 144;

__device__ __forceinline__ float xmax_q(float v) {
    auto a = __builtin_amdgcn_permlane16_swap(__float_as_uint(v), __float_as_uint(v), false, false);
    const float m = __builtin_fmaxf(__uint_as_float(a[0]), __uint_as_float(a[1]));
    auto b = __builtin_amdgcn_permlane32_swap(__float_as_uint(m), __float_as_uint(m), false, false);
    return __builtin_fmaxf(__uint_as_float(b[0]), __uint_as_float(b[1]));
}
__device__ __forceinline__ void attn_tile64(const LAS unsigned char* Kt, const LAS unsigned char* Vt, const LAS float* Ft, int key0, int Qw, bool diag,
                                            const bf16x8 (&qf)[2][2], const float (&fq)[2], float (&fqm)[2], float (&mrun)[2], float (&lrun)[2], f32x4 (&o)[4][2], int l16, int quad) {
    f32x4 s[4][2];
    bf16x8 kf[2][4]; f32x4 fk[4];
#pragma unroll
    for (int ks = 0; ks < 2; ++ks)
#pragma unroll
        for (int kt = 0; kt < 4; ++kt) kf[ks][kt] = *(const LAS bf16x8*)(Kt + (16 * kt + l16) * KP + ks * 64 + quad * 16);
#pragma unroll
    for (int kt = 0; kt < 4; ++kt) fk[kt] = *(const LAS f32x4*)(Ft + 16 * kt + 4 * quad);
    __builtin_amdgcn_sched_barrier(0);
#pragma unroll
    for (int kt = 0; kt < 4; ++kt)
#pragma unroll
        for (int qt = 0; qt < 2; ++qt) s[kt][qt] = (f32x4){fqm[qt] - fk[kt][0], fqm[qt] - fk[kt][1], fqm[qt] - fk[kt][2], fqm[qt] - fk[kt][3]};
#pragma unroll
    for (int ks = 0; ks < 2; ++ks)
#pragma unroll
        for (int kt = 0; kt < 4; ++kt)
#pragma unroll
            for (int qt = 0; qt < 2; ++qt) s[kt][qt] = __builtin_amdgcn_mfma_f32_16x16x32_bf16(kf[ks][kt], qf[qt][ks], s[kt][qt], 0, 0, 0);
    s16x4 va[2][4][2];
    {
        const LAS unsigned char* vb0 = Vt + (4 * quad + (l16 >> 2)) * KP + 8 * (l16 & 3);
#pragma unroll
        for (int k2 = 0; k2 < 2; ++k2)
#pragma unroll
            for (int dt = 0; dt < 4; ++dt) { va[k2][dt][0] = vtr(vb0 + 32 * k2 * KP + 32 * dt); va[k2][dt][1] = vtr(vb0 + (32 * k2 + 16) * KP + 32 * dt); }
    }
    __builtin_amdgcn_sched_barrier(0);
    if (diag) {
#pragma unroll
        for (int kt = 0; kt < 4; ++kt)
#pragma unroll
            for (int qt = 0; qt < 2; ++qt)
#pragma unroll
                for (int r = 0; r < 4; ++r) { const int key = key0 + 16 * kt + 4 * quad + r, qq = Qw + 16 * qt + l16; if (key > qq) s[kt][qt][r] = -INFINITY; }
    }
    float mx[2];
#pragma unroll
    for (int qt = 0; qt < 2; ++qt) {
        float a = __builtin_fmaxf(__builtin_fmaxf(s[0][qt][0], s[0][qt][1]), s[0][qt][2]), c = __builtin_fmaxf(__builtin_fmaxf(s[0][qt][3], s[1][qt][0]), s[1][qt][1]);
        a = __builtin_fmaxf(__builtin_fmaxf(a, s[1][qt][2]), s[1][qt][3]); c = __builtin_fmaxf(__builtin_fmaxf(c, s[2][qt][0]), s[2][qt][1]);
        a = __builtin_fmaxf(__builtin_fmaxf(a, s[2][qt][2]), s[2][qt][3]); c = __builtin_fmaxf(__builtin_fmaxf(c, s[3][qt][0]), s[3][qt][1]);
        a = __builtin_fmaxf(__builtin_fmaxf(a, s[3][qt][2]), s[3][qt][3]);
        float m_ = __builtin_fmaxf(a, c);
        mx[qt] = xmax_q(m_);
    }
    if (__any((mx[0] > 8.f) || (mx[1] > 8.f))) {
#pragma unroll
        for (int qt = 0; qt < 2; ++qt) {
            const float dl = __builtin_fmaxf(mx[qt], 0.f);
            mrun[qt] += dl; fqm[qt] = fq[qt] - mrun[qt];
            const float al = __builtin_amdgcn_exp2f(-dl);
            lrun[qt] *= al;
#pragma unroll
            for (int kt = 0; kt < 4; ++kt) s[kt][qt] -= dl;
#pragma unroll
            for (int dt = 0; dt < 4; ++dt) o[dt][qt] *= al;
        }
    }
#pragma unroll
    for (int qt = 0; qt < 2; ++qt) {
        float ps = 0.f;
#pragma unroll
        for (int kt = 0; kt < 4; ++kt)
#pragma unroll
            for (int r = 0; r < 4; ++r) { const float e = __builtin_amdgcn_exp2f(s[kt][qt][r]); s[kt][qt][r] = e; ps += e; }
        lrun[qt] += ps;
    }
#pragma unroll
    for (int k2 = 0; k2 < 2; ++k2) {
        bf16x8 pb[2];
#pragma unroll
        for (int qt = 0; qt < 2; ++qt) {
            u32x4 w; w.x = pk2(s[2 * k2][qt][0], s[2 * k2][qt][1]); w.y = pk2(s[2 * k2][qt][2], s[2 * k2][qt][3]);
            w.z = pk2(s[2 * k2 + 1][qt][0], s[2 * k2 + 1][qt][1]); w.w = pk2(s[2 * k2 + 1][qt][2], s[2 * k2 + 1][qt][3]);
            pb[qt] = __builtin_bit_cast(bf16x8, w);
        }
#pragma unroll
        for (int dt = 0; dt < 4; ++dt) {
            const s16x4 a0 = va[k2][dt][0], a1 = va[k2][dt][1];
            const bf16x8 vf = (bf16x8){a0[0], a0[1], a0[2], a0[3], a1[0], a1[1], a1[2], a1[3]};
#pragma unroll
            for (int qt = 0; qt < 2; ++qt) o[dt][qt] = __builtin_amdgcn_mfma_f32_16x16x32_bf16(vf, pb[qt], o[dt][qt], 0, 0, 0);
        }
    }
}

constexpr int TB = 128 * KP;
__device__ __forceinline__ void attn_prompt_unit(int b, int h, int qb, const bf16_t* Q, const bf16_t* Kb, const bf16_t* Vb, const float* F2, bf16_t* mix,
                                                 LAS unsigned char* lds, int tid, int lane, int wave) {
    const int l16 = lane & 15, quad = lane >> 4;
    const size_t rowbase = (size_t)b * T;
    const int Qw = qb * 256 + wave * 32;
    const float* Fh = F2 + (size_t)(b * NH + h) * T;
    bf16x8 qf[2][2]; float fq[2];
#pragma unroll
    for (int qt = 0; qt < 2; ++qt) {
#pragma unroll
        for (int ks = 0; ks < 2; ++ks) qf[qt][ks] = *(const bf16x8*)(Q + (rowbase + Qw + 16 * qt + l16) * AW + h * HD + 32 * ks + 8 * quad);
        fq[qt] = Fh[Qw + 16 * qt + l16];
    }
    f32x4 o[4][2];
#pragma unroll
    for (int dt = 0; dt < 4; ++dt) { o[dt][0] = (f32x4){0.f, 0.f, 0.f, 0.f}; o[dt][1] = o[dt][0]; }
    float mrun[2] = {0.f, 0.f}, lrun[2] = {0.f, 0.f}, fqm[2] = {fq[0], fq[1]};
    const int NT = 2 * qb + 2;
    LAS unsigned char* Kl = lds; LAS unsigned char* Vl = lds + 2 * TB; LAS float* Fl = (LAS float*)(lds + 4 * TB);
    const int skey = tid >> 3, sch = tid & 7;
    const bf16_t* kg = Kb + (rowbase + skey) * AW + h * HD + sch * 8;
    const bf16_t* vg = Vb + (rowbase + skey) * AW + h * HD + sch * 8;
    u32x4 kreg0 = *(const u32x4*)kg, kreg1 = *(const u32x4*)(kg + (size_t)64 * AW), vreg0 = *(const u32x4*)vg, vreg1 = *(const u32x4*)(vg + (size_t)64 * AW);
    f32x4 freg = (f32x4){0.f, 0.f, 0.f, 0.f};
    if (tid < 32) freg = *(const f32x4*)(Fh + tid * 4);
    const int soff = skey * KP + sch * 16;
    *(LAS u32x4*)(Kl + soff) = kreg0; *(LAS u32x4*)(Kl + 64 * KP + soff) = kreg1; *(LAS u32x4*)(Vl + soff) = vreg0; *(LAS u32x4*)(Vl + 64 * KP + soff) = vreg1;
    if (tid < 32) *(LAS f32x4*)(Fl + tid * 4) = freg;
    __syncthreads();
    for (int t = 0; t < NT; ++t) {
        const int buf = t & 1;
        if (t + 1 < NT) {
            const size_t go = (size_t)(t + 1) * 128 * AW;
            kreg0 = *(const u32x4*)(kg + go); kreg1 = *(const u32x4*)(kg + go + (size_t)64 * AW); vreg0 = *(const u32x4*)(vg + go); vreg1 = *(const u32x4*)(vg + go + (size_t)64 * AW);
            if (tid < 32) freg = *(const f32x4*)(Fh + (t + 1) * 128 + tid * 4);
        }
#pragma unroll
        for (int sub = 0; sub < 2; ++sub) {
            const int key0 = t * 128 + sub * 64;
            if (key0 <= Qw)
                attn_tile64(Kl + buf * TB + sub * 64 * KP, Vl + buf * TB + sub * 64 * KP, Fl + buf * 128 + sub * 64, key0, Qw, key0 + 63 > Qw, qf, fq, fqm, mrun, lrun, o, l16, quad);
        }
        if (t + 1 < NT) {
            const int nb = buf ^ 1;
            *(LAS u32x4*)(Kl + nb * TB + soff) = kreg0; *(LAS u32x4*)(Kl + nb * TB + 64 * KP + soff) = kreg1;
            *(LAS u32x4*)(Vl + nb * TB + soff) = vreg0; *(LAS u32x4*)(Vl + nb * TB + 64 * KP + soff) = vreg1;
            if (tid < 32) *(LAS f32x4*)(Fl + nb * 128 + tid * 4) = freg;
        }
        __syncthreads();
    }
#pragma unroll
    for (int qt = 0; qt < 2; ++qt) {
        float lt = lrun[qt]; lt += __shfl_xor(lt, 16); lt += __shfl_xor(lt, 32);
        const float il = 1.0f / lt;
        bf16_t* op = mix + (rowbase + Qw + 16 * qt + l16) * D + PW + h * HD + 4 * quad;
#pragma unroll
        for (int dt = 0; dt < 4; ++dt) {
            u32x2 w; w.x = pk2(o[dt][qt][0] * il, o[dt][qt][1] * il); w.y = pk2(o[dt][qt][2] * il, o[dt][qt][3] * il);
            *(u32x2*)(op + 16 * dt) = w;
        }
    }
}


namespace fa {
using f32x16 = __attribute__((ext_vector_type(16))) float;
constexpr int SEQ = T, DH = 64, DM = AW;
constexpr int NW = 8, QBLK = 32, QB = QBLK * NW, KVBLK = 64;
__device__ __forceinline__ int crow(int r, int hi) { return (r & 3) + 8 * (r >> 2) + 4 * hi; }
#define SBAR() __builtin_amdgcn_sched_barrier(0)
__device__ __forceinline__ void cmask(f32x16& p0, f32x16& p1, int jb, int qrel, int hi) {
    const float NEG = -INFINITY; int kb = 64 * jb + 4 * hi;
#pragma unroll
    for (int r = 0; r < 16; ++r) { int kv = kb + (r & 3) + 8 * (r >> 2); if (kv > qrel) p0[r] = NEG; if (kv + 32 > qrel) p1[r] = NEG; }
}
constexpr int NSLOT = 3, SLOTB = 8192;
constexpr int LDS_K = 0, LDS_V = NSLOT * SLOTB, LDS_WS = 2 * NSLOT * SLOTB, LDS_OST = LDS_WS + NW * 64 * 4, LDS_FK = LDS_OST + NW * 4096, LDS_END = LDS_FK + SEQ * 4;
__device__ __forceinline__ void glds16(const void* gsrc, unsigned lds_dst) { unsigned keep;
    asm volatile("s_mov_b32 %0, m0\n\ts_mov_b32 m0, %2\n\ts_nop 0\n\tglobal_load_lds_dwordx4 %1, off\n\ts_mov_b32 m0, %0" : "=&s"(keep) : "v"(gsrc), "s"(lds_dst) : "memory"); }
__device__ __forceinline__ float max3f(float a, float b, float c) { float r; asm("v_max3_f32 %0, %1, %2, %3" : "=v"(r) : "v"(a), "v"(b), "v"(c)); return r; }
__device__ __forceinline__ float max2f(float a, float b) { float r; asm("v_max_f32_e32 %0, %1, %2" : "=v"(r) : "v"(a), "v"(b)); return r; }
__device__ __forceinline__ float fadd_s(float a, float b) { float r; asm("v_add_f32_e32 %0, %1, %2" : "=v"(r) : "v"(a), "v"(b)); return r; }
__device__ __forceinline__ float fsub_s(float a, float b) { float r; asm("v_sub_f32_e32 %0, %1, %2" : "=v"(r) : "v"(a), "v"(b)); return r; }
__device__ __forceinline__ unsigned cvtpk_s(float lo, float hi) { return pk2(lo, hi); }
#define WAIT_BAR(N) asm volatile("s_waitcnt vmcnt(" #N ") lgkmcnt(0)\n\ts_barrier" ::: "memory")
typedef __attribute__((address_space(3))) const char* lds_cptr;
__device__ __forceinline__ void bias_half(f32x16& c, lds_cptr fkt, float cq, int hi) {
#pragma unroll
    for (int g = 0; g < 4; ++g) {
        const f32x4 a = *(const LAS f32x4*)(fkt + (8 * g + 4 * hi) * 4);
#pragma unroll
        for (int j = 0; j < 4; ++j) c[4 * g + j] = cq - a[j];
    }
}
__device__ __forceinline__ void bias_init(f32x16& c0, f32x16& c1, lds_cptr fkt, float cq, int hi) {
#pragma unroll
    for (int g = 0; g < 4; ++g) {
        const f32x4 a = *(const LAS f32x4*)(fkt + (8 * g + 4 * hi) * 4), b = *(const LAS f32x4*)(fkt + (32 + 8 * g + 4 * hi) * 4);
#pragma unroll
        for (int j = 0; j < 4; ++j) { c0[4 * g + j] = cq - a[j]; c1[4 * g + j] = cq - b[j]; }
    }
}
__device__ __forceinline__ void qkt(f32x16& p0, f32x16& p1, const char* Kslot, const bf16x8* qr, int r32, int hi) {
    const char* kb = Kslot + hi * 1024 + r32 * 16;
#pragma unroll
    for (int d0 = 0; d0 < 4; ++d0) {
        const bf16x8 b0 = *reinterpret_cast<const bf16x8*>(kb + d0 * 2048);
        const bf16x8 b1 = *reinterpret_cast<const bf16x8*>(kb + d0 * 2048 + 512);
        p0 = __builtin_amdgcn_mfma_f32_32x32x16_bf16(b0, qr[d0], p0, 0, 0, 0); p1 = __builtin_amdgcn_mfma_f32_32x32x16_bf16(b1, qr[d0], p1, 0, 0, 0); }
}
__device__ __forceinline__ void kload8(bf16x8* kf, lds_cptr kp) {
    kf[0] = *(const LAS bf16x8*)(kp);        kf[1] = *(const LAS bf16x8*)(kp + 512);
    kf[2] = *(const LAS bf16x8*)(kp + 2048); kf[3] = *(const LAS bf16x8*)(kp + 2560);
    kf[4] = *(const LAS bf16x8*)(kp + 4096); kf[5] = *(const LAS bf16x8*)(kp + 4608);
    kf[6] = *(const LAS bf16x8*)(kp + 6144); kf[7] = *(const LAS bf16x8*)(kp + 6656);
}
__device__ __forceinline__ void kload2(bf16x8* kf, lds_cptr kp, int j) { kf[2 * j] = *(const LAS bf16x8*)(kp + j * 2048); kf[2 * j + 1] = *(const LAS bf16x8*)(kp + j * 2048 + 512); }
__device__ __forceinline__ s16x4 vtr2(lds_cptr p) { return __builtin_bit_cast(s16x4, __builtin_amdgcn_ds_read_tr16_b64_v4i16((LAS s16x4*)p)); }
__device__ __forceinline__ float rowmax(const f32x16& p0, const f32x16& p1) {
    float a = max3f(p0[0], p0[1], p1[0]), b = max3f(p0[2], p0[3], p1[1]); a = max3f(a, p1[2], p1[3]);
#pragma unroll
    for (int r = 4; r < 16; r += 4) { a = max3f(a, p0[r], p0[r + 1]); b = max3f(b, p0[r + 2], p0[r + 3]); a = max3f(a, p1[r], p1[r + 1]); b = max3f(b, p1[r + 2], p1[r + 3]); }
    const float m = max2f(a, b);
    auto rr = __builtin_amdgcn_permlane32_swap(__float_as_uint(m), __float_as_uint(m), false, false);
    return max2f(__uint_as_float(rr[0]), __uint_as_float(rr[1]));
}
__device__ __forceinline__ void pv(f32x16* o, int vb, bf16x8 pa0, bf16x8 pa1, bf16x8 pa2, bf16x8 pa3) {
#pragma unroll
    for (int d0 = 0; d0 < 2; ++d0) { s16x4 lo[4], hi[4];
#pragma unroll
        for (int ks = 0; ks < 4; ++ks) {
            asm volatile("ds_read_b64_tr_b16 %0,%1 offset:%c2" : "=&v"(lo[ks]) : "v"(vb), "i"(d0 * 4096 + ks * 1024) : "memory");
            asm volatile("ds_read_b64_tr_b16 %0,%1 offset:%c2" : "=&v"(hi[ks]) : "v"(vb), "i"(d0 * 4096 + ks * 1024 + 512) : "memory"); }
        asm volatile("s_waitcnt lgkmcnt(0)" ::: "memory"); SBAR();
#define PK(k) (bf16x8){lo[k][0], lo[k][1], lo[k][2], lo[k][3], hi[k][0], hi[k][1], hi[k][2], hi[k][3]}
        o[d0] = __builtin_amdgcn_mfma_f32_32x32x16_bf16(pa0, PK(0), o[d0], 0, 0, 0);
        o[d0] = __builtin_amdgcn_mfma_f32_32x32x16_bf16(pa1, PK(1), o[d0], 0, 0, 0);
        o[d0] = __builtin_amdgcn_mfma_f32_32x32x16_bf16(pa2, PK(2), o[d0], 0, 0, 0);
        o[d0] = __builtin_amdgcn_mfma_f32_32x32x16_bf16(pa3, PK(3), o[d0], 0, 0, 0);
#undef PK
    }
}

template <int THRL> __device__ __forceinline__ void attn_unit(int b, int h, int qb, const bf16_t* Q, const bf16_t* __restrict__ K, const bf16_t* __restrict__ V, const float* F2, bf16_t* mix, char* shm, const int tid, const int t0) {
    const int lane = tid & 63, r32 = lane & 31, hi = lane >> 5; const int wid = __builtin_amdgcn_readfirstlane(tid >> 6);
    const long rowbase = (long)b * SEQ; const int q0 = qb * QB;
    const bf16_t* Qw = Q + (rowbase + q0 + wid * QBLK) * DM + h * DH;
    const bf16_t* Kh = K + (rowbase + t0 * KVBLK) * DM + h * DH, *Vh = V + (rowbase + t0 * KVBLK) * DM + h * DH;
    const float* Fh = F2 + (long)(b * NH + h) * SEQ;
    const unsigned lds0 = (unsigned)(uintptr_t)shm;
    float* wsf = (float*)(shm + LDS_WS) + wid * 64;
    const bf16_t* ksrc = Kh + (long)lane * DM + wid * 8;
    const bf16_t* vsrc = Vh + (long)(16 * (wid & 3) + (lane >> 2)) * DM + (wid >> 2) * 32 + (lane & 3) * 8;
    const unsigned kdst = lds0 + LDS_K + wid * 1024, vdst = lds0 + LDS_V + wid * 1024;
#define DMA_K(t, slot) glds16(ksrc + (long)(t) * KVBLK * DM, (unsigned)__builtin_amdgcn_readfirstlane(kdst + (slot)))
#define DMA_V(t, slot) glds16(vsrc + (long)(t) * KVBLK * DM, (unsigned)__builtin_amdgcn_readfirstlane(vdst + (slot)))
    const int vb0 = (int)(lds0 + LDS_V) + ((lane >> 4) & 1) * 32 + (lane & 3) * 8 + (4 * hi + ((lane & 15) >> 2)) * 64;
    const char* Kbase = shm + LDS_K; bf16x8 kf[8];
    const lds_cptr shm3 = (lds_cptr)shm; const lds_cptr kp0 = shm3 + LDS_K + hi * 1024 + r32 * 16; const lds_cptr vp0 = shm3 + LDS_V + ((lane >> 4) & 1) * 32 + (lane & 3) * 8 + (4 * hi + ((lane & 15) >> 2)) * 64;
    const lds_cptr fk0 = shm3 + LDS_FK;
    const int NT = (q0 + QB) / KVBLK - t0;
    DMA_K(0, 0); DMA_V(0, 0); DMA_K(1, SLOTB);
    { float* fl = (float*)(shm + LDS_FK); for (int i = t0 * KVBLK + tid * 4; i < q0 + QB; i += 2048) *(f32x4*)(fl + i - t0 * KVBLK) = *(const f32x4*)(Fh + i); }
    const float fq = Fh[q0 + wid * QBLK + r32];
    bf16x8 qr[4];
#pragma unroll
    for (int d0 = 0; d0 < 4; ++d0) qr[d0] = *reinterpret_cast<const bf16x8*>(&Qw[(long)r32 * DM + d0 * 16 + hi * 8]);
    float mhat = 0.f, l_reg = 0.f, cq = fq; f32x16 o[2]; o[0] = f32x16{}; o[1] = f32x16{};
    const int qrel = wid * QBLK + r32;
#define CMASK(P0, P1, t) do { int jb_ = (t) - (NT - 4); if (jb_ >= 0) cmask(P0, P1, jb_, qrel, hi); } while (0)
    bool resc = false;
#define START(P0, P1) do { const float rm = rowmax(P0, P1); resc = false; \
    { const float dl = rm; mhat = fadd_s(mhat, dl); \
      _Pragma("unroll") for (int r = 0; r < 16; ++r) { P0[r] = fsub_s(P0[r], dl); P1[r] = fsub_s(P1[r], dl); } \
      cq = fq - mhat; } \
    _Pragma("unroll") for (int r = 0; r < 16; ++r) P0[r] = __builtin_amdgcn_exp2f(P0[r]); } while (0)
#define RESC() do { if (resc) { asm volatile("s_waitcnt lgkmcnt(0)" ::: "memory"); \
      _Pragma("unroll") for (int d_ = 0; d_ < 2; ++d_) _Pragma("unroll") for (int r = 0; r < 16; ++r) o[d_][r] *= wsf[crow(r, hi)]; } } while (0)
    f32x16 pA0, pA1, pB0, pB1;
    int sl_prev = 0, sl_cur = 0, sl_next = SLOTB;
#define ROT() do { sl_prev = sl_cur; sl_cur = sl_next; sl_next = (sl_next == (NSLOT - 1) * SLOTB) ? 0 : sl_next + SLOTB; } while (0)
    DMA_K(2, 2 * SLOTB);
    WAIT_BAR(3);
    bias_init(pA0, pA1, fk0, cq, hi);
    qkt(pA0, pA1, Kbase, qr, r32, hi); asm volatile("s_nop 15\n\ts_nop 7" : "+v"(pA0), "+v"(pA1)); CMASK(pA0, pA1, 0);
    START(pA0, pA1);
    _Pragma("unroll") for (int r = 0; r < 16; ++r) pA1[r] = __builtin_amdgcn_exp2f(pA1[r]);
    WAIT_BAR(0);
    DMA_K(3, 0); DMA_V(1, SLOTB);
    ROT();
    kload8(kf, kp0 + sl_cur);
    WAIT_BAR(2);
    s16x4 vlo[8], vhi[8]; u32x4 pw0, pw1, pw2, pw3;
#define PKW(P, B) cvtpk_s(P[B], P[B + 1])
#define PAF(k) __builtin_bit_cast(bf16x8, pw##k)
#define VFR(i) (bf16x8){vlo[i][0], vlo[i][1], vlo[i][2], vlo[i][3], vhi[i][0], vhi[i][1], vhi[i][2], vhi[i][3]}
#define PIN(x) asm volatile("" : "+v"(x))
#define MX3(a, b, c) __builtin_fmaxf(__builtin_fmaxf((a), (b)), (c))
#define GAPA(MF, A0, A1, A2, A3, W0, W1, PW) do { MF; sacc += A0; sacc += A1; sacc += A2; sacc += A3; PIN(sacc); W0; W1; PIN(PW); SBAR(); } while (0)
#define EX(v) __builtin_amdgcn_exp2f(v)
#define GAPB(MF, X, B) do { MF; X[B] = EX(X[B]); X[B + 1] = EX(X[B + 1]); X[B + 2] = EX(X[B + 2]); X[B + 3] = EX(X[B + 3]); PIN(X); SBAR(); } while (0)
#define VRD(i) do { vlo[i] = vtr2(vp_ + (((i) >> 2) * 4096 + ((i) & 3) * 1024)); vhi[i] = vtr2(vp_ + (((i) >> 2) * 4096 + ((i) & 3) * 1024 + 512)); } while (0)
#define KRD(G, j) do { if (G) { kload2(kf, kp0 + sl_next, j); SBAR(); } } while (0)
#define STEP(C0, C1, P0, P1, t, GK, GV, GL) do { SBAR(); \
    bias_half(C0, fk0 + (t) * 256, cq, hi); SBAR(); \
    const lds_cptr vp_ = vp0 + sl_prev; \
    VRD(0); SBAR(); float sacc = (P0[0] + P0[1]); \
    GAPA(C0 = __builtin_amdgcn_mfma_f32_32x32x16_bf16(kf[0], qr[0], C0, 0, 0, 0), P0[2], P0[3], P0[4], P0[5],     pw0[0] = PKW(P0, 0), pw0[1] = PKW(P0, 2), pw0); \
    bias_half(C1, fk0 + (t) * 256 + 128, cq, hi); SBAR(); \
    VRD(4); SBAR(); GAPA(C1 = __builtin_amdgcn_mfma_f32_32x32x16_bf16(kf[1], qr[0], C1, 0, 0, 0), P0[6], P0[7], P0[8], P0[9],     pw0[2] = PKW(P0, 4), pw0[3] = PKW(P0, 6), pw0); \
    VRD(1); SBAR(); GAPA(C0 = __builtin_amdgcn_mfma_f32_32x32x16_bf16(kf[2], qr[1], C0, 0, 0, 0),   P0[10], P0[11], P0[12], P0[13], pw1[0] = PKW(P0, 8), pw1[1] = PKW(P0, 10), pw1); \
    VRD(5); SBAR(); GAPA(C1 = __builtin_amdgcn_mfma_f32_32x32x16_bf16(kf[3], qr[1], C1, 0, 0, 0),   P0[14], P0[15], P1[0], P1[1],   pw1[2] = PKW(P0, 12), pw1[3] = PKW(P0, 14), pw1); \
    VRD(2); SBAR(); GAPA(C0 = __builtin_amdgcn_mfma_f32_32x32x16_bf16(kf[4], qr[2], C0, 0, 0, 0),   P1[2], P1[3], P1[4], P1[5],     pw2[0] = PKW(P1, 0), pw2[1] = PKW(P1, 2), pw2); \
    VRD(6); SBAR(); GAPA(C1 = __builtin_amdgcn_mfma_f32_32x32x16_bf16(kf[5], qr[2], C1, 0, 0, 0),   P1[6], P1[7], P1[8], P1[9],     pw2[2] = PKW(P1, 4), pw2[3] = PKW(P1, 6), pw2); \
    VRD(3); SBAR(); GAPA(C0 = __builtin_amdgcn_mfma_f32_32x32x16_bf16(kf[6], qr[3], C0, 0, 0, 0),   P1[10], P1[11], P1[12], P1[13], pw3[0] = PKW(P1, 8), pw3[1] = PKW(P1, 10), pw3); \
    VRD(7); SBAR(); GAPA(C1 = __builtin_amdgcn_mfma_f32_32x32x16_bf16(kf[7], qr[3], C1, 0, 0, 0),   P1[14], P1[15], 0.f, 0.f,       pw3[2] = PKW(P1, 12), pw3[3] = PKW(P1, 14), pw3); \
    l_reg += sacc; \
    if (GK) { DMA_K((t) + 3, sl_cur); } if (GV) { DMA_V((t) + 1, sl_next); } \
    CMASK(C0, C1, t); \
    { float a = MX3(C0[0], C0[1], C1[0]), b = MX3(C0[2], C0[3], C1[1]); a = MX3(a, C1[2], C1[3]); \
      _Pragma("unroll") for (int r = 4; r < 16; r += 4) { a = MX3(a, C0[r], C0[r + 1]); b = MX3(b, C0[r + 2], C0[r + 3]); a = MX3(a, C1[r], C1[r + 1]); b = MX3(b, C1[r + 2], C1[r + 3]); } \
      float rm = __builtin_fmaxf(a, b); { auto rr = __builtin_amdgcn_permlane32_swap(__float_as_uint(rm), __float_as_uint(rm), false, false); rm = __builtin_fmaxf(__uint_as_float(rr[0]), __uint_as_float(rr[1])); } \
      resc = false; \
      if (__builtin_expect(__any(rm > (float)THRL), 0)) { const float dl = __builtin_fmaxf(rm, 0.f); mhat += dl; \
        _Pragma("unroll") for (int r = 0; r < 16; ++r) { C0[r] -= dl; C1[r] -= dl; } \
        cq = fq - mhat; \
        const float f = __builtin_amdgcn_exp2f(-dl); l_reg *= f; if (hi == 0) wsf[r32] = f; resc = true; } } \
    SBAR(); \
    GAPB(o[0] = __builtin_amdgcn_mfma_f32_32x32x16_bf16(PAF(0), VFR(0), o[0], 0, 0, 0), C0, 0); \
    GAPB(o[1] = __builtin_amdgcn_mfma_f32_32x32x16_bf16(PAF(0), VFR(4), o[1], 0, 0, 0), C0, 4); \
    KRD(GL, 0); GAPB(o[0] = __builtin_amdgcn_mfma_f32_32x32x16_bf16(PAF(1), VFR(1), o[0], 0, 0, 0), C0, 8); \
    KRD(GL, 1); GAPB(o[1] = __builtin_amdgcn_mfma_f32_32x32x16_bf16(PAF(1), VFR(5), o[1], 0, 0, 0), C0, 12); \
    KRD(GL, 2); GAPB(o[0] = __builtin_amdgcn_mfma_f32_32x32x16_bf16(PAF(2), VFR(2), o[0], 0, 0, 0), C1, 0); \
    KRD(GL, 3); GAPB(o[1] = __builtin_amdgcn_mfma_f32_32x32x16_bf16(PAF(2), VFR(6), o[1], 0, 0, 0), C1, 4); \
    GAPB(o[0] = __builtin_amdgcn_mfma_f32_32x32x16_bf16(PAF(3), VFR(3), o[0], 0, 0, 0), C1, 8); \
    GAPB(o[1] = __builtin_amdgcn_mfma_f32_32x32x16_bf16(PAF(3), VFR(7), o[1], 0, 0, 0), C1, 12); \
    } while (0)
    int t = 1;
#undef CMASK
#define CMASK(P0, P1, t) do { } while (0)
    for (; t + 5 < NT; t += 2) {
        STEP(pB0, pB1, pA0, pA1, t, true, true, true);     WAIT_BAR(2); RESC(); ROT();
        STEP(pA0, pA1, pB0, pB1, t + 1, true, true, true); WAIT_BAR(2); RESC(); ROT();
    }
#undef CMASK
#define CMASK(P0, P1, t) do { int jb_ = (t) - (NT - 4); if (jb_ >= 0) cmask(P0, P1, jb_, qrel, hi); } while (0)
#define ENDW(tt) do { if ((tt) + 3 < NT) { WAIT_BAR(2); } else if ((tt) + 2 < NT) { WAIT_BAR(1); } else { WAIT_BAR(0); } } while (0)
    for (; t + 1 < NT; t += 2) {
        STEP(pB0, pB1, pA0, pA1, t, (t + 3 < NT), (t + 1 < NT), (t + 1 < NT));       ENDW(t);     RESC(); ROT();
        STEP(pA0, pA1, pB0, pB1, t + 1, (t + 4 < NT), (t + 2 < NT), (t + 2 < NT)); ENDW(t + 1); RESC(); ROT();
    }
    STEP(pB0, pB1, pA0, pA1, NT - 1, false, false, false); RESC();
    { float sacc = pB0[0] + pB0[1]; _Pragma("unroll") for (int r = 2; r < 16; ++r) sacc += pB0[r]; _Pragma("unroll") for (int r = 0; r < 16; ++r) sacc += pB1[r]; l_reg += sacc;
      pw0 = (u32x4){PKW(pB0, 0), PKW(pB0, 2), PKW(pB0, 4), PKW(pB0, 6)}; pw1 = (u32x4){PKW(pB0, 8), PKW(pB0, 10), PKW(pB0, 12), PKW(pB0, 14)}; pw2 = (u32x4){PKW(pB1, 0), PKW(pB1, 2), PKW(pB1, 4), PKW(pB1, 6)}; pw3 = (u32x4){PKW(pB1, 8), PKW(pB1, 10), PKW(pB1, 12), PKW(pB1, 14)};
      SBAR(); pv(o, vb0 + sl_cur, PAF(0), PAF(1), PAF(2), PAF(3)); }
#undef PKW
#undef PAF
#undef VFR
#undef PIN
#undef MX3
#undef GAPA
#undef GAPB
#undef EX
#undef VRD
#undef KRD
#undef STEP
#undef ENDW
    { auto rr = __builtin_amdgcn_permlane32_swap(__float_as_uint(l_reg), __float_as_uint(l_reg), false, false); l_reg = __uint_as_float(rr[0]) + __uint_as_float(rr[1]); }
    if (hi == 0) wsf[32 + r32] = l_reg; asm volatile("s_waitcnt lgkmcnt(0)" ::: "memory");
    float rli[16];
#pragma unroll
    for (int r = 0; r < 16; ++r) rli[r] = __builtin_amdgcn_rcpf(wsf[32 + crow(r, hi)]);
    bf16_t* Ow = mix + (rowbase + q0 + wid * QBLK) * D + PW + h * DH;
    { bf16_t* stg = (bf16_t*)(shm + LDS_OST) + wid * 2048;
#pragma unroll
      for (int r = 0; r < 16; ++r) { const int orow = crow(r, hi);
#pragma unroll
        for (int d0 = 0; d0 < 2; ++d0) stg[orow * 64 + d0 * 32 + r32] = (bf16_t)f2bf(o[d0][r] * rli[r]); }
      asm volatile("s_waitcnt lgkmcnt(0)" ::: "memory");
#pragma unroll
      for (int i = 0; i < 4; ++i) { const int row = i * 8 + (lane >> 3), ch = lane & 7; const u32x4 v = *(const u32x4*)(stg + row * 64 + ch * 8); *(u32x4*)(Ow + (long)row * D + ch * 8) = v; } }
    asm volatile("s_waitcnt lgkmcnt(0)\n\ts_barrier" ::: "memory");
#undef DMA_K
#undef DMA_V
#undef CMASK
#undef START
#undef RESC
#undef ROT
}
#undef SBAR
#undef WAIT_BAR
}

__device__ __forceinline__ void attn_sample_unit(int l, int b, int h, const Params& p, LAS unsigned char* lds, int tid, int lane, int wave, float thr) {
    const int l16 = lane & 15, quad = lane >> 4;
    const bf16_t* Q = (const bf16_t*)(p.ws + WS_Q); const bf16_t* Kb = (const bf16_t*)(p.ws + WS_K); const bf16_t* Vb = (const bf16_t*)(p.ws + WS_V);
    bf16_t* mix = (bf16_t*)(p.ws + WS_MIX);
    const size_t row0 = (size_t)MP + b * ST;
    const float* Fh = (const float*)(p.ws + WS_FS) + (size_t)(b * NH + h) * SKEYS;
    bf16x8 qf[2];
#pragma unroll
    for (int ks = 0; ks < 2; ++ks) qf[ks] = *(const bf16x8*)(Q + (row0 + l16) * AW + h * HD + 32 * ks + 8 * quad);
    const float fq = Fh[PAST + l16];
    f32x4 o[4];
#pragma unroll
    for (int dt = 0; dt < 4; ++dt) o[dt] = (f32x4){0.f, 0.f, 0.f, 0.f};
    float mrun = -INFINITY, lrun = 0.f;
    const float* Kc = p.in[4] + ((size_t)(l * SB + b) * PAST) * AW + h * HD;
    const float* Vc = p.in[5] + ((size_t)(l * SB + b) * PAST) * AW + h * HD;
    LAS unsigned char* Vw = lds + wave * (64 * KP);
    f32x4 rk[2][2][2], rv[8], rf[2];
#define SAMPLE_LOAD(key0_) do { \
        _Pragma("unroll") for (int kt = 0; kt < 2; ++kt) _Pragma("unroll") for (int ks = 0; ks < 2; ++ks) { \
            const float* kp = Kc + (size_t)((key0_) + 16 * kt + l16) * AW + 32 * ks + 8 * quad; rk[kt][ks][0] = __builtin_nontemporal_load((const f32x4*)kp); rk[kt][ks][1] = __builtin_nontemporal_load((const f32x4*)(kp + 4)); } \
        _Pragma("unroll") for (int j = 0; j < 8; ++j) rv[j] = __builtin_nontemporal_load((const f32x4*)(Vc + (size_t)((key0_) + 4 * j + quad) * AW + 4 * l16)); \
        _Pragma("unroll") for (int kt = 0; kt < 2; ++kt) rf[kt] = *(const f32x4*)(Fh + (key0_) + 16 * kt + 4 * quad); } while (0)
    int ks;
    { const int j = lane & 15; const bool c = (j >= 1) && (Fh[256 * (j >= 1 ? j : 1) - 1] - Fh[PAST + vzero()] >= thr); ks = 256 * __popcll(__ballot(c && lane < 16)); }
    const int nst = (PAST - ks) >> 8;
    const int kbeg = ks + wave * nst * 32;
    SAMPLE_LOAD(kbeg);
    const int nsteps = nst + (wave == 7 ? 1 : 0);
    for (int step = 0; step < nsteps; ++step) {
        const bool isnew = step == nst;
        f32x4 s[2];
        bf16x8 kf[2][2];
        asm volatile("s_waitcnt lgkmcnt(0)" ::: "memory");
        if (!isnew) {
#pragma unroll
            for (int kt = 0; kt < 2; ++kt)
#pragma unroll
                for (int ks = 0; ks < 2; ++ks) {
                    const f32x4 a = rk[kt][ks][0], c = rk[kt][ks][1];
                    u32x4 w; w.x = pk2(a[0], a[1]); w.y = pk2(a[2], a[3]); w.z = pk2(c[0], c[1]); w.w = pk2(c[2], c[3]);
                    kf[kt][ks] = __builtin_bit_cast(bf16x8, w);
                }
#pragma unroll
            for (int j = 0; j < 8; ++j) {
                const int kr = 4 * j + quad;
                u32x2 w; w.x = pk2(rv[j][0], rv[j][1]); w.y = pk2(rv[j][2], rv[j][3]);
                *(LAS u32x2*)(Vw + kr * KP + 8 * l16) = w;
            }
#pragma unroll
            for (int kt = 0; kt < 2; ++kt) s[kt] = (f32x4){fq - rf[kt][0], fq - rf[kt][1], fq - rf[kt][2], fq - rf[kt][3]};
            if (step + 1 < nst) SAMPLE_LOAD(kbeg + (step + 1) * 32);
        } else {
#pragma unroll
            for (int ks = 0; ks < 2; ++ks) { kf[0][ks] = *(const bf16x8*)(Kb + (row0 + l16) * AW + h * HD + 32 * ks + 8 * quad); kf[1][ks] = (bf16x8){0, 0, 0, 0, 0, 0, 0, 0}; }
            {
                const int kr = lane >> 2, ch = lane & 3;
                const u32x4 a = *(const u32x4*)(Vb + (row0 + kr) * AW + h * HD + 16 * ch), c = *(const u32x4*)(Vb + (row0 + kr) * AW + h * HD + 16 * ch + 8);
                *(LAS u32x4*)(Vw + kr * KP + 32 * ch) = a; *(LAS u32x4*)(Vw + kr * KP + 32 * ch + 16) = c;
                *(LAS u32x4*)(Vw + (16 + kr) * KP + 32 * ch) = (u32x4){0u, 0u, 0u, 0u}; *(LAS u32x4*)(Vw + (16 + kr) * KP + 32 * ch + 16) = (u32x4){0u, 0u, 0u, 0u};
            }
            const f32x4 fk = *(const f32x4*)(Fh + PAST + 4 * quad);
            s[0] = (f32x4){fq - fk[0], fq - fk[1], fq - fk[2], fq - fk[3]};
            s[1] = (f32x4){-INFINITY, -INFINITY, -INFINITY, -INFINITY};
        }
#pragma unroll
        for (int ks = 0; ks < 2; ++ks) {
            s[0] = __builtin_amdgcn_mfma_f32_16x16x32_bf16(kf[0][ks], qf[ks], s[0], 0, 0, 0);
            if (!isnew) s[1] = __builtin_amdgcn_mfma_f32_16x16x32_bf16(kf[1][ks], qf[ks], s[1], 0, 0, 0);
        }
        if (isnew) {
#pragma unroll
            for (int r = 0; r < 4; ++r) if (4 * quad + r > l16) s[0][r] = -INFINITY;
        }
        float mx = fmaxf(fmaxf(s[0][0], s[0][1]), fmaxf(s[0][2], s[0][3]));
        mx = fmaxf(mx, fmaxf(fmaxf(s[1][0], s[1][1]), fmaxf(s[1][2], s[1][3])));
        mx = fmaxf(mx, __shfl_xor(mx, 16)); mx = fmaxf(mx, __shfl_xor(mx, 32));
        const float mnew = fmaxf(mrun, mx);
        const float alpha = __builtin_amdgcn_exp2f(mrun - mnew);
        mrun = mnew;
        float ps = 0.f;
#pragma unroll
        for (int kt = 0; kt < 2; ++kt)
#pragma unroll
            for (int r = 0; r < 4; ++r) { const float e = __builtin_amdgcn_exp2f(s[kt][r] - mnew); s[kt][r] = e; ps += e; }
        lrun = lrun * alpha + ps;
        u32x4 w; w.x = pk2(s[0][0], s[0][1]); w.y = pk2(s[0][2], s[0][3]); w.z = pk2(s[1][0], s[1][1]); w.w = pk2(s[1][2], s[1][3]);
        const bf16x8 pb = __builtin_bit_cast(bf16x8, w);
        asm volatile("s_waitcnt lgkmcnt(0)" ::: "memory");
        const LAS unsigned char* vb0 = Vw + (4 * quad + (l16 >> 2)) * KP + 8 * (l16 & 3);
#pragma unroll
        for (int dt = 0; dt < 4; ++dt) {
            const s16x4 a0 = vtr(vb0 + 32 * dt), a1 = vtr(vb0 + 16 * KP + 32 * dt);
            const bf16x8 vf = (bf16x8){a0[0], a0[1], a0[2], a0[3], a1[0], a1[1], a1[2], a1[3]};
            o[dt] = o[dt] * alpha;
            o[dt] = __builtin_amdgcn_mfma_f32_16x16x32_bf16(vf, pb, o[dt], 0, 0, 0);
        }
    }
#undef SAMPLE_LOAD
    float lt = lrun; lt += __shfl_xor(lt, 16); lt += __shfl_xor(lt, 32);
    LAS float* cm = (LAS float*)(lds + 8 * 64 * KP);
    LAS float* cl = cm + 128; LAS float* co = cl + 128;
    if (quad == 0) { cm[wave * 16 + l16] = mrun; cl[wave * 16 + l16] = lt; }
#pragma unroll
    for (int dt = 0; dt < 4; ++dt)
#pragma unroll
        for (int r = 0; r < 4; ++r) co[(wave * 16 + l16) * 64 + 16 * dt + 4 * quad + r] = o[dt][r];
    __syncthreads();
    {
        const int q = tid >> 5, d0 = (tid & 31) * 2;
        float mm = cm[q];
#pragma unroll
        for (int w = 1; w < 8; ++w) mm = fmaxf(mm, cm[w * 16 + q]);
        float L = 0.f, a0 = 0.f, a1 = 0.f;
#pragma unroll
        for (int w = 0; w < 8; ++w) { const float f = __builtin_amdgcn_exp2f(cm[w * 16 + q] - mm); L += cl[w * 16 + q] * f; a0 += co[(w * 16 + q) * 64 + d0] * f; a1 += co[(w * 16 + q) * 64 + d0 + 1] * f; }
        const float il = 1.0f / L;
        *(unsigned*)(mix + (row0 + q) * D + PW + h * HD + d0) = pk2(a0 * il, a1 * il);
    }
    __syncthreads();
}

__device__ __forceinline__ void phase_attn(const Params& p, LAS unsigned char* lds, int l, int ci, int mode, int tid, int lane, int wave) {
    unsigned* ctr = (unsigned*)(p.ws + WS_CTL) + 64 * ci;
    LAS unsigned* slot = (LAS unsigned*)(lds + LDS_BYTES - 64);
    char* lds_generic = (char*)lds;
    const bf16_t* Q = (const bf16_t*)(p.ws + WS_Q); const bf16_t* Kb = (const bf16_t*)(p.ws + WS_K); const bf16_t* Vb = (const bf16_t*)(p.ws + WS_V);
    const float* Fp = (const float*)(p.ws + WS_FP); bf16_t* mix = (bf16_t*)(p.ws + WS_MIX);
    float thr;
    {
        const float gq = fabsf(p.in[12][l * HD + lane]), gk = fabsf(p.in[13][l * HD + lane]);
        float mq = gq, mk = gk;
#pragma unroll
        for (int o = 1; o < 64; o <<= 1) { mq = fmaxf(mq, __shfl_xor(mq, o)); mk = fmaxf(mk, __shfl_xor(mk, o)); }
        thr = 53.f + 2.f * (64.f * mq * mk * C2 + 0.5f);
    }
    LAS unsigned* cnt = (LAS unsigned*)lds;
    LAS unsigned* keys = (LAS unsigned*)(lds + 1024);
    LAS unsigned short* order = (LAS unsigned short*)(lds + fa::LDS_END);
    const float* Fs = (const float*)(p.ws + WS_FS);
    for (int i = tid; i < 216; i += 512) cnt[i] = 0u;
    if (tid < 160) { ((LAS unsigned*)(lds + 5120))[tid] = 0u; ((LAS unsigned*)(lds + 7168))[tid] = 0u; }
    __syncthreads();
    for (int i = tid; i < 24 * 124; i += 512) { const int bh = i / 124, j = i % 124 + 1; const float* Fh = Fp + (size_t)bh * T; if (Fh[64 * j - 1] - Fh[31 * 256] >= thr) atomicAdd((unsigned*)(cnt + bh), 1u); }
    for (int i = tid; i < 192 * 15; i += 512) { const int si = i / 15, j = i % 15 + 1; const float* Fh = Fs + (size_t)si * SKEYS; if (Fh[256 * j - 1] - Fh[PAST] >= thr) atomicAdd((unsigned*)(cnt + 24 + si), 1u); }
    __syncthreads();
    LAS unsigned* hist = (LAS unsigned*)(lds + 5120);
    LAS unsigned* bst = (LAS unsigned*)(lds + 6144);
    LAS unsigned* cur = (LAS unsigned*)(lds + 7168);
    LAS unsigned* tmp = (LAS unsigned*)(lds + 8192);
    unsigned kk[2];
#pragma unroll
    for (int e = 0; e < 2; ++e) {
        const int id = tid + 512 * e; unsigned key = 0u;
        if (id < 768) { const int bh = id >> 5, qb = id & 31, w = 124 - (int)(cnt[bh] & ~1u); int t0a = 4 * qb - w; t0a = t0a > 0 ? (t0a & ~1) : 0;
            key = ((unsigned)(4 * (qb + 1) - t0a + 3) << 10) | (unsigned)(1023 - id); }
        else if (id < 960) { const int nst = 16 - (int)cnt[24 + id - 768]; key = ((unsigned)(5 + (10 * nst) / 3) << 10) | (unsigned)(1023 - id); }
        kk[e] = key;
        if (id < 960) atomicAdd((unsigned*)(hist + (key >> 10)), 1u);
    }
    __syncthreads();
    if (tid < 160) { unsigned s = 0u; for (int b = tid + 1; b < 160; ++b) s += hist[b]; bst[tid] = s; }
    __syncthreads();
#pragma unroll
    for (int e = 0; e < 2; ++e) {
        const int id = tid + 512 * e;
        if (id < 960) { const unsigned c = kk[e] >> 10; const unsigned sl = atomicAdd((unsigned*)(cur + c), 1u); tmp[bst[c] + sl] = kk[e]; }
    }
    __syncthreads();
#pragma unroll
    for (int e = 0; e < 2; ++e) {
        const int id = tid + 512 * e;
        if (id < 960) { const unsigned c = kk[e] >> 10, beg = bst[c], n = hist[c]; unsigned g = 0u;
            for (unsigned j = 0; j < n; ++j) g += (tmp[beg + j] > kk[e]) ? 1u : 0u;
            order[beg + g] = (unsigned short)id; }
    }
    __syncthreads();
    for (;;) {
        if (tid == 0) *slot = atomicAdd(ctr, 1u);
        __syncthreads();
        const int idx = (int)*slot;
        __syncthreads();
        if (idx >= 960) break;
        const int id = (int)order[idx];
        const int tf = fresh_tid(), lf = tf & 63, wf = __builtin_amdgcn_readfirstlane(tf >> 6);
        if (id >= 768) { if (mode == 1) continue; const int si = id - 768; attn_sample_unit(l, si / NH, si % NH, p, lds, tf, lf, wf, thr); }
        else { if (mode == 2) continue; const int bh = id >> 5, qb = id & 31;
            int t0;
            { const float* Fh = Fp + (size_t)bh * T; const float f0 = Fh[qb * 256 + vzero()];
              const int ja = lf + 1, jb2 = lf + 65, jmax = 4 * qb;
              const bool ca = (ja <= jmax) && (Fh[64 * (ja <= jmax ? ja : 1) - 1] - f0 >= thr), cb = (jb2 <= jmax) && (Fh[64 * (jb2 <= jmax ? jb2 : 1) - 1] - f0 >= thr);
              t0 = (__popcll(__ballot(ca)) + __popcll(__ballot(cb))) & ~1; }
            fa::attn_unit<8>(bh / NH, bh % NH, qb, Q, Kb, Vb, Fp, mix, lds_generic, tf, t0);
        }
    }
    if (mode == 0) { const int tf = fresh_tid(); pool_items(p, lds, l, ctr + 8, slot, tf, tf & 63, __builtin_amdgcn_readfirstlane(tf >> 6)); }
}

#define XB_XCNT(j) (1024 + 64 * (j))
#define XB_XSUB(j) (2048 + 64 * (j))
#define XB_XGEN(j) (3072 + 64 * (j))
#define XB_TOP 4096
#define XB_TOPGEN 4160
__device__ __forceinline__ unsigned xb_ld(unsigned* p) { return __hip_atomic_load(p, __ATOMIC_RELAXED, __HIP_MEMORY_SCOPE_AGENT); }
__device__ __forceinline__ unsigned xb_add(unsigned* p, unsigned v) { return __hip_atomic_fetch_add(p, v, __ATOMIC_RELAXED, __HIP_MEMORY_SCOPE_AGENT); }
__device__ __forceinline__ unsigned xcc_id() { return (unsigned)__builtin_amdgcn_s_getreg((3 << 11) | 20) & 0xFu; }
__device__ __forceinline__ void grid_bar(unsigned* bar, volatile LAS unsigned* st) {
    asm volatile("s_waitcnt vmcnt(0)" ::: "memory");
    __syncthreads();
    if (threadIdx.x == 0) {
        __builtin_amdgcn_s_waitcnt(0);
        const unsigned x = xcc_id(), nloc = st[0], nx = st[1];
        const unsigned old = xb_add(&bar[XB_XSUB(x)], 1u);
        const unsigned gen = old / nloc;
        if (old + 1u == (gen + 1u) * nloc) {
            __builtin_amdgcn_fence(__ATOMIC_RELEASE, "agent");
            asm volatile("s_waitcnt vmcnt(0)" ::: "memory");
            const unsigned og = xb_add(&bar[XB_TOP], 1u);
            const unsigned tg = og / nx;
            if (og + 1u == (tg + 1u) * nx) xb_add(&bar[XB_TOPGEN], 1u);
            else { while (xb_ld(&bar[XB_TOPGEN]) == tg) __builtin_amdgcn_s_sleep(1); }
            __builtin_amdgcn_fence(__ATOMIC_ACQUIRE, "agent");
            xb_add(&bar[XB_XGEN(x)], 1u);
            asm volatile("s_waitcnt vmcnt(0)" ::: "memory");
        } else {
            while (xb_ld(&bar[XB_XGEN(x)]) == gen) __builtin_amdgcn_s_sleep(1);
            __builtin_amdgcn_fence(__ATOMIC_ACQUIRE, "agent");
            asm volatile("s_waitcnt vmcnt(0)" ::: "memory");
        }
    }
    __syncthreads();
}
#define FRESH_TID() fresh_tid()
#define TLW(t) (t), ((t) & 63), __builtin_amdgcn_readfirstlane((t) >> 6)
__global__ void __launch_bounds__(512, 2) fwd_megakernel(Params p) {
    extern __shared__ __attribute__((aligned(16))) unsigned char lds_raw[];
    LAS unsigned char* lds = (LAS unsigned char*)lds_raw;
    cg::grid_group grid = cg::this_grid();
    const int G = gridDim.x;

    unsigned* bar_w = (unsigned*)(p.ws + WS_CTL);
    if (threadIdx.x == 0) (void)xb_add(&bar_w[XB_XCNT(xcc_id())], 1u);
    { const int t_ = FRESH_TID(); phase_prologue(p, lds, TLW(t_)); }

#ifdef XSYNC
    for (int i = 0; i < XSYNC; ++i) grid.sync();
#endif
    volatile LAS unsigned* bar_st = (volatile LAS unsigned*)(lds + LDS_BYTES - 32);
    if (threadIdx.x == 0) {
        unsigned mine, cnt, sum; const unsigned x = xcc_id();
        for (;;) {
            mine = 0u; cnt = 0u; sum = 0u;
            for (unsigned j = 0; j < 16; ++j) { const unsigned c = xb_ld(&bar_w[XB_XCNT(j)]); sum += c; cnt += (c > 0u) ? 1u : 0u; mine = (j == x) ? c : mine; }
            if (sum == (unsigned)G) break;
            __builtin_amdgcn_s_sleep(1);
        }
        bar_st[0] = mine; bar_st[1] = cnt;
    }
    __syncthreads();
#define GB() grid_bar(bar_w, bar_st)
    if (G == 0x7fffffff) grid.sync();
    GB();
    float* xa = (float*)(p.ws + WS_XA); float* xb = (float*)(p.ws + WS_XB);
    bf16_t* hn = (bf16_t*)(p.ws + WS_HN);
    for (int l = 0; l < 2; ++l) {
        const float* xp = (l == 0) ? p.in[0] : xb; const float* xs = (l == 0) ? p.in[1] : xb + (size_t)MP * D;
        float* yp = (l == 0) ? xb : p.out; float* ys = yp + (size_t)MP * D;
        const float* modl = (const float*)(p.ws + WS_MOD) + (size_t)l * NMODROW * MODW;
        for (int rep = 0; rep < NREP(0); ++rep) {
            { const int t_ = FRESH_TID(); phase_norm(p, lds, l, 1, xp, xs, TLW(t_)); }
            GB();
        }
        for (int rep = 0; rep < NREP(1); ++rep) {
            pg8::Gemm g{hn, (const bf16_t*)(p.ws + WS_WIN) + (size_t)l * NMAIN * D, M, NMAIN, D};
            pg8::StaticOrder S; S.init(MP, NMAIN, G, (int)blockIdx.x);
            EpiIn E{l, p.out, (bf16_t*)(p.ws + WS_Q), (bf16_t*)(p.ws + WS_K), (bf16_t*)(p.ws + WS_V), (float*)(p.ws + WS_U), p.in[12] + l * HD, p.in[13] + l * HD};
            pg8::gemm_phase<EpiIn, true, true>(lds, g, S, E, FRESH_TID());
            { SEpiIn SE{l, p.out, (bf16_t*)(p.ws + WS_Q), (bf16_t*)(p.ws + WS_K), (bf16_t*)(p.ws + WS_V), (float*)(p.ws + WS_U), p.in[12] + l * HD, p.in[13] + l * HD};
              const int t_ = FRESH_TID(); skinny_phase<SEpiIn>(lds, g.A, g.Bt, NMAIN, D, SE, TLW(t_)); }
            { const int t_ = FRESH_TID(); scan_items(p, lds, l, TLW(t_)); }
            if (l == 0 && rep == 0) {
                for (int ll = 0; ll < 2; ++ll) { SEpiBias SE{(float*)(p.ws + WS_BIAS2) + (size_t)ll * NMODROW * FF}; const int t_ = FRESH_TID();
                    skinny_phase<SEpiBias>(lds, (const bf16_t*)(p.ws + WS_SH2) + (size_t)ll * 32 * D, (const bf16_t*)(p.ws + WS_WUP) + (size_t)ll * FF * D, FF, D, SE, TLW(t_), 0, 2); }
            }
            GB();
        }
        for (int rep = 0; rep < NREP(3); ++rep) {
            { const int t_ = FRESH_TID(); phase_attn(p, lds, l, l * 2 + rep, rep == 0 ? 0 : ATT_DUP_MODE, TLW(t_)); }
            GB();
        }
        for (int rep = 0; rep < NREP(4); ++rep) {
            pg8::Gemm g{(const bf16_t*)(p.ws + WS_MIX), (const bf16_t*)(p.ws + WS_WOUT) + (size_t)l * D * D, M, D, D};
            pg8::StaticOrder S; S.init(MP, D, G, (int)blockIdx.x);
            EpiResN E{xp, xa, modl + 2 * D, modl + 4 * D, hn, (float*)(p.ws + WS_SS)};
            pg8::gemm_phase<EpiResN, false, true>(lds, g, S, E, FRESH_TID());
            { SEpiResN SE{xs, xa + (size_t)MP * D, modl + 2 * D, modl + 4 * D, hn, (float*)(p.ws + WS_SS)}; const int t_ = FRESH_TID(); skinny_phase<SEpiResN>(lds, g.A, g.Bt, D, D, SE, TLW(t_)); }
            GB();
        }
        for (int rep = 0; rep < NREP(6); ++rep) {
            pg8::Gemm g{hn, (const bf16_t*)(p.ws + WS_WUP) + (size_t)l * FF * D, M, FF, D};
            pg8::StaticOrder S; S.init(MP, FF, G, (int)blockIdx.x);
            const float* bias_l = (const float*)(p.ws + WS_BIAS2) + (size_t)l * NMODROW * FF;
            EpiUpN E{(bf16_t*)(p.ws + WS_HID), (const float*)(p.ws + WS_SS), bias_l};
            pg8::gemm_phase<EpiUpN, true, true>(lds, g, S, E, FRESH_TID());
            { SEpiUpN SE{(bf16_t*)(p.ws + WS_HID), (const float*)(p.ws + WS_SS), bias_l}; const int t_ = FRESH_TID(); skinny_phase<SEpiUpN>(lds, g.A, g.Bt, FF, D, SE, TLW(t_)); }
            GB();
        }
        for (int rep = 0; rep < NREP(7); ++rep) {
            pg8::Gemm g{(const bf16_t*)(p.ws + WS_HID), (const bf16_t*)(p.ws + WS_WDN) + (size_t)l * D * FF, M, D, FF};
            pg8::StaticOrder S; S.init(MP, D, G, (int)blockIdx.x);
            EpiRes E{xa, xa + (size_t)MP * D, yp, ys, modl + 5 * D};
            pg8::gemm_phase<EpiRes, false, true>(lds, g, S, E, FRESH_TID());
            { SEpiRes SE{xa + (size_t)MP * D, ys, modl + 5 * D}; const int t_ = FRESH_TID(); skinny_phase<SEpiRes>(lds, g.A, g.Bt, D, FF, SE, TLW(t_)); }
            if (l == 0 || rep + 1 < NREP(7)) GB();
        }
    }
}

extern "C" void kernel_launch(void* const* d_in, const int* in_sizes, int n_in, void* d_out, int out_size, void* d_ws, size_t ws_size, hipStream_t stream) {
    static int grid = 0;
    if (grid == 0) {
        if (n_in != 19 || (size_t)out_size != OUT_TOTAL || ws_size < WS_END) { fprintf(stderr, "kernel_launch: unexpected shapes (n_in %d out %d ws %zu)\n", n_in, out_size, ws_size); grid = -1; return; }
        int dev = 0, cus = 0, per_cu = 0;
        hipGetDevice(&dev);
        hipDeviceGetAttribute(&cus, hipDeviceAttributeMultiprocessorCount, dev);
        hipFuncSetAttribute((const void*)fwd_megakernel, hipFuncAttributeMaxDynamicSharedMemorySize, LDS_BYTES);
        hipOccupancyMaxActiveBlocksPerMultiprocessor(&per_cu, (const void*)fwd_megakernel, 512, LDS_BYTES);
        if (per_cu < 1) { fprintf(stderr, "kernel_launch: occupancy query says %d blocks per CU\n", per_cu); per_cu = 1; }
        grid = cus;
    }
    if (grid < 0) return;
    hipMemsetAsync((char*)d_ws + WS_CTL, 0, 20480, stream);
    Params p{};
    for (int i = 0; i < 19; ++i) p.in[i] = (const float*)d_in[i];
    p.out = (float*)d_out; p.ws = (unsigned char*)d_ws;
    void* args[] = {&p};
    hipError_t e = hipLaunchCooperativeKernel((const void*)fwd_megakernel, dim3(grid), dim3(512), args, LDS_BYTES, stream);
    if (e != hipSuccess) fprintf(stderr, "cooperative launch failed: %s (grid %d)\n", hipGetErrorString(e), grid);
}
```
